# Optimizing an MI355X kernel written in HIP

```python
import jax, jax.numpy as jnp
from jax import lax
import numpy as np

D_MODEL = 1024
BATCH = 8
SEQ = 8192
DEPTH = 2

GRID_W = 64
CTX_LEN = 256
N_EVEN = (DEPTH + 1) // 2
N_ODD = DEPTH // 2
NORM_EPS = 1e-6

GLA_HEADS = 4
GLA_DK = 64
GLA_DV = 128
GLA_GATE_RANK = 16
GLA_GATE_NORM = 16.0
GLA_CHUNK = 64
GLA_QK = GLA_HEADS * GLA_DK
GLA_V = GLA_HEADS * GLA_DV
GLA_COLS = 2 * GLA_QK + 2 * GLA_V + GLA_GATE_RANK
GLA_SPLITS = [GLA_QK, 2 * GLA_QK, 2 * GLA_QK + GLA_V, 2 * GLA_QK + 2 * GLA_V]

RW_HEADS = 8
RW_HEAD = 64
RW_W = RW_HEADS * RW_HEAD
RW_DECAY_RANK = 64
RW_ICLR_RANK = 64
RW_GATE_RANK = 160
RW_GN_EPS = 64e-5
RW_COLS = 3 * RW_W + RW_DECAY_RANK + RW_ICLR_RANK + RW_GATE_RANK
RW_SPLITS = [RW_W, 2 * RW_W, 3 * RW_W, 3 * RW_W + RW_DECAY_RANK, 3 * RW_W + RW_DECAY_RANK + RW_ICLR_RANK]

EVEN_IN = GLA_COLS + RW_COLS
EVEN_MIX = GLA_V + RW_W

MLA_HEADS = 8
MLA_NOPE = 128
MLA_ROPE = 64
MLA_V = 128
MLA_Q_RANK = 256
MLA_KV_RANK = 128
ODD_IN = MLA_Q_RANK + MLA_KV_RANK + MLA_ROPE
MLA_SPLITS = [MLA_Q_RANK, MLA_Q_RANK + MLA_KV_RANK]
ROPE_THETA = 10000.0
Q_BLOCK = 128

N_EXPERTS = 32
TOP_K = 4
D_EXPERT = 1024
SWIGLU_LIMIT = 7.0
SWIGLU_ALPHA = 1.702
MOE_BLOCK = 256

kernel_name = 'hybrid_gla_rwkv7_mla_moe_dit'


def rms_norm(x, g, eps=NORM_EPS):
    xf = x.astype(jnp.float32)
    y = xf * lax.rsqrt(jnp.mean(xf * xf, axis=-1, keepdims=True) + eps)
    return (y * g.astype(jnp.float32)).astype(x.dtype)


def modulate(x, g, shift, scale):
    return rms_norm(x, g) * (1.0 + scale) + shift


def shift_mix(p, mu_prev, mu_next):
    zero = jnp.zeros_like(p[:, :1])
    prev = jnp.concatenate([zero, p[:, :-1]], axis=1)
    nxt = jnp.concatenate([p[:, 1:], zero], axis=1)
    return p + mu_prev * (prev - p) + mu_next * (nxt - p)


def flip_if(a, d):
    return jnp.flip(a, 1) if d == 1 else a


def gla_chunked(q, k, v, g, s0):
    b, t, h, _ = q.shape
    dv = v.shape[-1]
    n = t // GLA_CHUNK
    def chunks(a):
        return a.reshape(b, n, GLA_CHUNK, h, a.shape[-1])
    q, k, v, g = chunks(q), chunks(k), chunks(v), chunks(g)
    G = jnp.cumsum(g, axis=2)
    G_last = G[:, :, -1]
    q_dec = q * jnp.exp(G)
    k_inv = k * jnp.exp(-G)
    k_end = k * jnp.exp(G_last[:, :, None] - G)
    mask = jnp.tril(jnp.ones((GLA_CHUNK, GLA_CHUNK), dtype=bool))
    att = jnp.where(mask, jnp.einsum('bnihd,bnjhd->bnhij', q_dec, k_inv), 0.0)
    o_intra = jnp.einsum('bnhij,bnjhv->bnihv', att, v)
    d_state = jnp.einsum('bnjhd,bnjhv->bnhdv', k_end, v)
    def step(s, inp):
        dec, ds = inp
        return s * dec[..., None] + ds, s
    s_fin, s_prev = lax.scan(step, s0, (jnp.moveaxis(jnp.exp(G_last), 1, 0), jnp.moveaxis(d_state, 1, 0)))
    o_inter = jnp.einsum('bnihd,nbhdv->bnihv', q_dec, s_prev)
    return (o_intra + o_inter).reshape(b, t, h, dv), s_fin


def gla_branch(p_lat, p_ctx, gk_up, gk_b, norm_g, need_ctx):
    def feats(p):
        bb, t, _ = p.shape
        q, k, v, og, gd = jnp.split(p, GLA_SPLITS, axis=-1)
        return (q.reshape(bb, t, GLA_HEADS, GLA_DK) * GLA_DK ** -0.5,
                k.reshape(bb, t, GLA_HEADS, GLA_DK),
                v.reshape(bb, t, GLA_HEADS, GLA_DV), og, gd)
    def dir_seq(f, d):
        q, k, v, _, gd = f
        bb, t, _ = gd.shape
        g = (jax.nn.log_sigmoid(gd @ gk_up[d] + gk_b[d]) / GLA_GATE_NORM).reshape(bb, t, GLA_HEADS, GLA_DK)
        return tuple(flip_if(a, d) for a in (q, k, v, g))
    lat, ctx = feats(p_lat), feats(p_ctx)
    b = p_lat.shape[0]
    o_l, o_c = [], []
    for d in range(2):
        s0 = jnp.zeros((b, GLA_HEADS, GLA_DK, GLA_DV), jnp.float32)
        oc, s_ctx = gla_chunked(*dir_seq(ctx, d), s0)
        ol, _ = gla_chunked(*dir_seq(lat, d), s_ctx)
        o_l.append(flip_if(ol, d))
        o_c.append(flip_if(oc, d))
    def finish(o, og):
        bb, t = o.shape[:2]
        return (rms_norm(o, norm_g) * jax.nn.silu(og).reshape(bb, t, GLA_HEADS, GLA_DV)).reshape(bb, t, GLA_V)
    out_lat = finish(o_l[0] + o_l[1], lat[3])
    out_ctx = finish(o_c[0] + o_c[1], ctx[3]) if need_ctx else None
    return out_lat, out_ctx


def rwkv7_scan(r, w, k, v, a, b, s0):
    def step(s, inp):
        r_t, w_t, k_t, v_t, a_t, b_t = inp
        sa = jnp.einsum('bhij,bhj->bhi', s, a_t)
        s = s * w_t[:, :, None, :] + sa[..., None] * b_t[:, :, None, :] + v_t[..., None] * k_t[:, :, None, :]
        return s, jnp.einsum('bhij,bhj->bhi', s, r_t)
    xs = tuple(jnp.swapaxes(t_, 0, 1) for t_ in (r, w, k, v, a, b))
    s_fin, y = lax.scan(step, s0, xs)
    return jnp.swapaxes(y, 0, 1), s_fin


def rwkv_branch(p_lat, p_ctx, mu, w0, w2, a0, a2, k_k, k_a, r_k, g2, ln_w, ln_b, need_ctx):
    def heads(a):
        bb, t, _ = a.shape
        return a.reshape(bb, t, RW_HEADS, RW_HEAD)
    def feats(p):
        return jnp.split(shift_mix(p, mu[0], mu[1]), RW_SPLITS, axis=-1)
    def dir_seq(f, d):
        r, k, v, wd, ad, _ = f
        w_log = -jax.nn.softplus(-(w0[d] + jnp.tanh(wd) @ w2[d])) - 0.5
        a = jax.nn.sigmoid(a0[d] + ad @ a2[d])
        kk = heads(k * k_k)
        kk = kk / jnp.maximum(jnp.sqrt(jnp.sum(kk * kk, axis=-1, keepdims=True)), 1e-12)
        kd = heads(k * (1.0 + (a - 1.0) * k_a))
        seq = (heads(r), heads(jnp.exp(-jnp.exp(w_log))), kd, heads(v), -kk, kk * heads(a))
        return tuple(flip_if(t_, d) for t_ in seq), kd
    lat, ctx = feats(p_lat), feats(p_ctx)
    b = p_lat.shape[0]
    y_l, y_c, kd_l, kd_c = [], [], [], []
    for d in range(2):
        seq_c, kdc = dir_seq(ctx, d)
        seq_l, kdl = dir_seq(lat, d)
        s0 = jnp.zeros((b, RW_HEADS, RW_HEAD, RW_HEAD), jnp.float32)
        yc, s_ctx = rwkv7_scan(*seq_c, s0)
        yl, _ = rwkv7_scan(*seq_l, s_ctx)
        y_l.append(flip_if(yl, d)); y_c.append(flip_if(yc, d))
        kd_l.append(kdl); kd_c.append(kdc)
    def finish(f, ys, kds):
        r, _, v, _, _, gd = f
        bb, t, _ = r.shape
        y = ys[0] + ys[1]
        mean = jnp.mean(y, axis=-1, keepdims=True)
        var = jnp.mean(jnp.square(y - mean), axis=-1, keepdims=True)
        y = ((y - mean) * lax.rsqrt(var + RW_GN_EPS)).reshape(bb, t, RW_W) * ln_w + ln_b
        rh, vh = heads(r), heads(v)
        bonus = (jnp.sum(rh * kds[0] * r_k, axis=-1, keepdims=True)
                 + jnp.sum(rh * kds[1] * r_k, axis=-1, keepdims=True)) * vh
        g = jax.nn.sigmoid(gd) @ g2
        return (y + bonus.reshape(bb, t, RW_W)) * g
    out_lat = finish(lat, y_l, kd_l)
    out_ctx = finish(ctx, y_c, kd_c) if need_ctx else None
    return out_lat, out_ctx


def even_mixer(h_lat, h_ctx, w_in, w_out, gk_up, gk_b, gla_g, mu, w0, w2, a0, a2, k_k, k_a, r_k, g2, ln_w, ln_b, need_ctx):
    p_lat = (h_lat @ w_in).astype(jnp.float32)
    p_ctx = (h_ctx @ w_in).astype(jnp.float32)
    gl, gc = gla_branch(p_lat[..., :GLA_COLS], p_ctx[..., :GLA_COLS], gk_up, gk_b, gla_g, need_ctx)
    rl, rc = rwkv_branch(p_lat[..., GLA_COLS:], p_ctx[..., GLA_COLS:], mu, w0, w2, a0, a2,
                         k_k, k_a, r_k, g2, ln_w, ln_b, need_ctx)
    o_lat = jnp.concatenate([gl, rl], axis=-1).astype(h_lat.dtype) @ w_out
    o_ctx = jnp.concatenate([gc, rc], axis=-1).astype(h_ctx.dtype) @ w_out if need_ctx else None
    return o_lat, o_ctx


def axial_angles(n_tok):
    rows = n_tok // GRID_W
    row = jnp.broadcast_to(jnp.arange(rows, dtype=jnp.float32)[:, None], (rows, GRID_W)).reshape(-1)
    col = jnp.broadcast_to(jnp.arange(GRID_W, dtype=jnp.float32)[None, :], (rows, GRID_W)).reshape(-1)
    quarter = MLA_ROPE // 4
    inv_freq = ROPE_THETA ** (-jnp.arange(quarter, dtype=jnp.float32) / quarter)
    return row[:, None] * inv_freq, col[:, None] * inv_freq


def apply_axial_rope(x, ang_row, ang_col):
    r1, r2, c1, c2 = jnp.split(x.astype(jnp.float32), 4, axis=-1)
    cr, sr = jnp.cos(ang_row)[:, None, :], jnp.sin(ang_row)[:, None, :]
    cc, sc = jnp.cos(ang_col)[:, None, :], jnp.sin(ang_col)[:, None, :]
    out = jnp.concatenate([r1 * cr - r2 * sr, r2 * cr + r1 * sr, c1 * cc - c2 * sc, c2 * cc + c1 * sc], axis=-1)
    return out.astype(x.dtype)


def odd_mixer(h_lat, h_ctx, w_in, q_norm, wq_up, kv_norm, wkv_up, w_out, need_ctx):
    def project(h):
        bb, t, _ = h.shape
        cq, ckv, k_rope = jnp.split(h @ w_in, MLA_SPLITS, axis=-1)
        q = (rms_norm(cq, q_norm) @ wq_up).reshape(bb, t, MLA_HEADS, MLA_NOPE + MLA_ROPE)
        kv = (rms_norm(ckv, kv_norm) @ wkv_up).reshape(bb, t, MLA_HEADS, MLA_NOPE + MLA_V)
        return q[..., :MLA_NOPE], q[..., MLA_NOPE:], kv[..., :MLA_NOPE], kv[..., MLA_NOPE:], k_rope[:, :, None, :]
    qn_l, qr_l, kn_l, v_l, kr_l = project(h_lat)
    qn_c, qr_c, kn_c, v_c, kr_c = project(h_ctx)
    b, n_lat, _ = h_lat.shape
    ang_r, ang_c = axial_angles(n_lat)
    qr_l = apply_axial_rope(qr_l, ang_r, ang_c)
    kr_l = apply_axial_rope(kr_l, ang_r, ang_c)
    kn = jnp.concatenate([kn_c, kn_l], axis=1)
    kr = jnp.concatenate([kr_c, kr_l], axis=1)[:, :, 0]
    v = jnp.concatenate([v_c, v_l], axis=1)
    scale = (MLA_NOPE + MLA_ROPE) ** -0.5
    def attend(qn, qr, kn_, kr_, v_):
        s = (jnp.einsum('bqhd,bkhd->bhqk', qn, kn_) + jnp.einsum('bqhr,bkr->bhqk', qr, kr_)).astype(jnp.float32) * scale
        p = jax.nn.softmax(s, axis=-1).astype(v_.dtype)
        return jnp.einsum('bhqk,bkhd->bqhd', p, v_)
    nb = n_lat // Q_BLOCK
    def blocks(a):
        return jnp.moveaxis(a.reshape(b, nb, Q_BLOCK, *a.shape[2:]), 1, 0)
    o = lax.map(lambda qb: attend(qb[0], qb[1], kn, kr, v), (blocks(qn_l), blocks(qr_l)))
    o_lat = jnp.moveaxis(o, 0, 1).reshape(b, n_lat, MLA_HEADS * MLA_V) @ w_out
    o_ctx = None
    if need_ctx:
        n_ctx = h_ctx.shape[1]
        o_ctx = attend(qn_c, qr_c, kn_c, kr_c[:, :, 0], v_c).reshape(b, n_ctx, MLA_HEADS * MLA_V) @ w_out
    return o_lat, o_ctx


def moe_ffn(h, w_r, b_r, w_gu, b_gu, w_dn, b_dn):
    n, d = h.shape
    logits = (h @ w_r + b_r).astype(jnp.float32)
    top_logit, top_e = lax.top_k(logits, TOP_K)
    gate = jax.nn.softmax(top_logit, axis=-1)
    n_assign = n * TOP_K
    flat_e = top_e.reshape(-1)
    flat_tok = jnp.arange(n_assign, dtype=jnp.int32) // TOP_K
    flat_g = gate.reshape(-1)
    order = jnp.argsort(flat_e)
    se, stok, sg = flat_e[order], flat_tok[order], flat_g[order]
    counts = jnp.bincount(flat_e, length=N_EXPERTS)
    padded = (counts + MOE_BLOCK - 1) // MOE_BLOCK * MOE_BLOCK
    pad_end = jnp.cumsum(padded)
    pad_start = pad_end - padded
    start = jnp.cumsum(counts) - counts
    dest = pad_start[se] + jnp.arange(n_assign, dtype=jnp.int32) - start[se]
    n_blocks = (n_assign + MOE_BLOCK - 1) // MOE_BLOCK + N_EXPERTS
    tok_buf = jnp.zeros((n_blocks * MOE_BLOCK,), jnp.int32).at[dest].set(stok)
    g_buf = jnp.zeros((n_blocks * MOE_BLOCK,), jnp.float32).at[dest].set(sg)
    blk_e = jnp.minimum(jnp.searchsorted(pad_end, jnp.arange(n_blocks, dtype=jnp.int32) * MOE_BLOCK, side='right'),
                        N_EXPERTS - 1)
    def step(acc, blk):
        tok, g, e = blk
        gu = (h[tok] @ w_gu[e] + b_gu[e]).astype(jnp.float32)
        x_glu = jnp.minimum(gu[:, :D_EXPERT], SWIGLU_LIMIT)
        x_lin = jnp.clip(gu[:, D_EXPERT:], -SWIGLU_LIMIT, SWIGLU_LIMIT)
        act = x_glu * jax.nn.sigmoid(SWIGLU_ALPHA * x_glu) * (x_lin + 1.0)
        y = (act.astype(h.dtype) @ w_dn[e] + b_dn[e]).astype(jnp.float32)
        return acc.at[tok].add(y * g[:, None]), None
    acc, _ = lax.scan(step, jnp.zeros((n, d), jnp.float32),
                      (tok_buf.reshape(n_blocks, MOE_BLOCK), g_buf.reshape(n_blocks, MOE_BLOCK), blk_e))
    return acc.astype(h.dtype)


def setup_inputs(seed: int = 0) -> dict:
    key = jax.random.key(seed)
    ks = iter(jax.random.split(key, 64))
    def nrm(shape, scale):
        return jax.random.normal(next(ks), shape, jnp.float32) * scale
    def gain(shape):
        return 1.0 + nrm(shape, 0.02)
    D = D_MODEL
    return {
        'x': nrm((BATCH, SEQ, D), 1.0),
        'c': nrm((BATCH, D), 1.0),
        'ctx': nrm((BATCH, CTX_LEN, D), 1.0),
        'c_ctx': nrm((D,), 1.0),
        'ada_w': nrm((DEPTH, D, 6 * D), 0.5 * D ** -0.5),
        'ada_b': nrm((DEPTH, 6 * D), 0.02),
        'norm1_g': gain((DEPTH, D)),
        'norm2_g': gain((DEPTH, D)),
        'ev_w_in': nrm((N_EVEN, D, EVEN_IN), D ** -0.5),
        'ev_w_out': nrm((N_EVEN, EVEN_MIX, D), EVEN_MIX ** -0.5),
        'gla_gk_up': nrm((N_EVEN, 2, GLA_GATE_RANK, GLA_QK), GLA_GATE_RANK ** -0.5),
        'gla_gk_b': nrm((N_EVEN, 2, GLA_QK), 0.1),
        'gla_norm_g': gain((N_EVEN, GLA_DV)),
        'rw_mu': jax.random.uniform(next(ks), (N_EVEN, 2, RW_COLS), jnp.float32) * 0.6,
        'rw_w0': nrm((N_EVEN, 2, RW_W), 0.5) - 2.0,
        'rw_w2': nrm((N_EVEN, 2, RW_DECAY_RANK, RW_W), 0.1),
        'rw_a0': nrm((N_EVEN, 2, RW_W), 0.5),
        'rw_a2': nrm((N_EVEN, 2, RW_ICLR_RANK, RW_W), 0.1),
        'rw_k_k': 0.85 + nrm((N_EVEN, RW_W), 0.02),
        'rw_k_a': gain((N_EVEN, RW_W)),
        'rw_r_k': nrm((N_EVEN, RW_HEADS, RW_HEAD), 0.1),
        'rw_g2': nrm((N_EVEN, RW_GATE_RANK, RW_W), RW_GATE_RANK ** -0.5),
        'rw_ln_w': gain((N_EVEN, RW_W)),
        'rw_ln_b': nrm((N_EVEN, RW_W), 0.02),
        'od_w_in': nrm((N_ODD, D, ODD_IN), D ** -0.5),
        'mla_q_norm': gain((N_ODD, MLA_Q_RANK)),
        'mla_wq_up': nrm((N_ODD, MLA_Q_RANK, MLA_HEADS * (MLA_NOPE + MLA_ROPE)), MLA_Q_RANK ** -0.5),
        'mla_kv_norm': gain((N_ODD, MLA_KV_RANK)),
        'mla_wkv_up': nrm((N_ODD, MLA_KV_RANK, MLA_HEADS * (MLA_NOPE + MLA_V)), MLA_KV_RANK ** -0.5),
        'od_w_out': nrm((N_ODD, MLA_HEADS * MLA_V, D), (MLA_HEADS * MLA_V) ** -0.5),
        'router_w': nrm((DEPTH, D, N_EXPERTS), D ** -0.5),
        'router_b': nrm((DEPTH, N_EXPERTS), 0.01),
        'moe_gu_w': nrm((DEPTH, N_EXPERTS, D, 2 * D_EXPERT), D ** -0.5),
        'moe_gu_b': nrm((DEPTH, N_EXPERTS, 2 * D_EXPERT), 0.02),
        'moe_down_w': nrm((DEPTH, N_EXPERTS, D_EXPERT, D), D_EXPERT ** -0.5),
        'moe_down_b': nrm((DEPTH, N_EXPERTS, D), 0.02),
        'final_norm_g': gain((D,)),
    }


def reference(x, c, ctx, c_ctx, ada_w, ada_b, norm1_g, norm2_g, ev_w_in, ev_w_out, gla_gk_up, gla_gk_b,
              gla_norm_g, rw_mu, rw_w0, rw_w2, rw_a0, rw_a2, rw_k_k, rw_k_a, rw_r_k, rw_g2, rw_ln_w, rw_ln_b,
              od_w_in, mla_q_norm, mla_wq_up, mla_kv_norm, mla_wkv_up, od_w_out, router_w, router_b,
              moe_gu_w, moe_gu_b, moe_down_w, moe_down_b, final_norm_g):
    b, n_lat, d = x.shape
    n_ctx = ctx.shape[1]
    x_lat, x_ctx = x, ctx
    for layer in range(DEPTH):
        need_ctx = layer < DEPTH - 1
        i = layer // 2
        mod_lat = jax.nn.silu(c) @ ada_w[layer] + ada_b[layer]
        mod_ctx = jax.nn.silu(c_ctx) @ ada_w[layer] + ada_b[layer]
        sh1, sc1, gt1, sh2, sc2, gt2 = jnp.split(mod_lat[:, None, :], 6, axis=-1)
        sh1c, sc1c, gt1c, sh2c, sc2c, gt2c = jnp.split(mod_ctx, 6, axis=-1)
        h_lat = modulate(x_lat, norm1_g[layer], sh1, sc1)
        h_ctx = modulate(x_ctx, norm1_g[layer], sh1c, sc1c)
        if layer % 2 == 0:
            o_lat, o_ctx = even_mixer(h_lat, h_ctx, ev_w_in[i], ev_w_out[i], gla_gk_up[i], gla_gk_b[i], gla_norm_g[i],
                                      rw_mu[i], rw_w0[i], rw_w2[i], rw_a0[i], rw_a2[i], rw_k_k[i], rw_k_a[i],
                                      rw_r_k[i], rw_g2[i], rw_ln_w[i], rw_ln_b[i], need_ctx)
        else:
            o_lat, o_ctx = odd_mixer(h_lat, h_ctx, od_w_in[i], mla_q_norm[i], mla_wq_up[i], mla_kv_norm[i],
                                     mla_wkv_up[i], od_w_out[i], need_ctx)
        x_lat = x_lat + gt1 * o_lat
        h_lat = modulate(x_lat, norm2_g[layer], sh2, sc2).reshape(b * n_lat, d)
        if need_ctx:
            x_ctx = x_ctx + gt1c * o_ctx
            h_ctx = modulate(x_ctx, norm2_g[layer], sh2c, sc2c).reshape(b * n_ctx, d)
            tokens = jnp.concatenate([h_lat, h_ctx], axis=0)
        else:
            tokens = h_lat
        y = moe_ffn(tokens, router_w[layer], router_b[layer], moe_gu_w[layer], moe_gu_b[layer],
                    moe_down_w[layer], moe_down_b[layer])
        x_lat = x_lat + gt2 * y[:b * n_lat].reshape(b, n_lat, d)
        if need_ctx:
            x_ctx = x_ctx + gt2c * y[b * n_lat:].reshape(b, n_ctx, d)
    return rms_norm(x_lat, final_norm_g)
```

```cpp
#include <hip/hip_runtime.h>
#include <cstdio>
#include <cstdint>

#ifndef MK_N_LAUNCHES
#define MK_N_LAUNCHES 1
#endif

#define GAS __attribute__((address_space(1)))
#define LAS __attribute__((address_space(3)))
typedef unsigned short bf16;
typedef short bf16x8 __attribute__((ext_vector_type(8)));
typedef short s16x4 __attribute__((ext_vector_type(4)));
typedef float f32x4 __attribute__((ext_vector_type(4)));
typedef float f32x2 __attribute__((ext_vector_type(2)));
typedef float f32x16 __attribute__((ext_vector_type(16)));
typedef unsigned u32x4 __attribute__((ext_vector_type(4)));
typedef unsigned u32x2 __attribute__((ext_vector_type(2)));
typedef GAS unsigned gu32;
#define RLX_AGENT __ATOMIC_RELAXED, __HIP_MEMORY_SCOPE_AGENT
#define LDS_WAIT() asm volatile("s_waitcnt lgkmcnt(0)" ::: "memory")
#define VM_WAIT() asm volatile("s_waitcnt vmcnt(0)" ::: "memory")
#define SBAR() __builtin_amdgcn_sched_barrier(0)

constexpr int DM = 1024, NB = 8, SEQ = 8192, CTXL = 256;
constexpr int NLAT = NB * SEQ;
constexpr int NCTX = NB * CTXL;
constexpr int NTOK = NLAT + NCTX;
constexpr int GLA_COLS = 1552, RW_COLS = 1824, RW0 = 1664, PW = 3584;
constexpr int LRK = 384, LRN = 2560;
constexpr int NE = 32, TOPK = 4, DE = 1024;
constexpr int NASG0 = NTOK * TOPK;
constexpr int MAXSLOT = NASG0 + NE * 256;
constexpr int YS_DUMMY = NASG0;
constexpr int NKEY = CTXL + SEQ;
constexpr int MH = 8, QKD = 192, VD = 128;

constexpr size_t MiB = 1u << 20;
constexpr size_t WS_CTL = 0, CTL_ZERO_BYTES = 1 * MiB;
constexpr size_t WS_MOD = 1 * MiB;
constexpr size_t WS_ROPE = 2 * MiB;
constexpr size_t WS_WIN = 4 * MiB;
constexpr size_t WS_WOUT = 11 * MiB;
constexpr size_t WS_WLR = 13 * MiB;
constexpr size_t WS_WODIN = 15 * MiB;
constexpr size_t WS_WQUP = 16 * MiB;
constexpr size_t WS_WKVUP = 17 * MiB;
constexpr size_t WS_WODOUT = 18 * MiB;
constexpr size_t WS_ROUTE = 20 * MiB;
constexpr size_t WS_WGU = 24 * MiB;
constexpr size_t WS_WDN = 280 * MiB;
constexpr size_t WS_X1 = 408 * MiB;
constexpr size_t WS_H = 672 * MiB;
constexpr size_t WS_ARENA = 804 * MiB;
constexpr size_t WS_P = WS_ARENA;
constexpr size_t WS_LOUT = WS_P + 462 * MiB;
constexpr size_t WS_GLAO = WS_LOUT + 330 * MiB;
constexpr size_t WS_RWY = WS_GLAO + 132 * MiB;
constexpr size_t WS_ALR = WS_RWY + 132 * MiB;
constexpr size_t WS_BONUS = WS_ALR + 50 * MiB;
constexpr size_t WS_ACT = WS_ARENA;
constexpr size_t WS_YS = WS_ACT + 544 * MiB;
constexpr size_t WS_C = WS_ARENA;
constexpr size_t WS_QN = WS_C + 132 * MiB;
constexpr size_t WS_KVN = WS_QN + 32 * MiB;
constexpr size_t WS_Q = WS_KVN + 33 * MiB;
constexpr size_t WS_K = WS_Q + 192 * MiB;
constexpr size_t WS_V = WS_K + 198 * MiB;
constexpr size_t WS_END = 2048 * MiB;
static_assert(WS_BONUS + 5 * MiB <= WS_END && WS_YS + 529 * MiB <= WS_END && WS_V + 132 * MiB <= WS_END, "d_ws map");
constexpr size_t RT_E = 0;
constexpr size_t RT_POS = 512 * 1024;
constexpr size_t RT_GATE = 1024 * 1024 + 512 * 1024;
constexpr size_t RT_HIST = 3 * MiB;
constexpr size_t RT_TOK = 3 * MiB + 64 * 1024;
constexpr size_t WS_SORT = WS_YS + 529 * MiB;
static_assert(WS_SORT + 4 * MiB <= WS_END, "sort lists");

constexpr int CW_TMO = 0, CW_CODE = 1;
constexpr int CW_BAR = 4096;

constexpr int RING_BYTES = 131072;
constexpr int LDS_BYTES = 163840;
constexpr int MISC_OFF = 163840 - 256;

__device__ __forceinline__ unsigned f2bf(float f) { unsigned u = __builtin_bit_cast(unsigned, f); return (u + 0x7fffu + ((u >> 16) & 1u)) >> 16; }
__device__ __forceinline__ float bf2f(unsigned h) { return __builtin_bit_cast(float, h << 16); }
__device__ __forceinline__ unsigned cvt_pk_bf16(float lo, float hi) { unsigned r; asm volatile("v_cvt_pk_bf16_f32 %0, %1, %2" : "=v"(r) : "v"(lo), "v"(hi)); return r; }
__device__ __forceinline__ float bflo(unsigned w) { return __builtin_bit_cast(float, w << 16); }
__device__ __forceinline__ float bfhi(unsigned w) { return __builtin_bit_cast(float, w & 0xffff0000u); }
__device__ __forceinline__ float wave_sum(float v) {
#pragma unroll
    for (int o = 1; o < 64; o <<= 1) v += __shfl_xor(v, o);
    return v;
}
__device__ __forceinline__ float sigmoidf_(float x) { return 1.f / (1.f + __expf(-x)); }

namespace pg8 {
constexpr int BM = 256, BK = 64, HALF = 128, HTB = HALF * BK * 2, STAGE_BYTES = 8 * HTB;
__host__ __device__ __forceinline__ int lds_byte(int r, int c) { const int st = (r >> 4) * 2 + (c >> 5), rr = r & 15, cc = c & 31, ob = rr * 64 + cc * 2; return st * 1024 + (ob ^ (((ob >> 9) & 1) << 5)); }
__host__ __device__ __forceinline__ void stage_rc(int b, int& R, int& C) { const int st = b / 1024, sb = b % 1024, swz = sb ^ (((sb >> 9) & 1) << 5); R = (st >> 1) * 16 + swz / 64; C = (st & 1) * 32 + (swz % 64) / 2; }
__host__ __device__ __forceinline__ int perm32(int rho) { const int n = rho >> 4, i = rho & 15; return 8 * (i >> 2) + 4 * n + (i & 3); }
struct Unit { int pm, pn; };

template <class Epi, class Sched>
__device__ __forceinline__ void gemm_phase(LAS unsigned char* lds, const bf16* Abase, const int Kc, const Sched& S, const Epi& E) {
    int K = Kc; asm volatile("" : "+s"(K));
    const int tid = threadIdx.x, wid = __builtin_amdgcn_readfirstlane(tid >> 6), lane = tid & 63, wr = wid >> 2, wc = wid & 3, fr = lane & 15, fq = lane >> 4;
    const int nt = K / BK;
    int sR[2], sC[2]; unsigned voffB[2];
#pragma unroll
    for (int i = 0; i < 2; ++i) { int R, C; stage_rc(tid * 16 + i * 8192, R, C); const int Rb = Epi::PERM ? ((R & ~31) + perm32(R & 31)) : R; sR[i] = R; sC[i] = C; voffB[i] = (unsigned)(Rb * K + C) * 2u; }
    const size_t kstep = (size_t)(BK * 2);
    const size_t hstep = (size_t)HALF * K * 2;
    const unsigned ldsw = (unsigned)wid * 1024u;
    const int aoff = lds_byte(wr * 64 + fr, fq * 8), boff = lds_byte(wc * 32 + fr, fq * 8);
    const char* Ab = (const char*)Abase;
#define PG8_SA(b, h) (((b) * 2 + (h)) * HTB)
#define PG8_SB(b, h) ((4 + (b) * 2 + (h)) * HTB)
#define PG8_STAGE(bufoff, gbase, voff) do { _Pragma("unroll") for (int _i = 0; _i < 2; ++_i) \
        __builtin_amdgcn_global_load_lds((const unsigned*)((const char*)(gbase) + (voff)[_i]), (LAS unsigned*)(lds + (bufoff) + ldsw + _i * 8192), 16, 0, 0); } while (0)
#define PG8_STAGEA(bufoff, kb, ao, h) do { _Pragma("unroll") for (int _i = 0; _i < 2; ++_i) \
        __builtin_amdgcn_global_load_lds((const unsigned*)((Ab + (kb)) + (ao)[h][_i]), (LAS unsigned*)(lds + (bufoff) + ldsw + _i * 8192), 16, 0, 0); } while (0)
#define PG8_LDA(dst, b, h) do { _Pragma("unroll") for (int m = 0; m < 4; ++m) _Pragma("unroll") for (int k = 0; k < 2; ++k) dst[m][k] = *(const LAS bf16x8*)(lds + PG8_SA(b, h) + aoff + m * 2048 + k * 1024); } while (0)
#define PG8_LDB(dst, b, h) do { _Pragma("unroll") for (int n = 0; n < 2; ++n) _Pragma("unroll") for (int k = 0; k < 2; ++k) dst[n][k] = *(const LAS bf16x8*)(lds + PG8_SB(b, h) + boff + n * 2048 + k * 1024); } while (0)
#define PG8_MMA(ai, bj, At, Bt) do { __builtin_amdgcn_s_setprio(1); _Pragma("unroll") for (int m = 0; m < 4; ++m) _Pragma("unroll") for (int n = 0; n < 2; ++n) _Pragma("unroll") for (int k = 0; k < 2; ++k) \
        acc[ai][bj][m][n] = __builtin_amdgcn_mfma_f32_16x16x32_bf16(Bt[n][k], At[m][k], acc[ai][bj][m][n], 0, 0, 0); __builtin_amdgcn_s_setprio(0); } while (0)
#define PG8_WAIT_V(n) asm volatile("s_waitcnt vmcnt(" #n ")" ::: "memory")
#define PG8_WAIT_L(n) asm volatile("s_waitcnt lgkmcnt(" #n ")" ::: "memory")
#define PG8_BAR __builtin_amdgcn_s_barrier()
#define PG8_SCHED __builtin_amdgcn_sched_barrier(0)
    Unit cur, nxt; int ui = 0;
    if (!S.next(0, cur)) return;
    f32x4 acc[2][2][4][2];
#pragma unroll
    for (int a = 0; a < 2; ++a)
#pragma unroll
        for (int b = 0; b < 2; ++b)
#pragma unroll
            for (int m = 0; m < 4; ++m)
#pragma unroll
                for (int n = 0; n < 2; ++n) acc[a][b][m][n] = (f32x4){0.f, 0.f, 0.f, 0.f};
    bf16x8 At[4][2], B0[2][2], B1[2][2];
    unsigned cao[2][2], nao[2][2];
    S.a_offs(cur, cao, sR, sC);
    const char* cB = S.b_tile(cur);
    PG8_STAGE(PG8_SB(0, 0), cB, voffB); PG8_STAGE(PG8_SB(0, 1), cB + hstep, voffB); PG8_STAGEA(PG8_SA(0, 0), 0, cao, 0); PG8_STAGEA(PG8_SA(0, 1), 0, cao, 1);
    if (wr == 1) PG8_BAR;
    PG8_WAIT_V(2); PG8_BAR;
    PG8_STAGE(PG8_SB(1, 0), cB + kstep, voffB); PG8_STAGEA(PG8_SA(1, 0), kstep, cao, 0); PG8_STAGE(PG8_SB(1, 1), cB + hstep + kstep, voffB);
    PG8_WAIT_V(6); PG8_BAR;
    for (;;) {
        const bool has_next = S.next(ui + 1, nxt);
        const char* nB = cB;
        if (has_next) { S.a_offs(nxt, nao, sR, sC); nB = S.b_tile(nxt); }
        else {
#pragma unroll
            for (int h = 0; h < 2; ++h)
#pragma unroll
                for (int i = 0; i < 2; ++i) nao[h][i] = cao[h][i];
        }
        for (int t = 0; t < nt; t += 2) {
            const bool last = (t == nt - 2);
            const size_t a1k = (size_t)(t + 1) * kstep;
            const size_t a2k = last ? 0 : (size_t)(t + 2) * kstep; const char* b2 = last ? nB : cB + (size_t)(t + 2) * kstep;
            const size_t a3k = a2k + kstep; const char* b3 = b2 + kstep;
            unsigned sao[2][2];
#pragma unroll
            for (int h = 0; h < 2; ++h)
#pragma unroll
                for (int i = 0; i < 2; ++i) sao[h][i] = last ? nao[h][i] : cao[h][i];
            PG8_LDB(B0, 0, 0); PG8_LDB(B1, 0, 1); PG8_SCHED; PG8_LDA(At, 0, 0); PG8_STAGEA(PG8_SA(1, 1), a1k, cao, 1);
            PG8_WAIT_V(8); PG8_WAIT_L(0); PG8_BAR; PG8_MMA(0, 0, At, B0); PG8_MMA(0, 1, At, B1); PG8_BAR; PG8_SCHED;
            PG8_LDA(At, 0, 1); PG8_STAGE(PG8_SB(0, 0), b2, voffB); PG8_STAGE(PG8_SB(0, 1), b2 + hstep, voffB); PG8_STAGEA(PG8_SA(0, 0), a2k, sao, 0);
            PG8_WAIT_V(8); PG8_WAIT_L(0); PG8_BAR; PG8_MMA(1, 0, At, B0); PG8_MMA(1, 1, At, B1); PG8_BAR; PG8_SCHED;
            PG8_LDB(B0, 1, 0); PG8_LDB(B1, 1, 1); PG8_SCHED; PG8_LDA(At, 1, 0); PG8_STAGEA(PG8_SA(0, 1), a2k, sao, 1);
            PG8_WAIT_V(8); PG8_WAIT_L(0); PG8_BAR; PG8_MMA(0, 0, At, B0); PG8_MMA(0, 1, At, B1); PG8_BAR; PG8_SCHED;
            PG8_LDA(At, 1, 1); PG8_STAGE(PG8_SB(1, 0), b3, voffB); PG8_STAGE(PG8_SB(1, 1), b3 + hstep, voffB); PG8_STAGEA(PG8_SA(1, 0), a3k, sao, 0);
            PG8_WAIT_V(8); PG8_WAIT_L(0); PG8_BAR; PG8_MMA(1, 0, At, B0); PG8_MMA(1, 1, At, B1); PG8_BAR; PG8_SCHED;
        }
        if (wr == 0) PG8_BAR;
        E(acc, cur, wr, wc, fr, fq);
        if (!has_next) break;
#pragma unroll
        for (int a = 0; a < 2; ++a)
#pragma unroll
            for (int b = 0; b < 2; ++b)
#pragma unroll
                for (int m = 0; m < 4; ++m)
#pragma unroll
                    for (int n = 0; n < 2; ++n) acc[a][b][m][n] = (f32x4){0.f, 0.f, 0.f, 0.f};
        cur = nxt; cB = nB; ++ui;
#pragma unroll
        for (int h = 0; h < 2; ++h)
#pragma unroll
            for (int i = 0; i < 2; ++i) cao[h][i] = nao[h][i];
        if (wr == 1) PG8_BAR;
    }
    PG8_WAIT_V(0);
    PG8_BAR;
#undef PG8_SA
#undef PG8_SB
#undef PG8_STAGE
#undef PG8_STAGEA
#undef PG8_LDA
#undef PG8_LDB
#undef PG8_MMA
#undef PG8_WAIT_V
#undef PG8_WAIT_L
#undef PG8_BAR
#undef PG8_SCHED
}
}

#define XB_TMO      128
#define XB_XCNT(j)  (256  + 64 * (j))
#define XB_XSUB(j)  (1280 + 64 * (j))
#define XB_XGEN(j)  (2304 + 64 * (j))
#define XB_TOP      3328
#define XB_TOPGEN   3392
#define XCD_BAR_WORDS 3456
#define XB_SPIN_CAP (1u << 22)
__device__ __forceinline__ unsigned xb_ld(unsigned* p)              { return __hip_atomic_load(p, __ATOMIC_RELAXED, __HIP_MEMORY_SCOPE_AGENT); }
__device__ __forceinline__ unsigned xb_add(unsigned* p, unsigned v) { return __hip_atomic_fetch_add(p, v, __ATOMIC_RELAXED, __HIP_MEMORY_SCOPE_AGENT); }
__device__ __forceinline__ unsigned xb_xcc_id() { return (unsigned)__builtin_amdgcn_s_getreg((3 << 11) | 20) & 0xFu; }
#define XB_SPIN(cond, bar) do { unsigned _sp = 0; while (cond) { __builtin_amdgcn_s_sleep(1); \
    if ((++_sp & 255u) == 0u) { if (xb_ld(&(bar)[XB_TMO])) break; if (_sp > XB_SPIN_CAP) { atomicAdd(&(bar)[XB_TMO], 1u); break; } } } } while (0)
struct XcdBarrier { unsigned* bar; unsigned x; volatile LAS unsigned* st; };
__device__ __forceinline__ XcdBarrier xcd_barrier_post(unsigned* bar, volatile LAS unsigned* st) {
    XcdBarrier b; b.bar = bar; b.x = xb_xcc_id(); b.st = st;
    if (threadIdx.x == 0) (void)xb_add(&bar[XB_XCNT(b.x)], 1u);
    return b;
}
__device__ __forceinline__ void xcd_barrier_complete(unsigned* bar, unsigned x, unsigned& nloc, unsigned& nx) {
    const unsigned G = gridDim.x * gridDim.y * gridDim.z;
    unsigned sum, cnt, mine, sp = 0u;
    for (;;) {
        sum = 0u; cnt = 0u; mine = 0u;
#pragma unroll
        for (unsigned j = 0; j < 16; ++j) { const unsigned c = xb_ld(&bar[XB_XCNT(j)]); sum += c; cnt += (c > 0u) ? 1u : 0u; mine = (j == x) ? c : mine; }
        if (sum == G) break;
        __builtin_amdgcn_s_sleep(1);
        if ((++sp & 255u) == 0u) { if (xb_ld(&bar[XB_TMO])) break; if (sp > XB_SPIN_CAP) { atomicAdd(&bar[XB_TMO], 1u); break; } }
    }
    nloc = mine > 0u ? mine : 1u; nx = cnt > 0u ? cnt : 1u;
}
__device__ __forceinline__ void xcd_barrier(const XcdBarrier& b) {
    asm volatile("s_waitcnt vmcnt(0)" ::: "memory");
    __syncthreads();
    if (threadIdx.x == 0) {
        unsigned* bar = b.bar;
        __builtin_amdgcn_s_waitcnt(0);
        unsigned nloc = b.st[0], nx = b.st[1];
        if (nloc == 0u) { xcd_barrier_complete(bar, b.x, nloc, nx); b.st[0] = nloc; b.st[1] = nx; }
        const unsigned old = xb_add(&bar[XB_XSUB(b.x)], 1u);
        const unsigned gen = old / nloc;
        if (old + 1u == (gen + 1u) * nloc) {
            __builtin_amdgcn_fence(__ATOMIC_RELEASE, "agent");
            asm volatile("s_waitcnt vmcnt(0)" ::: "memory");
            const unsigned og = xb_add(&bar[XB_TOP], 1u);
            const unsigned tg = og / nx;
            if (og + 1u == (tg + 1u) * nx) xb_add(&bar[XB_TOPGEN], 1u);
            else XB_SPIN(xb_ld(&bar[XB_TOPGEN]) == tg, bar);
            __builtin_amdgcn_fence(__ATOMIC_ACQUIRE, "agent");
            xb_add(&bar[XB_XGEN(b.x)], 1u);
            asm volatile("s_waitcnt vmcnt(0)" ::: "memory");
        } else {
            XB_SPIN(xb_ld(&bar[XB_XGEN(b.x)]) == gen, bar);
            __builtin_amdgcn_fence(__ATOMIC_ACQUIRE, "agent");
            asm volatile("s_waitcnt vmcnt(0)" ::: "memory");
        }
    }
    __syncthreads();
}

struct Frame {
    LAS unsigned char* lds;
    int tid, lane, wave, G, bid;
    const float* const __attribute__((address_space(4)))* in;
    float* out;
    unsigned char* ws;
};
enum { I_X = 0, I_C, I_CTX, I_CCTX, I_ADAW, I_ADAB, I_N1G, I_N2G, I_EVWIN, I_EVWOUT, I_GKUP, I_GKB, I_GNG, I_MU, I_W0, I_W2, I_A0, I_A2, I_KK, I_KA, I_RK, I_G2, I_LNW, I_LNB,
       I_ODWIN, I_QNORM, I_WQUP, I_KVNORM, I_WKVUP, I_ODWOUT, I_RW, I_RB, I_GUW, I_GUB, I_DNW, I_DNB, I_FNG };
template <class T> __device__ __forceinline__ T* wsp(const Frame& F, size_t off) { return (T*)(F.ws + off); }
__device__ __forceinline__ int mod_row(int row) { return row < NLAT ? (row >> 13) : 8; }
__device__ __forceinline__ const float* mod_ptr(const Frame& F, int layer, int row, int which) { return wsp<const float>(F, WS_MOD) + ((size_t)(layer * 9 + mod_row(row)) * 6 + which) * 1024; }

__device__ __forceinline__ void p0_mod(Frame& F) {
    LAS float* s = (LAS float*)F.lds;
    LAS float* red = (LAS float*)(F.lds + 9 * 1024 * 4);
    const float* c = F.in[I_C]; const float* cc = F.in[I_CCTX]; const float* W = F.in[I_ADAW]; const float* Bv = F.in[I_ADAB];
    for (int idx = F.tid; idx < 9 * 1024; idx += 512) { const int r = idx >> 10, k = idx & 1023; const float v = r < 8 ? c[r * 1024 + k] : cc[k]; s[idx] = v / (1.f + __expf(-v)); }
    __syncthreads();
    for (int item = F.bid; item < 192; item += F.G) {
        const int l = item / 96, n0 = (item % 96) * 64;
        float acc[9];
#pragma unroll
        for (int r = 0; r < 9; ++r) acc[r] = 0.f;
        const float* wp = W + ((size_t)l * 1024 + F.wave * 128) * 6144 + n0 + F.lane;
        for (int k = 0; k < 128; ++k) { const float wv = wp[(size_t)k * 6144];
#pragma unroll
            for (int r = 0; r < 9; ++r) acc[r] += s[r * 1024 + F.wave * 128 + k] * wv; }
#pragma unroll
        for (int r = 0; r < 9; ++r) red[(F.wave * 9 + r) * 64 + F.lane] = acc[r];
        __syncthreads();
        for (int idx = F.tid; idx < 576; idx += 512) { const int r = idx >> 6, ln = idx & 63; float v = Bv[l * 6144 + n0 + ln];
#pragma unroll
            for (int w = 0; w < 8; ++w) v += red[(w * 9 + r) * 64 + ln];
            wsp<float>(F, WS_MOD)[(size_t)(l * 9 + r) * 6144 + n0 + ln] = v; }
        __syncthreads();
    }
}
__device__ __forceinline__ void p0_rope(Frame& F) {
    for (int idx = F.bid * 512 + F.tid; idx < SEQ * 32; idx += F.G * 512) {
        const int t = idx >> 5, i = idx & 31;
        const float fr = (float)pow(10000.0, -(double)(i & 15) / 16.0);
        const float pos = (float)(i < 16 ? (t >> 6) : (t & 63));
        const float ang = pos * fr;
        const double a = (double)ang;
        wsp<f32x2>(F, WS_ROPE)[idx] = (f32x2){(float)cos(a), (float)sin(a)};
    }
}
template <class V> __device__ __forceinline__ void cvt_item(const V& val, bf16* dst, int K, int item, int nblk, LAS float* scr, int lane) {
    const int kb = item / nblk, nb = item % nblk, k0 = 64 * kb, n0 = 32 * nb;
#pragma unroll 8
    for (int i = 0; i < 32; ++i) { const int kk = 2 * i + (lane >> 5); scr[kk * 33 + (lane & 31)] = val(n0 + (lane & 31), k0 + kk); }
    LDS_WAIT(); asm volatile("" ::: "memory");
    const int c = lane & 7;
#pragma unroll
    for (int j = 0; j < 4; ++j) { const int n = (lane >> 3) + 8 * j; const LAS float* sp = scr + (8 * c) * 33 + n;
        u32x4 o; o.x = f2bf(sp[0 * 33]) | (f2bf(sp[1 * 33]) << 16); o.y = f2bf(sp[2 * 33]) | (f2bf(sp[3 * 33]) << 16); o.z = f2bf(sp[4 * 33]) | (f2bf(sp[5 * 33]) << 16); o.w = f2bf(sp[6 * 33]) | (f2bf(sp[7 * 33]) << 16);
        *(u32x4*)(dst + (size_t)(n0 + n) * K + k0 + 8 * c) = o; }
    LDS_WAIT(); asm volatile("" ::: "memory");
}
struct VPlain { const float* W; int ldn, Nr, Kr; __device__ __forceinline__ float operator()(int n, int k) const { return (n < Nr && k < Kr) ? W[(size_t)k * ldn + n] : 0.f; } };
struct VWin { const float* W; __device__ __forceinline__ float operator()(int n, int k) const { const int col = n < GLA_COLS ? n : ((n >= RW0 && n < RW0 + RW_COLS) ? n - (RW0 - GLA_COLS) : -1); return col >= 0 ? W[(size_t)k * (GLA_COLS + RW_COLS) + col] : 0.f; } };
struct VQup { const float* W; __device__ __forceinline__ float operator()(int n, int k) const { const int col = n < 1024 ? (n >> 7) * 192 + (n & 127) : ((n - 1024) >> 6) * 192 + 128 + ((n - 1024) & 63); return W[(size_t)k * 1536 + col]; } };
struct VGu { const float* W; __device__ __forceinline__ float operator()(int n, int k) const { const int col = ((n & 128) ? 1024 : 0) + (n >> 8) * 128 + (n & 127); return W[(size_t)k * 2048 + col]; } };
struct VLr { const float *w2, *a2, *g2; __device__ __forceinline__ float operator()(int n, int k) const {
        if (n < 1024) return k < 64 ? w2[((size_t)(n >> 9) * 64 + k) * 512 + (n & 511)] : 0.f;
        if (n < 2048) return (k >= 64 && k < 128) ? a2[((size_t)((n - 1024) >> 9) * 64 + (k - 64)) * 512 + (n & 511)] : 0.f;
        return (k >= 128 && k < 288) ? g2[(size_t)(k - 128) * 512 + (n - 2048)] : 0.f; } };
__device__ __forceinline__ void p0_convert(Frame& F) {
    LAS float* scr = (LAS float*)(F.lds + 65536 + F.wave * 8704);
    const int gw = F.bid * 8 + F.wave, NGW = F.G * 8;
    constexpr int I_WIN = (1024 / 64) * (PW / 32), I_SQ = (1024 / 64) * (1024 / 32), I_LR = (LRK / 64) * (LRN / 32), I_ODIN = (1024 / 64) * (512 / 32), I_QUP = (256 / 64) * (1536 / 32), I_KVUP = (256 / 64) * (2048 / 32);
    constexpr int I_GU1 = (1024 / 64) * (2048 / 32), I_DN1 = (1024 / 64) * (1024 / 32);
    constexpr int NSMALL = I_WIN + I_SQ + I_LR + I_ODIN + I_QUP + I_KVUP + I_SQ;
    constexpr int NITEMS = NSMALL + 64 * I_GU1 + 64 * I_DN1;
    for (int it = gw; it < NITEMS; it += NGW) {
        int r = it;
        if (r < I_WIN) { cvt_item(VWin{F.in[I_EVWIN]}, wsp<bf16>(F, WS_WIN), 1024, r, PW / 32, scr, F.lane); continue; } r -= I_WIN;
        if (r < I_SQ) { cvt_item(VPlain{F.in[I_EVWOUT], 1024, 1024, 1024}, wsp<bf16>(F, WS_WOUT), 1024, r, 32, scr, F.lane); continue; } r -= I_SQ;
        if (r < I_LR) { cvt_item(VLr{F.in[I_W2], F.in[I_A2], F.in[I_G2]}, wsp<bf16>(F, WS_WLR), LRK, r, LRN / 32, scr, F.lane); continue; } r -= I_LR;
        if (r < I_ODIN) { cvt_item(VPlain{F.in[I_ODWIN], 448, 448, 1024}, wsp<bf16>(F, WS_WODIN), 1024, r, 16, scr, F.lane); continue; } r -= I_ODIN;
        if (r < I_QUP) { cvt_item(VQup{F.in[I_WQUP]}, wsp<bf16>(F, WS_WQUP), 256, r, 48, scr, F.lane); continue; } r -= I_QUP;
        if (r < I_KVUP) { cvt_item(VPlain{F.in[I_WKVUP], 2048, 2048, 128}, wsp<bf16>(F, WS_WKVUP), 256, r, 64, scr, F.lane); continue; } r -= I_KVUP;
        if (r < I_SQ) { cvt_item(VPlain{F.in[I_ODWOUT], 1024, 1024, 1024}, wsp<bf16>(F, WS_WODOUT), 1024, r, 32, scr, F.lane); continue; } r -= I_SQ;
        if (r < 64 * I_GU1) { const int le = r / I_GU1, ri = r % I_GU1; cvt_item(VGu{F.in[I_GUW] + (size_t)le * 1024 * 2048}, wsp<bf16>(F, WS_WGU) + (size_t)le * 2048 * 1024, 1024, ri, 64, scr, F.lane); continue; } r -= 64 * I_GU1;
        { const int le = r / I_DN1, ri = r % I_DN1; cvt_item(VPlain{F.in[I_DNW] + (size_t)le * 1024 * 1024, 1024, 1024, 1024}, wsp<bf16>(F, WS_WDN) + (size_t)le * 1024 * 1024, 1024, ri, 32, scr, F.lane); }
    }
}

struct RowV { f32x4 v[4]; };
__device__ __forceinline__ void row_load(RowV& r, const float* p, int lane) {
#pragma unroll
    for (int j = 0; j < 4; ++j) r.v[j] = ((const f32x4*)p)[lane + 64 * j];
}
__device__ __forceinline__ float row_ss(const RowV& r) {
    float s = 0.f;
#pragma unroll
    for (int j = 0; j < 4; ++j) s += (r.v[j].x * r.v[j].x + r.v[j].y * r.v[j].y) + (r.v[j].z * r.v[j].z + r.v[j].w * r.v[j].w);
    return wave_sum(s);
}
__device__ __forceinline__ void row_modulate(RowV& r, float rstd, const float* g, const float* sh, const float* sc, int lane) {
#pragma unroll
    for (int j = 0; j < 4; ++j) { const f32x4 gv = ((const f32x4*)g)[lane + 64 * j], shv = ((const f32x4*)sh)[lane + 64 * j], scv = ((const f32x4*)sc)[lane + 64 * j];
        r.v[j] = r.v[j] * rstd * gv * (scv + 1.0f) + shv; }
}
__device__ __forceinline__ void row_store_bf16(const RowV& r, bf16* p, int lane) {
#pragma unroll
    for (int j = 0; j < 4; ++j) { u32x2 w; w.x = cvt_pk_bf16(r.v[j].x, r.v[j].y); w.y = cvt_pk_bf16(r.v[j].z, r.v[j].w); ((u32x2*)p)[lane + 64 * j] = w; }
}
__device__ __forceinline__ void row_add_moe(RowV& r, const bf16* ys, int row, const float* gate, int lane) {
#pragma unroll
    for (int j = 0; j < 4; ++j) { f32x4 s = (f32x4){0.f, 0.f, 0.f, 0.f};
#pragma unroll
        for (int k = 0; k < 4; ++k) { const u32x2 w = ((const u32x2*)(ys + (size_t)(row * 4 + k) * 1024))[lane + 64 * j]; s.x += bflo(w.x); s.y += bfhi(w.x); s.z += bflo(w.y); s.w += bfhi(w.y); }
        const f32x4 gv = ((const f32x4*)gate)[lane + 64 * j]; r.v[j] = r.v[j] + gv * s; }
}
__device__ __forceinline__ const float* src_row_l0(const Frame& F, int row) { return row < NLAT ? F.in[I_X] + (size_t)row * 1024 : F.in[I_CTX] + (size_t)(row - NLAT) * 1024; }

__device__ __forceinline__ void p_norm1_l0(Frame& F) {
    const int gw = F.bid * 8 + F.wave, NGW = F.G * 8;
    for (int row = gw; row < NTOK; row += NGW) {
        RowV r; row_load(r, src_row_l0(F, row), F.lane);
        const float rstd = 1.f / sqrtf(row_ss(r) * (1.f / 1024.f) + 1e-6f);
        row_modulate(r, rstd, F.in[I_N1G], mod_ptr(F, 0, row, 0), mod_ptr(F, 0, row, 1), F.lane);
        row_store_bf16(r, wsp<bf16>(F, WS_H) + (size_t)row * 1024, F.lane);
    }
}
__device__ __forceinline__ void p_combine_norm1_l1(Frame& F) {
    const int gw = F.bid * 8 + F.wave, NGW = F.G * 8;
    for (int row = gw; row < NTOK; row += NGW) {
        float* xp = wsp<float>(F, WS_X1) + (size_t)row * 1024;
        RowV r; row_load(r, xp, F.lane);
        row_add_moe(r, wsp<const bf16>(F, WS_YS), row, mod_ptr(F, 0, row, 5), F.lane);
#pragma unroll
        for (int j = 0; j < 4; ++j) ((f32x4*)xp)[F.lane + 64 * j] = r.v[j];
        const float rstd = 1.f / sqrtf(row_ss(r) * (1.f / 1024.f) + 1e-6f);
        row_modulate(r, rstd, F.in[I_N1G] + 1024, mod_ptr(F, 1, row, 0), mod_ptr(F, 1, row, 1), F.lane);
        row_store_bf16(r, wsp<bf16>(F, WS_H) + (size_t)row * 1024, F.lane);
    }
}
__device__ __forceinline__ void p_final(Frame& F) {
    const int gw = F.bid * 8 + F.wave, NGW = F.G * 8;
    for (int row = gw; row < NLAT; row += NGW) {
        RowV r; row_load(r, wsp<const float>(F, WS_X1) + (size_t)row * 1024, F.lane);
        row_add_moe(r, wsp<const bf16>(F, WS_YS), row, mod_ptr(F, 1, row, 5), F.lane);
        const float rstd = 1.f / sqrtf(row_ss(r) * (1.f / 1024.f) + 1e-6f);
#pragma unroll
        for (int j = 0; j < 4; ++j) { const f32x4 gv = ((const f32x4*)F.in[I_FNG])[F.lane + 64 * j]; ((f32x4*)(F.out + (size_t)row * 1024))[F.lane + 64 * j] = r.v[j] * rstd * gv; }
    }
}

constexpr int RT_LDS_CNT = 131072;
constexpr int RT_LDS_SEL = 131072 + 256;
__device__ __forceinline__ void p_norm2_route(Frame& F, const int layer, const int ntok) {
    LAS float* wT = (LAS float*)F.lds;
    LAS int* cnt = (LAS int*)(F.lds + RT_LDS_CNT);
    LAS int* sel_e = (LAS int*)(F.lds + RT_LDS_SEL + F.wave * 32);
    LAS float* sel_l = (LAS float*)(F.lds + RT_LDS_SEL + F.wave * 32 + 16);
    const float* rw = F.in[I_RW] + (size_t)layer * 1024 * 32;
    for (int idx = F.tid; idx < 1024 * 32; idx += 512) { const int k = idx >> 5, e = idx & 31; wT[e * 1024 + k] = rw[idx]; }
    const int rpb = ntok / 256;
    unsigned char* rt = F.ws + WS_ROUTE;
    const float* g2 = F.in[I_N2G] + layer * 1024;
    const float br = F.in[I_RB][layer * 32 + ((F.lane >> 1) & 31)];
    for (int vb = F.bid; vb < 256; vb += F.G) {
        if (F.tid < 32) cnt[F.tid] = 0;
        __syncthreads();
        for (int rr = F.wave; rr < rpb; rr += 8) {
            const int row = vb * rpb + rr;
            RowV r; row_load(r, wsp<const float>(F, WS_X1) + (size_t)row * 1024, F.lane);
            const float rstd = 1.f / sqrtf(row_ss(r) * (1.f / 1024.f) + 1e-6f);
            row_modulate(r, rstd, g2, mod_ptr(F, layer, row, 3), mod_ptr(F, layer, row, 4), F.lane);
            row_store_bf16(r, wsp<bf16>(F, WS_H) + (size_t)row * 1024, F.lane);
            float a[32];
#pragma unroll
            for (int e = 0; e < 32; ++e) { float s = 0.f;
#pragma unroll
                for (int j = 0; j < 4; ++j) { const f32x4 w = *(const LAS f32x4*)(wT + e * 1024 + 256 * j + 4 * F.lane); s += (r.v[j].x * w.x + r.v[j].y * w.y) + (r.v[j].z * w.z + r.v[j].w * w.w); }
                a[e] = s; if ((e & 1) == 1) SBAR(); }
#pragma unroll
            for (int st = 0; st < 5; ++st) { const int off = 32 >> st, n = 16 >> st; const bool up = (F.lane & off) != 0;
#pragma unroll
                for (int i = 0; i < n; ++i) { const float send = up ? a[i] : a[i + n], keep = up ? a[i + n] : a[i]; a[i] = keep + __shfl_xor(send, off); } }
            float lg = a[0] + __shfl_xor(a[0], 1) + br;
            const int e = (F.lane >> 1) & 31;
            int rank = 0;
#pragma unroll
            for (int e2 = 0; e2 < 32; ++e2) { const float l2 = __shfl(lg, 2 * e2); rank += (l2 > lg || (l2 == lg && e2 < e)) ? 1 : 0; }
            if (rank < 4 && (F.lane & 1) == 0) { sel_e[rank] = e; sel_l[rank] = lg; }
            LDS_WAIT(); asm volatile("" ::: "memory");
            const float l0 = sel_l[0], l1 = sel_l[1], l2 = sel_l[2], l3 = sel_l[3];
            const float e0 = 1.f, e1 = __expf(l1 - l0), e2x = __expf(l2 - l0), e3 = __expf(l3 - l0);
            const float inv = 1.f / (e0 + e1 + e2x + e3);
            if (F.lane < 4) {
                const int ee = sel_e[F.lane]; const float gg = (F.lane == 0 ? e0 : F.lane == 1 ? e1 : F.lane == 2 ? e2x : e3) * inv;
                const int pos = __hip_atomic_fetch_add(cnt + ee, 1, __ATOMIC_RELAXED, __HIP_MEMORY_SCOPE_WORKGROUP);
                rt[RT_E + (size_t)row * 4 + F.lane] = (unsigned char)ee;
                ((unsigned short*)(rt + RT_POS))[(size_t)row * 4 + F.lane] = (unsigned short)pos;
                ((float*)(rt + RT_GATE))[(size_t)row * 4 + F.lane] = gg;
            }
            LDS_WAIT(); asm volatile("" ::: "memory");
        }
        __syncthreads();
        if (F.tid < 32) ((unsigned*)(rt + RT_HIST))[vb * 32 + F.tid] = (unsigned)cnt[F.tid];
        __syncthreads();
    }
}
constexpr int MT_OFF = 131072 + 1024;
__device__ __forceinline__ void moe_tables(Frame& F) {
    LAS int* tab = (LAS int*)(F.lds + MT_OFF);
    const unsigned* hist = (const unsigned*)(F.ws + WS_ROUTE + RT_HIST);
    if (F.tid < 32) { int c = 0; for (int b = 0; b < 256; ++b) c += (int)hist[b * 32 + F.tid]; tab[32 + F.tid] = c; }
    __syncthreads();
    if (F.tid == 0) { int s = 0; for (int e = 0; e < 32; ++e) { tab[e] = s; const int nb = (tab[32 + e] + 255) >> 8; for (int i = 0; i < nb; ++i) tab[128 + (s >> 8) + i] = e; s += nb << 8; } tab[64] = s >> 8; }
    __syncthreads();
}
__device__ __forceinline__ void p_moe_scatter(Frame& F, const int ntok) {
    moe_tables(F);
    LAS int* tab = (LAS int*)(F.lds + MT_OFF);
    LAS int* base = (LAS int*)(F.lds + MT_OFF + 8192);
    const unsigned* hist = (const unsigned*)(F.ws + WS_ROUTE + RT_HIST);
    const unsigned char* rt = F.ws + WS_ROUTE;
    unsigned* stok = wsp<unsigned>(F, WS_SORT); unsigned* sdst = stok + MAXSLOT; float* sgate = (float*)(sdst + MAXSLOT);
    const int rpb = ntok / 256;
    for (int vb = F.bid; vb < 256; vb += F.G) {
        if (F.tid < 32) { int c = 0; for (int b = 0; b < vb; ++b) c += (int)hist[b * 32 + F.tid]; base[F.tid] = tab[F.tid] + c; }
        __syncthreads();
        for (int i = F.tid; i < rpb * 4; i += 512) {
            const int row = vb * rpb + (i >> 2), k = i & 3; const size_t a = (size_t)row * 4 + k;
            const int e = rt[RT_E + a], pos = ((const unsigned short*)(rt + RT_POS))[a];
            const int slot = base[e] + pos;
            stok[slot] = (unsigned)row; sdst[slot] = (unsigned)(row * 4 + k); sgate[slot] = ((const float*)(rt + RT_GATE))[a];
        }
        if (vb < 32) { const int e = vb, c = tab[32 + e], s0 = tab[e] + c, s1 = tab[e] + (((c + 255) >> 8) << 8);
            for (int s = s0 + F.tid; s < s1; s += 512) { stok[s] = 0u; sdst[s] = (unsigned)YS_DUMMY; sgate[s] = 0.f; } }
        __syncthreads();
    }
}

namespace pg8 {
struct DenseSched {
    int nM, nN, nwg, G, c, K; const bf16* Bt;
    __device__ __forceinline__ void init(int M, int N, int K_, const bf16* Bt_, int G_, int c_) { nM = M / BM; nN = N / BM; nwg = nM * nN; G = G_; c = c_; K = K_; Bt = Bt_; }
    __device__ __forceinline__ bool next(int i, Unit& u) const {
        const long L = (long)i * G + c; if (L >= nwg) return false;
        int wgid = (int)L; { const int q = nwg / 8, r = nwg % 8, xcd = wgid % 8, off = wgid / 8; wgid = (xcd < r ? xcd * (q + 1) : r * (q + 1) + (xcd - r) * q) + off; }
        const int nig = 8 * nN, gid = wgid / nig, fm = gid * 8, gsz = (nM - fm) < 8 ? (nM - fm) : 8;
        u.pm = fm + ((wgid % nig) % gsz); u.pn = (wgid % nig) / gsz; return true;
    }
    __device__ __forceinline__ void a_offs(const Unit& u, unsigned (&ao)[2][2], const int (&R)[2], const int (&C)[2]) const {
#pragma unroll
        for (int h = 0; h < 2; ++h)
#pragma unroll
            for (int i = 0; i < 2; ++i) ao[h][i] = (unsigned)(((u.pm * BM + h * HALF + R[i]) * K + C[i]) * 2);
    }
    __device__ __forceinline__ const char* b_tile(const Unit& u) const { return (const char*)Bt + (size_t)u.pn * BM * K * 2; }
};
template <bool GATHER> struct MoeSched {
    int nrb, npn, G, c; const LAS int* blk_e; const unsigned* tok; const bf16* Wt; size_t wstride;
    __device__ __forceinline__ bool next(int i, Unit& u) const { const long L = (long)i * G + c; if (L >= (long)nrb * npn) return false; u.pm = (int)(L / npn); u.pn = (int)(L % npn); return true; }
    __device__ __forceinline__ void a_offs(const Unit& u, unsigned (&ao)[2][2], const int (&R)[2], const int (&C)[2]) const {
#pragma unroll
        for (int h = 0; h < 2; ++h)
#pragma unroll
            for (int i = 0; i < 2; ++i) { const int slot = u.pm * BM + h * HALF + R[i]; const unsigned row = GATHER ? tok[slot] : (unsigned)slot; ao[h][i] = (row * 1024u + (unsigned)C[i]) * 2u; }
    }
    __device__ __forceinline__ const char* b_tile(const Unit& u) const { return (const char*)(Wt + (size_t)blk_e[u.pm] * wstride + (size_t)u.pn * BM * 1024); }
};

struct MapPlain { bf16* O; int ld; __device__ __forceinline__ bf16* operator()(int row, int col) const { return O + (size_t)row * ld + col; } };
struct MapQ { bf16* Q; __device__ __forceinline__ bf16* operator()(int row, int col) const {
        const int b = row >> 13, t = row & 8191, h = col < 1024 ? (col >> 7) : ((col - 1024) >> 6), d = col < 1024 ? (col & 127) : 128 + ((col - 1024) & 63);
        return Q + ((size_t)((b * 8 + h) * SEQ + t)) * QKD + d; } };
struct MapKV { bf16* Kb; bf16* Vb; __device__ __forceinline__ bf16* operator()(int row, int col) const {
        const int b = row < NLAT ? (row >> 13) : ((row - NLAT) >> 8), key = row < NLAT ? CTXL + (row & 8191) : ((row - NLAT) & 255), h = col >> 8, w = col & 255;
        const size_t kr = (size_t)((b * 8 + h) * NKEY + key);
        return w < 128 ? Kb + kr * QKD + w : Vb + kr * VD + (w - 128); } };
template <class Map> struct EpiBf16 {
    static constexpr bool PERM = true; Map map;
    __device__ __forceinline__ void operator()(const f32x4 (&acc)[2][2][4][2], const Unit& u, int wr, int wc, int fr, int fq) const {
#pragma unroll
        for (int ai = 0; ai < 2; ++ai)
#pragma unroll
            for (int m = 0; m < 4; ++m) { const int row = u.pm * BM + ai * HALF + wr * 64 + m * 16 + fr;
#pragma unroll
                for (int bj = 0; bj < 2; ++bj) { const int col = u.pn * BM + bj * HALF + wc * 32 + 8 * fq; const f32x4 v0 = acc[ai][bj][m][0], v1 = acc[ai][bj][m][1];
                    u32x4 w; w.x = cvt_pk_bf16(v0[0], v0[1]); w.y = cvt_pk_bf16(v0[2], v0[3]); w.z = cvt_pk_bf16(v1[0], v1[1]); w.w = cvt_pk_bf16(v1[2], v1[3]);
                    *(u32x4*)map(row, col) = w; } }
    }
};
struct EpiF32 {
    static constexpr bool PERM = false; float* C; int ldc;
    __device__ __forceinline__ void operator()(const f32x4 (&acc)[2][2][4][2], const Unit& u, int wr, int wc, int fr, int fq) const {
#pragma unroll
        for (int ai = 0; ai < 2; ++ai)
#pragma unroll
            for (int m = 0; m < 4; ++m) { float* rowp = C + (size_t)(u.pm * BM + ai * HALF + wr * 64 + m * 16 + fr) * ldc + u.pn * BM + wc * 32 + 4 * fq;
#pragma unroll
                for (int bj = 0; bj < 2; ++bj)
#pragma unroll
                    for (int n = 0; n < 2; ++n) *(f32x4*)(rowp + bj * HALF + n * 16) = acc[ai][bj][m][n]; }
    }
};
struct EpiResid {
    static constexpr bool PERM = false; float* X1; const float* xlat; const float* xctx; const float* mod; int layer;
    __device__ __forceinline__ void operator()(const f32x4 (&acc)[2][2][4][2], const Unit& u, int wr, int wc, int fr, int fq) const {
#pragma unroll
        for (int ai = 0; ai < 2; ++ai)
#pragma unroll
            for (int m = 0; m < 4; ++m) { const int row = u.pm * BM + ai * HALF + wr * 64 + m * 16 + fr; const int col0 = u.pn * BM + wc * 32 + 4 * fq;
                const float* bp = (layer == 0) ? (row < NLAT ? xlat + (size_t)row * 1024 : xctx + (size_t)(row - NLAT) * 1024) : X1 + (size_t)row * 1024;
                const float* gp = mod + ((size_t)(layer * 9 + (row < NLAT ? (row >> 13) : 8)) * 6 + 2) * 1024;
                float* op = X1 + (size_t)row * 1024;
#pragma unroll
                for (int bj = 0; bj < 2; ++bj)
#pragma unroll
                    for (int n = 0; n < 2; ++n) { const int c = col0 + bj * HALF + n * 16; *(f32x4*)(op + c) = *(const f32x4*)(bp + c) + *(const f32x4*)(gp + c) * acc[ai][bj][m][n]; } }
    }
};
struct EpiSwiglu {
    static constexpr bool PERM = true; bf16* ACT; const float* bgu; const LAS int* blk_e;
    __device__ __forceinline__ void operator()(const f32x4 (&acc)[2][2][4][2], const Unit& u, int wr, int wc, int fr, int fq) const {
        const int e = blk_e[u.pm]; const int c0 = u.pn * 128 + wc * 32 + 8 * fq;
        const float* bg = bgu + (size_t)e * 2048 + c0;
        f32x4 bgl[2], bln[2];
#pragma unroll
        for (int n = 0; n < 2; ++n) { bgl[n] = *(const f32x4*)(bg + 4 * n); bln[n] = *(const f32x4*)(bg + 1024 + 4 * n); }
#pragma unroll
        for (int ai = 0; ai < 2; ++ai)
#pragma unroll
            for (int m = 0; m < 4; ++m) { const int slot = u.pm * BM + ai * HALF + wr * 64 + m * 16 + fr; float o[8];
#pragma unroll
                for (int n = 0; n < 2; ++n)
#pragma unroll
                    for (int j = 0; j < 4; ++j) { const float xg = fminf(acc[ai][0][m][n][j] + bgl[n][j], 7.0f); const float xl = fminf(fmaxf(acc[ai][1][m][n][j] + bln[n][j], -7.0f), 7.0f);
                        o[n * 4 + j] = xg * (1.f / (1.f + __expf(-1.702f * xg))) * (xl + 1.0f); }
                u32x4 w; w.x = cvt_pk_bf16(o[0], o[1]); w.y = cvt_pk_bf16(o[2], o[3]); w.z = cvt_pk_bf16(o[4], o[5]); w.w = cvt_pk_bf16(o[6], o[7]);
                *(u32x4*)(ACT + (size_t)slot * 1024 + c0) = w; }
    }
};
struct EpiDown {
    static constexpr bool PERM = true; bf16* YS; const float* bdn; const LAS int* blk_e; const unsigned* dst; const float* gate;
    __device__ __forceinline__ void operator()(const f32x4 (&acc)[2][2][4][2], const Unit& u, int wr, int wc, int fr, int fq) const {
        const int e = blk_e[u.pm]; const int c0 = u.pn * BM + wc * 32 + 8 * fq;
        f32x4 bv[2][2];
#pragma unroll
        for (int bj = 0; bj < 2; ++bj)
#pragma unroll
            for (int n = 0; n < 2; ++n) bv[bj][n] = *(const f32x4*)(bdn + (size_t)e * 1024 + c0 + bj * HALF + 4 * n);
#pragma unroll
        for (int ai = 0; ai < 2; ++ai)
#pragma unroll
            for (int m = 0; m < 4; ++m) { const int slot = u.pm * BM + ai * HALF + wr * 64 + m * 16 + fr; const float g = gate[slot]; bf16* op = YS + (size_t)dst[slot] * 1024 + c0;
#pragma unroll
                for (int bj = 0; bj < 2; ++bj) { const f32x4 v0 = (acc[ai][bj][m][0] + bv[bj][0]) * g, v1 = (acc[ai][bj][m][1] + bv[bj][1]) * g;
                    u32x4 w; w.x = cvt_pk_bf16(v0[0], v0[1]); w.y = cvt_pk_bf16(v0[2], v0[3]); w.z = cvt_pk_bf16(v1[0], v1[1]); w.w = cvt_pk_bf16(v1[2], v1[3]);
                    *(u32x4*)(op + bj * HALF) = w; } }
    }
};
}

__device__ __forceinline__ float ldbf(const bf16* p) { return bf2f((unsigned)*p); }
__device__ __forceinline__ void seq_pos(int row, bool& hp, bool& hn) { if (row < NLAT) { const int t = row & 8191; hp = t > 0; hn = t < SEQ - 1; } else { const int t = (row - NLAT) & 255; hp = t > 0; hn = t < CTXL - 1; } }

__device__ __forceinline__ void p_alr(Frame& F) {
    const int gw = F.bid * 8 + F.wave, NGW = F.G * 8;
    const bf16* P = wsp<const bf16>(F, WS_P); bf16* A = wsp<bf16>(F, WS_ALR); const float* mu = F.in[I_MU];
    for (int row = gw; row < NTOK; row += NGW) {
        bool hp, hn; seq_pos(row, hp, hn);
        const bf16* pr = P + (size_t)row * PW + RW0 + 1536;
#pragma unroll
        for (int q = 0; q < 6; ++q) { const int c = F.lane + 64 * q; float o = 0.f;
            if (c < 288) { const float p0 = ldbf(pr + c), pm = hp ? ldbf(pr + c - PW) : 0.f, pn = hn ? ldbf(pr + c + PW) : 0.f;
                const float xs = p0 + mu[1536 + c] * (pm - p0) + mu[RW_COLS + 1536 + c] * (pn - p0);
                o = c < 64 ? tanhf(xs) : (c < 128 ? xs : 1.f / (1.f + __expf(-xs))); }
            A[(size_t)row * LRK + c] = (bf16)f2bf(o); }
    }
}

constexpr int GL_QRAW = 0, GL_KRAW = 8192, GL_GDS = 16384, GL_QD = 20480, GL_KI = 29696, GL_KE = 38912, GL_AT = 48128, GL_VT = 57344, GL_ST = 61952, GL_GSUM = 71168, GL_DEC = 73216;
constexpr int GL_RS = 144;
__device__ __forceinline__ bf16x8 lds_frag(const LAS unsigned char* base, int row, int kbyte) { return *(const LAS bf16x8*)(base + row * GL_RS + kbyte); }
__device__ __forceinline__ void p_gla(Frame& F) {
    LAS unsigned char* L = F.lds;
    const bf16* P = wsp<const bf16>(F, WS_P);
    const int tid = F.tid, lane = F.lane, wave = F.wave, r32 = lane & 31, hi = lane >> 5;
    for (int id = F.bid; id < 256; id += F.G) {
        const int b = id >> 5, h = (id >> 3) & 3, dir = (id >> 2) & 1, vs = id & 3;
        const int dk = lane, tg = wave;
        float gkw[16];
#pragma unroll
        for (int r = 0; r < 16; ++r) gkw[r] = F.in[I_GKUP][(size_t)(dir * 16 + r) * 256 + h * 64 + dk];
        const float gkb = F.in[I_GKB][dir * 256 + h * 64 + dk];
        f32x16 Sacc;
#pragma unroll
        for (int r = 0; r < 16; ++r) Sacc[r] = 0.f;
        for (int i = tid; i < 4608 / 4; i += 512) ((LAS unsigned*)(L + GL_ST))[i] = 0u;
        bf16x8 qv, kv, gv, vv;
#define GLA_ROW(n, i) ((n) < 4 ? NLAT + b * 256 + (dir ? 3 - (n) : (n)) * 64 + (dir ? 63 - (i) : (i)) : b * 8192 + (dir ? 127 - ((n) - 4) : ((n) - 4)) * 64 + (dir ? 63 - (i) : (i)))
#define GLA_LOAD(n) do { const bf16* rp = P + (size_t)GLA_ROW(n, tid >> 3) * PW; qv = *(const bf16x8*)(rp + h * 64 + (tid & 7) * 8); kv = *(const bf16x8*)(rp + 256 + h * 64 + (tid & 7) * 8); \
        if (tid < 128) gv = *(const bf16x8*)(P + (size_t)GLA_ROW(n, tid >> 1) * PW + 1536 + (tid & 1) * 8); \
        if (tid < 256) vv = *(const bf16x8*)(P + (size_t)GLA_ROW(n, tid >> 2) * PW + 512 + h * 128 + vs * 32 + (tid & 3) * 8); } while (0)
        GLA_LOAD(0);
        __syncthreads();
        for (int n = 0; n < 132; ++n) {
            *(LAS bf16x8*)(L + GL_QRAW + (tid >> 3) * 128 + (tid & 7) * 16) = qv;
            *(LAS bf16x8*)(L + GL_KRAW + (tid >> 3) * 128 + (tid & 7) * 16) = kv;
            if (tid < 128) { LAS float* gp = (LAS float*)(L + GL_GDS) + (tid >> 1) * 16 + (tid & 1) * 8;
#pragma unroll
                for (int e = 0; e < 8; ++e) gp[e] = bf2f((unsigned)(unsigned short)gv[e]); }
            if (tid < 256) { const int i = tid >> 2;
#pragma unroll
                for (int e = 0; e < 8; ++e) *(LAS unsigned short*)(L + GL_VT + ((tid & 3) * 8 + e) * GL_RS + i * 2) = (unsigned short)vv[e]; }
            __syncthreads();
            if (n + 1 < 132) GLA_LOAD(n + 1);
            float Gl[8]; float cum = 0.f;
#pragma unroll
            for (int ii = 0; ii < 8; ++ii) { const LAS float* gp = (const LAS float*)(L + GL_GDS) + (tg * 8 + ii) * 16; float x = gkb;
#pragma unroll
                for (int r = 0; r < 16; ++r) x += gp[r] * gkw[r];
                const float ls = fminf(x, 0.f) - log1pf(__expf(-fabsf(x)));
                cum += ls * (1.f / 16.f); Gl[ii] = cum; }
            ((LAS float*)(L + GL_GSUM))[tg * 64 + dk] = cum;
            __syncthreads();
            float off = 0.f, tot = 0.f;
#pragma unroll
            for (int t2 = 0; t2 < 8; ++t2) { const float gs = ((const LAS float*)(L + GL_GSUM))[t2 * 64 + dk]; tot += gs; off += (t2 < tg) ? gs : 0.f; }
            unsigned kep[4];
#pragma unroll
            for (int ii = 0; ii < 8; ii += 2) { float kev[2];
#pragma unroll
                for (int z = 0; z < 2; ++z) { const int i = tg * 8 + ii + z; const float G = off + Gl[ii + z];
                    const float q = bf2f((unsigned)*(const LAS unsigned short*)(L + GL_QRAW + i * 128 + dk * 2)), k = bf2f((unsigned)*(const LAS unsigned short*)(L + GL_KRAW + i * 128 + dk * 2));
                    *(LAS unsigned short*)(L + GL_QD + i * GL_RS + dk * 2) = (unsigned short)f2bf(q * 0.125f * __expf(G));
                    *(LAS unsigned short*)(L + GL_KI + i * GL_RS + dk * 2) = (unsigned short)f2bf(k * __expf(-G));
                    kev[z] = k * __expf(tot - G); }
                kep[ii >> 1] = cvt_pk_bf16(kev[0], kev[1]); }
            *(LAS u32x4*)(L + GL_KE + dk * GL_RS + tg * 16) = (u32x4){kep[0], kep[1], kep[2], kep[3]};
            if (tg == 0) ((LAS float*)(L + GL_DEC))[dk] = __expf(tot);
            __syncthreads();
            if (wave < 4) { const int tj = wave & 1, ti = wave >> 1;
                f32x16 acc;
#pragma unroll
                for (int r = 0; r < 16; ++r) acc[r] = 0.f;
                if (!(ti == 0 && tj == 1)) {
#pragma unroll
                    for (int ks = 0; ks < 4; ++ks) acc = __builtin_amdgcn_mfma_f32_32x32x16_bf16(lds_frag(L + GL_KI, tj * 32 + r32, ks * 32 + hi * 16), lds_frag(L + GL_QD, ti * 32 + r32, ks * 32 + hi * 16), acc, 0, 0, 0);
                }
                const int i = ti * 32 + r32;
#pragma unroll
                for (int g = 0; g < 4; ++g) { const int j0 = tj * 32 + 8 * g + 4 * hi; float v4[4];
#pragma unroll
                    for (int z = 0; z < 4; ++z) v4[z] = (j0 + z <= i) ? acc[4 * g + z] : 0.f;
                    *(LAS u32x2*)(L + GL_AT + i * GL_RS + j0 * 2) = (u32x2){cvt_pk_bf16(v4[0], v4[1]), cvt_pk_bf16(v4[2], v4[3])}; } }
            __syncthreads();
            const LAS unsigned char* STc = L + GL_ST + (n & 1) * 4608; LAS unsigned char* STn = L + GL_ST + ((n + 1) & 1) * 4608;
            if (wave < 2) {
                const int ti = wave; f32x16 acc;
#pragma unroll
                for (int r = 0; r < 16; ++r) acc[r] = 0.f;
#pragma unroll
                for (int ks = 0; ks < 4; ++ks) acc = __builtin_amdgcn_mfma_f32_32x32x16_bf16(lds_frag(L + GL_AT, ti * 32 + r32, ks * 32 + hi * 16), lds_frag(L + GL_VT, r32, ks * 32 + hi * 16), acc, 0, 0, 0);
#pragma unroll
                for (int ks = 0; ks < 4; ++ks) acc = __builtin_amdgcn_mfma_f32_32x32x16_bf16(lds_frag(L + GL_QD, ti * 32 + r32, ks * 32 + hi * 16), lds_frag(STc, r32, ks * 32 + hi * 16), acc, 0, 0, 0);
                bf16* O = wsp<bf16>(F, WS_GLAO) + (size_t)dir * NTOK * 512 + h * 128 + vs * 32 + r32;
#pragma unroll
                for (int r = 0; r < 16; ++r) { const int i = ti * 32 + (r & 3) + 8 * (r >> 2) + 4 * hi; O[(size_t)GLA_ROW(n, i) * 512] = (bf16)f2bf(acc[r]); }
            } else if (wave < 4) {
                const int dt = wave - 2;
#pragma unroll
                for (int g = 0; g < 4; ++g) { const f32x4 dv = *(const LAS f32x4*)(L + GL_DEC + (dt * 32 + 8 * g + 4 * hi) * 4);
#pragma unroll
                    for (int z = 0; z < 4; ++z) Sacc[4 * g + z] *= dv[z]; }
#pragma unroll
                for (int ks = 0; ks < 4; ++ks) Sacc = __builtin_amdgcn_mfma_f32_32x32x16_bf16(lds_frag(L + GL_KE, dt * 32 + r32, ks * 32 + hi * 16), lds_frag(L + GL_VT, r32, ks * 32 + hi * 16), Sacc, 0, 0, 0);
#pragma unroll
                for (int g = 0; g < 4; ++g) *(LAS u32x2*)(STn + r32 * GL_RS + (dt * 32 + 8 * g + 4 * hi) * 2) = (u32x2){cvt_pk_bf16(Sacc[4 * g], Sacc[4 * g + 1]), cvt_pk_bf16(Sacc[4 * g + 2], Sacc[4 * g + 3])};
            }
            __syncthreads();
        }
#undef GLA_LOAD
#undef GLA_ROW
    }
}

template <int CTRL> __device__ __forceinline__ float dpp_add(float x) { const int xi = __builtin_bit_cast(int, x); const int yi = __builtin_amdgcn_update_dpp(xi, xi, CTRL, 0xf, 0xf, false); return x + __builtin_bit_cast(float, yi); }
__device__ __forceinline__ float red16(float x) { x = dpp_add<0xB1>(x); x = dpp_add<0x4E>(x); x = dpp_add<0x141>(x); x = dpp_add<0x140>(x); return x; }
constexpr int RW_T = 32;
constexpr int RW_BUF = RW_T * 6 * 64 * 4;
constexpr int RW_YB = 2 * RW_BUF;
__device__ __forceinline__ void p_rwkv_scan(Frame& F) {
    LAS unsigned char* L = F.lds;
    const bf16* P = wsp<const bf16>(F, WS_P); const bf16* LO = wsp<const bf16>(F, WS_LOUT);
    const int tid = F.tid, lane = F.lane, wave = F.wave;
    for (int id = F.bid; id < 256; id += F.G) {
        const int b = id >> 5, h = (id >> 2) & 7, dir = (id >> 1) & 1, rh = id & 1;
        const int hj = h * 64 + lane;
        const float* mu = F.in[I_MU];
        const float cpr = mu[hj], cnr = mu[RW_COLS + hj], cpk = mu[512 + hj], cnk = mu[RW_COLS + 512 + hj], cpv = mu[1024 + hj], cnv = mu[RW_COLS + 1024 + hj];
        const float w0v = F.in[I_W0][dir * 512 + hj], a0v = F.in[I_A0][dir * 512 + hj], kkc = F.in[I_KK][hj], kac = F.in[I_KA][hj], rkc = F.in[I_RK][hj];
#define RW_ROW(s) ((s) < 256 ? NLAT + b * 256 + (dir ? 255 - (s) : (s)) : b * 8192 + (dir ? 8191 - ((s) - 256) : ((s) - 256)))
        unsigned short ld[4][11];
#define RW_LOAD(rd) do { _Pragma("unroll") for (int q = 0; q < 4; ++q) { const int s = (rd) * RW_T + wave * 4 + q; const int row = RW_ROW(s); bool hp, hn; seq_pos(row, hp, hn); \
            const bf16* pr = P + (size_t)row * PW + RW0 + hj; \
            _Pragma("unroll") for (int c = 0; c < 3; ++c) { ld[q][3 * c] = pr[512 * c]; ld[q][3 * c + 1] = hp ? pr[512 * c - PW] : (unsigned short)0; ld[q][3 * c + 2] = hn ? pr[512 * c + PW] : (unsigned short)0; } \
            const bf16* lr = LO + (size_t)row * LRN + dir * 512 + hj; ld[q][9] = lr[0]; ld[q][10] = lr[1024]; } } while (0)
#define RW_FEAT(rd, buf) do { _Pragma("unroll") for (int q = 0; q < 4; ++q) { const int st = wave * 4 + q; const int s = (rd) * RW_T + st; \
            const float r0 = bf2f(ld[q][0]), k0 = bf2f(ld[q][3]), v0 = bf2f(ld[q][6]); \
            const float xr = r0 + cpr * (bf2f(ld[q][1]) - r0) + cnr * (bf2f(ld[q][2]) - r0); \
            const float xk = k0 + cpk * (bf2f(ld[q][4]) - k0) + cnk * (bf2f(ld[q][5]) - k0); \
            const float xv = v0 + cpv * (bf2f(ld[q][7]) - v0) + cnv * (bf2f(ld[q][8]) - v0); \
            const float z = -(w0v + bf2f(ld[q][9])); const float sp = fmaxf(z, 0.f) + log1pf(__expf(-fabsf(z))); \
            const float wdec = __expf(-__expf(-sp - 0.5f)); \
            const float alr = 1.f / (1.f + __expf(-(a0v + bf2f(ld[q][10])))); \
            const float kkv = xk * kkc; const float nrm = sqrtf(wave_sum(kkv * kkv)); const float kk = kkv / fmaxf(nrm, 1e-12f); \
            const float kd = xk * (1.f + (alr - 1.f) * kac); \
            const float bon = wave_sum(xr * kd * rkc); \
            if (rh == 0 && lane == 0) wsp<float>(F, WS_BONUS)[((size_t)dir * NTOK + RW_ROW(s)) * 8 + h] = bon; \
            LAS float* o = (LAS float*)(L + (buf) * RW_BUF) + st * 384 + lane; \
            o[0] = wdec; o[64] = -kk; o[128] = kk * alr; o[192] = kd; o[256] = xr; o[320] = xv; } } while (0)
        const int rowl = wave * 4 + (lane >> 4), jl = lane & 15;
        float s0 = 0.f, s1 = 0.f, s2 = 0.f, s3 = 0.f;
        RW_LOAD(0); RW_FEAT(0, 0);
        __syncthreads();
        constexpr int NRD = (CTXL + SEQ) / RW_T;
        for (int rd = 0; rd < NRD; ++rd) {
            if (rd + 1 < NRD) RW_LOAD(rd + 1);
            const LAS float* sb = (const LAS float*)(L + (rd & 1) * RW_BUF);
            LAS float* yb = (LAS float*)(L + RW_YB);
#pragma unroll 4
            for (int st = 0; st < RW_T; ++st) {
                const LAS float* p = sb + st * 384;
                const f32x4 w4 = *(const LAS f32x4*)(p + 4 * jl), a4 = *(const LAS f32x4*)(p + 64 + 4 * jl), b4 = *(const LAS f32x4*)(p + 128 + 4 * jl), k4 = *(const LAS f32x4*)(p + 192 + 4 * jl), r4 = *(const LAS f32x4*)(p + 256 + 4 * jl);
                const float vv = p[320 + rh * 32 + rowl];
                const float sa = red16((s0 * a4.x + s1 * a4.y) + (s2 * a4.z + s3 * a4.w));
                s0 = s0 * w4.x + (sa * b4.x + vv * k4.x); s1 = s1 * w4.y + (sa * b4.y + vv * k4.y); s2 = s2 * w4.z + (sa * b4.z + vv * k4.z); s3 = s3 * w4.w + (sa * b4.w + vv * k4.w);
                const float y = red16((s0 * r4.x + s1 * r4.y) + (s2 * r4.z + s3 * r4.w));
                if (jl == 0) yb[st * 32 + rowl] = y;
            }
            __syncthreads();
            { const int st = tid >> 4, r2 = (tid & 15) * 2; const int s = rd * RW_T + st;
              *(unsigned*)(wsp<bf16>(F, WS_RWY) + ((size_t)dir * NTOK + RW_ROW(s)) * 512 + h * 64 + rh * 32 + r2) = cvt_pk_bf16(yb[st * 32 + r2], yb[st * 32 + r2 + 1]); }
            if (rd + 1 < NRD) RW_FEAT(rd + 1, (rd + 1) & 1);
            __syncthreads();
        }
#undef RW_LOAD
#undef RW_FEAT
#undef RW_ROW
    }
}

__device__ __forceinline__ void p_mix_finish(Frame& F) {
    const int gw = F.bid * 8 + F.wave, NGW = F.G * 8, lane = F.lane;
    const bf16* P = wsp<const bf16>(F, WS_P); const bf16* LO = wsp<const bf16>(F, WS_LOUT);
    const bf16* GO = wsp<const bf16>(F, WS_GLAO); const bf16* RY = wsp<const bf16>(F, WS_RWY); const float* BON = wsp<const float>(F, WS_BONUS);
    bf16* MIX = wsp<bf16>(F, WS_H);
    const int c0 = lane * 8;
    float gng[8], lnw[8], lnb[8], cpv[8], cnv[8];
#pragma unroll
    for (int e = 0; e < 8; ++e) { gng[e] = F.in[I_GNG][(c0 + e) & 127]; lnw[e] = F.in[I_LNW][c0 + e]; lnb[e] = F.in[I_LNB][c0 + e]; cpv[e] = F.in[I_MU][1024 + c0 + e]; cnv[e] = F.in[I_MU][RW_COLS + 1024 + c0 + e]; }
    for (int row = gw; row < NTOK; row += NGW) {
        { const u32x4 a = *(const u32x4*)(GO + (size_t)row * 512 + c0), bb = *(const u32x4*)(GO + ((size_t)NTOK + row) * 512 + c0), og = *(const u32x4*)(P + (size_t)row * PW + 1024 + c0);
          float o[8]; float ss = 0.f;
#pragma unroll
          for (int e = 0; e < 4; ++e) { o[2 * e] = bflo(a[e]) + bflo(bb[e]); o[2 * e + 1] = bfhi(a[e]) + bfhi(bb[e]); ss += o[2 * e] * o[2 * e] + o[2 * e + 1] * o[2 * e + 1]; }
          ss += __shfl_xor(ss, 1); ss += __shfl_xor(ss, 2); ss += __shfl_xor(ss, 4); ss += __shfl_xor(ss, 8);
          const float rstd = 1.f / sqrtf(ss * (1.f / 128.f) + 1e-6f);
          float y[8];
#pragma unroll
          for (int e = 0; e < 4; ++e) { const float g0 = bflo(og[e]), g1 = bfhi(og[e]);
              y[2 * e] = o[2 * e] * rstd * gng[2 * e] * (g0 / (1.f + __expf(-g0))); y[2 * e + 1] = o[2 * e + 1] * rstd * gng[2 * e + 1] * (g1 / (1.f + __expf(-g1))); }
          *(u32x4*)(MIX + (size_t)row * 1024 + c0) = (u32x4){cvt_pk_bf16(y[0], y[1]), cvt_pk_bf16(y[2], y[3]), cvt_pk_bf16(y[4], y[5]), cvt_pk_bf16(y[6], y[7])}; }
        { bool hp, hn; seq_pos(row, hp, hn);
          const u32x4 a = *(const u32x4*)(RY + (size_t)row * 512 + c0), bb = *(const u32x4*)(RY + ((size_t)NTOK + row) * 512 + c0);
          const bf16* pv = P + (size_t)row * PW + RW0 + 1024 + c0;
          const u32x4 v0 = *(const u32x4*)pv; u32x4 vm = (u32x4){0u, 0u, 0u, 0u}, vn = (u32x4){0u, 0u, 0u, 0u};
          if (hp) vm = *(const u32x4*)(pv - PW); if (hn) vn = *(const u32x4*)(pv + PW);
          const u32x4 gg = *(const u32x4*)(LO + (size_t)row * LRN + 2048 + c0);
          const int hd = lane >> 3; const float bon = BON[(size_t)row * 8 + hd] + BON[((size_t)NTOK + row) * 8 + hd];
          float yv[8]; float sm = 0.f;
#pragma unroll
          for (int e = 0; e < 4; ++e) { yv[2 * e] = bflo(a[e]) + bflo(bb[e]); yv[2 * e + 1] = bfhi(a[e]) + bfhi(bb[e]); sm += yv[2 * e] + yv[2 * e + 1]; }
          sm += __shfl_xor(sm, 1); sm += __shfl_xor(sm, 2); sm += __shfl_xor(sm, 4);
          const float mean = sm * (1.f / 64.f); float sv = 0.f;
#pragma unroll
          for (int e = 0; e < 8; ++e) { const float d = yv[e] - mean; sv += d * d; }
          sv += __shfl_xor(sv, 1); sv += __shfl_xor(sv, 2); sv += __shfl_xor(sv, 4);
          const float rstd = 1.f / sqrtf(sv * (1.f / 64.f) + 64e-5f);
          float o[8];
#pragma unroll
          for (int e = 0; e < 8; ++e) { const unsigned w0 = v0[e >> 1], wm = vm[e >> 1], wn = vn[e >> 1];
              const float p0 = (e & 1) ? bfhi(w0) : bflo(w0), pm = (e & 1) ? bfhi(wm) : bflo(wm), pn = (e & 1) ? bfhi(wn) : bflo(wn);
              const float xv = p0 + cpv[e] * (pm - p0) + cnv[e] * (pn - p0);
              const float g = (e & 1) ? bfhi(gg[e >> 1]) : bflo(gg[e >> 1]);
              o[e] = ((yv[e] - mean) * rstd * lnw[e] + lnb[e] + bon * xv) * g; }
          *(u32x4*)(MIX + (size_t)row * 1024 + 512 + c0) = (u32x4){cvt_pk_bf16(o[0], o[1]), cvt_pk_bf16(o[2], o[3]), cvt_pk_bf16(o[4], o[5]), cvt_pk_bf16(o[6], o[7])}; }
    }
}

__device__ __forceinline__ void p_mla_prep(Frame& F) {
    const int gw = F.bid * 8 + F.wave, NGW = F.G * 8, lane = F.lane;
    const float* C = wsp<const float>(F, WS_C); bf16* QN = wsp<bf16>(F, WS_QN); bf16* KVN = wsp<bf16>(F, WS_KVN); bf16* Kb = wsp<bf16>(F, WS_K);
    const f32x2* ROPE = wsp<const f32x2>(F, WS_ROPE);
    const f32x4 qg = ((const f32x4*)F.in[I_QNORM])[lane]; const f32x4 kg = ((const f32x4*)F.in[I_KVNORM])[lane & 31];
    for (int row = gw; row < NTOK; row += NGW) {
        const float* cr = C + (size_t)row * 512;
        const f32x4 cq = ((const f32x4*)cr)[lane];
        const f32x4 ck = ((const f32x4*)(cr + 256))[lane & 31];
        const float xr = cr[384 + lane];
        const float ssq = wave_sum((cq.x * cq.x + cq.y * cq.y) + (cq.z * cq.z + cq.w * cq.w));
        const float ssk = wave_sum(lane < 32 ? (ck.x * ck.x + ck.y * ck.y) + (ck.z * ck.z + ck.w * ck.w) : 0.f);
        if (row < NLAT) { const float rs = 1.f / sqrtf(ssq * (1.f / 256.f) + 1e-6f);
            ((u32x2*)(QN + (size_t)row * 256))[lane] = (u32x2){cvt_pk_bf16(cq.x * rs * qg.x, cq.y * rs * qg.y), cvt_pk_bf16(cq.z * rs * qg.z, cq.w * rs * qg.w)}; }
        { const float rs = 1.f / sqrtf(ssk * (1.f / 128.f) + 1e-6f);
          u32x2 w = (u32x2){0u, 0u};
          if (lane < 32) w = (u32x2){cvt_pk_bf16(ck.x * rs * kg.x, ck.y * rs * kg.y), cvt_pk_bf16(ck.z * rs * kg.z, ck.w * rs * kg.w)};
          ((u32x2*)(KVN + (size_t)row * 256))[lane] = w; }
        float kr = xr; int b, key;
        const float pr = __shfl_xor(xr, 16);
        if (row < NLAT) { b = row >> 13; const int t = row & 8191; key = CTXL + t;
            const f32x2 cs = ROPE[t * 32 + ((lane >> 5) << 4) + (lane & 15)];
            kr = (lane & 16) ? xr * cs.x + pr * cs.y : xr * cs.x - pr * cs.y;
        } else { b = (row - NLAT) >> 8; key = (row - NLAT) & 255; }
        const bf16 kb = (bf16)f2bf(kr);
#pragma unroll
        for (int h = 0; h < 8; ++h) Kb[((size_t)((b * 8 + h) * NKEY + key)) * QKD + 128 + lane] = kb;
    }
}
__device__ __forceinline__ void p_q_rope(Frame& F) {
    const int gw = F.bid * 8 + F.wave, NGW = F.G * 8, lane = F.lane;
    bf16* Q = wsp<bf16>(F, WS_Q); const f32x2* ROPE = wsp<const f32x2>(F, WS_ROPE);
    for (int it = gw; it < NB * MH * SEQ; it += NGW) {
        const int t = it & 8191;
        bf16* qp = Q + (size_t)it * QKD + 128 + lane;
        const float x = bf2f((unsigned)*qp), pr = __shfl_xor(x, 16);
        const f32x2 cs = ROPE[t * 32 + ((lane >> 5) << 4) + (lane & 15)];
        *qp = (bf16)f2bf((lane & 16) ? x * cs.x + pr * cs.y : x * cs.x - pr * cs.y);
    }
}

namespace att {
constexpr float SCALE = 0.07216878364870322f;
constexpr float THR = 8.f;
constexpr int KT = 64 * QKD * 2, VT = 64 * VD * 2;
constexpr int LDS_K = 0, LDS_V = 3 * KT, LDS_WS = LDS_V + 3 * VT;
constexpr int NT = NKEY / 64;
__device__ __forceinline__ int crow(int r, int hi) { return (r & 3) + 8 * (r >> 2) + 4 * hi; }
__device__ __forceinline__ int kswz(int row, int colB) { return row * 384 + (colB ^ (((row >> 1) & 7) << 4)); }
__device__ __forceinline__ void partialSM(f32x16& p0, f32x16& p1, float& m_reg, float& mn, float& alpha) {
    constexpr float C = SCALE * 1.4426950408889634f;
    float pmax = p0[0];
#pragma unroll
    for (int r = 1; r < 16; ++r) pmax = fmaxf(pmax, p0[r]);
#pragma unroll
    for (int r = 0; r < 16; ++r) pmax = fmaxf(pmax, p1[r]);
    { auto rr = __builtin_amdgcn_permlane32_swap(__float_as_uint(pmax), __float_as_uint(pmax), false, false); pmax = fmaxf(__uint_as_float(rr[0]), __uint_as_float(rr[1])); }
    if (__builtin_expect(__all(pmax - m_reg <= THR / SCALE), 1)) { mn = m_reg; alpha = 1.f; }
    else { mn = fmaxf(m_reg, pmax); alpha = __builtin_amdgcn_exp2f((m_reg - mn) * C); m_reg = mn; }
    const float mnC = -mn * C;
#pragma unroll
    for (int r = 0; r < 16; ++r) p0[r] = fmaf(p0[r], C, mnC);
#pragma unroll
    for (int r = 0; r < 16; ++r) p1[r] = fmaf(p1[r], C, mnC);
#pragma unroll
    for (int r = 0; r < 16; ++r) p0[r] = __builtin_amdgcn_exp2f(p0[r]);
}
__device__ __forceinline__ void finishSM(f32x16& p0, f32x16& p1, float alpha, float& l_reg, bf16x8& pa0, bf16x8& pa1, bf16x8& pa2, bf16x8& pa3) {
#pragma unroll
    for (int r = 0; r < 16; ++r) p1[r] = __builtin_amdgcn_exp2f(p1[r]);
    float ps = 0;
#pragma unroll
    for (int r = 0; r < 16; ++r) ps += p0[r];
#pragma unroll
    for (int r = 0; r < 16; ++r) ps += p1[r];
    { auto rr = __builtin_amdgcn_permlane32_swap(__float_as_uint(ps), __float_as_uint(ps), false, false); ps = __uint_as_float(rr[0]) + __uint_as_float(rr[1]); }
    l_reg = l_reg * alpha + ps;
#define PK4(P, BASE, OUT) do { unsigned a0 = cvt_pk_bf16(P[BASE + 0], P[BASE + 1]), a1 = cvt_pk_bf16(P[BASE + 2], P[BASE + 3]);   \
    unsigned b0 = cvt_pk_bf16(P[BASE + 4], P[BASE + 5]), b1 = cvt_pk_bf16(P[BASE + 6], P[BASE + 7]);                              \
    auto r0 = __builtin_amdgcn_permlane32_swap(a0, b0, false, false); auto r1 = __builtin_amdgcn_permlane32_swap(a1, b1, false, false); \
    u32x4 w = {r0[0], r1[0], r0[1], r1[1]}; OUT = *reinterpret_cast<bf16x8*>(&w); } while (0)
    PK4(p0, 0, pa0); PK4(p0, 8, pa1); PK4(p1, 0, pa2); PK4(p1, 8, pa3);
#undef PK4
}
__device__ __forceinline__ void qkt(f32x16& p0, f32x16& p1, const LAS unsigned char* Ks, const bf16x8 (&qr)[12], int r32, int hi) {
#pragma unroll
    for (int r = 0; r < 16; ++r) { p0[r] = 0.f; p1[r] = 0.f; }
#pragma unroll
    for (int d0 = 0; d0 < 12; ++d0) { const int cb = (d0 * 16 + hi * 8) * 2;
        const bf16x8 b0 = *(const LAS bf16x8*)(Ks + kswz(r32, cb));
        const bf16x8 b1 = *(const LAS bf16x8*)(Ks + kswz(32 + r32, cb));
        p0 = __builtin_amdgcn_mfma_f32_32x32x16_bf16(b0, qr[d0], p0, 0, 0, 0);
        p1 = __builtin_amdgcn_mfma_f32_32x32x16_bf16(b1, qr[d0], p1, 0, 0, 0); }
}
__device__ __forceinline__ int v_rd_base(int lane) { return ((lane & 3) << 3) | (((lane >> 2) & 3) << 6) | (((lane >> 4) & 1) << 5) | (((lane >> 5) & 1) << 8); }
constexpr int v_rd_off(int d0, int ks, int half) { return d0 * 512 + ks * 4096 + half * 2048; }
template <int OFF> __device__ __forceinline__ s16x4 tr_read(int vb) { s16x4 r; asm volatile("ds_read_b64_tr_b16 %0, %1 offset:%2" : "=&v"(r) : "v"(vb), "i"(OFF) : "memory"); return r; }
template <int D0> __device__ __forceinline__ void pv_one(f32x16& od, int vb, bf16x8 pa0, bf16x8 pa1, bf16x8 pa2, bf16x8 pa3) {
    const s16x4 l0 = tr_read<v_rd_off(D0, 0, 0)>(vb), h0 = tr_read<v_rd_off(D0, 0, 1)>(vb), l1 = tr_read<v_rd_off(D0, 1, 0)>(vb), h1 = tr_read<v_rd_off(D0, 1, 1)>(vb);
    const s16x4 l2 = tr_read<v_rd_off(D0, 2, 0)>(vb), h2 = tr_read<v_rd_off(D0, 2, 1)>(vb), l3 = tr_read<v_rd_off(D0, 3, 0)>(vb), h3 = tr_read<v_rd_off(D0, 3, 1)>(vb);
    asm volatile("s_waitcnt lgkmcnt(0)" ::: "memory"); SBAR();
#define PK(Lo, Hi) (bf16x8){Lo[0], Lo[1], Lo[2], Lo[3], Hi[0], Hi[1], Hi[2], Hi[3]}
    od = __builtin_amdgcn_mfma_f32_32x32x16_bf16(pa0, PK(l0, h0), od, 0, 0, 0);
    od = __builtin_amdgcn_mfma_f32_32x32x16_bf16(pa1, PK(l1, h1), od, 0, 0, 0);
    od = __builtin_amdgcn_mfma_f32_32x32x16_bf16(pa2, PK(l2, h2), od, 0, 0, 0);
    od = __builtin_amdgcn_mfma_f32_32x32x16_bf16(pa3, PK(l3, h3), od, 0, 0, 0);
#undef PK
}
__device__ __forceinline__ void pv_d0(f32x16 (&o)[4], int vb, bf16x8 pa0, bf16x8 pa1, bf16x8 pa2, bf16x8 pa3) {
    pv_one<0>(o[0], vb, pa0, pa1, pa2, pa3); pv_one<1>(o[1], vb, pa0, pa1, pa2, pa3); pv_one<2>(o[2], vb, pa0, pa1, pa2, pa3); pv_one<3>(o[3], vb, pa0, pa1, pa2, pa3);
}
__device__ __forceinline__ void glds16(const void* gsrc, LAS unsigned char* lds_wave_base) { unsigned keep; const unsigned dst = (unsigned)__builtin_amdgcn_readfirstlane((int)(uintptr_t)lds_wave_base);
    asm volatile("s_mov_b32 %0, m0\n\ts_mov_b32 m0, %2\n\ts_nop 0\n\tglobal_load_lds_dwordx4 %1, off\n\ts_mov_b32 m0, %0" : "=&s"(keep) : "v"(gsrc), "s"(dst) : "memory"); }

__device__ __forceinline__ void unit(const bf16* __restrict__ Qb, const bf16* __restrict__ Kh, const bf16* __restrict__ Vh, bf16* __restrict__ Ob, LAS unsigned char* lds, int tid) {
    const int wid = __builtin_amdgcn_readfirstlane(tid >> 6), lane = tid & 63, r32 = lane & 31, hi = lane >> 5;
    LAS float* ws = (LAS float*)(lds + LDS_WS) + wid * 64; LAS float* li_l = ws; LAS float* al_l = ws + 32;
    float m_reg = -1e30f, l_reg = 0.f; f32x16 o[4]; bf16x8 qr[12];
#pragma unroll
    for (int d = 0; d < 4; ++d)
#pragma unroll
        for (int r = 0; r < 16; ++r) o[d][r] = 0.f;
    const bf16* Qw = Qb + (size_t)(wid * 32 + r32) * QKD + hi * 8;
#pragma unroll
    for (int d0 = 0; d0 < 12; ++d0) qr[d0] = *(const bf16x8*)(Qw + d0 * 16);
    unsigned koff[3], voff[2];
#pragma unroll
    for (int i = 0; i < 3; ++i) { const int s = (i * 8 + wid) * 64 + lane, row = s / 24, cpos = s % 24, c = cpos ^ ((row >> 1) & 7); koff[i] = (unsigned)(row * 384 + c * 16); }
#pragma unroll
    for (int i = 0; i < 2; ++i) { const int s = (i * 8 + wid) * 64 + lane, sub = s >> 5, kkh = sub >> 2, cg = sub & 3, kkl = (s & 31) >> 2, cin = (s & 3) * 8, kk = kkh * 8 + kkl;
        const int k = (kk & ~0xC) | ((kk & 4) << 1) | ((kk & 8) >> 1); voff[i] = (unsigned)(k * 256 + (cg * 32 + cin) * 2); }
    const char* Kc = (const char*)Kh; const char* Vc = (const char*)Vh;
#define DMA_K(j, slot) do { _Pragma("unroll") for (int _i = 0; _i < 3; ++_i) glds16(Kc + (size_t)(j) * KT + koff[_i], lds + LDS_K + (slot) * KT + (_i * 8 + wid) * 1024); } while (0)
#define DMA_V(j, slot) do { _Pragma("unroll") for (int _i = 0; _i < 2; ++_i) glds16(Vc + (size_t)(j) * VT + voff[_i], lds + LDS_V + (slot) * VT + (_i * 8 + wid) * 1024); } while (0)
#define WAITBAR(n) asm volatile("s_waitcnt vmcnt(" #n ")\n\ts_barrier" ::: "memory")
#define RESC(a) do { if (__any((a) < 1.f)) { if (hi == 0) al_l[r32] = (a); asm volatile("s_waitcnt lgkmcnt(0)" ::: "memory"); \
    _Pragma("unroll") for (int d = 0; d < 4; ++d) _Pragma("unroll") for (int r = 0; r < 16; ++r) o[d][r] *= al_l[crow(r, hi)]; } } while (0)
    const int vb0 = (int)(uintptr_t)(lds + LDS_V) + v_rd_base(lane);
    f32x16 pA0, pA1, pB0, pB1; float mnA, mnB, alA, alB; bf16x8 pa0, pa1, pa2, pa3;
    asm volatile("s_barrier" ::: "memory");
    DMA_K(0, 0); DMA_K(1, 1); DMA_V(0, 0);
    WAITBAR(5);
    DMA_K(2, 2); DMA_V(1, 1);
    qkt(pA0, pA1, lds + LDS_K, qr, r32, hi); partialSM(pA0, pA1, m_reg, mnA, alA);
    WAITBAR(5);
    int ks = 1, vs = 0;
    for (int j = 1; j + 1 < NT; j += 2) {
        { const int k2 = ks == 0 ? 2 : ks - 1, v2 = vs == 0 ? 2 : vs - 1; DMA_K(j + 2, k2); DMA_V(j + 1, v2); }
        SBAR(); qkt(pB0, pB1, lds + LDS_K + ks * KT, qr, r32, hi);
        finishSM(pA0, pA1, alA, l_reg, pa0, pa1, pa2, pa3); SBAR();
        pv_d0(o, vb0 + vs * VT, pa0, pa1, pa2, pa3); partialSM(pB0, pB1, m_reg, mnB, alB);
        RESC(alB);
        WAITBAR(5);
        ks = ks == 2 ? 0 : ks + 1; vs = vs == 2 ? 0 : vs + 1;
        { const int k2 = ks == 0 ? 2 : ks - 1, v2 = vs == 0 ? 2 : vs - 1; if (j + 3 < NT) DMA_K(j + 3, k2); DMA_V(j + 2, v2); }
        SBAR(); qkt(pA0, pA1, lds + LDS_K + ks * KT, qr, r32, hi);
        finishSM(pB0, pB1, alB, l_reg, pa0, pa1, pa2, pa3); SBAR();
        pv_d0(o, vb0 + vs * VT, pa0, pa1, pa2, pa3); partialSM(pA0, pA1, m_reg, mnA, alA);
        RESC(alA);
        if (j + 3 < NT) WAITBAR(5); else WAITBAR(0);
        ks = ks == 2 ? 0 : ks + 1; vs = vs == 2 ? 0 : vs + 1;
    }
    SBAR(); qkt(pB0, pB1, lds + LDS_K + ks * KT, qr, r32, hi);
    finishSM(pA0, pA1, alA, l_reg, pa0, pa1, pa2, pa3); SBAR();
    pv_d0(o, vb0 + vs * VT, pa0, pa1, pa2, pa3); partialSM(pB0, pB1, m_reg, mnB, alB);
    RESC(alB);
    vs = vs == 2 ? 0 : vs + 1;
    finishSM(pB0, pB1, alB, l_reg, pa0, pa1, pa2, pa3); SBAR();
    pv_d0(o, vb0 + vs * VT, pa0, pa1, pa2, pa3);
    if (hi == 0) li_l[r32] = l_reg; asm volatile("s_waitcnt lgkmcnt(0)" ::: "memory");
    float rli[16];
#pragma unroll
    for (int r = 0; r < 16; ++r) rli[r] = __builtin_amdgcn_rcpf(li_l[crow(r, hi)]);
    bf16* Ow = Ob + (size_t)(wid * 32) * 1024;
#pragma unroll
    for (int r = 0; r < 16; ++r) { const int orow = crow(r, hi);
#pragma unroll
        for (int d0 = 0; d0 < 4; ++d0) Ow[(size_t)orow * 1024 + d0 * 32 + r32] = (bf16)f2bf(o[d0][r] * rli[r]); }
#undef DMA_K
#undef DMA_V
#undef WAITBAR
#undef RESC
}
}
__device__ __forceinline__ void p_attention(Frame& F) {
    const bf16* Q = wsp<const bf16>(F, WS_Q); const bf16* Kb = wsp<const bf16>(F, WS_K); const bf16* Vb = wsp<const bf16>(F, WS_V); bf16* O = wsp<bf16>(F, WS_H);
    for (int u = F.bid; u < NB * MH * 32; u += F.G) {
        const int pair = (u >> 8) * 8 + (u & 7), qb = (u & 255) >> 3, b = pair >> 3, h = pair & 7;
        att::unit(Q + ((size_t)pair * SEQ + qb * 256) * QKD, Kb + (size_t)pair * NKEY * QKD, Vb + (size_t)pair * NKEY * VD, O + ((size_t)(b * SEQ + qb * 256)) * 1024 + h * 128, F.lds, F.tid);
    }
    VM_WAIT(); __syncthreads();
}

constexpr int N_PHASES = 24;
struct Args { const float* in[37]; float* out; unsigned char* ws; int ph_lo, ph_hi, pad0, pad1; };
__global__ void __launch_bounds__(512, 2) mk_fwd(Args args) {
    extern __shared__ __attribute__((aligned(16))) unsigned char lds_raw[];
    Frame F;
    F.lds = (LAS unsigned char*)lds_raw;
    F.tid = threadIdx.x; F.lane = F.tid & 63; F.wave = __builtin_amdgcn_readfirstlane(F.tid >> 6);
    F.G = gridDim.x; F.bid = blockIdx.x;
    F.in = (const float* const __attribute__((address_space(4)))*)__builtin_amdgcn_kernarg_segment_ptr();
    F.out = args.out; F.ws = args.ws;
    volatile LAS unsigned* MISC = (volatile LAS unsigned*)(F.lds + MISC_OFF);
    if (F.tid < 64) MISC[F.tid] = 0u;
    __syncthreads();
    const int lo = args.ph_lo, hi = args.ph_hi;
    XcdBarrier bar; bar.bar = (unsigned*)(F.ws + WS_CTL) + CW_BAR; bar.x = 0; bar.st = nullptr;
    if (hi - lo > 1) bar = xcd_barrier_post((unsigned*)(F.ws + WS_CTL) + CW_BAR, MISC + 8);
#ifndef ONLY_PHASE
#define ONLY_PHASE -1
#endif
#define IN(k) ((ONLY_PHASE < 0 || ONLY_PHASE == (k)) && lo <= (k) && (k) < hi)
#define SEAM(k) do { if (IN(k) && IN((k) + 1)) xcd_barrier(bar); } while (0)
    LAS unsigned char* ring = F.lds;
    const LAS int* blk_e = (const LAS int*)(F.lds + MT_OFF) + 128;
    const LAS int* mtab = (const LAS int*)(F.lds + MT_OFF);

    if (IN(0)) { p0_mod(F); p0_rope(F); p0_convert(F); } SEAM(0);
    if (IN(1)) { p_norm1_l0(F); } SEAM(1);
    if (IN(2)) {
        pg8::DenseSched S; S.init(NTOK, PW, 1024, wsp<const bf16>(F, WS_WIN), F.G, F.bid);
        pg8::EpiBf16<pg8::MapPlain> E{pg8::MapPlain{wsp<bf16>(F, WS_P), PW}};
        pg8::gemm_phase(ring, wsp<const bf16>(F, WS_H), 1024, S, E);
    } SEAM(2);
    if (IN(3)) { p_alr(F); p_gla(F); } SEAM(3);
    if (IN(4)) {
        pg8::DenseSched S; S.init(NTOK, LRN, LRK, wsp<const bf16>(F, WS_WLR), F.G, F.bid);
        pg8::EpiBf16<pg8::MapPlain> E{pg8::MapPlain{wsp<bf16>(F, WS_LOUT), LRN}};
        pg8::gemm_phase(ring, wsp<const bf16>(F, WS_ALR), LRK, S, E);
    } SEAM(4);
    if (IN(5)) { p_rwkv_scan(F); } SEAM(5);
    if (IN(6)) { p_mix_finish(F); } SEAM(6);
    if (IN(7)) {
        pg8::DenseSched S; S.init(NTOK, 1024, 1024, wsp<const bf16>(F, WS_WOUT), F.G, F.bid);
        pg8::EpiResid E{wsp<float>(F, WS_X1), F.in[I_X], F.in[I_CTX], wsp<const float>(F, WS_MOD), 0};
        pg8::gemm_phase(ring, wsp<const bf16>(F, WS_H), 1024, S, E);
    } SEAM(7);
    if (IN(8)) { p_norm2_route(F, 0, NTOK); } SEAM(8);
    if (IN(9)) { p_moe_scatter(F, NTOK); } SEAM(9);
    if (IN(10)) {
        moe_tables(F);
        pg8::MoeSched<true> S{mtab[64], 8, F.G, F.bid, blk_e, wsp<const unsigned>(F, WS_SORT), wsp<const bf16>(F, WS_WGU), (size_t)2048 * 1024};
        pg8::EpiSwiglu E{wsp<bf16>(F, WS_ACT), F.in[I_GUB], blk_e};
        pg8::gemm_phase(ring, wsp<const bf16>(F, WS_H), 1024, S, E);
    } SEAM(10);
    if (IN(11)) {
        moe_tables(F);
        pg8::MoeSched<false> S{mtab[64], 4, F.G, F.bid, blk_e, nullptr, wsp<const bf16>(F, WS_WDN), (size_t)1024 * 1024};
        pg8::EpiDown E{wsp<bf16>(F, WS_YS), F.in[I_DNB], blk_e, wsp<const unsigned>(F, WS_SORT) + MAXSLOT, (const float*)(wsp<const unsigned>(F, WS_SORT) + 2 * MAXSLOT)};
        pg8::gemm_phase(ring, wsp<const bf16>(F, WS_ACT), 1024, S, E);
    } SEAM(11);
    if (IN(12)) { p_combine_norm1_l1(F); } SEAM(12);
    if (IN(13)) {
        pg8::DenseSched S; S.init(NTOK, 512, 1024, wsp<const bf16>(F, WS_WODIN), F.G, F.bid);
        pg8::EpiF32 E{wsp<float>(F, WS_C), 512};
        pg8::gemm_phase(ring, wsp<const bf16>(F, WS_H), 1024, S, E);
    } SEAM(13);
    if (IN(14)) { p_mla_prep(F); } SEAM(14);
    if (IN(15)) {
        { pg8::DenseSched S; S.init(NLAT, 1536, 256, wsp<const bf16>(F, WS_WQUP), F.G, F.bid);
          pg8::EpiBf16<pg8::MapQ> E{pg8::MapQ{wsp<bf16>(F, WS_Q)}};
          pg8::gemm_phase(ring, wsp<const bf16>(F, WS_QN), 256, S, E); }
        { pg8::DenseSched S; S.init(NTOK, 2048, 256, wsp<const bf16>(F, WS_WKVUP), F.G, F.bid);
          pg8::EpiBf16<pg8::MapKV> E{pg8::MapKV{wsp<bf16>(F, WS_K), wsp<bf16>(F, WS_V)}};
          pg8::gemm_phase(ring, wsp<const bf16>(F, WS_KVN), 256, S, E); }
    } SEAM(15);
    if (IN(16)) { p_q_rope(F); } SEAM(16);
    if (IN(17)) { p_attention(F); } SEAM(17);
    if (IN(18)) {
        pg8::DenseSched S; S.init(NLAT, 1024, 1024, wsp<const bf16>(F, WS_WODOUT), F.G, F.bid);
        pg8::EpiResid E{wsp<float>(F, WS_X1), F.in[I_X], F.in[I_CTX], wsp<const float>(F, WS_MOD), 1};
        pg8::gemm_phase(ring, wsp<const bf16>(F, WS_H), 1024, S, E);
    } SEAM(18);
    if (IN(19)) { p_norm2_route(F, 1, NLAT); } SEAM(19);
    if (IN(20)) { p_moe_scatter(F, NLAT); } SEAM(20);
    if (IN(21)) {
        moe_tables(F);
        pg8::MoeSched<true> S{mtab[64], 8, F.G, F.bid, blk_e, wsp<const unsigned>(F, WS_SORT), wsp<const bf16>(F, WS_WGU) + (size_t)32 * 2048 * 1024, (size_t)2048 * 1024};
        pg8::EpiSwiglu E{wsp<bf16>(F, WS_ACT), F.in[I_GUB] + 32 * 2048, blk_e};
        pg8::gemm_phase(ring, wsp<const bf16>(F, WS_H), 1024, S, E);
    } SEAM(21);
    if (IN(22)) {
        moe_tables(F);
        pg8::MoeSched<false> S{mtab[64], 4, F.G, F.bid, blk_e, nullptr, wsp<const bf16>(F, WS_WDN) + (size_t)32 * 1024 * 1024, (size_t)1024 * 1024};
        pg8::EpiDown E{wsp<bf16>(F, WS_YS), F.in[I_DNB] + 32 * 1024, blk_e, wsp<const unsigned>(F, WS_SORT) + MAXSLOT, (const float*)(wsp<const unsigned>(F, WS_SORT) + 2 * MAXSLOT)};
        pg8::gemm_phase(ring, wsp<const bf16>(F, WS_ACT), 1024, S, E);
    } SEAM(22);
    if (IN(23)) { p_final(F); }
#undef IN
#undef SEAM
}

extern "C" void kernel_launch(void* const* d_in, const int* in_sizes, int n_in, void* d_out, int out_size, void* d_ws, size_t ws_size, hipStream_t stream) {
    static int grid = 0;
    if (grid == 0) {
        if (n_in != 37 || out_size != NLAT * DM || ws_size < WS_END) { fprintf(stderr, "kernel_launch: built for 37 inputs, %d outputs, >= %zu bytes of workspace; got n_in %d, out %d, ws %zu\n", NLAT * DM, (size_t)WS_END, n_in, out_size, ws_size); grid = -1; return; }
        int dev = 0, cus = 0, per_cu = 0;
        if (hipGetDevice(&dev) != hipSuccess || hipDeviceGetAttribute(&cus, hipDeviceAttributeMultiprocessorCount, dev) != hipSuccess) { grid = -1; return; }
        if (hipFuncSetAttribute((const void*)mk_fwd, hipFuncAttributeMaxDynamicSharedMemorySize, LDS_BYTES) != hipSuccess) { fprintf(stderr, "kernel_launch: hipFuncSetAttribute failed\n"); grid = -1; return; }
        if (hipOccupancyMaxActiveBlocksPerMultiprocessor(&per_cu, (const void*)mk_fwd, 512, LDS_BYTES) != hipSuccess || per_cu < 1) fprintf(stderr, "kernel_launch: occupancy query says %d\n", per_cu);
        (void)hipGetLastError();
        grid = cus;
    }
    if (grid < 0) return;
    if (hipMemsetAsync((char*)d_ws + WS_CTL, 0, CTL_ZERO_BYTES, stream) != hipSuccess) return;
    Args a{};
    for (int i = 0; i < 37; ++i) a.in[i] = (const float*)d_in[i];
    a.out = (float*)d_out; a.ws = (unsigned char*)d_ws;
#if MK_N_LAUNCHES == 1
    a.ph_lo = 0; a.ph_hi = N_PHASES;
    hipLaunchKernelGGL(mk_fwd, dim3(grid), dim3(512), LDS_BYTES, stream, a);
#else
    for (int p = 0; p < N_PHASES; ++p) { a.ph_lo = p; a.ph_hi = p + 1; hipLaunchKernelGGL(mk_fwd, dim3(grid), dim3(512), LDS_BYTES, stream, a); }
#endif
    const hipError_t le = hipPeekAtLastError();
    if (le != hipSuccess) fprintf(stderr, "kernel_launch: launch failed: %s\n", hipGetErrorName(le));
}
```

```cpp
#include <hip/hip_runtime.h>
#include <cstdio>
#include <cstdint>

#ifndef MK_N_LAUNCHES
#define MK_N_LAUNCHES 1
#endif

#define GAS __attribute__((address_space(1)))
#define LAS __attribute__((address_space(3)))
typedef unsigned short bf16;
typedef short bf16x8 __attribute__((ext_vector_type(8)));
typedef short s16x4 __attribute__((ext_vector_type(4)));
typedef float f32x4 __attribute__((ext_vector_type(4)));
typedef float f32x2 __attribute__((ext_vector_type(2)));
typedef float f32x16 __attribute__((ext_vector_type(16)));
typedef unsigned u32x4 __attribute__((ext_vector_type(4)));
typedef unsigned u32x2 __attribute__((ext_vector_type(2)));
typedef GAS unsigned gu32;
#define RLX_AGENT __ATOMIC_RELAXED, __HIP_MEMORY_SCOPE_AGENT
#define LDS_WAIT() asm volatile("s_waitcnt lgkmcnt(0)" ::: "memory")
#define VM_WAIT() asm volatile("s_waitcnt vmcnt(0)" ::: "memory")
#define SBAR() __builtin_amdgcn_sched_barrier(0)

constexpr int DM = 1024, NB = 8, SEQ = 8192, CTXL = 256;
constexpr int NLAT = NB * SEQ;
constexpr int NCTX = NB * CTXL;
constexpr int NTOK = NLAT + NCTX;
constexpr int GLA_COLS = 1552, RW_COLS = 1824, RW0 = 1664, PW = 3584;
constexpr int LRK = 384, LRN = 2560;
constexpr int NE = 32, TOPK = 4, DE = 1024;
constexpr int NASG0 = NTOK * TOPK;
constexpr int MAXSLOT = NASG0 + NE * 256;
constexpr int YS_DUMMY = NASG0;
constexpr int NKEY = CTXL + SEQ;
constexpr int MH = 8, QKD = 192, VD = 128;

constexpr size_t MiB = 1u << 20;
constexpr size_t WS_CTL = 0, CTL_ZERO_BYTES = 1 * MiB;
constexpr size_t WS_MOD = 1 * MiB;
constexpr size_t WS_ROPE = 2 * MiB;
constexpr size_t WS_WIN = 4 * MiB;
constexpr size_t WS_WOUT = 11 * MiB;
constexpr size_t WS_WLR = 13 * MiB;
constexpr size_t WS_WODIN = 15 * MiB;
constexpr size_t WS_WQUP = 16 * MiB;
constexpr size_t WS_WKVUP = 17 * MiB;
constexpr size_t WS_WODOUT = 18 * MiB;
constexpr size_t WS_ROUTE = 20 * MiB;
constexpr size_t WS_WGU = 24 * MiB;
constexpr size_t WS_WDN = 280 * MiB;
constexpr size_t WS_X1 = 408 * MiB;
constexpr size_t WS_H = 672 * MiB;
constexpr size_t WS_ARENA = 804 * MiB;
constexpr size_t WS_P = WS_ARENA;
constexpr size_t WS_LOUT = WS_P + 462 * MiB;
constexpr size_t WS_GLAO = WS_LOUT + 330 * MiB;
constexpr size_t WS_RWY = WS_GLAO + 132 * MiB;
constexpr size_t WS_ALR = WS_RWY + 132 * MiB;
constexpr size_t WS_BONUS = WS_ALR + 50 * MiB;
constexpr size_t WS_ACT = WS_ARENA;
constexpr size_t WS_YS = WS_ACT + 544 * MiB;
constexpr size_t WS_C = WS_ARENA;
constexpr size_t WS_QN = WS_C + 132 * MiB;
constexpr size_t WS_KVN = WS_QN + 32 * MiB;
constexpr size_t WS_Q = WS_KVN + 33 * MiB;
constexpr size_t WS_K = WS_Q + 192 * MiB;
constexpr size_t WS_V = WS_K + 198 * MiB;
constexpr size_t WS_END = 2048 * MiB;
static_assert(WS_BONUS + 5 * MiB <= WS_END && WS_YS + 529 * MiB <= WS_END && WS_V + 132 * MiB <= WS_END, "d_ws map");
constexpr size_t RT_E = 0;
constexpr size_t RT_POS = 512 * 1024;
constexpr size_t RT_GATE = 1024 * 1024 + 512 * 1024;
constexpr size_t RT_HIST = 3 * MiB;
constexpr size_t RT_TOK = 3 * MiB + 64 * 1024;
constexpr size_t WS_SORT = WS_YS + 529 * MiB;
static_assert(WS_SORT + 4 * MiB <= WS_END, "sort lists");

constexpr int CW_TMO = 0, CW_CODE = 1;
constexpr int CW_BAR = 4096;

constexpr int RING_BYTES = 131072;
constexpr int LDS_BYTES = 163840;
constexpr int MISC_OFF = 163840 - 256;

__device__ __forceinline__ unsigned f2bf(float f) { unsigned u = __builtin_bit_cast(unsigned, f); return (u + 0x7fffu + ((u >> 16) & 1u)) >> 16; }
__device__ __forceinline__ float bf2f(unsigned h) { return __builtin_bit_cast(float, h << 16); }
typedef __bf16 bf16x2v __attribute__((ext_vector_type(2)));
__device__ __forceinline__ unsigned cvt_pk_bf16(float lo, float hi) { const f32x2 v = {lo, hi}; const bf16x2v r = __builtin_convertvector(v, bf16x2v); return __builtin_bit_cast(unsigned, r); }
__device__ __forceinline__ float bflo(unsigned w) { return __builtin_bit_cast(float, w << 16); }
__device__ __forceinline__ float bfhi(unsigned w) { return __builtin_bit_cast(float, w & 0xffff0000u); }
__device__ __forceinline__ float wave_sum(float v) {
#pragma unroll
    for (int o = 1; o < 64; o <<= 1) v += __shfl_xor(v, o);
    return v;
}
__device__ __forceinline__ float sigmoidf_(float x) { return 1.f / (1.f + __expf(-x)); }

namespace pg8 {
constexpr int BM = 256, BK = 64, HALF = 128, HTB = HALF * BK * 2, STAGE_BYTES = 8 * HTB;
__host__ __device__ __forceinline__ int lds_byte(int r, int c) { const int st = (r >> 4) * 2 + (c >> 5), rr = r & 15, cc = c & 31, ob = rr * 64 + cc * 2; return st * 1024 + (ob ^ (((ob >> 9) & 1) << 5)); }
__host__ __device__ __forceinline__ void stage_rc(int b, int& R, int& C) { const int st = b / 1024, sb = b % 1024, swz = sb ^ (((sb >> 9) & 1) << 5); R = (st >> 1) * 16 + swz / 64; C = (st & 1) * 32 + (swz % 64) / 2; }
__host__ __device__ __forceinline__ int perm32(int rho) { const int n = rho >> 4, i = rho & 15; return 8 * (i >> 2) + 4 * n + (i & 3); }
struct Unit { int pm, pn; };

template <class Epi, class Sched>
__device__ __forceinline__ void gemm_phase(LAS unsigned char* lds, const bf16* Abase, const int Kc, const Sched& S, const Epi& E) {
    int K = Kc; asm volatile("" : "+s"(K));
    const int tid = threadIdx.x, wid = __builtin_amdgcn_readfirstlane(tid >> 6), lane = tid & 63, wr = wid >> 2, wc = wid & 3, fr = lane & 15, fq = lane >> 4;
    const int nt = K / BK;
    int sR[2], sC[2]; unsigned voffB[2];
#pragma unroll
    for (int i = 0; i < 2; ++i) { int R, C; stage_rc(tid * 16 + i * 8192, R, C); const int Rb = Epi::PERM ? ((R & ~31) + perm32(R & 31)) : R; sR[i] = R; sC[i] = C; voffB[i] = (unsigned)(Rb * K + C) * 2u; }
    const size_t kstep = (size_t)(BK * 2);
    const size_t hstep = (size_t)HALF * K * 2;
    const unsigned ldsw = (unsigned)wid * 1024u;
    const int aoff = lds_byte(wr * 64 + fr, fq * 8), boff = lds_byte(wc * 32 + fr, fq * 8);
    const char* Ab = (const char*)Abase;
#define PG8_SA(b, h) (((b) * 2 + (h)) * HTB)
#define PG8_SB(b, h) ((4 + (b) * 2 + (h)) * HTB)
#define PG8_STAGE(bufoff, gbase, voff) do { _Pragma("unroll") for (int _i = 0; _i < 2; ++_i) \
        __builtin_amdgcn_global_load_lds((const unsigned*)((const char*)(gbase) + (voff)[_i]), (LAS unsigned*)(lds + (bufoff) + ldsw + _i * 8192), 16, 0, 0); } while (0)
#define PG8_STAGEA(bufoff, kb, ao, h) do { _Pragma("unroll") for (int _i = 0; _i < 2; ++_i) \
        __builtin_amdgcn_global_load_lds((const unsigned*)((Ab + (kb)) + (ao)[h][_i]), (LAS unsigned*)(lds + (bufoff) + ldsw + _i * 8192), 16, 0, 0); } while (0)
#define PG8_LDA(dst, b, h) do { _Pragma("unroll") for (int m = 0; m < 4; ++m) _Pragma("unroll") for (int k = 0; k < 2; ++k) dst[m][k] = *(const LAS bf16x8*)(lds + PG8_SA(b, h) + aoff + m * 2048 + k * 1024); } while (0)
#define PG8_LDB(dst, b, h) do { _Pragma("unroll") for (int n = 0; n < 2; ++n) _Pragma("unroll") for (int k = 0; k < 2; ++k) dst[n][k] = *(const LAS bf16x8*)(lds + PG8_SB(b, h) + boff + n * 2048 + k * 1024); } while (0)
#define PG8_MMA(ai, bj, At, Bt) do { __builtin_amdgcn_s_setprio(1); _Pragma("unroll") for (int m = 0; m < 4; ++m) _Pragma("unroll") for (int n = 0; n < 2; ++n) _Pragma("unroll") for (int k = 0; k < 2; ++k) \
        acc[ai][bj][m][n] = __builtin_amdgcn_mfma_f32_16x16x32_bf16(Bt[n][k], At[m][k], acc[ai][bj][m][n], 0, 0, 0); __builtin_amdgcn_s_setprio(0); } while (0)
#define PG8_WAIT_V(n) asm volatile("s_waitcnt vmcnt(" #n ")" ::: "memory")
#define PG8_WAIT_L(n) asm volatile("s_waitcnt lgkmcnt(" #n ")" ::: "memory")
#define PG8_BAR __builtin_amdgcn_s_barrier()
#define PG8_SCHED __builtin_amdgcn_sched_barrier(0)
    Unit cur, nxt; int ui = 0;
    if (!S.next(0, cur)) return;
    f32x4 acc[2][2][4][2];
#pragma unroll
    for (int a = 0; a < 2; ++a)
#pragma unroll
        for (int b = 0; b < 2; ++b)
#pragma unroll
            for (int m = 0; m < 4; ++m)
#pragma unroll
                for (int n = 0; n < 2; ++n) acc[a][b][m][n] = (f32x4){0.f, 0.f, 0.f, 0.f};
    bf16x8 At[4][2], B0[2][2], B1[2][2];
    unsigned cao[2][2], nao[2][2];
    S.a_offs(cur, cao, sR, sC);
    const char* cB = S.b_tile(cur);
    PG8_STAGE(PG8_SB(0, 0), cB, voffB); PG8_STAGE(PG8_SB(0, 1), cB + hstep, voffB); PG8_STAGEA(PG8_SA(0, 0), 0, cao, 0); PG8_STAGEA(PG8_SA(0, 1), 0, cao, 1);
    if (wr == 1) PG8_BAR;
    PG8_WAIT_V(2); PG8_BAR;
    PG8_STAGE(PG8_SB(1, 0), cB + kstep, voffB); PG8_STAGEA(PG8_SA(1, 0), kstep, cao, 0); PG8_STAGE(PG8_SB(1, 1), cB + hstep + kstep, voffB);
    PG8_WAIT_V(6); PG8_BAR;
    for (;;) {
        const bool has_next = S.next(ui + 1, nxt);
        const char* nB = cB;
        if (has_next) { S.a_offs(nxt, nao, sR, sC); nB = S.b_tile(nxt); }
        else {
#pragma unroll
            for (int h = 0; h < 2; ++h)
#pragma unroll
                for (int i = 0; i < 2; ++i) nao[h][i] = cao[h][i];
        }
        for (int t = 0; t < nt; t += 2) {
            const bool last = (t == nt - 2);
            const size_t a1k = (size_t)(t + 1) * kstep;
            const size_t a2k = last ? 0 : (size_t)(t + 2) * kstep; const char* b2 = last ? nB : cB + (size_t)(t + 2) * kstep;
            const size_t a3k = a2k + kstep; const char* b3 = b2 + kstep;
            unsigned sao[2][2];
#pragma unroll
            for (int h = 0; h < 2; ++h)
#pragma unroll
                for (int i = 0; i < 2; ++i) sao[h][i] = last ? nao[h][i] : cao[h][i];
            PG8_LDB(B0, 0, 0); PG8_LDB(B1, 0, 1); PG8_SCHED; PG8_LDA(At, 0, 0); PG8_STAGEA(PG8_SA(1, 1), a1k, cao, 1);
            PG8_WAIT_V(8); PG8_WAIT_L(0); PG8_BAR; PG8_MMA(0, 0, At, B0); PG8_MMA(0, 1, At, B1); PG8_BAR; PG8_SCHED;
            PG8_LDA(At, 0, 1); PG8_STAGE(PG8_SB(0, 0), b2, voffB); PG8_STAGE(PG8_SB(0, 1), b2 + hstep, voffB); PG8_STAGEA(PG8_SA(0, 0), a2k, sao, 0);
            PG8_WAIT_V(8); PG8_WAIT_L(0); PG8_BAR; PG8_MMA(1, 0, At, B0); PG8_MMA(1, 1, At, B1); PG8_BAR; PG8_SCHED;
            PG8_LDB(B0, 1, 0); PG8_LDB(B1, 1, 1); PG8_SCHED; PG8_LDA(At, 1, 0); PG8_STAGEA(PG8_SA(0, 1), a2k, sao, 1);
            PG8_WAIT_V(8); PG8_WAIT_L(0); PG8_BAR; PG8_MMA(0, 0, At, B0); PG8_MMA(0, 1, At, B1); PG8_BAR; PG8_SCHED;
            PG8_LDA(At, 1, 1); PG8_STAGE(PG8_SB(1, 0), b3, voffB); PG8_STAGE(PG8_SB(1, 1), b3 + hstep, voffB); PG8_STAGEA(PG8_SA(1, 0), a3k, sao, 0);
            PG8_WAIT_V(8); PG8_WAIT_L(0); PG8_BAR; PG8_MMA(1, 0, At, B0); PG8_MMA(1, 1, At, B1); PG8_BAR; PG8_SCHED;
        }
        if (wr == 0) PG8_BAR;
        E(acc, cur, wr, wc, fr, fq);
        if (!has_next) break;
#pragma unroll
        for (int a = 0; a < 2; ++a)
#pragma unroll
            for (int b = 0; b < 2; ++b)
#pragma unroll
                for (int m = 0; m < 4; ++m)
#pragma unroll
                    for (int n = 0; n < 2; ++n) acc[a][b][m][n] = (f32x4){0.f, 0.f, 0.f, 0.f};
        cur = nxt; cB = nB; ++ui;
#pragma unroll
        for (int h = 0; h < 2; ++h)
#pragma unroll
            for (int i = 0; i < 2; ++i) cao[h][i] = nao[h][i];
        if (wr == 1) PG8_BAR;
    }
    PG8_WAIT_V(0);
    PG8_BAR;
#undef PG8_SA
#undef PG8_SB
#undef PG8_STAGE
#undef PG8_STAGEA
#undef PG8_LDA
#undef PG8_LDB
#undef PG8_MMA
#undef PG8_WAIT_V
#undef PG8_WAIT_L
#undef PG8_BAR
#undef PG8_SCHED
}
}

#define XB_TMO      128
#define XB_XCNT(j)  (256  + 64 * (j))
#define XB_XSUB(j)  (1280 + 64 * (j))
#define XB_XGEN(j)  (2304 + 64 * (j))
#define XB_TOP      3328
#define XB_TOPGEN   3392
#define XCD_BAR_WORDS 3456
#define XB_SPIN_CAP (1u << 22)
__device__ __forceinline__ unsigned xb_ld(unsigned* p)              { return __hip_atomic_load(p, __ATOMIC_RELAXED, __HIP_MEMORY_SCOPE_AGENT); }
__device__ __forceinline__ unsigned xb_add(unsigned* p, unsigned v) { return __hip_atomic_fetch_add(p, v, __ATOMIC_RELAXED, __HIP_MEMORY_SCOPE_AGENT); }
__device__ __forceinline__ unsigned xb_xcc_id() { return (unsigned)__builtin_amdgcn_s_getreg((3 << 11) | 20) & 0xFu; }
#define XB_SPIN(cond, bar) do { unsigned _sp = 0; while (cond) { __builtin_amdgcn_s_sleep(1); \
    if ((++_sp & 255u) == 0u) { if (xb_ld(&(bar)[XB_TMO])) break; if (_sp > XB_SPIN_CAP) { atomicAdd(&(bar)[XB_TMO], 1u); break; } } } } while (0)
struct XcdBarrier { unsigned* bar; unsigned x; volatile LAS unsigned* st; };
__device__ __forceinline__ XcdBarrier xcd_barrier_post(unsigned* bar, volatile LAS unsigned* st) {
    XcdBarrier b; b.bar = bar; b.x = xb_xcc_id(); b.st = st;
    if (threadIdx.x == 0) (void)xb_add(&bar[XB_XCNT(b.x)], 1u);
    return b;
}
__device__ __forceinline__ void xcd_barrier_complete(unsigned* bar, unsigned x, unsigned& nloc, unsigned& nx) {
    const unsigned G = gridDim.x * gridDim.y * gridDim.z;
    unsigned sum, cnt, mine, sp = 0u;
    for (;;) {
        sum = 0u; cnt = 0u; mine = 0u;
#pragma unroll
        for (unsigned j = 0; j < 16; ++j) { const unsigned c = xb_ld(&bar[XB_XCNT(j)]); sum += c; cnt += (c > 0u) ? 1u : 0u; mine = (j == x) ? c : mine; }
        if (sum == G) break;
        __builtin_amdgcn_s_sleep(1);
        if ((++sp & 255u) == 0u) { if (xb_ld(&bar[XB_TMO])) break; if (sp > XB_SPIN_CAP) { atomicAdd(&bar[XB_TMO], 1u); break; } }
    }
    nloc = mine > 0u ? mine : 1u; nx = cnt > 0u ? cnt : 1u;
}
__device__ __forceinline__ void xcd_barrier(const XcdBarrier& b) {
    asm volatile("s_waitcnt vmcnt(0)" ::: "memory");
    __syncthreads();
    if (threadIdx.x == 0) {
        unsigned* bar = b.bar;
        __builtin_amdgcn_s_waitcnt(0);
        unsigned nloc = b.st[0], nx = b.st[1];
        if (nloc == 0u) { xcd_barrier_complete(bar, b.x, nloc, nx); b.st[0] = nloc; b.st[1] = nx; }
        const unsigned old = xb_add(&bar[XB_XSUB(b.x)], 1u);
        const unsigned gen = old / nloc;
        if (old + 1u == (gen + 1u) * nloc) {
            __builtin_amdgcn_fence(__ATOMIC_RELEASE, "agent");
            asm volatile("s_waitcnt vmcnt(0)" ::: "memory");
            const unsigned og = xb_add(&bar[XB_TOP], 1u);
            const unsigned tg = og / nx;
            if (og + 1u == (tg + 1u) * nx) xb_add(&bar[XB_TOPGEN], 1u);
            else XB_SPIN(xb_ld(&bar[XB_TOPGEN]) == tg, bar);
            __builtin_amdgcn_fence(__ATOMIC_ACQUIRE, "agent");
            xb_add(&bar[XB_XGEN(b.x)], 1u);
            asm volatile("s_waitcnt vmcnt(0)" ::: "memory");
        } else {
            XB_SPIN(xb_ld(&bar[XB_XGEN(b.x)]) == gen, bar);
            __builtin_amdgcn_fence(__ATOMIC_ACQUIRE, "agent");
            asm volatile("s_waitcnt vmcnt(0)" ::: "memory");
        }
    }
    __syncthreads();
}

struct Frame {
    LAS unsigned char* lds;
    int tid, lane, wave, G, bid;
    const float* const __attribute__((address_space(4)))* in;
    float* out;
    unsigned char* ws;
};
enum { I_X = 0, I_C, I_CTX, I_CCTX, I_ADAW, I_ADAB, I_N1G, I_N2G, I_EVWIN, I_EVWOUT, I_GKUP, I_GKB, I_GNG, I_MU, I_W0, I_W2, I_A0, I_A2, I_KK, I_KA, I_RK, I_G2, I_LNW, I_LNB,
       I_ODWIN, I_QNORM, I_WQUP, I_KVNORM, I_WKVUP, I_ODWOUT, I_RW, I_RB, I_GUW, I_GUB, I_DNW, I_DNB, I_FNG };
template <class T> __device__ __forceinline__ T* wsp(const Frame& F, size_t off) { return (T*)(F.ws + off); }
__device__ __forceinline__ int mod_row(int row) { return row < NLAT ? (row >> 13) : 8; }
__device__ __forceinline__ const float* mod_ptr(const Frame& F, int layer, int row, int which) { return wsp<const float>(F, WS_MOD) + ((size_t)(layer * 9 + mod_row(row)) * 6 + which) * 1024; }

__device__ __forceinline__ void p0_mod(Frame& F) {
    LAS float* s = (LAS float*)F.lds;
    LAS float* red = (LAS float*)(F.lds + 9 * 1024 * 4);
    const float* c = F.in[I_C]; const float* cc = F.in[I_CCTX]; const float* W = F.in[I_ADAW]; const float* Bv = F.in[I_ADAB];
    for (int idx = F.tid; idx < 9 * 1024; idx += 512) { const int r = idx >> 10, k = idx & 1023; const float v = r < 8 ? c[r * 1024 + k] : cc[k]; s[idx] = v / (1.f + __expf(-v)); }
    __syncthreads();
    for (int item = F.bid; item < 192; item += F.G) {
        const int l = item / 96, n0 = (item % 96) * 64;
        float acc[9];
#pragma unroll
        for (int r = 0; r < 9; ++r) acc[r] = 0.f;
        const float* wp = W + ((size_t)l * 1024 + F.wave * 128) * 6144 + n0 + F.lane;
        for (int k = 0; k < 128; ++k) { const float wv = wp[(size_t)k * 6144];
#pragma unroll
            for (int r = 0; r < 9; ++r) acc[r] += s[r * 1024 + F.wave * 128 + k] * wv; }
#pragma unroll
        for (int r = 0; r < 9; ++r) red[(F.wave * 9 + r) * 64 + F.lane] = acc[r];
        __syncthreads();
        for (int idx = F.tid; idx < 576; idx += 512) { const int r = idx >> 6, ln = idx & 63; float v = Bv[l * 6144 + n0 + ln];
#pragma unroll
            for (int w = 0; w < 8; ++w) v += red[(w * 9 + r) * 64 + ln];
            wsp<float>(F, WS_MOD)[(size_t)(l * 9 + r) * 6144 + n0 + ln] = v; }
        __syncthreads();
    }
}
__device__ __forceinline__ void p0_rope(Frame& F) {
    for (int idx = F.bid * 512 + F.tid; idx < SEQ * 32; idx += F.G * 512) {
        const int t = idx >> 5, i = idx & 31;
        const float fr = (float)pow(10000.0, -(double)(i & 15) / 16.0);
        const float pos = (float)(i < 16 ? (t >> 6) : (t & 63));
        const float ang = pos * fr;
        const double a = (double)ang;
        wsp<f32x2>(F, WS_ROPE)[idx] = (f32x2){(float)cos(a), (float)sin(a)};
    }
}
template <class V> __device__ __forceinline__ void cvt_item(const V& val, bf16* dst, int K, int item, int nblk, LAS float* scr, int lane) {
    const int kb = item / nblk, nb = item % nblk, k0 = 64 * kb, n0 = 32 * nb;
#pragma unroll 8
    for (int i = 0; i < 32; ++i) { const int kk = 2 * i + (lane >> 5); scr[kk * 33 + (lane & 31)] = val(n0 + (lane & 31), k0 + kk); }
    LDS_WAIT(); asm volatile("" ::: "memory");
    const int c = lane & 7;
#pragma unroll
    for (int j = 0; j < 4; ++j) { const int n = (lane >> 3) + 8 * j; const LAS float* sp = scr + (8 * c) * 33 + n;
        u32x4 o; o.x = f2bf(sp[0 * 33]) | (f2bf(sp[1 * 33]) << 16); o.y = f2bf(sp[2 * 33]) | (f2bf(sp[3 * 33]) << 16); o.z = f2bf(sp[4 * 33]) | (f2bf(sp[5 * 33]) << 16); o.w = f2bf(sp[6 * 33]) | (f2bf(sp[7 * 33]) << 16);
        *(u32x4*)(dst + (size_t)(n0 + n) * K + k0 + 8 * c) = o; }
    LDS_WAIT(); asm volatile("" ::: "memory");
}
struct VPlain { const float* W; int ldn, Nr, Kr; __device__ __forceinline__ float operator()(int n, int k) const { return (n < Nr && k < Kr) ? W[(size_t)k * ldn + n] : 0.f; } };
struct VWin { const float* W; __device__ __forceinline__ float operator()(int n, int k) const { const int col = n < GLA_COLS ? n : ((n >= RW0 && n < RW0 + RW_COLS) ? n - (RW0 - GLA_COLS) : -1); return col >= 0 ? W[(size_t)k * (GLA_COLS + RW_COLS) + col] : 0.f; } };
struct VQup { const float* W; __device__ __forceinline__ float operator()(int n, int k) const { const int col = n < 1024 ? (n >> 7) * 192 + (n & 127) : ((n - 1024) >> 6) * 192 + 128 + ((n - 1024) & 63); return W[(size_t)k * 1536 + col]; } };
struct VGu { const float* W; __device__ __forceinline__ float operator()(int n, int k) const { const int col = ((n & 128) ? 1024 : 0) + (n >> 8) * 128 + (n & 127); return W[(size_t)k * 2048 + col]; } };
struct VLr { const float *w2, *a2, *g2; __device__ __forceinline__ float operator()(int n, int k) const {
        if (n < 1024) return k < 64 ? w2[((size_t)(n >> 9) * 64 + k) * 512 + (n & 511)] : 0.f;
        if (n < 2048) return (k >= 64 && k < 128) ? a2[((size_t)((n - 1024) >> 9) * 64 + (k - 64)) * 512 + (n & 511)] : 0.f;
        return (k >= 128 && k < 288) ? g2[(size_t)(k - 128) * 512 + (n - 2048)] : 0.f; } };
__device__ __forceinline__ void p0_convert(Frame& F) {
    LAS float* scr = (LAS float*)(F.lds + 65536 + F.wave * 8704);
    const int gw = F.bid * 8 + F.wave, NGW = F.G * 8;
    constexpr int I_WIN = (1024 / 64) * (PW / 32), I_SQ = (1024 / 64) * (1024 / 32), I_LR = (LRK / 64) * (LRN / 32), I_ODIN = (1024 / 64) * (512 / 32), I_QUP = (256 / 64) * (1536 / 32), I_KVUP = (256 / 64) * (2048 / 32);
    constexpr int I_GU1 = (1024 / 64) * (2048 / 32), I_DN1 = (1024 / 64) * (1024 / 32);
    constexpr int NSMALL = I_WIN + I_SQ + I_LR + I_ODIN + I_QUP + I_KVUP + I_SQ;
    constexpr int NITEMS = NSMALL + 64 * I_GU1 + 64 * I_DN1;
    for (int it = gw; it < NITEMS; it += NGW) {
        int r = it;
        if (r < I_WIN) { cvt_item(VWin{F.in[I_EVWIN]}, wsp<bf16>(F, WS_WIN), 1024, r, PW / 32, scr, F.lane); continue; } r -= I_WIN;
        if (r < I_SQ) { cvt_item(VPlain{F.in[I_EVWOUT], 1024, 1024, 1024}, wsp<bf16>(F, WS_WOUT), 1024, r, 32, scr, F.lane); continue; } r -= I_SQ;
        if (r < I_LR) { cvt_item(VLr{F.in[I_W2], F.in[I_A2], F.in[I_G2]}, wsp<bf16>(F, WS_WLR), LRK, r, LRN / 32, scr, F.lane); continue; } r -= I_LR;
        if (r < I_ODIN) { cvt_item(VPlain{F.in[I_ODWIN], 448, 448, 1024}, wsp<bf16>(F, WS_WODIN), 1024, r, 16, scr, F.lane); continue; } r -= I_ODIN;
        if (r < I_QUP) { cvt_item(VQup{F.in[I_WQUP]}, wsp<bf16>(F, WS_WQUP), 256, r, 48, scr, F.lane); continue; } r -= I_QUP;
        if (r < I_KVUP) { cvt_item(VPlain{F.in[I_WKVUP], 2048, 2048, 128}, wsp<bf16>(F, WS_WKVUP), 256, r, 64, scr, F.lane); continue; } r -= I_KVUP;
        if (r < I_SQ) { cvt_item(VPlain{F.in[I_ODWOUT], 1024, 1024, 1024}, wsp<bf16>(F, WS_WODOUT), 1024, r, 32, scr, F.lane); continue; } r -= I_SQ;
        if (r < 64 * I_GU1) { const int le = r / I_GU1, ri = r % I_GU1; cvt_item(VGu{F.in[I_GUW] + (size_t)le * 1024 * 2048}, wsp<bf16>(F, WS_WGU) + (size_t)le * 2048 * 1024, 1024, ri, 64, scr, F.lane); continue; } r -= 64 * I_GU1;
        { const int le = r / I_DN1, ri = r % I_DN1; cvt_item(VPlain{F.in[I_DNW] + (size_t)le * 1024 * 1024, 1024, 1024, 1024}, wsp<bf16>(F, WS_WDN) + (size_t)le * 1024 * 1024, 1024, ri, 32, scr, F.lane); }
    }
}

struct RowV { f32x4 v[4]; };
__device__ __forceinline__ void row_load(RowV& r, const float* p, int lane) {
#pragma unroll
    for (int j = 0; j < 4; ++j) r.v[j] = ((const f32x4*)p)[lane + 64 * j];
}
__device__ __forceinline__ float row_ss(const RowV& r) {
    float s = 0.f;
#pragma unroll
    for (int j = 0; j < 4; ++j) s += (r.v[j].x * r.v[j].x + r.v[j].y * r.v[j].y) + (r.v[j].z * r.v[j].z + r.v[j].w * r.v[j].w);
    return wave_sum(s);
}
__device__ __forceinline__ void row_modulate(RowV& r, float rstd, const float* g, const float* sh, const float* sc, int lane) {
#pragma unroll
    for (int j = 0; j < 4; ++j) { const f32x4 gv = ((const f32x4*)g)[lane + 64 * j], shv = ((const f32x4*)sh)[lane + 64 * j], scv = ((const f32x4*)sc)[lane + 64 * j];
        r.v[j] = r.v[j] * rstd * gv * (scv + 1.0f) + shv; }
}
__device__ __forceinline__ void row_store_bf16(const RowV& r, bf16* p, int lane) {
#pragma unroll
    for (int j = 0; j < 4; ++j) { u32x2 w; w.x = cvt_pk_bf16(r.v[j].x, r.v[j].y); w.y = cvt_pk_bf16(r.v[j].z, r.v[j].w); ((u32x2*)p)[lane + 64 * j] = w; }
}
__device__ __forceinline__ void row_add_moe(RowV& r, const bf16* ys, int row, const float* gate, int lane) {
#pragma unroll
    for (int j = 0; j < 4; ++j) { f32x4 s = (f32x4){0.f, 0.f, 0.f, 0.f};
#pragma unroll
        for (int k = 0; k < 4; ++k) { const u32x2 w = ((const u32x2*)(ys + (size_t)(row * 4 + k) * 1024))[lane + 64 * j]; s.x += bflo(w.x); s.y += bfhi(w.x); s.z += bflo(w.y); s.w += bfhi(w.y); }
        const f32x4 gv = ((const f32x4*)gate)[lane + 64 * j]; r.v[j] = r.v[j] + gv * s; }
}
__device__ __forceinline__ const float* src_row_l0(const Frame& F, int row) { return row < NLAT ? F.in[I_X] + (size_t)row * 1024 : F.in[I_CTX] + (size_t)(row - NLAT) * 1024; }

__device__ __forceinline__ void p_norm1_l0(Frame& F) {
    const int gw = F.bid * 8 + F.wave, NGW = F.G * 8;
    for (int row = gw; row < NTOK; row += NGW) {
        RowV r; row_load(r, src_row_l0(F, row), F.lane);
        const float rstd = 1.f / sqrtf(row_ss(r) * (1.f / 1024.f) + 1e-6f);
        row_modulate(r, rstd, F.in[I_N1G], mod_ptr(F, 0, row, 0), mod_ptr(F, 0, row, 1), F.lane);
        row_store_bf16(r, wsp<bf16>(F, WS_H) + (size_t)row * 1024, F.lane);
    }
}
__device__ __forceinline__ void p_combine_norm1_l1(Frame& F) {
    const int gw = F.bid * 8 + F.wave, NGW = F.G * 8;
    for (int row = gw; row < NTOK; row += NGW) {
        float* xp = wsp<float>(F, WS_X1) + (size_t)row * 1024;
        RowV r; row_load(r, xp, F.lane);
        row_add_moe(r, wsp<const bf16>(F, WS_YS), row, mod_ptr(F, 0, row, 5), F.lane);
#pragma unroll
        for (int j = 0; j < 4; ++j) ((f32x4*)xp)[F.lane + 64 * j] = r.v[j];
        const float rstd = 1.f / sqrtf(row_ss(r) * (1.f / 1024.f) + 1e-6f);
        row_modulate(r, rstd, F.in[I_N1G] + 1024, mod_ptr(F, 1, row, 0), mod_ptr(F, 1, row, 1), F.lane);
        row_store_bf16(r, wsp<bf16>(F, WS_H) + (size_t)row * 1024, F.lane);
    }
}
__device__ __forceinline__ void p_final(Frame& F) {
    const int gw = F.bid * 8 + F.wave, NGW = F.G * 8;
    for (int row = gw; row < NLAT; row += NGW) {
        RowV r; row_load(r, wsp<const float>(F, WS_X1) + (size_t)row * 1024, F.lane);
        row_add_moe(r, wsp<const bf16>(F, WS_YS), row, mod_ptr(F, 1, row, 5), F.lane);
        const float rstd = 1.f / sqrtf(row_ss(r) * (1.f / 1024.f) + 1e-6f);
#pragma unroll
        for (int j = 0; j < 4; ++j) { const f32x4 gv = ((const f32x4*)F.in[I_FNG])[F.lane + 64 * j]; ((f32x4*)(F.out + (size_t)row * 1024))[F.lane + 64 * j] = r.v[j] * rstd * gv; }
    }
}

constexpr int RT_LDS_CNT = 131072;
constexpr int RT_LDS_SEL = 131072 + 256;
__device__ __forceinline__ void p_norm2_route(Frame& F, const int layer, const int ntok) {
    LAS float* wT = (LAS float*)F.lds;
    LAS int* cnt = (LAS int*)(F.lds + RT_LDS_CNT);
    LAS int* sel_e = (LAS int*)(F.lds + RT_LDS_SEL + F.wave * 32);
    LAS float* sel_l = (LAS float*)(F.lds + RT_LDS_SEL + F.wave * 32 + 16);
    const float* rw = F.in[I_RW] + (size_t)layer * 1024 * 32;
    for (int idx = F.tid; idx < 1024 * 32; idx += 512) { const int k = idx >> 5, e = idx & 31; wT[e * 1024 + k] = rw[idx]; }
    const int rpb = ntok / 256;
    unsigned char* rt = F.ws + WS_ROUTE;
    const float* g2 = F.in[I_N2G] + layer * 1024;
    const float br = F.in[I_RB][layer * 32 + ((F.lane >> 1) & 31)];
    for (int vb = F.bid; vb < 256; vb += F.G) {
        if (F.tid < 32) cnt[F.tid] = 0;
        __syncthreads();
        for (int rr = F.wave; rr < rpb; rr += 8) {
            const int row = vb * rpb + rr;
            RowV r; row_load(r, wsp<const float>(F, WS_X1) + (size_t)row * 1024, F.lane);
            const float rstd = 1.f / sqrtf(row_ss(r) * (1.f / 1024.f) + 1e-6f);
            row_modulate(r, rstd, g2, mod_ptr(F, layer, row, 3), mod_ptr(F, layer, row, 4), F.lane);
            row_store_bf16(r, wsp<bf16>(F, WS_H) + (size_t)row * 1024, F.lane);
            float a[32];
#pragma unroll
            for (int e = 0; e < 32; ++e) { float s = 0.f;
#pragma unroll
                for (int j = 0; j < 4; ++j) { const f32x4 w = *(const LAS f32x4*)(wT + e * 1024 + 256 * j + 4 * F.lane); s += (r.v[j].x * w.x + r.v[j].y * w.y) + (r.v[j].z * w.z + r.v[j].w * w.w); }
                a[e] = s; if ((e & 1) == 1) SBAR(); }
#pragma unroll
            for (int st = 0; st < 5; ++st) { const int off = 32 >> st, n = 16 >> st; const bool up = (F.lane & off) != 0;
#pragma unroll
                for (int i = 0; i < n; ++i) { const float send = up ? a[i] : a[i + n], keep = up ? a[i + n] : a[i]; a[i] = keep + __shfl_xor(send, off); } }
            float lg = a[0] + __shfl_xor(a[0], 1) + br;
            const int e = (F.lane >> 1) & 31;
            int rank = 0;
#pragma unroll
            for (int e2 = 0; e2 < 32; ++e2) { const float l2 = __shfl(lg, 2 * e2); rank += (l2 > lg || (l2 == lg && e2 < e)) ? 1 : 0; }
            if (rank < 4 && (F.lane & 1) == 0) { sel_e[rank] = e; sel_l[rank] = lg; }
            LDS_WAIT(); asm volatile("" ::: "memory");
            const float l0 = sel_l[0], l1 = sel_l[1], l2 = sel_l[2], l3 = sel_l[3];
            const float e0 = 1.f, e1 = __expf(l1 - l0), e2x = __expf(l2 - l0), e3 = __expf(l3 - l0);
            const float inv = 1.f / (e0 + e1 + e2x + e3);
            if (F.lane < 4) {
                const int ee = sel_e[F.lane]; const float gg = (F.lane == 0 ? e0 : F.lane == 1 ? e1 : F.lane == 2 ? e2x : e3) * inv;
                const int pos = __hip_atomic_fetch_add(cnt + ee, 1, __ATOMIC_RELAXED, __HIP_MEMORY_SCOPE_WORKGROUP);
                rt[RT_E + (size_t)row * 4 + F.lane] = (unsigned char)ee;
                ((unsigned short*)(rt + RT_POS))[(size_t)row * 4 + F.lane] = (unsigned short)pos;
                ((float*)(rt + RT_GATE))[(size_t)row * 4 + F.lane] = gg;
            }
            LDS_WAIT(); asm volatile("" ::: "memory");
        }
        __syncthreads();
        if (F.tid < 32) ((unsigned*)(rt + RT_HIST))[vb * 32 + F.tid] = (unsigned)cnt[F.tid];
        __syncthreads();
    }
}
constexpr int MT_OFF = 131072 + 1024;
__device__ __forceinline__ void moe_tables(Frame& F) {
    LAS int* tab = (LAS int*)(F.lds + MT_OFF);
    const unsigned* hist = (const unsigned*)(F.ws + WS_ROUTE + RT_HIST);
    if (F.tid < 32) { int c = 0; for (int b = 0; b < 256; ++b) c += (int)hist[b * 32 + F.tid]; tab[32 + F.tid] = c; }
    __syncthreads();
    if (F.tid == 0) { int s = 0; for (int e = 0; e < 32; ++e) { tab[e] = s; const int nb = (tab[32 + e] + 255) >> 8; for (int i = 0; i < nb; ++i) tab[128 + (s >> 8) + i] = e; s += nb << 8; } tab[64] = s >> 8; }
    __syncthreads();
}
__device__ __forceinline__ void p_moe_scatter(Frame& F, const int ntok) {
    moe_tables(F);
    LAS int* tab = (LAS int*)(F.lds + MT_OFF);
    LAS int* base = (LAS int*)(F.lds + MT_OFF + 8192);
    const unsigned* hist = (const unsigned*)(F.ws + WS_ROUTE + RT_HIST);
    const unsigned char* rt = F.ws + WS_ROUTE;
    unsigned* stok = wsp<unsigned>(F, WS_SORT); unsigned* sdst = stok + MAXSLOT; float* sgate = (float*)(sdst + MAXSLOT);
    const int rpb = ntok / 256;
    for (int vb = F.bid; vb < 256; vb += F.G) {
        if (F.tid < 32) { int c = 0; for (int b = 0; b < vb; ++b) c += (int)hist[b * 32 + F.tid]; base[F.tid] = tab[F.tid] + c; }
        __syncthreads();
        for (int i = F.tid; i < rpb * 4; i += 512) {
            const int row = vb * rpb + (i >> 2), k = i & 3; const size_t a = (size_t)row * 4 + k;
            const int e = rt[RT_E + a], pos = ((const unsigned short*)(rt + RT_POS))[a];
            const int slot = base[e] + pos;
            stok[slot] = (unsigned)row; sdst[slot] = (unsigned)(row * 4 + k); sgate[slot] = ((const float*)(rt + RT_GATE))[a];
        }
        if (vb < 32) { const int e = vb, c = tab[32 + e], s0 = tab[e] + c, s1 = tab[e] + (((c + 255) >> 8) << 8);
            for (int s = s0 + F.tid; s < s1; s += 512) { stok[s] = 0u; sdst[s] = (unsigned)YS_DUMMY; sgate[s] = 0.f; } }
        __syncthreads();
    }
}

namespace pg8 {
struct DenseSched {
    int nM, nN, nwg, G, c, K; const bf16* Bt;
    __device__ __forceinline__ void init(int M, int N, int K_, const bf16* Bt_, int G_, int c_) { nM = M / BM; nN = N / BM; nwg = nM * nN; G = G_; c = c_; K = K_; Bt = Bt_; }
    __device__ __forceinline__ bool next(int i, Unit& u) const {
        const long L = (long)i * G + c; if (L >= nwg) return false;
        int wgid = (int)L; { const int q = nwg / 8, r = nwg % 8, xcd = wgid % 8, off = wgid / 8; wgid = (xcd < r ? xcd * (q + 1) : r * (q + 1) + (xcd - r) * q) + off; }
        const int nig = 8 * nN, gid = wgid / nig, fm = gid * 8, gsz = (nM - fm) < 8 ? (nM - fm) : 8;
        u.pm = fm + ((wgid % nig) % gsz); u.pn = (wgid % nig) / gsz; return true;
    }
    __device__ __forceinline__ void a_offs(const Unit& u, unsigned (&ao)[2][2], const int (&R)[2], const int (&C)[2]) const {
#pragma unroll
        for (int h = 0; h < 2; ++h)
#pragma unroll
            for (int i = 0; i < 2; ++i) ao[h][i] = (unsigned)(((u.pm * BM + h * HALF + R[i]) * K + C[i]) * 2);
    }
    __device__ __forceinline__ const char* b_tile(const Unit& u) const { return (const char*)Bt + (size_t)u.pn * BM * K * 2; }
};
template <bool GATHER> struct MoeSched {
    int nrb, npn, G, c; const LAS int* blk_e; const unsigned* tok; const bf16* Wt; size_t wstride;
    __device__ __forceinline__ bool next(int i, Unit& u) const { const long L = (long)i * G + c; if (L >= (long)nrb * npn) return false; u.pm = (int)(L / npn); u.pn = (int)(L % npn); return true; }
    __device__ __forceinline__ void a_offs(const Unit& u, unsigned (&ao)[2][2], const int (&R)[2], const int (&C)[2]) const {
#pragma unroll
        for (int h = 0; h < 2; ++h)
#pragma unroll
            for (int i = 0; i < 2; ++i) { const int slot = u.pm * BM + h * HALF + R[i]; const unsigned row = GATHER ? tok[slot] : (unsigned)slot; ao[h][i] = (row * 1024u + (unsigned)C[i]) * 2u; }
    }
    __device__ __forceinline__ const char* b_tile(const Unit& u) const { return (const char*)(Wt + (size_t)blk_e[u.pm] * wstride + (size_t)u.pn * BM * 1024); }
};

struct MapPlain { bf16* O; int ld; __device__ __forceinline__ bf16* operator()(int row, int col) const { return O + (size_t)row * ld + col; } };
struct MapQ { bf16* Q; __device__ __forceinline__ bf16* operator()(int row, int col) const {
        const int b = row >> 13, t = row & 8191, h = col < 1024 ? (col >> 7) : ((col - 1024) >> 6), d = col < 1024 ? (col & 127) : 128 + ((col - 1024) & 63);
        return Q + ((size_t)((b * 8 + h) * SEQ + t)) * QKD + d; } };
struct MapKV { bf16* Kb; bf16* Vb; __device__ __forceinline__ bf16* operator()(int row, int col) const {
        const int b = row < NLAT ? (row >> 13) : ((row - NLAT) >> 8), key = row < NLAT ? CTXL + (row & 8191) : ((row - NLAT) & 255), h = col >> 8, w = col & 255;
        const size_t kr = (size_t)((b * 8 + h) * NKEY + key);
        return w < 128 ? Kb + kr * QKD + w : Vb + kr * VD + (w - 128); } };
template <class Map> struct EpiBf16 {
    static constexpr bool PERM = true; Map map;
    __device__ __forceinline__ void operator()(const f32x4 (&acc)[2][2][4][2], const Unit& u, int wr, int wc, int fr, int fq) const {
#pragma unroll
        for (int ai = 0; ai < 2; ++ai)
#pragma unroll
            for (int m = 0; m < 4; ++m) { const int row = u.pm * BM + ai * HALF + wr * 64 + m * 16 + fr;
#pragma unroll
                for (int bj = 0; bj < 2; ++bj) { const int col = u.pn * BM + bj * HALF + wc * 32 + 8 * fq; const f32x4 v0 = acc[ai][bj][m][0], v1 = acc[ai][bj][m][1];
                    u32x4 w; w.x = cvt_pk_bf16(v0[0], v0[1]); w.y = cvt_pk_bf16(v0[2], v0[3]); w.z = cvt_pk_bf16(v1[0], v1[1]); w.w = cvt_pk_bf16(v1[2], v1[3]);
                    *(u32x4*)map(row, col) = w; } }
    }
};
struct EpiF32 {
    static constexpr bool PERM = false; float* C; int ldc;
    __device__ __forceinline__ void operator()(const f32x4 (&acc)[2][2][4][2], const Unit& u, int wr, int wc, int fr, int fq) const {
#pragma unroll
        for (int ai = 0; ai < 2; ++ai)
#pragma unroll
            for (int m = 0; m < 4; ++m) { float* rowp = C + (size_t)(u.pm * BM + ai * HALF + wr * 64 + m * 16 + fr) * ldc + u.pn * BM + wc * 32 + 4 * fq;
#pragma unroll
                for (int bj = 0; bj < 2; ++bj)
#pragma unroll
                    for (int n = 0; n < 2; ++n) *(f32x4*)(rowp + bj * HALF + n * 16) = acc[ai][bj][m][n]; }
    }
};
struct EpiResid {
    static constexpr bool PERM = false; float* X1; const float* xlat; const float* xctx; const float* mod; int layer;
    __device__ __forceinline__ void operator()(const f32x4 (&acc)[2][2][4][2], const Unit& u, int wr, int wc, int fr, int fq) const {
#pragma unroll
        for (int ai = 0; ai < 2; ++ai)
#pragma unroll
            for (int m = 0; m < 4; ++m) { const int row = u.pm * BM + ai * HALF + wr * 64 + m * 16 + fr; const int col0 = u.pn * BM + wc * 32 + 4 * fq;
                const float* bp = (layer == 0) ? (row < NLAT ? xlat + (size_t)row * 1024 : xctx + (size_t)(row - NLAT) * 1024) : X1 + (size_t)row * 1024;
                const float* gp = mod + ((size_t)(layer * 9 + (row < NLAT ? (row >> 13) : 8)) * 6 + 2) * 1024;
                float* op = X1 + (size_t)row * 1024;
#pragma unroll
                for (int bj = 0; bj < 2; ++bj)
#pragma unroll
                    for (int n = 0; n < 2; ++n) { const int c = col0 + bj * HALF + n * 16; *(f32x4*)(op + c) = *(const f32x4*)(bp + c) + *(const f32x4*)(gp + c) * acc[ai][bj][m][n]; } }
    }
};
struct EpiSwiglu {
    static constexpr bool PERM = true; bf16* ACT; const float* bgu; const LAS int* blk_e;
    __device__ __forceinline__ void operator()(const f32x4 (&acc)[2][2][4][2], const Unit& u, int wr, int wc, int fr, int fq) const {
        const int e = blk_e[u.pm]; const int c0 = u.pn * 128 + wc * 32 + 8 * fq;
        const float* bg = bgu + (size_t)e * 2048 + c0;
        f32x4 bgl[2], bln[2];
#pragma unroll
        for (int n = 0; n < 2; ++n) { bgl[n] = *(const f32x4*)(bg + 4 * n); bln[n] = *(const f32x4*)(bg + 1024 + 4 * n); }
#pragma unroll
        for (int ai = 0; ai < 2; ++ai)
#pragma unroll
            for (int m = 0; m < 4; ++m) { const int slot = u.pm * BM + ai * HALF + wr * 64 + m * 16 + fr; float o[8];
#pragma unroll
                for (int n = 0; n < 2; ++n)
#pragma unroll
                    for (int j = 0; j < 4; ++j) { const float xg = fminf(acc[ai][0][m][n][j] + bgl[n][j], 7.0f); const float xl = fminf(fmaxf(acc[ai][1][m][n][j] + bln[n][j], -7.0f), 7.0f);
                        o[n * 4 + j] = xg * (1.f / (1.f + __expf(-1.702f * xg))) * (xl + 1.0f); }
                u32x4 w; w.x = cvt_pk_bf16(o[0], o[1]); w.y = cvt_pk_bf16(o[2], o[3]); w.z = cvt_pk_bf16(o[4], o[5]); w.w = cvt_pk_bf16(o[6], o[7]);
                *(u32x4*)(ACT + (size_t)slot * 1024 + c0) = w; }
    }
};
struct EpiDown {
    static constexpr bool PERM = true; bf16* YS; const float* bdn; const LAS int* blk_e; const unsigned* dst; const float* gate;
    __device__ __forceinline__ void operator()(const f32x4 (&acc)[2][2][4][2], const Unit& u, int wr, int wc, int fr, int fq) const {
        const int e = blk_e[u.pm]; const int c0 = u.pn * BM + wc * 32 + 8 * fq;
        f32x4 bv[2][2];
#pragma unroll
        for (int bj = 0; bj < 2; ++bj)
#pragma unroll
            for (int n = 0; n < 2; ++n) bv[bj][n] = *(const f32x4*)(bdn + (size_t)e * 1024 + c0 + bj * HALF + 4 * n);
#pragma unroll
        for (int ai = 0; ai < 2; ++ai)
#pragma unroll
            for (int m = 0; m < 4; ++m) { const int slot = u.pm * BM + ai * HALF + wr * 64 + m * 16 + fr; const float g = gate[slot]; bf16* op = YS + (size_t)dst[slot] * 1024 + c0;
#pragma unroll
                for (int bj = 0; bj < 2; ++bj) { const f32x4 v0 = (acc[ai][bj][m][0] + bv[bj][0]) * g, v1 = (acc[ai][bj][m][1] + bv[bj][1]) * g;
                    u32x4 w; w.x = cvt_pk_bf16(v0[0], v0[1]); w.y = cvt_pk_bf16(v0[2], v0[3]); w.z = cvt_pk_bf16(v1[0], v1[1]); w.w = cvt_pk_bf16(v1[2], v1[3]);
                    *(u32x4*)(op + bj * HALF) = w; } }
    }
};
}

__device__ __forceinline__ float ldbf(const bf16* p) { return bf2f((unsigned)*p); }
__device__ __forceinline__ void seq_pos(int row, bool& hp, bool& hn) { if (row < NLAT) { const int t = row & 8191; hp = t > 0; hn = t < SEQ - 1; } else { const int t = (row - NLAT) & 255; hp = t > 0; hn = t < CTXL - 1; } }

__device__ __forceinline__ void p_alr(Frame& F) {
    const int gw = F.bid * 8 + F.wave, NGW = F.G * 8;
    const bf16* P = wsp<const bf16>(F, WS_P); bf16* A = wsp<bf16>(F, WS_ALR); const float* mu = F.in[I_MU];
    for (int row = gw; row < NTOK; row += NGW) {
        bool hp, hn; seq_pos(row, hp, hn);
        const bf16* pr = P + (size_t)row * PW + RW0 + 1536;
#pragma unroll
        for (int q = 0; q < 6; ++q) { const int c = F.lane + 64 * q; float o = 0.f;
            if (c < 288) { const float p0 = ldbf(pr + c), pm = hp ? ldbf(pr + c - PW) : 0.f, pn = hn ? ldbf(pr + c + PW) : 0.f;
                const float xs = p0 + mu[1536 + c] * (pm - p0) + mu[RW_COLS + 1536 + c] * (pn - p0);
                o = c < 64 ? tanhf(xs) : (c < 128 ? xs : 1.f / (1.f + __expf(-xs))); }
            A[(size_t)row * LRK + c] = (bf16)f2bf(o); }
    }
}

constexpr int GL_QRAW = 0, GL_KRAW = 8192, GL_GDS = 16384, GL_QD = 20480, GL_KI = 29696, GL_KE = 38912, GL_AT = 48128, GL_VT = 57344, GL_ST = 61952, GL_GSUM = 71168, GL_DEC = 73216;
constexpr int GL_RS = 144;
__device__ __forceinline__ bf16x8 lds_frag(const LAS unsigned char* base, int row, int kbyte) { return *(const LAS bf16x8*)(base + row * GL_RS + kbyte); }
__device__ __forceinline__ void p_gla(Frame& F) {
    LAS unsigned char* L = F.lds;
    const bf16* P = wsp<const bf16>(F, WS_P);
    const int tid = F.tid, lane = F.lane, wave = F.wave, r32 = lane & 31, hi = lane >> 5;
    for (int id = F.bid; id < 256; id += F.G) {
        const int b = id >> 5, h = (id >> 3) & 3, dir = (id >> 2) & 1, vs = id & 3;
        const int dk = lane, tg = wave;
        float gkw[16];
#pragma unroll
        for (int r = 0; r < 16; ++r) gkw[r] = F.in[I_GKUP][(size_t)(dir * 16 + r) * 256 + h * 64 + dk];
        const float gkb = F.in[I_GKB][dir * 256 + h * 64 + dk];
        f32x16 Sacc;
#pragma unroll
        for (int r = 0; r < 16; ++r) Sacc[r] = 0.f;
        for (int i = tid; i < 4608 / 4; i += 512) ((LAS unsigned*)(L + GL_ST))[i] = 0u;
        bf16x8 qv, kv, gv, vv;
#define GLA_ROW(n, i) ((n) < 4 ? NLAT + b * 256 + (dir ? 3 - (n) : (n)) * 64 + (dir ? 63 - (i) : (i)) : b * 8192 + (dir ? 127 - ((n) - 4) : ((n) - 4)) * 64 + (dir ? 63 - (i) : (i)))
#define GLA_LOAD(n) do { const bf16* rp = P + (size_t)GLA_ROW(n, tid >> 3) * PW; qv = *(const bf16x8*)(rp + h * 64 + (tid & 7) * 8); kv = *(const bf16x8*)(rp + 256 + h * 64 + (tid & 7) * 8); \
        if (tid < 128) gv = *(const bf16x8*)(P + (size_t)GLA_ROW(n, tid >> 1) * PW + 1536 + (tid & 1) * 8); \
        if (tid < 256) vv = *(const bf16x8*)(P + (size_t)GLA_ROW(n, tid >> 2) * PW + 512 + h * 128 + vs * 32 + (tid & 3) * 8); } while (0)
        GLA_LOAD(0);
        __syncthreads();
        for (int n = 0; n < 132; ++n) {
            *(LAS bf16x8*)(L + GL_QRAW + (tid >> 3) * 128 + (tid & 7) * 16) = qv;
            *(LAS bf16x8*)(L + GL_KRAW + (tid >> 3) * 128 + (tid & 7) * 16) = kv;
            if (tid < 128) { LAS float* gp = (LAS float*)(L + GL_GDS) + (tid >> 1) * 16 + (tid & 1) * 8;
#pragma unroll
                for (int e = 0; e < 8; ++e) gp[e] = bf2f((unsigned)(unsigned short)gv[e]); }
            if (tid < 256) { const int i = tid >> 2;
#pragma unroll
                for (int e = 0; e < 8; ++e) *(LAS unsigned short*)(L + GL_VT + ((tid & 3) * 8 + e) * GL_RS + i * 2) = (unsigned short)vv[e]; }
            __syncthreads();
            if (n + 1 < 132) GLA_LOAD(n + 1);
            float Gl[8]; float cum = 0.f;
#pragma unroll
            for (int ii = 0; ii < 8; ++ii) { const LAS float* gp = (const LAS float*)(L + GL_GDS) + (tg * 8 + ii) * 16; float x = gkb;
#pragma unroll
                for (int r = 0; r < 16; ++r) x += gp[r] * gkw[r];
                const float ls = fminf(x, 0.f) - log1pf(__expf(-fabsf(x)));
                cum += ls * (1.f / 16.f); Gl[ii] = cum; }
            ((LAS float*)(L + GL_GSUM))[tg * 64 + dk] = cum;
            __syncthreads();
            float off = 0.f, tot = 0.f;
#pragma unroll
            for (int t2 = 0; t2 < 8; ++t2) { const float gs = ((const LAS float*)(L + GL_GSUM))[t2 * 64 + dk]; tot += gs; off += (t2 < tg) ? gs : 0.f; }
            unsigned kep[4];
#pragma unroll
            for (int ii = 0; ii < 8; ii += 2) { float kev[2];
#pragma unroll
                for (int z = 0; z < 2; ++z) { const int i = tg * 8 + ii + z; const float G = off + Gl[ii + z];
                    const float q = bf2f((unsigned)*(const LAS unsigned short*)(L + GL_QRAW + i * 128 + dk * 2)), k = bf2f((unsigned)*(const LAS unsigned short*)(L + GL_KRAW + i * 128 + dk * 2));
                    *(LAS unsigned short*)(L + GL_QD + i * GL_RS + dk * 2) = (unsigned short)f2bf(q * 0.125f * __expf(G));
                    *(LAS unsigned short*)(L + GL_KI + i * GL_RS + dk * 2) = (unsigned short)f2bf(k * __expf(-G));
                    kev[z] = k * __expf(tot - G); }
                kep[ii >> 1] = cvt_pk_bf16(kev[0], kev[1]); }
            *(LAS u32x4*)(L + GL_KE + dk * GL_RS + tg * 16) = (u32x4){kep[0], kep[1], kep[2], kep[3]};
            if (tg == 0) ((LAS float*)(L + GL_DEC))[dk] = __expf(tot);
            __syncthreads();
            if (wave < 4) { const int tj = wave & 1, ti = wave >> 1;
                f32x16 acc;
#pragma unroll
                for (int r = 0; r < 16; ++r) acc[r] = 0.f;
                if (!(ti == 0 && tj == 1)) {
#pragma unroll
                    for (int ks = 0; ks < 4; ++ks) acc = __builtin_amdgcn_mfma_f32_32x32x16_bf16(lds_frag(L + GL_KI, tj * 32 + r32, ks * 32 + hi * 16), lds_frag(L + GL_QD, ti * 32 + r32, ks * 32 + hi * 16), acc, 0, 0, 0);
                }
                const int i = ti * 32 + r32;
#pragma unroll
                for (int g = 0; g < 4; ++g) { const int j0 = tj * 32 + 8 * g + 4 * hi; float v4[4];
#pragma unroll
                    for (int z = 0; z < 4; ++z) v4[z] = (j0 + z <= i) ? acc[4 * g + z] : 0.f;
                    *(LAS u32x2*)(L + GL_AT + i * GL_RS + j0 * 2) = (u32x2){cvt_pk_bf16(v4[0], v4[1]), cvt_pk_bf16(v4[2], v4[3])}; } }
            __syncthreads();
            const LAS unsigned char* STc = L + GL_ST + (n & 1) * 4608; LAS unsigned char* STn = L + GL_ST + ((n + 1) & 1) * 4608;
            if (wave < 2) {
                const int ti = wave; f32x16 acc;
#pragma unroll
                for (int r = 0; r < 16; ++r) acc[r] = 0.f;
#pragma unroll
                for (int ks = 0; ks < 4; ++ks) acc = __builtin_amdgcn_mfma_f32_32x32x16_bf16(lds_frag(L + GL_AT, ti * 32 + r32, ks * 32 + hi * 16), lds_frag(L + GL_VT, r32, ks * 32 + hi * 16), acc, 0, 0, 0);
#pragma unroll
                for (int ks = 0; ks < 4; ++ks) acc = __builtin_amdgcn_mfma_f32_32x32x16_bf16(lds_frag(L + GL_QD, ti * 32 + r32, ks * 32 + hi * 16), lds_frag(STc, r32, ks * 32 + hi * 16), acc, 0, 0, 0);
                bf16* O = wsp<bf16>(F, WS_GLAO) + (size_t)dir * NTOK * 512 + h * 128 + vs * 32 + r32;
#pragma unroll
                for (int r = 0; r < 16; ++r) { const int i = ti * 32 + (r & 3) + 8 * (r >> 2) + 4 * hi; O[(size_t)GLA_ROW(n, i) * 512] = (bf16)f2bf(acc[r]); }
            } else if (wave < 4) {
                const int dt = wave - 2;
#pragma unroll
                for (int g = 0; g < 4; ++g) { const f32x4 dv = *(const LAS f32x4*)(L + GL_DEC + (dt * 32 + 8 * g + 4 * hi) * 4);
#pragma unroll
                    for (int z = 0; z < 4; ++z) Sacc[4 * g + z] *= dv[z]; }
#pragma unroll
                for (int ks = 0; ks < 4; ++ks) Sacc = __builtin_amdgcn_mfma_f32_32x32x16_bf16(lds_frag(L + GL_KE, dt * 32 + r32, ks * 32 + hi * 16), lds_frag(L + GL_VT, r32, ks * 32 + hi * 16), Sacc, 0, 0, 0);
#pragma unroll
                for (int g = 0; g < 4; ++g) *(LAS u32x2*)(STn + r32 * GL_RS + (dt * 32 + 8 * g + 4 * hi) * 2) = (u32x2){cvt_pk_bf16(Sacc[4 * g], Sacc[4 * g + 1]), cvt_pk_bf16(Sacc[4 * g + 2], Sacc[4 * g + 3])};
            }
            __syncthreads();
        }
#undef GLA_LOAD
#undef GLA_ROW
    }
}

template <int CTRL> __device__ __forceinline__ float dpp_add(float x) { const int xi = __builtin_bit_cast(int, x); const int yi = __builtin_amdgcn_update_dpp(xi, xi, CTRL, 0xf, 0xf, false); return x + __builtin_bit_cast(float, yi); }
__device__ __forceinline__ float red16(float x) { x = dpp_add<0xB1>(x); x = dpp_add<0x4E>(x); x = dpp_add<0x141>(x); x = dpp_add<0x140>(x); return x; }
constexpr int RW_T = 32;
constexpr int RW_BUF = RW_T * 6 * 64 * 4;
constexpr int RW_YB = 2 * RW_BUF;
__device__ __forceinline__ void p_rwkv_scan(Frame& F) {
    LAS unsigned char* L = F.lds;
    const bf16* P = wsp<const bf16>(F, WS_P); const bf16* LO = wsp<const bf16>(F, WS_LOUT);
    const int tid = F.tid, lane = F.lane, wave = F.wave;
    for (int id = F.bid; id < 256; id += F.G) {
        const int b = id >> 5, h = (id >> 2) & 7, dir = (id >> 1) & 1, rh = id & 1;
        const int hj = h * 64 + lane;
        const float* mu = F.in[I_MU];
        const float cpr = mu[hj], cnr = mu[RW_COLS + hj], cpk = mu[512 + hj], cnk = mu[RW_COLS + 512 + hj], cpv = mu[1024 + hj], cnv = mu[RW_COLS + 1024 + hj];
        const float w0v = F.in[I_W0][dir * 512 + hj], a0v = F.in[I_A0][dir * 512 + hj], kkc = F.in[I_KK][hj], kac = F.in[I_KA][hj], rkc = F.in[I_RK][hj];
#define RW_ROW(s) ((s) < 256 ? NLAT + b * 256 + (dir ? 255 - (s) : (s)) : b * 8192 + (dir ? 8191 - ((s) - 256) : ((s) - 256)))
        unsigned short ld[4][11];
#define RW_LOAD(rd) do { _Pragma("unroll") for (int q = 0; q < 4; ++q) { const int s = (rd) * RW_T + wave * 4 + q; const int row = RW_ROW(s); bool hp, hn; seq_pos(row, hp, hn); \
            const bf16* pr = P + (size_t)row * PW + RW0 + hj; \
            _Pragma("unroll") for (int c = 0; c < 3; ++c) { ld[q][3 * c] = pr[512 * c]; ld[q][3 * c + 1] = hp ? pr[512 * c - PW] : (unsigned short)0; ld[q][3 * c + 2] = hn ? pr[512 * c + PW] : (unsigned short)0; } \
            const bf16* lr = LO + (size_t)row * LRN + dir * 512 + hj; ld[q][9] = lr[0]; ld[q][10] = lr[1024]; } } while (0)
#define RW_FEAT(rd, buf) do { _Pragma("unroll") for (int q = 0; q < 4; ++q) { const int st = wave * 4 + q; const int s = (rd) * RW_T + st; \
            const float r0 = bf2f(ld[q][0]), k0 = bf2f(ld[q][3]), v0 = bf2f(ld[q][6]); \
            const float xr = r0 + cpr * (bf2f(ld[q][1]) - r0) + cnr * (bf2f(ld[q][2]) - r0); \
            const float xk = k0 + cpk * (bf2f(ld[q][4]) - k0) + cnk * (bf2f(ld[q][5]) - k0); \
            const float xv = v0 + cpv * (bf2f(ld[q][7]) - v0) + cnv * (bf2f(ld[q][8]) - v0); \
            const float z = -(w0v + bf2f(ld[q][9])); const float sp = fmaxf(z, 0.f) + log1pf(__expf(-fabsf(z))); \
            const float wdec = __expf(-__expf(-sp - 0.5f)); \
            const float alr = 1.f / (1.f + __expf(-(a0v + bf2f(ld[q][10])))); \
            const float kkv = xk * kkc; const float nrm = sqrtf(wave_sum(kkv * kkv)); const float kk = kkv / fmaxf(nrm, 1e-12f); \
            const float kd = xk * (1.f + (alr - 1.f) * kac); \
            const float bon = wave_sum(xr * kd * rkc); \
            if (rh == 0 && lane == 0) wsp<float>(F, WS_BONUS)[((size_t)dir * NTOK + RW_ROW(s)) * 8 + h] = bon; \
            LAS float* o = (LAS float*)(L + (buf) * RW_BUF) + st * 384 + lane; \
            o[0] = wdec; o[64] = -kk; o[128] = kk * alr; o[192] = kd; o[256] = xr; o[320] = xv; } } while (0)
        const int rowl = wave * 4 + (lane >> 4), jl = lane & 15;
        float s0 = 0.f, s1 = 0.f, s2 = 0.f, s3 = 0.f;
        RW_LOAD(0); RW_FEAT(0, 0);
        __syncthreads();
        constexpr int NRD = (CTXL + SEQ) / RW_T;
        for (int rd = 0; rd < NRD; ++rd) {
            if (rd + 1 < NRD) RW_LOAD(rd + 1);
            const LAS float* sb = (const LAS float*)(L + (rd & 1) * RW_BUF);
            LAS float* yb = (LAS float*)(L + RW_YB);
#pragma unroll 4
            for (int st = 0; st < RW_T; ++st) {
                const LAS float* p = sb + st * 384;
                const f32x4 w4 = *(const LAS f32x4*)(p + 4 * jl), a4 = *(const LAS f32x4*)(p + 64 + 4 * jl), b4 = *(const LAS f32x4*)(p + 128 + 4 * jl), k4 = *(const LAS f32x4*)(p + 192 + 4 * jl), r4 = *(const LAS f32x4*)(p + 256 + 4 * jl);
                const float vv = p[320 + rh * 32 + rowl];
                const float sa = red16((s0 * a4.x + s1 * a4.y) + (s2 * a4.z + s3 * a4.w));
                s0 = s0 * w4.x + (sa * b4.x + vv * k4.x); s1 = s1 * w4.y + (sa * b4.y + vv * k4.y); s2 = s2 * w4.z + (sa * b4.z + vv * k4.z); s3 = s3 * w4.w + (sa * b4.w + vv * k4.w);
                const float y = red16((s0 * r4.x + s1 * r4.y) + (s2 * r4.z + s3 * r4.w));
                if (jl == 0) yb[st * 32 + rowl] = y;
            }
            __syncthreads();
            { const int st = tid >> 4, r2 = (tid & 15) * 2; const int s = rd * RW_T + st;
              *(unsigned*)(wsp<bf16>(F, WS_RWY) + ((size_t)dir * NTOK + RW_ROW(s)) * 512 + h * 64 + rh * 32 + r2) = cvt_pk_bf16(yb[st * 32 + r2], yb[st * 32 + r2 + 1]); }
            if (rd + 1 < NRD) RW_FEAT(rd + 1, (rd + 1) & 1);
            __syncthreads();
        }
#undef RW_LOAD
#undef RW_FEAT
#undef RW_ROW
    }
}

__device__ __forceinline__ void p_mix_finish(Frame& F) {
    const int gw = F.bid * 8 + F.wave, NGW = F.G * 8, lane = F.lane;
    const bf16* P = wsp<const bf16>(F, WS_P); const bf16* LO = wsp<const bf16>(F, WS_LOUT);
    const bf16* GO = wsp<const bf16>(F, WS_GLAO); const bf16* RY = wsp<const bf16>(F, WS_RWY); const float* BON = wsp<const float>(F, WS_BONUS);
    bf16* MIX = wsp<bf16>(F, WS_H);
    const int c0 = lane * 8;
    float gng[8], lnw[8], lnb[8], cpv[8], cnv[8];
#pragma unroll
    for (int e = 0; e < 8; ++e) { gng[e] = F.in[I_GNG][(c0 + e) & 127]; lnw[e] = F.in[I_LNW][c0 + e]; lnb[e] = F.in[I_LNB][c0 + e]; cpv[e] = F.in[I_MU][1024 + c0 + e]; cnv[e] = F.in[I_MU][RW_COLS + 1024 + c0 + e]; }
    for (int row = gw; row < NTOK; row += NGW) {
        { const u32x4 a = *(const u32x4*)(GO + (size_t)row * 512 + c0), bb = *(const u32x4*)(GO + ((size_t)NTOK + row) * 512 + c0), og = *(const u32x4*)(P + (size_t)row * PW + 1024 + c0);
          float o[8]; float ss = 0.f;
#pragma unroll
          for (int e = 0; e < 4; ++e) { o[2 * e] = bflo(a[e]) + bflo(bb[e]); o[2 * e + 1] = bfhi(a[e]) + bfhi(bb[e]); ss += o[2 * e] * o[2 * e] + o[2 * e + 1] * o[2 * e + 1]; }
          ss += __shfl_xor(ss, 1); ss += __shfl_xor(ss, 2); ss += __shfl_xor(ss, 4); ss += __shfl_xor(ss, 8);
          const float rstd = 1.f / sqrtf(ss * (1.f / 128.f) + 1e-6f);
          float y[8];
#pragma unroll
          for (int e = 0; e < 4; ++e) { const float g0 = bflo(og[e]), g1 = bfhi(og[e]);
              y[2 * e] = o[2 * e] * rstd * gng[2 * e] * (g0 / (1.f + __expf(-g0))); y[2 * e + 1] = o[2 * e + 1] * rstd * gng[2 * e + 1] * (g1 / (1.f + __expf(-g1))); }
          *(u32x4*)(MIX + (size_t)row * 1024 + c0) = (u32x4){cvt_pk_bf16(y[0], y[1]), cvt_pk_bf16(y[2], y[3]), cvt_pk_bf16(y[4], y[5]), cvt_pk_bf16(y[6], y[7])}; }
        { bool hp, hn; seq_pos(row, hp, hn);
          const u32x4 a = *(const u32x4*)(RY + (size_t)row * 512 + c0), bb = *(const u32x4*)(RY + ((size_t)NTOK + row) * 512 + c0);
          const bf16* pv = P + (size_t)row * PW + RW0 + 1024 + c0;
          const u32x4 v0 = *(const u32x4*)pv; u32x4 vm = (u32x4){0u, 0u, 0u, 0u}, vn = (u32x4){0u, 0u, 0u, 0u};
          if (hp) vm = *(const u32x4*)(pv - PW); if (hn) vn = *(const u32x4*)(pv + PW);
          const u32x4 gg = *(const u32x4*)(LO + (size_t)row * LRN + 2048 + c0);
          const int hd = lane >> 3; const float bon = BON[(size_t)row * 8 + hd] + BON[((size_t)NTOK + row) * 8 + hd];
          float yv[8]; float sm = 0.f;
#pragma unroll
          for (int e = 0; e < 4; ++e) { yv[2 * e] = bflo(a[e]) + bflo(bb[e]); yv[2 * e + 1] = bfhi(a[e]) + bfhi(bb[e]); sm += yv[2 * e] + yv[2 * e + 1]; }
          sm += __shfl_xor(sm, 1); sm += __shfl_xor(sm, 2); sm += __shfl_xor(sm, 4);
          const float mean = sm * (1.f / 64.f); float sv = 0.f;
#pragma unroll
          for (int e = 0; e < 8; ++e) { const float d = yv[e] - mean; sv += d * d; }
          sv += __shfl_xor(sv, 1); sv += __shfl_xor(sv, 2); sv += __shfl_xor(sv, 4);
          const float rstd = 1.f / sqrtf(sv * (1.f / 64.f) + 64e-5f);
          float o[8];
#pragma unroll
          for (int e = 0; e < 8; ++e) { const unsigned w0 = v0[e >> 1], wm = vm[e >> 1], wn = vn[e >> 1];
              const float p0 = (e & 1) ? bfhi(w0) : bflo(w0), pm = (e & 1) ? bfhi(wm) : bflo(wm), pn = (e & 1) ? bfhi(wn) : bflo(wn);
              const float xv = p0 + cpv[e] * (pm - p0) + cnv[e] * (pn - p0);
              const float g = (e & 1) ? bfhi(gg[e >> 1]) : bflo(gg[e >> 1]);
              o[e] = ((yv[e] - mean) * rstd * lnw[e] + lnb[e] + bon * xv) * g; }
          *(u32x4*)(MIX + (size_t)row * 1024 + 512 + c0) = (u32x4){cvt_pk_bf16(o[0], o[1]), cvt_pk_bf16(o[2], o[3]), cvt_pk_bf16(o[4], o[5]), cvt_pk_bf16(o[6], o[7])}; }
    }
}

__device__ __forceinline__ void p_mla_prep(Frame& F) {
    const int gw = F.bid * 8 + F.wave, NGW = F.G * 8, lane = F.lane;
    const float* C = wsp<const float>(F, WS_C); bf16* QN = wsp<bf16>(F, WS_QN); bf16* KVN = wsp<bf16>(F, WS_KVN); bf16* Kb = wsp<bf16>(F, WS_K);
    const f32x2* ROPE = wsp<const f32x2>(F, WS_ROPE);
    const f32x4 qg = ((const f32x4*)F.in[I_QNORM])[lane]; const f32x4 kg = ((const f32x4*)F.in[I_KVNORM])[lane & 31];
    for (int row = gw; row < NTOK; row += NGW) {
        const float* cr = C + (size_t)row * 512;
        const f32x4 cq = ((const f32x4*)cr)[lane];
        const f32x4 ck = ((const f32x4*)(cr + 256))[lane & 31];
        const float xr = cr[384 + lane];
        const float ssq = wave_sum((cq.x * cq.x + cq.y * cq.y) + (cq.z * cq.z + cq.w * cq.w));
        const float ssk = wave_sum(lane < 32 ? (ck.x * ck.x + ck.y * ck.y) + (ck.z * ck.z + ck.w * ck.w) : 0.f);
        if (row < NLAT) { const float rs = 1.f / sqrtf(ssq * (1.f / 256.f) + 1e-6f);
            ((u32x2*)(QN + (size_t)row * 256))[lane] = (u32x2){cvt_pk_bf16(cq.x * rs * qg.x, cq.y * rs * qg.y), cvt_pk_bf16(cq.z * rs * qg.z, cq.w * rs * qg.w)}; }
        { const float rs = 1.f / sqrtf(ssk * (1.f / 128.f) + 1e-6f);
          u32x2 w = (u32x2){0u, 0u};
          if (lane < 32) w = (u32x2){cvt_pk_bf16(ck.x * rs * kg.x, ck.y * rs * kg.y), cvt_pk_bf16(ck.z * rs * kg.z, ck.w * rs * kg.w)};
          ((u32x2*)(KVN + (size_t)row * 256))[lane] = w; }
        float kr = xr; int b, key;
        const float pr = __shfl_xor(xr, 16);
        if (row < NLAT) { b = row >> 13; const int t = row & 8191; key = CTXL + t;
            const f32x2 cs = ROPE[t * 32 + ((lane >> 5) << 4) + (lane & 15)];
            kr = (lane & 16) ? xr * cs.x + pr * cs.y : xr * cs.x - pr * cs.y;
        } else { b = (row - NLAT) >> 8; key = (row - NLAT) & 255; }
        const bf16 kb = (bf16)f2bf(kr);
#pragma unroll
        for (int h = 0; h < 8; ++h) Kb[((size_t)((b * 8 + h) * NKEY + key)) * QKD + 128 + lane] = kb;
    }
}
__device__ __forceinline__ void p_q_rope(Frame& F) {
    const int gw = F.bid * 8 + F.wave, NGW = F.G * 8, lane = F.lane;
    bf16* Q = wsp<bf16>(F, WS_Q); const f32x2* ROPE = wsp<const f32x2>(F, WS_ROPE);
    for (int it = gw; it < NB * MH * SEQ; it += NGW) {
        const int t = it & 8191;
        bf16* qp = Q + (size_t)it * QKD + 128 + lane;
        const float x = bf2f((unsigned)*qp), pr = __shfl_xor(x, 16);
        const f32x2 cs = ROPE[t * 32 + ((lane >> 5) << 4) + (lane & 15)];
        *qp = (bf16)f2bf((lane & 16) ? x * cs.x + pr * cs.y : x * cs.x - pr * cs.y);
    }
}

namespace att {
constexpr float SCALE = 0.07216878364870322f;
constexpr float THR = 8.f;
constexpr int KT = 64 * QKD * 2, VT = 64 * VD * 2;
constexpr int LDS_K = 0, LDS_V = 3 * KT, LDS_WS = LDS_V + 3 * VT;
constexpr int NT = NKEY / 64;
__device__ __forceinline__ int crow(int r, int hi) { return (r & 3) + 8 * (r >> 2) + 4 * hi; }
__device__ __forceinline__ int kswz(int row, int colB) { return row * 384 + (colB ^ (((row >> 1) & 7) << 4)); }
__device__ __forceinline__ void partialSM(f32x16& p0, f32x16& p1, float& m_reg, float& mn, float& alpha) {
    constexpr float C = SCALE * 1.4426950408889634f;
    float pmax = p0[0];
#pragma unroll
    for (int r = 1; r < 16; ++r) pmax = fmaxf(pmax, p0[r]);
#pragma unroll
    for (int r = 0; r < 16; ++r) pmax = fmaxf(pmax, p1[r]);
    { auto rr = __builtin_amdgcn_permlane32_swap(__float_as_uint(pmax), __float_as_uint(pmax), false, false); pmax = fmaxf(__uint_as_float(rr[0]), __uint_as_float(rr[1])); }
    if (__builtin_expect(__all(pmax - m_reg <= THR / SCALE), 1)) { mn = m_reg; alpha = 1.f; }
    else { mn = fmaxf(m_reg, pmax); alpha = __builtin_amdgcn_exp2f((m_reg - mn) * C); m_reg = mn; }
    const float mnC = -mn * C;
#pragma unroll
    for (int r = 0; r < 16; ++r) p0[r] = fmaf(p0[r], C, mnC);
#pragma unroll
    for (int r = 0; r < 16; ++r) p1[r] = fmaf(p1[r], C, mnC);
#pragma unroll
    for (int r = 0; r < 16; ++r) p0[r] = __builtin_amdgcn_exp2f(p0[r]);
}
__device__ __forceinline__ void finishSM(f32x16& p0, f32x16& p1, float alpha, float& l_reg, bf16x8& pa0, bf16x8& pa1, bf16x8& pa2, bf16x8& pa3) {
#pragma unroll
    for (int r = 0; r < 16; ++r) p1[r] = __builtin_amdgcn_exp2f(p1[r]);
    float ps = 0;
#pragma unroll
    for (int r = 0; r < 16; ++r) ps += p0[r];
#pragma unroll
    for (int r = 0; r < 16; ++r) ps += p1[r];
    { auto rr = __builtin_amdgcn_permlane32_swap(__float_as_uint(ps), __float_as_uint(ps), false, false); ps = __uint_as_float(rr[0]) + __uint_as_float(rr[1]); }
    l_reg = l_reg * alpha + ps;
#define PK4(P, BASE, OUT) do { unsigned a0 = cvt_pk_bf16(P[BASE + 0], P[BASE + 1]), a1 = cvt_pk_bf16(P[BASE + 2], P[BASE + 3]);   \
    unsigned b0 = cvt_pk_bf16(P[BASE + 4], P[BASE + 5]), b1 = cvt_pk_bf16(P[BASE + 6], P[BASE + 7]);                              \
    auto r0 = __builtin_amdgcn_permlane32_swap(a0, b0, false, false); auto r1 = __builtin_amdgcn_permlane32_swap(a1, b1, false, false); \
    u32x4 w = {r0[0], r1[0], r0[1], r1[1]}; OUT = *reinterpret_cast<bf16x8*>(&w); } while (0)
    PK4(p0, 0, pa0); PK4(p0, 8, pa1); PK4(p1, 0, pa2); PK4(p1, 8, pa3);
#undef PK4
}
__device__ __forceinline__ void qkt(f32x16& p0, f32x16& p1, const LAS unsigned char* Ks, const bf16x8 (&qr)[12], int r32, int hi) {
#pragma unroll
    for (int r = 0; r < 16; ++r) { p0[r] = 0.f; p1[r] = 0.f; }
#pragma unroll
    for (int d0 = 0; d0 < 12; ++d0) { const int cb = (d0 * 16 + hi * 8) * 2;
        const bf16x8 b0 = *(const LAS bf16x8*)(Ks + kswz(r32, cb));
        const bf16x8 b1 = *(const LAS bf16x8*)(Ks + kswz(32 + r32, cb));
        p0 = __builtin_amdgcn_mfma_f32_32x32x16_bf16(b0, qr[d0], p0, 0, 0, 0);
        p1 = __builtin_amdgcn_mfma_f32_32x32x16_bf16(b1, qr[d0], p1, 0, 0, 0); }
}
__device__ __forceinline__ int v_rd_base(int lane) { return ((lane & 3) << 3) | (((lane >> 2) & 3) << 6) | (((lane >> 4) & 1) << 5) | (((lane >> 5) & 1) << 8); }
constexpr int v_rd_off(int d0, int ks, int half) { return d0 * 512 + ks * 4096 + half * 2048; }
template <int OFF> __device__ __forceinline__ s16x4 tr_read(int vb) { s16x4 r; asm volatile("ds_read_b64_tr_b16 %0, %1 offset:%2" : "=&v"(r) : "v"(vb), "i"(OFF) : "memory"); return r; }
template <int D0> __device__ __forceinline__ void pv_one(f32x16& od, int vb, bf16x8 pa0, bf16x8 pa1, bf16x8 pa2, bf16x8 pa3) {
    const s16x4 l0 = tr_read<v_rd_off(D0, 0, 0)>(vb), h0 = tr_read<v_rd_off(D0, 0, 1)>(vb), l1 = tr_read<v_rd_off(D0, 1, 0)>(vb), h1 = tr_read<v_rd_off(D0, 1, 1)>(vb);
    const s16x4 l2 = tr_read<v_rd_off(D0, 2, 0)>(vb), h2 = tr_read<v_rd_off(D0, 2, 1)>(vb), l3 = tr_read<v_rd_off(D0, 3, 0)>(vb), h3 = tr_read<v_rd_off(D0, 3, 1)>(vb);
    asm volatile("s_waitcnt lgkmcnt(0)" ::: "memory"); SBAR();
#define PK(Lo, Hi) (bf16x8){Lo[0], Lo[1], Lo[2], Lo[3], Hi[0], Hi[1], Hi[2], Hi[3]}
    od = __builtin_amdgcn_mfma_f32_32x32x16_bf16(pa0, PK(l0, h0), od, 0, 0, 0);
    od = __builtin_amdgcn_mfma_f32_32x32x16_bf16(pa1, PK(l1, h1), od, 0, 0, 0);
    od = __builtin_amdgcn_mfma_f32_32x32x16_bf16(pa2, PK(l2, h2), od, 0, 0, 0);
    od = __builtin_amdgcn_mfma_f32_32x32x16_bf16(pa3, PK(l3, h3), od, 0, 0, 0);
#undef PK
}
__device__ __forceinline__ void pv_d0(f32x16 (&o)[4], int vb, bf16x8 pa0, bf16x8 pa1, bf16x8 pa2, bf16x8 pa3) {
    pv_one<0>(o[0], vb, pa0, pa1, pa2, pa3); pv_one<1>(o[1], vb, pa0, pa1, pa2, pa3); pv_one<2>(o[2], vb, pa0, pa1, pa2, pa3); pv_one<3>(o[3], vb, pa0, pa1, pa2, pa3);
}
__device__ __forceinline__ void glds16(const void* gsrc, LAS unsigned char* lds_wave_base) { unsigned keep; const unsigned dst = (unsigned)__builtin_amdgcn_readfirstlane((int)(uintptr_t)lds_wave_base);
    asm volatile("s_mov_b32 %0, m0\n\ts_mov_b32 m0, %2\n\ts_nop 0\n\tglobal_load_lds_dwordx4 %1, off\n\ts_mov_b32 m0, %0" : "=&s"(keep) : "v"(gsrc), "s"(dst) : "memory"); }

__device__ __forceinline__ void unit(const bf16* __restrict__ Qb, const bf16* __restrict__ Kh, const bf16* __restrict__ Vh, bf16* __restrict__ Ob, LAS unsigned char* lds, int tid) {
    const int wid = __builtin_amdgcn_readfirstlane(tid >> 6), lane = tid & 63, r32 = lane & 31, hi = lane >> 5;
    LAS float* ws = (LAS float*)(lds + LDS_WS) + wid * 64; LAS float* li_l = ws; LAS float* al_l = ws + 32;
    float m_reg = -1e30f, l_reg = 0.f; f32x16 o[4]; bf16x8 qr[12];
#pragma unroll
    for (int d = 0; d < 4; ++d)
#pragma unroll
        for (int r = 0; r < 16; ++r) o[d][r] = 0.f;
    const bf16* Qw = Qb + (size_t)(wid * 32 + r32) * QKD + hi * 8;
#pragma unroll
    for (int d0 = 0; d0 < 12; ++d0) qr[d0] = *(const bf16x8*)(Qw + d0 * 16);
    unsigned koff[3], voff[2];
#pragma unroll
    for (int i = 0; i < 3; ++i) { const int s = (i * 8 + wid) * 64 + lane, row = s / 24, cpos = s % 24, c = cpos ^ ((row >> 1) & 7); koff[i] = (unsigned)(row * 384 + c * 16); }
#pragma unroll
    for (int i = 0; i < 2; ++i) { const int s = (i * 8 + wid) * 64 + lane, sub = s >> 5, kkh = sub >> 2, cg = sub & 3, kkl = (s & 31) >> 2, cin = (s & 3) * 8, kk = kkh * 8 + kkl;
        const int k = (kk & ~0xC) | ((kk & 4) << 1) | ((kk & 8) >> 1); voff[i] = (unsigned)(k * 256 + (cg * 32 + cin) * 2); }
    const char* Kc = (const char*)Kh; const char* Vc = (const char*)Vh;
#define DMA_K(j, slot) do { _Pragma("unroll") for (int _i = 0; _i < 3; ++_i) glds16(Kc + (size_t)(j) * KT + koff[_i], lds + LDS_K + (slot) * KT + (_i * 8 + wid) * 1024); } while (0)
#define DMA_V(j, slot) do { _Pragma("unroll") for (int _i = 0; _i < 2; ++_i) glds16(Vc + (size_t)(j) * VT + voff[_i], lds + LDS_V + (slot) * VT + (_i * 8 + wid) * 1024); } while (0)
#define WAITBAR(n) asm volatile("s_waitcnt vmcnt(" #n ")\n\ts_barrier" ::: "memory")
#define RESC(a) do { if (__any((a) < 1.f)) { if (hi == 0) al_l[r32] = (a); asm volatile("s_waitcnt lgkmcnt(0)" ::: "memory"); \
    _Pragma("unroll") for (int d = 0; d < 4; ++d) _Pragma("unroll") for (int r = 0; r < 16; ++r) o[d][r] *= al_l[crow(r, hi)]; } } while (0)
    const int vb0 = (int)(uintptr_t)(lds + LDS_V) + v_rd_base(lane);
    f32x16 pA0, pA1, pB0, pB1; float mnA, mnB, alA, alB; bf16x8 pa0, pa1, pa2, pa3;
    asm volatile("s_barrier" ::: "memory");
    DMA_K(0, 0); DMA_K(1, 1); DMA_V(0, 0);
    WAITBAR(5);
    DMA_K(2, 2); DMA_V(1, 1);
    qkt(pA0, pA1, lds + LDS_K, qr, r32, hi); partialSM(pA0, pA1, m_reg, mnA, alA);
    WAITBAR(5);
    int ks = 1, vs = 0;
    for (int j = 1; j + 1 < NT; j += 2) {
        { const int k2 = ks == 0 ? 2 : ks - 1, v2 = vs == 0 ? 2 : vs - 1; DMA_K(j + 2, k2); DMA_V(j + 1, v2); }
        SBAR(); qkt(pB0, pB1, lds + LDS_K + ks * KT, qr, r32, hi);
        finishSM(pA0, pA1, alA, l_reg, pa0, pa1, pa2, pa3); SBAR();
        pv_d0(o, vb0 + vs * VT, pa0, pa1, pa2, pa3); partialSM(pB0, pB1, m_reg, mnB, alB);
        RESC(alB);
        WAITBAR(5);
        ks = ks == 2 ? 0 : ks + 1; vs = vs == 2 ? 0 : vs + 1;
        { const int k2 = ks == 0 ? 2 : ks - 1, v2 = vs == 0 ? 2 : vs - 1; if (j + 3 < NT) DMA_K(j + 3, k2); DMA_V(j + 2, v2); }
        SBAR(); qkt(pA0, pA1, lds + LDS_K + ks * KT, qr, r32, hi);
        finishSM(pB0, pB1, alB, l_reg, pa0, pa1, pa2, pa3); SBAR();
        pv_d0(o, vb0 + vs * VT, pa0, pa1, pa2, pa3); partialSM(pA0, pA1, m_reg, mnA, alA);
        RESC(alA);
        if (j + 3 < NT) WAITBAR(5); else WAITBAR(0);
        ks = ks == 2 ? 0 : ks + 1; vs = vs == 2 ? 0 : vs + 1;
    }
    SBAR(); qkt(pB0, pB1, lds + LDS_K + ks * KT, qr, r32, hi);
    finishSM(pA0, pA1, alA, l_reg, pa0, pa1, pa2, pa3); SBAR();
    pv_d0(o, vb0 + vs * VT, pa0, pa1, pa2, pa3); partialSM(pB0, pB1, m_reg, mnB, alB);
    RESC(alB);
    vs = vs == 2 ? 0 : vs + 1;
    finishSM(pB0, pB1, alB, l_reg, pa0, pa1, pa2, pa3); SBAR();
    pv_d0(o, vb0 + vs * VT, pa0, pa1, pa2, pa3);
    if (hi == 0) li_l[r32] = l_reg; asm volatile("s_waitcnt lgkmcnt(0)" ::: "memory");
    float rli[16];
#pragma unroll
    for (int r = 0; r < 16; ++r) rli[r] = __builtin_amdgcn_rcpf(li_l[crow(r, hi)]);
    bf16* Ow = Ob + (size_t)(wid * 32) * 1024;
#pragma unroll
    for (int r = 0; r < 16; ++r) { const int orow = crow(r, hi);
#pragma unroll
        for (int d0 = 0; d0 < 4; ++d0) Ow[(size_t)orow * 1024 + d0 * 32 + r32] = (bf16)f2bf(o[d0][r] * rli[r]); }
#undef DMA_K
#undef DMA_V
#undef WAITBAR
#undef RESC
}
}
__device__ __forceinline__ void p_attention(Frame& F) {
    const bf16* Q = wsp<const bf16>(F, WS_Q); const bf16* Kb = wsp<const bf16>(F, WS_K); const bf16* Vb = wsp<const bf16>(F, WS_V); bf16* O = wsp<bf16>(F, WS_H);
    for (int u = F.bid; u < NB * MH * 32; u += F.G) {
        const int pair = (u >> 8) * 8 + (u & 7), qb = (u & 255) >> 3, b = pair >> 3, h = pair & 7;
        att::unit(Q + ((size_t)pair * SEQ + qb * 256) * QKD, Kb + (size_t)pair * NKEY * QKD, Vb + (size_t)pair * NKEY * VD, O + ((size_t)(b * SEQ + qb * 256)) * 1024 + h * 128, F.lds, F.tid);
    }
    VM_WAIT(); __syncthreads();
}

constexpr int N_PHASES = 24;
struct Args { const float* in[37]; float* out; unsigned char* ws; int ph_lo, ph_hi, pad0, pad1; };
__global__ void __launch_bounds__(512, 2) mk_fwd(Args args) {
    extern __shared__ __attribute__((aligned(16))) unsigned char lds_raw[];
    Frame F;
    F.lds = (LAS unsigned char*)lds_raw;
    F.tid = threadIdx.x; F.lane = F.tid & 63; F.wave = __builtin_amdgcn_readfirstlane(F.tid >> 6);
    F.G = gridDim.x; F.bid = blockIdx.x;
    F.in = (const float* const __attribute__((address_space(4)))*)__builtin_amdgcn_kernarg_segment_ptr();
    F.out = args.out; F.ws = args.ws;
    volatile LAS unsigned* MISC = (volatile LAS unsigned*)(F.lds + MISC_OFF);
    if (F.tid < 64) MISC[F.tid] = 0u;
    __syncthreads();
    const int lo = args.ph_lo, hi = args.ph_hi;
    XcdBarrier bar; bar.bar = (unsigned*)(F.ws + WS_CTL) + CW_BAR; bar.x = 0; bar.st = nullptr;
    if (hi - lo > 1) bar = xcd_barrier_post((unsigned*)(F.ws + WS_CTL) + CW_BAR, MISC + 8);
#ifndef ONLY_PHASE
#define ONLY_PHASE -1
#endif
#define IN(k) ((ONLY_PHASE < 0 || ONLY_PHASE == (k)) && lo <= (k) && (k) < hi)
#define SEAM(k) do { if (IN(k) && IN((k) + 1)) xcd_barrier(bar); } while (0)
    LAS unsigned char* ring = F.lds;
    const LAS int* blk_e = (const LAS int*)(F.lds + MT_OFF) + 128;
    const LAS int* mtab = (const LAS int*)(F.lds + MT_OFF);

    if (IN(0)) { p0_mod(F); p0_rope(F); p0_convert(F); } SEAM(0);
    if (IN(1)) { p_norm1_l0(F); } SEAM(1);
    if (IN(2)) {
        pg8::DenseSched S; S.init(NTOK, PW, 1024, wsp<const bf16>(F, WS_WIN), F.G, F.bid);
        pg8::EpiBf16<pg8::MapPlain> E{pg8::MapPlain{wsp<bf16>(F, WS_P), PW}};
        pg8::gemm_phase(ring, wsp<const bf16>(F, WS_H), 1024, S, E);
    } SEAM(2);
    if (IN(3)) { p_alr(F); p_gla(F); } SEAM(3);
    if (IN(4)) {
        pg8::DenseSched S; S.init(NTOK, LRN, LRK, wsp<const bf16>(F, WS_WLR), F.G, F.bid);
        pg8::EpiBf16<pg8::MapPlain> E{pg8::MapPlain{wsp<bf16>(F, WS_LOUT), LRN}};
        pg8::gemm_phase(ring, wsp<const bf16>(F, WS_ALR), LRK, S, E);
    } SEAM(4);
    if (IN(5)) { p_rwkv_scan(F); } SEAM(5);
    if (IN(6)) { p_mix_finish(F); } SEAM(6);
    if (IN(7)) {
        pg8::DenseSched S; S.init(NTOK, 1024, 1024, wsp<const bf16>(F, WS_WOUT), F.G, F.bid);
        pg8::EpiResid E{wsp<float>(F, WS_X1), F.in[I_X], F.in[I_CTX], wsp<const float>(F, WS_MOD), 0};
        pg8::gemm_phase(ring, wsp<const bf16>(F, WS_H), 1024, S, E);
    } SEAM(7);
    if (IN(8)) { p_norm2_route(F, 0, NTOK); } SEAM(8);
    if (IN(9)) { p_moe_scatter(F, NTOK); } SEAM(9);
    if (IN(10)) {
        moe_tables(F);
        pg8::MoeSched<true> S{mtab[64], 8, F.G, F.bid, blk_e, wsp<const unsigned>(F, WS_SORT), wsp<const bf16>(F, WS_WGU), (size_t)2048 * 1024};
        pg8::EpiSwiglu E{wsp<bf16>(F, WS_ACT), F.in[I_GUB], blk_e};
        pg8::gemm_phase(ring, wsp<const bf16>(F, WS_H), 1024, S, E);
    } SEAM(10);
    if (IN(11)) {
        moe_tables(F);
        pg8::MoeSched<false> S{mtab[64], 4, F.G, F.bid, blk_e, nullptr, wsp<const bf16>(F, WS_WDN), (size_t)1024 * 1024};
        pg8::EpiDown E{wsp<bf16>(F, WS_YS), F.in[I_DNB], blk_e, wsp<const unsigned>(F, WS_SORT) + MAXSLOT, (const float*)(wsp<const unsigned>(F, WS_SORT) + 2 * MAXSLOT)};
        pg8::gemm_phase(ring, wsp<const bf16>(F, WS_ACT), 1024, S, E);
    } SEAM(11);
    if (IN(12)) { p_combine_norm1_l1(F); } SEAM(12);
    if (IN(13)) {
        pg8::DenseSched S; S.init(NTOK, 512, 1024, wsp<const bf16>(F, WS_WODIN), F.G, F.bid);
        pg8::EpiF32 E{wsp<float>(F, WS_C), 512};
        pg8::gemm_phase(ring, wsp<const bf16>(F, WS_H), 1024, S, E);
    } SEAM(13);
    if (IN(14)) { p_mla_prep(F); } SEAM(14);
    if (IN(15)) {
        { pg8::DenseSched S; S.init(NLAT, 1536, 256, wsp<const bf16>(F, WS_WQUP), F.G, F.bid);
          pg8::EpiBf16<pg8::MapQ> E{pg8::MapQ{wsp<bf16>(F, WS_Q)}};
          pg8::gemm_phase(ring, wsp<const bf16>(F, WS_QN), 256, S, E); }
        { pg8::DenseSched S; S.init(NTOK, 2048, 256, wsp<const bf16>(F, WS_WKVUP), F.G, F.bid);
          pg8::EpiBf16<pg8::MapKV> E{pg8::MapKV{wsp<bf16>(F, WS_K), wsp<bf16>(F, WS_V)}};
          pg8::gemm_phase(ring, wsp<const bf16>(F, WS_KVN), 256, S, E); }
    } SEAM(15);
    if (IN(16)) { p_q_rope(F); } SEAM(16);
    if (IN(17)) { p_attention(F); } SEAM(17);
    if (IN(18)) {
        pg8::DenseSched S; S.init(NLAT, 1024, 1024, wsp<const bf16>(F, WS_WODOUT), F.G, F.bid);
        pg8::EpiResid E{wsp<float>(F, WS_X1), F.in[I_X], F.in[I_CTX], wsp<const float>(F, WS_MOD), 1};
        pg8::gemm_phase(ring, wsp<const bf16>(F, WS_H), 1024, S, E);
    } SEAM(18);
    if (IN(19)) { p_norm2_route(F, 1, NLAT); } SEAM(19);
    if (IN(20)) { p_moe_scatter(F, NLAT); } SEAM(20);
    if (IN(21)) {
        moe_tables(F);
        pg8::MoeSched<true> S{mtab[64], 8, F.G, F.bid, blk_e, wsp<const unsigned>(F, WS_SORT), wsp<const bf16>(F, WS_WGU) + (size_t)32 * 2048 * 1024, (size_t)2048 * 1024};
        pg8::EpiSwiglu E{wsp<bf16>(F, WS_ACT), F.in[I_GUB] + 32 * 2048, blk_e};
        pg8::gemm_phase(ring, wsp<const bf16>(F, WS_H), 1024, S, E);
    } SEAM(21);
    if (IN(22)) {
        moe_tables(F);
        pg8::MoeSched<false> S{mtab[64], 4, F.G, F.bid, blk_e, nullptr, wsp<const bf16>(F, WS_WDN) + (size_t)32 * 1024 * 1024, (size_t)1024 * 1024};
        pg8::EpiDown E{wsp<bf16>(F, WS_YS), F.in[I_DNB] + 32 * 1024, blk_e, wsp<const unsigned>(F, WS_SORT) + MAXSLOT, (const float*)(wsp<const unsigned>(F, WS_SORT) + 2 * MAXSLOT)};
        pg8::gemm_phase(ring, wsp<const bf16>(F, WS_ACT), 1024, S, E);
    } SEAM(22);
    if (IN(23)) { p_final(F); }
#undef IN
#undef SEAM
}

extern "C" void kernel_launch(void* const* d_in, const int* in_sizes, int n_in, void* d_out, int out_size, void* d_ws, size_t ws_size, hipStream_t stream) {
    static int grid = 0;
    if (grid == 0) {
        if (n_in != 37 || out_size != NLAT * DM || ws_size < WS_END) { fprintf(stderr, "kernel_launch: built for 37 inputs, %d outputs, >= %zu bytes of workspace; got n_in %d, out %d, ws %zu\n", NLAT * DM, (size_t)WS_END, n_in, out_size, ws_size); grid = -1; return; }
        int dev = 0, cus = 0, per_cu = 0;
        if (hipGetDevice(&dev) != hipSuccess || hipDeviceGetAttribute(&cus, hipDeviceAttributeMultiprocessorCount, dev) != hipSuccess) { grid = -1; return; }
        if (hipFuncSetAttribute((const void*)mk_fwd, hipFuncAttributeMaxDynamicSharedMemorySize, LDS_BYTES) != hipSuccess) { fprintf(stderr, "kernel_launch: hipFuncSetAttribute failed\n"); grid = -1; return; }
        if (hipOccupancyMaxActiveBlocksPerMultiprocessor(&per_cu, (const void*)mk_fwd, 512, LDS_BYTES) != hipSuccess || per_cu < 1) fprintf(stderr, "kernel_launch: occupancy query says %d\n", per_cu);
        (void)hipGetLastError();
        grid = cus;
    }
    if (grid < 0) return;
    if (hipMemsetAsync((char*)d_ws + WS_CTL, 0, CTL_ZERO_BYTES, stream) != hipSuccess) return;
    Args a{};
    for (int i = 0; i < 37; ++i) a.in[i] = (const float*)d_in[i];
    a.out = (float*)d_out; a.ws = (unsigned char*)d_ws;
#if MK_N_LAUNCHES == 1
    a.ph_lo = 0; a.ph_hi = N_PHASES;
    hipLaunchKernelGGL(mk_fwd, dim3(grid), dim3(512), LDS_BYTES, stream, a);
#else
    for (int p = 0; p < N_PHASES; ++p) { a.ph_lo = p; a.ph_hi = p + 1; hipLaunchKernelGGL(mk_fwd, dim3(grid), dim3(512), LDS_BYTES, stream, a); }
#endif
    const hipError_t le = hipPeekAtLastError();
    if (le != hipSuccess) fprintf(stderr, "kernel_launch: launch failed: %s\n", hipGetErrorName(le));
}
```

```cpp
#include <hip/hip_runtime.h>
#include <cstdio>
#include <cstdint>

#ifndef MK_N_LAUNCHES
#define MK_N_LAUNCHES 1
#endif

#define GAS __attribute__((address_space(1)))
#define LAS __attribute__((address_space(3)))
typedef unsigned short bf16;
typedef short bf16x8 __attribute__((ext_vector_type(8)));
typedef short s16x4 __attribute__((ext_vector_type(4)));
typedef float f32x4 __attribute__((ext_vector_type(4)));
typedef float f32x2 __attribute__((ext_vector_type(2)));
typedef float f32x16 __attribute__((ext_vector_type(16)));
typedef unsigned u32x4 __attribute__((ext_vector_type(4)));
typedef unsigned u32x2 __attribute__((ext_vector_type(2)));
typedef int i32x4 __attribute__((ext_vector_type(4)));
typedef int i32x8 __attribute__((ext_vector_type(8)));
typedef GAS unsigned gu32;
#define RLX_AGENT __ATOMIC_RELAXED, __HIP_MEMORY_SCOPE_AGENT
#define LDS_WAIT() asm volatile("s_waitcnt lgkmcnt(0)" ::: "memory")
#define VM_WAIT() asm volatile("s_waitcnt vmcnt(0)" ::: "memory")
#define SBAR() __builtin_amdgcn_sched_barrier(0)

constexpr int DM = 1024, NB = 8, SEQ = 8192, CTXL = 256;
constexpr int NLAT = NB * SEQ;
constexpr int NCTX = NB * CTXL;
constexpr int NTOK = NLAT + NCTX;
constexpr int GLA_COLS = 1552, RW_COLS = 1824, RW0 = 1664, PW = 3584;
constexpr int LRK = 384, LRN = 2560;
constexpr int NE = 32, TOPK = 4, DE = 1024;
constexpr int NASG0 = NTOK * TOPK;
constexpr int MAXSLOT = NASG0 + NE * 256;
constexpr int YS_DUMMY = NASG0;
constexpr int NKEY = CTXL + SEQ;
constexpr float YS_SCALE = 16.f;
constexpr int MH = 8, QKD = 192, VD = 128;

constexpr size_t MiB = 1u << 20;
constexpr size_t WS_CTL = 0, CTL_ZERO_BYTES = 1 * MiB;
constexpr size_t WS_MOD = 1 * MiB;
constexpr size_t WS_ROPE = 2 * MiB;
constexpr size_t WS_WIN = 4 * MiB;
constexpr size_t WS_WOUT = 11 * MiB;
constexpr size_t WS_WLR = 13 * MiB;
constexpr size_t WS_WODIN = 15 * MiB;
constexpr size_t WS_WQUP = 16 * MiB;
constexpr size_t WS_WKVUP = 17 * MiB;
constexpr size_t WS_WODOUT = 18 * MiB;
constexpr size_t WS_ROUTE = 20 * MiB;
constexpr size_t WS_WGU = 24 * MiB;
constexpr size_t WS_WDN = 280 * MiB;
constexpr size_t WS_X1 = 408 * MiB;
constexpr size_t WS_H = 672 * MiB;
constexpr size_t WS_ARENA = 804 * MiB;
constexpr size_t WS_P = WS_ARENA;
constexpr size_t WS_LOUT = WS_P + 462 * MiB;
constexpr size_t WS_GLAO = WS_LOUT + 330 * MiB;
constexpr size_t WS_RWY = WS_GLAO + 132 * MiB;
constexpr size_t WS_ALR = WS_RWY + 132 * MiB;
constexpr size_t WS_BONUS = WS_ALR + 50 * MiB;
constexpr size_t WS_ACT = WS_ARENA;
constexpr size_t WS_YS = WS_ACT + 544 * MiB;
constexpr size_t WS_C = WS_ARENA;
constexpr size_t WS_QN = WS_C + 132 * MiB;
constexpr size_t WS_KVN = WS_QN + 32 * MiB;
constexpr size_t WS_Q8 = WS_KVN + 33 * MiB;
constexpr size_t WS_QR = WS_Q8 + 101 * MiB;
constexpr size_t WS_K8 = WS_QR + 64 * MiB;
constexpr size_t WS_V8T = WS_K8 + 108 * MiB;
constexpr size_t WS_V = WS_V8T + 67 * MiB;
constexpr size_t WS_END = 2048 * MiB;
static_assert(WS_BONUS + 5 * MiB <= WS_END && WS_YS + 529 * MiB <= WS_END && WS_V + 132 * MiB <= WS_END, "d_ws map");
constexpr int K8ROW = 208;
constexpr size_t RT_E = 0;
constexpr size_t RT_POS = 512 * 1024;
constexpr size_t RT_GATE = 1024 * 1024 + 512 * 1024;
constexpr size_t RT_HIST = 3 * MiB;
constexpr size_t RT_TOK = 3 * MiB + 64 * 1024;
constexpr size_t WS_SORT = WS_YS + 529 * MiB;
static_assert(WS_SORT + 4 * MiB <= WS_END, "sort lists");

constexpr int CW_TMO = 0, CW_CODE = 1;
constexpr int CW_BAR = 4096;

constexpr int RING_BYTES = 131072;
constexpr int LDS_BYTES = 163840;
constexpr int MISC_OFF = 163840 - 256;

__device__ __forceinline__ unsigned f2bf(float f) { unsigned u = __builtin_bit_cast(unsigned, f); return (u + 0x7fffu + ((u >> 16) & 1u)) >> 16; }
__device__ __forceinline__ float bf2f(unsigned h) { return __builtin_bit_cast(float, h << 16); }
typedef __bf16 bf16x2v __attribute__((ext_vector_type(2)));
__device__ __forceinline__ unsigned cvt_pk_bf16(float lo, float hi) { const f32x2 v = {lo, hi}; const bf16x2v r = __builtin_convertvector(v, bf16x2v); return __builtin_bit_cast(unsigned, r); }
__device__ __forceinline__ unsigned pk4_fp8(float a, float b, float c, float d) { unsigned w = 0u; w = (unsigned)__builtin_amdgcn_cvt_pk_fp8_f32(a, b, (int)w, false); w = (unsigned)__builtin_amdgcn_cvt_pk_fp8_f32(c, d, (int)w, true); return w; }
__device__ __forceinline__ float bflo(unsigned w) { return __builtin_bit_cast(float, w << 16); }
__device__ __forceinline__ float bfhi(unsigned w) { return __builtin_bit_cast(float, w & 0xffff0000u); }
__device__ __forceinline__ float wave_sum(float v) {
#pragma unroll
    for (int o = 1; o < 64; o <<= 1) v += __shfl_xor(v, o);
    return v;
}
__device__ __forceinline__ float sigmoidf_(float x) { return 1.f / (1.f + __expf(-x)); }

namespace pg8 {
constexpr int BM = 256, BK = 64, HALF = 128, HTB = HALF * BK * 2, STAGE_BYTES = 8 * HTB;
__host__ __device__ __forceinline__ int lds_byte(int r, int c) { const int st = (r >> 4) * 2 + (c >> 5), rr = r & 15, cc = c & 31, ob = rr * 64 + cc * 2; return st * 1024 + (ob ^ (((ob >> 9) & 1) << 5)); }
__host__ __device__ __forceinline__ void stage_rc(int b, int& R, int& C) { const int st = b / 1024, sb = b % 1024, swz = sb ^ (((sb >> 9) & 1) << 5); R = (st >> 1) * 16 + swz / 64; C = (st & 1) * 32 + (swz % 64) / 2; }
__host__ __device__ __forceinline__ int perm32(int rho) { const int n = rho >> 4, i = rho & 15; return 8 * (i >> 2) + 4 * n + (i & 3); }
struct Unit { int pm, pn; };

template <class Epi, class Sched, bool FP8 = false>
__device__ __forceinline__ void gemm_phase(LAS unsigned char* lds, const void* Abase, const int KBc, const Sched& S, const Epi& E) {
    int K = KBc; asm volatile("" : "+s"(K));
    const int tid = threadIdx.x, wid = __builtin_amdgcn_readfirstlane(tid >> 6), lane = tid & 63, wr = wid >> 2, wc = wid & 3, fr = lane & 15, fq = lane >> 4;
    const int nt = K / 128;
    int sR[2], sC[2]; unsigned voffB[2];
#pragma unroll
    for (int i = 0; i < 2; ++i) { int R, C; stage_rc(tid * 16 + i * 8192, R, C); const int Rb = Epi::PERM ? ((R & ~31) + perm32(R & 31)) : R; sR[i] = R; sC[i] = C; voffB[i] = (unsigned)(Rb * K + C * 2); }
    const size_t kstep = (size_t)(BK * 2);
    const size_t hstep = (size_t)HALF * K;
    const unsigned ldsw = (unsigned)wid * 1024u;
    const int aoff = lds_byte(wr * 64 + fr, fq * 8), boff = lds_byte(wc * 32 + fr, fq * 8);
    const char* Ab = (const char*)Abase;
#define PG8_SA(b, h) (((b) * 2 + (h)) * HTB)
#define PG8_SB(b, h) ((4 + (b) * 2 + (h)) * HTB)
#define PG8_STAGE(bufoff, gbase, voff) do { _Pragma("unroll") for (int _i = 0; _i < 2; ++_i) \
        __builtin_amdgcn_global_load_lds((const unsigned*)((const char*)(gbase) + (voff)[_i]), (LAS unsigned*)(lds + (bufoff) + ldsw + _i * 8192), 16, 0, 0); } while (0)
#define PG8_STAGEA(bufoff, kb, ao, h) do { _Pragma("unroll") for (int _i = 0; _i < 2; ++_i) \
        __builtin_amdgcn_global_load_lds((const unsigned*)((Ab + (kb)) + (ao)[h][_i]), (LAS unsigned*)(lds + (bufoff) + ldsw + _i * 8192), 16, 0, 0); } while (0)
#define PG8_STAGEA2(bufoff, kb, h) do { _Pragma("unroll") for (int _i = 0; _i < 2; ++_i) \
        __builtin_amdgcn_global_load_lds((const unsigned*)((Ab + (kb)) + (last ? nao[h][_i] : cao[h][_i])), (LAS unsigned*)(lds + (bufoff) + ldsw + _i * 8192), 16, 0, 0); } while (0)
#define PG8_LD8(p) __builtin_shufflevector(*(const LAS i32x4*)(p), *(const LAS i32x4*)((p) + 1024), 0, 1, 2, 3, 4, 5, 6, 7)
#define PG8_LDA(dst, b, h) do { _Pragma("unroll") for (int m = 0; m < 4; ++m) dst[m] = PG8_LD8(lds + PG8_SA(b, h) + aoff + m * 2048); } while (0)
#define PG8_LDB(dst, b, h) do { _Pragma("unroll") for (int n = 0; n < 2; ++n) dst[n] = PG8_LD8(lds + PG8_SB(b, h) + boff + n * 2048); } while (0)
#define PG8_MMA(ai, bj, At, Bt) do { __builtin_amdgcn_s_setprio(1); _Pragma("unroll") for (int m = 0; m < 4; ++m) _Pragma("unroll") for (int n = 0; n < 2; ++n) { \
        if constexpr (FP8) asm volatile("v_mfma_scale_f32_16x16x128_f8f6f4 %0, %1, %2, %0, %3, %4 op_sel_hi:[0,0,0]" : "+v"(acc[ai][bj][m][n]) : "v"(Bt[n]), "v"(At[m]), "v"(scl_w), "v"(scl_x)); \
        else { acc[ai][bj][m][n] = __builtin_amdgcn_mfma_f32_16x16x32_bf16(__builtin_bit_cast(bf16x8, __builtin_shufflevector(Bt[n], Bt[n], 0, 1, 2, 3)), __builtin_bit_cast(bf16x8, __builtin_shufflevector(At[m], At[m], 0, 1, 2, 3)), acc[ai][bj][m][n], 0, 0, 0); \
               acc[ai][bj][m][n] = __builtin_amdgcn_mfma_f32_16x16x32_bf16(__builtin_bit_cast(bf16x8, __builtin_shufflevector(Bt[n], Bt[n], 4, 5, 6, 7)), __builtin_bit_cast(bf16x8, __builtin_shufflevector(At[m], At[m], 4, 5, 6, 7)), acc[ai][bj][m][n], 0, 0, 0); } } \
        __builtin_amdgcn_s_setprio(0); } while (0)
#define PG8_WAIT_V(n) asm volatile("s_waitcnt vmcnt(" #n ")" ::: "memory")
#define PG8_WAIT_L(n) asm volatile("s_waitcnt lgkmcnt(" #n ")" ::: "memory")
#define PG8_BAR __builtin_amdgcn_s_barrier()
#define PG8_SCHED __builtin_amdgcn_sched_barrier(0)
    Unit cur, nxt; int ui = 0;
    if (!S.next(0, cur)) return;
    f32x4 acc[2][2][4][2];
#pragma unroll
    for (int a = 0; a < 2; ++a)
#pragma unroll
        for (int b = 0; b < 2; ++b)
#pragma unroll
            for (int m = 0; m < 4; ++m)
#pragma unroll
                for (int n = 0; n < 2; ++n) acc[a][b][m][n] = (f32x4){0.f, 0.f, 0.f, 0.f};
    i32x8 At[4], B0[2], B1[2];
    int scl_w = 0x7A7A7A7A, scl_x = 0x7F7F7F7F;
    asm volatile("" : "+v"(scl_w), "+v"(scl_x));
    unsigned cao[2][2], nao[2][2];
    S.a_offs(cur, cao, sR, sC);
    const char* cB = S.b_tile(cur);
    PG8_STAGE(PG8_SB(0, 0), cB, voffB); PG8_STAGE(PG8_SB(0, 1), cB + hstep, voffB); PG8_STAGEA(PG8_SA(0, 0), 0, cao, 0); PG8_STAGEA(PG8_SA(0, 1), 0, cao, 1);
    if (wr == 1) PG8_BAR;
    PG8_WAIT_V(2); PG8_BAR;
    PG8_STAGE(PG8_SB(1, 0), cB + kstep, voffB); PG8_STAGEA(PG8_SA(1, 0), kstep, cao, 0); PG8_STAGE(PG8_SB(1, 1), cB + hstep + kstep, voffB);
    PG8_WAIT_V(6); PG8_BAR;
    for (;;) {
        const bool has_next = S.next(ui + 1, nxt);
        const char* nB = cB;
        if (has_next) { S.a_offs(nxt, nao, sR, sC); nB = S.b_tile(nxt); }
        else {
#pragma unroll
            for (int h = 0; h < 2; ++h)
#pragma unroll
                for (int i = 0; i < 2; ++i) nao[h][i] = cao[h][i];
        }
        for (int t = 0; t < nt; t += 2) {
            const bool last = (t == nt - 2);
            const size_t a1k = (size_t)(t + 1) * kstep;
            const size_t a2k = last ? 0 : (size_t)(t + 2) * kstep; const char* b2 = last ? nB : cB + (size_t)(t + 2) * kstep;
            const size_t a3k = a2k + kstep; const char* b3 = b2 + kstep;
            PG8_LDB(B0, 0, 0); PG8_LDB(B1, 0, 1); PG8_SCHED; PG8_LDA(At, 0, 0); PG8_STAGEA(PG8_SA(1, 1), a1k, cao, 1);
            PG8_WAIT_V(8); PG8_WAIT_L(0); PG8_BAR; PG8_MMA(0, 0, At, B0); PG8_MMA(0, 1, At, B1); PG8_BAR; PG8_SCHED;
            PG8_LDA(At, 0, 1); PG8_STAGE(PG8_SB(0, 0), b2, voffB); PG8_STAGE(PG8_SB(0, 1), b2 + hstep, voffB); PG8_STAGEA2(PG8_SA(0, 0), a2k, 0);
            PG8_WAIT_V(8); PG8_WAIT_L(0); PG8_BAR; PG8_MMA(1, 0, At, B0); PG8_MMA(1, 1, At, B1); PG8_BAR; PG8_SCHED;
            PG8_LDB(B0, 1, 0); PG8_LDB(B1, 1, 1); PG8_SCHED; PG8_LDA(At, 1, 0); PG8_STAGEA2(PG8_SA(0, 1), a2k, 1);
            PG8_WAIT_V(8); PG8_WAIT_L(0); PG8_BAR; PG8_MMA(0, 0, At, B0); PG8_MMA(0, 1, At, B1); PG8_BAR; PG8_SCHED;
            PG8_LDA(At, 1, 1); PG8_STAGE(PG8_SB(1, 0), b3, voffB); PG8_STAGE(PG8_SB(1, 1), b3 + hstep, voffB); PG8_STAGEA2(PG8_SA(1, 0), a3k, 0);
            PG8_WAIT_V(8); PG8_WAIT_L(0); PG8_BAR; PG8_MMA(1, 0, At, B0); PG8_MMA(1, 1, At, B1); PG8_BAR; PG8_SCHED;
        }
        if (wr == 0) PG8_BAR;
        if constexpr (FP8) asm volatile("s_nop 15\n\ts_nop 7" ::: "memory");
        E(acc, cur, wr, wc, fr, fq);
        if (!has_next) break;
#pragma unroll
        for (int a = 0; a < 2; ++a)
#pragma unroll
            for (int b = 0; b < 2; ++b)
#pragma unroll
                for (int m = 0; m < 4; ++m)
#pragma unroll
                    for (int n = 0; n < 2; ++n) acc[a][b][m][n] = (f32x4){0.f, 0.f, 0.f, 0.f};
        cur = nxt; cB = nB; ++ui;
#pragma unroll
        for (int h = 0; h < 2; ++h)
#pragma unroll
            for (int i = 0; i < 2; ++i) cao[h][i] = nao[h][i];
        if (wr == 1) PG8_BAR;
    }
    PG8_WAIT_V(0);
    PG8_BAR;
#undef PG8_SA
#undef PG8_SB
#undef PG8_STAGE
#undef PG8_STAGEA
#undef PG8_STAGEA2
#undef PG8_LDA
#undef PG8_LDB
#undef PG8_MMA
#undef PG8_WAIT_V
#undef PG8_WAIT_L
#undef PG8_BAR
#undef PG8_SCHED
}
}

#define XB_TMO      128
#define XB_XCNT(j)  (256  + 64 * (j))
#define XB_XSUB(j)  (1280 + 64 * (j))
#define XB_XGEN(j)  (2304 + 64 * (j))
#define XB_TOP      3328
#define XB_TOPGEN   3392
#define XCD_BAR_WORDS 3456
#define XB_SPIN_CAP (1u << 22)
__device__ __forceinline__ unsigned xb_ld(unsigned* p)              { return __hip_atomic_load(p, __ATOMIC_RELAXED, __HIP_MEMORY_SCOPE_AGENT); }
__device__ __forceinline__ unsigned xb_add(unsigned* p, unsigned v) { return __hip_atomic_fetch_add(p, v, __ATOMIC_RELAXED, __HIP_MEMORY_SCOPE_AGENT); }
__device__ __forceinline__ unsigned xb_xcc_id() { return (unsigned)__builtin_amdgcn_s_getreg((3 << 11) | 20) & 0xFu; }
#define XB_SPIN(cond, bar) do { unsigned _sp = 0; while (cond) { __builtin_amdgcn_s_sleep(1); \
    if ((++_sp & 255u) == 0u) { if (xb_ld(&(bar)[XB_TMO])) break; if (_sp > XB_SPIN_CAP) { atomicAdd(&(bar)[XB_TMO], 1u); break; } } } } while (0)
struct XcdBarrier { unsigned* bar; unsigned x; volatile LAS unsigned* st; };
__device__ __forceinline__ XcdBarrier xcd_barrier_post(unsigned* bar, volatile LAS unsigned* st) {
    XcdBarrier b; b.bar = bar; b.x = xb_xcc_id(); b.st = st;
    if (threadIdx.x == 0) (void)xb_add(&bar[XB_XCNT(b.x)], 1u);
    return b;
}
__device__ __forceinline__ void xcd_barrier_complete(unsigned* bar, unsigned x, unsigned& nloc, unsigned& nx) {
    const unsigned G = gridDim.x * gridDim.y * gridDim.z;
    unsigned sum, cnt, mine, sp = 0u;
    for (;;) {
        sum = 0u; cnt = 0u; mine = 0u;
#pragma unroll
        for (unsigned j = 0; j < 16; ++j) { const unsigned c = xb_ld(&bar[XB_XCNT(j)]); sum += c; cnt += (c > 0u) ? 1u : 0u; mine = (j == x) ? c : mine; }
        if (sum == G) break;
        __builtin_amdgcn_s_sleep(1);
        if ((++sp & 255u) == 0u) { if (xb_ld(&bar[XB_TMO])) break; if (sp > XB_SPIN_CAP) { atomicAdd(&bar[XB_TMO], 1u); break; } }
    }
    nloc = mine > 0u ? mine : 1u; nx = cnt > 0u ? cnt : 1u;
}
__device__ __forceinline__ void xcd_barrier(const XcdBarrier& b) {
    asm volatile("s_waitcnt vmcnt(0)" ::: "memory");
    __syncthreads();
    if (threadIdx.x == 0) {
        unsigned* bar = b.bar;
        __builtin_amdgcn_s_waitcnt(0);
        unsigned nloc = b.st[0], nx = b.st[1];
        if (nloc == 0u) { xcd_barrier_complete(bar, b.x, nloc, nx); b.st[0] = nloc; b.st[1] = nx; }
        const unsigned old = xb_add(&bar[XB_XSUB(b.x)], 1u);
        const unsigned gen = old / nloc;
        if (old + 1u == (gen + 1u) * nloc) {
            __builtin_amdgcn_fence(__ATOMIC_RELEASE, "agent");
            asm volatile("s_waitcnt vmcnt(0)" ::: "memory");
            const unsigned og = xb_add(&bar[XB_TOP], 1u);
            const unsigned tg = og / nx;
            if (og + 1u == (tg + 1u) * nx) xb_add(&bar[XB_TOPGEN], 1u);
            else XB_SPIN(xb_ld(&bar[XB_TOPGEN]) == tg, bar);
            __builtin_amdgcn_fence(__ATOMIC_ACQUIRE, "agent");
            xb_add(&bar[XB_XGEN(b.x)], 1u);
            asm volatile("s_waitcnt vmcnt(0)" ::: "memory");
        } else {
            XB_SPIN(xb_ld(&bar[XB_XGEN(b.x)]) == gen, bar);
            __builtin_amdgcn_fence(__ATOMIC_ACQUIRE, "agent");
            asm volatile("s_waitcnt vmcnt(0)" ::: "memory");
        }
    }
    __syncthreads();
}

struct Frame {
    LAS unsigned char* lds;
    int tid, lane, wave, G, bid;
    const float* const __attribute__((address_space(4)))* in;
    float* out;
    unsigned char* ws;
};
enum { I_X = 0, I_C, I_CTX, I_CCTX, I_ADAW, I_ADAB, I_N1G, I_N2G, I_EVWIN, I_EVWOUT, I_GKUP, I_GKB, I_GNG, I_MU, I_W0, I_W2, I_A0, I_A2, I_KK, I_KA, I_RK, I_G2, I_LNW, I_LNB,
       I_ODWIN, I_QNORM, I_WQUP, I_KVNORM, I_WKVUP, I_ODWOUT, I_RW, I_RB, I_GUW, I_GUB, I_DNW, I_DNB, I_FNG };
template <class T> __device__ __forceinline__ T* wsp(const Frame& F, size_t off) { return (T*)(F.ws + off); }
__device__ __forceinline__ int mod_row(int row) { return row < NLAT ? (row >> 13) : 8; }
__device__ __forceinline__ const float* mod_ptr(const Frame& F, int layer, int row, int which) { return wsp<const float>(F, WS_MOD) + ((size_t)(layer * 9 + mod_row(row)) * 6 + which) * 1024; }

__device__ __forceinline__ void p0_mod(Frame& F) {
    LAS float* s = (LAS float*)F.lds;
    LAS float* red = (LAS float*)(F.lds + 9 * 1024 * 4);
    const float* c = F.in[I_C]; const float* cc = F.in[I_CCTX]; const float* W = F.in[I_ADAW]; const float* Bv = F.in[I_ADAB];
    for (int idx = F.tid; idx < 9 * 1024; idx += 512) { const int r = idx >> 10, k = idx & 1023; const float v = r < 8 ? c[r * 1024 + k] : cc[k]; s[idx] = v / (1.f + __expf(-v)); }
    __syncthreads();
    for (int item = F.bid; item < 192; item += F.G) {
        const int l = item / 96, n0 = (item % 96) * 64;
        float acc[9];
#pragma unroll
        for (int r = 0; r < 9; ++r) acc[r] = 0.f;
        const float* wp = W + ((size_t)l * 1024 + F.wave * 128) * 6144 + n0 + F.lane;
        for (int k = 0; k < 128; ++k) { const float wv = wp[(size_t)k * 6144];
#pragma unroll
            for (int r = 0; r < 9; ++r) acc[r] += s[r * 1024 + F.wave * 128 + k] * wv; }
#pragma unroll
        for (int r = 0; r < 9; ++r) red[(F.wave * 9 + r) * 64 + F.lane] = acc[r];
        __syncthreads();
        for (int idx = F.tid; idx < 576; idx += 512) { const int r = idx >> 6, ln = idx & 63; float v = Bv[l * 6144 + n0 + ln];
#pragma unroll
            for (int w = 0; w < 8; ++w) v += red[(w * 9 + r) * 64 + ln];
            wsp<float>(F, WS_MOD)[(size_t)(l * 9 + r) * 6144 + n0 + ln] = v; }
        __syncthreads();
    }
}
__device__ __forceinline__ void p0_rope(Frame& F) {
    for (int idx = F.bid * 512 + F.tid; idx < SEQ * 32; idx += F.G * 512) {
        const int t = idx >> 5, i = idx & 31;
        const float fr = (float)pow(10000.0, -(double)(i & 15) / 16.0);
        const float pos = (float)(i < 16 ? (t >> 6) : (t & 63));
        const float ang = pos * fr;
        const double a = (double)ang;
        wsp<f32x2>(F, WS_ROPE)[idx] = (f32x2){(float)cos(a), (float)sin(a)};
    }
}
template <class V> __device__ __forceinline__ void cvt_item(const V& val, bf16* dst, int K, int item, int nblk, LAS float* scr, int lane) {
    const int kb = item / nblk, nb = item % nblk, k0 = 64 * kb, n0 = 32 * nb;
#pragma unroll 8
    for (int i = 0; i < 32; ++i) { const int kk = 2 * i + (lane >> 5); scr[kk * 33 + (lane & 31)] = val(n0 + (lane & 31), k0 + kk); }
    LDS_WAIT(); asm volatile("" ::: "memory");
    const int c = lane & 7;
#pragma unroll
    for (int j = 0; j < 4; ++j) { const int n = (lane >> 3) + 8 * j; const LAS float* sp = scr + (8 * c) * 33 + n;
        u32x4 o; o.x = f2bf(sp[0 * 33]) | (f2bf(sp[1 * 33]) << 16); o.y = f2bf(sp[2 * 33]) | (f2bf(sp[3 * 33]) << 16); o.z = f2bf(sp[4 * 33]) | (f2bf(sp[5 * 33]) << 16); o.w = f2bf(sp[6 * 33]) | (f2bf(sp[7 * 33]) << 16);
        *(u32x4*)(dst + (size_t)(n0 + n) * K + k0 + 8 * c) = o; }
    LDS_WAIT(); asm volatile("" ::: "memory");
}
template <class V> __device__ __forceinline__ void cvt_item_fp8(const V& val, unsigned char* dst, int K, int item, int nblk, LAS float* scr, int lane) {
    const int kb = item / nblk, nb = item % nblk, k0 = 64 * kb, n0 = 32 * nb;
#pragma unroll 8
    for (int i = 0; i < 32; ++i) { const int kk = 2 * i + (lane >> 5); scr[kk * 33 + (lane & 31)] = 32.f * val(n0 + (lane & 31), k0 + kk); }
    LDS_WAIT(); asm volatile("" ::: "memory");
    const int c = lane & 7;
#pragma unroll
    for (int j = 0; j < 4; ++j) { const int n = (lane >> 3) + 8 * j; const LAS float* sp = scr + (8 * c) * 33 + n;
        *(u32x2*)(dst + (size_t)(n0 + n) * K + k0 + 8 * c) = (u32x2){pk4_fp8(sp[0 * 33], sp[1 * 33], sp[2 * 33], sp[3 * 33]), pk4_fp8(sp[4 * 33], sp[5 * 33], sp[6 * 33], sp[7 * 33])}; }
    LDS_WAIT(); asm volatile("" ::: "memory");
}
template <class V4> __device__ __forceinline__ void cvt_item_fp8_wide(const V4& col4, const float* W, int ld, unsigned char* dst, int K, int item, int nblk, LAS float* scr, int lane) {
    const int kb = item / nblk, nb = item % nblk, k0 = 64 * kb, n0 = 64 * nb;
    const float* src = W + (size_t)(k0 + (lane >> 4)) * ld + col4(n0 + (lane & 15) * 4);
#pragma unroll
    for (int i = 0; i < 16; ++i) { const f32x4 v = *(const f32x4*)(src + (size_t)(4 * i) * ld); LAS float* sp = scr + (4 * i + (lane >> 4)) * 68 + (lane & 15) * 4; *(LAS f32x4*)sp = v; }
    LDS_WAIT(); asm volatile("" ::: "memory");
    const int nl = lane >> 2, part = lane & 3;
#pragma unroll
    for (int j = 0; j < 4; ++j) { const int n = nl + 16 * j; const LAS float* sp = scr + (part * 16) * 68 + n; unsigned o[4];
#pragma unroll
        for (int e = 0; e < 4; ++e) o[e] = pk4_fp8(32.f * sp[(4 * e) * 68], 32.f * sp[(4 * e + 1) * 68], 32.f * sp[(4 * e + 2) * 68], 32.f * sp[(4 * e + 3) * 68]);
        *(u32x4*)(dst + (size_t)(n0 + n) * K + k0 + part * 16) = (u32x4){o[0], o[1], o[2], o[3]}; }
    LDS_WAIT(); asm volatile("" ::: "memory");
}
struct C4Gu { __device__ __forceinline__ int operator()(int n) const { return ((n & 128) ? 1024 : 0) + (n >> 8) * 128 + (n & 127); } };
struct C4Id { __device__ __forceinline__ int operator()(int n) const { return n; } };
struct VPlain { const float* W; int ldn, Nr, Kr; __device__ __forceinline__ float operator()(int n, int k) const { return (n < Nr && k < Kr) ? W[(size_t)k * ldn + n] : 0.f; } };
struct VWin { const float* W; __device__ __forceinline__ float operator()(int n, int k) const { const int col = n < GLA_COLS ? n : ((n >= RW0 && n < RW0 + RW_COLS) ? n - (RW0 - GLA_COLS) : -1); return col >= 0 ? W[(size_t)k * (GLA_COLS + RW_COLS) + col] : 0.f; } };
struct VQup { const float* W; __device__ __forceinline__ float operator()(int n, int k) const { const int col = n < 1024 ? (n >> 7) * 192 + (n & 127) : ((n - 1024) >> 6) * 192 + 128 + ((n - 1024) & 63); return W[(size_t)k * 1536 + col]; } };
struct VGu { const float* W; __device__ __forceinline__ float operator()(int n, int k) const { const int col = ((n & 128) ? 1024 : 0) + (n >> 8) * 128 + (n & 127); return W[(size_t)k * 2048 + col]; } };
struct VLr { const float *w2, *a2, *g2; __device__ __forceinline__ float operator()(int n, int k) const {
        if (n < 1024) return k < 64 ? w2[((size_t)(n >> 9) * 64 + k) * 512 + (n & 511)] : 0.f;
        if (n < 2048) return (k >= 64 && k < 128) ? a2[((size_t)((n - 1024) >> 9) * 64 + (k - 64)) * 512 + (n & 511)] : 0.f;
        return (k >= 128 && k < 288) ? g2[(size_t)(k - 128) * 512 + (n - 2048)] : 0.f; } };
__device__ __forceinline__ void p0_convert(Frame& F) {
    LAS float* scrw = (LAS float*)(F.lds + F.wave * 17408);
    LAS float* scr = scrw;
    const int gw = F.bid * 8 + F.wave, NGW = F.G * 8;
    constexpr int I_WIN = (1024 / 64) * (PW / 32), I_SQ = (1024 / 64) * (1024 / 32), I_LR = (LRK / 64) * (LRN / 32), I_ODIN = (1024 / 64) * (512 / 32), I_QUP = (256 / 64) * (1536 / 32), I_KVUP = (256 / 64) * (2048 / 32);
    constexpr int I_GU1 = (1024 / 64) * (2048 / 64), I_DN1 = (1024 / 64) * (1024 / 64);
    constexpr int NSMALL = I_WIN + I_SQ + I_LR + I_ODIN + I_QUP + I_KVUP + I_SQ;
    constexpr int NITEMS = NSMALL + 32 * I_GU1 + 32 * I_DN1;
    for (int it = gw; it < NITEMS; it += NGW) {
        int r = it;
        if (r < I_WIN) { cvt_item(VWin{F.in[I_EVWIN]}, wsp<bf16>(F, WS_WIN), 1024, r, PW / 32, scr, F.lane); continue; } r -= I_WIN;
        if (r < I_SQ) { cvt_item(VPlain{F.in[I_EVWOUT], 1024, 1024, 1024}, wsp<bf16>(F, WS_WOUT), 1024, r, 32, scr, F.lane); continue; } r -= I_SQ;
        if (r < I_LR) { cvt_item(VLr{F.in[I_W2], F.in[I_A2], F.in[I_G2]}, wsp<bf16>(F, WS_WLR), LRK, r, LRN / 32, scr, F.lane); continue; } r -= I_LR;
        if (r < I_ODIN) { cvt_item_fp8(VPlain{F.in[I_ODWIN], 448, 448, 1024}, wsp<unsigned char>(F, WS_WODIN), 1024, r, 16, scr, F.lane); continue; } r -= I_ODIN;
        if (r < I_QUP) { cvt_item(VQup{F.in[I_WQUP]}, wsp<bf16>(F, WS_WQUP), 256, r, 48, scr, F.lane); continue; } r -= I_QUP;
        if (r < I_KVUP) { cvt_item(VPlain{F.in[I_WKVUP], 2048, 2048, 128}, wsp<bf16>(F, WS_WKVUP), 256, r, 64, scr, F.lane); continue; } r -= I_KVUP;
        if (r < I_SQ) { cvt_item_fp8(VPlain{F.in[I_ODWOUT], 1024, 1024, 1024}, wsp<unsigned char>(F, WS_WODOUT), 1024, r, 32, scr, F.lane); continue; } r -= I_SQ;
        if (r < 32 * I_GU1) { const int le = r / I_GU1, ri = r % I_GU1; cvt_item_fp8_wide(C4Gu{}, F.in[I_GUW] + (size_t)le * 1024 * 2048, 2048, wsp<unsigned char>(F, WS_WGU) + (size_t)le * 2048 * 1024, 1024, ri, 32, scrw, F.lane); continue; } r -= 32 * I_GU1;
        { const int le = r / I_DN1, ri = r % I_DN1; cvt_item_fp8_wide(C4Id{}, F.in[I_DNW] + (size_t)le * 1024 * 1024, 1024, wsp<unsigned char>(F, WS_WDN) + (size_t)le * 1024 * 1024, 1024, ri, 16, scrw, F.lane); }
    }
}

constexpr int FILL_N = 32 * 512 + 32 * 256, FILL_A = 6144, FILL_B = 9216, FILL_C = 19840, FILL_D = 21760, FILL_E = FILL_N;
__device__ __forceinline__ void p_fill_convert(Frame& F, int slot, int nslots, int i0, int i1) {
    LAS float* scrw = (LAS float*)(F.lds + F.wave * 17408);
    for (int i = i0 + slot * 8 + F.wave; i < i1; i += nslots * 8) {
        if (i < 32 * 512) { const int le = 32 + (i >> 9), ri = i & 511; cvt_item_fp8_wide(C4Gu{}, F.in[I_GUW] + (size_t)le * 1024 * 2048, 2048, wsp<unsigned char>(F, WS_WGU) + (size_t)le * 2048 * 1024, 1024, ri, 32, scrw, F.lane); }
        else { const int j = i - 32 * 512; const int le = 32 + (j >> 8), ri = j & 255; cvt_item_fp8_wide(C4Id{}, F.in[I_DNW] + (size_t)le * 1024 * 1024, 1024, wsp<unsigned char>(F, WS_WDN) + (size_t)le * 1024 * 1024, 1024, ri, 16, scrw, F.lane); }
    }
}

struct RowV { f32x4 v[4]; };
__device__ __forceinline__ void row_load(RowV& r, const float* p, int lane) {
#pragma unroll
    for (int j = 0; j < 4; ++j) r.v[j] = ((const f32x4*)p)[lane + 64 * j];
}
__device__ __forceinline__ float row_ss(const RowV& r) {
    float s = 0.f;
#pragma unroll
    for (int j = 0; j < 4; ++j) s += (r.v[j].x * r.v[j].x + r.v[j].y * r.v[j].y) + (r.v[j].z * r.v[j].z + r.v[j].w * r.v[j].w);
    return wave_sum(s);
}
__device__ __forceinline__ void row_modulate(RowV& r, float rstd, const float* g, const float* sh, const float* sc, int lane) {
#pragma unroll
    for (int j = 0; j < 4; ++j) { const f32x4 gv = ((const f32x4*)g)[lane + 64 * j], shv = ((const f32x4*)sh)[lane + 64 * j], scv = ((const f32x4*)sc)[lane + 64 * j];
        r.v[j] = r.v[j] * rstd * gv * (scv + 1.0f) + shv; }
}
__device__ __forceinline__ void row_store_bf16(const RowV& r, bf16* p, int lane) {
#pragma unroll
    for (int j = 0; j < 4; ++j) { u32x2 w; w.x = cvt_pk_bf16(r.v[j].x, r.v[j].y); w.y = cvt_pk_bf16(r.v[j].z, r.v[j].w); ((u32x2*)p)[lane + 64 * j] = w; }
}
__device__ __forceinline__ void row_load_bf16x(RowV& r, const bf16* p, int lane) {
#pragma unroll
    for (int j = 0; j < 4; ++j) { const u32x2 w = ((const u32x2*)p)[lane + 64 * j]; r.v[j] = (f32x4){bflo(w.x), bfhi(w.x), bflo(w.y), bfhi(w.y)}; }
}
__device__ __forceinline__ void row_store_fp8(const RowV& r, unsigned char* p, int lane) {
#pragma unroll
    for (int j = 0; j < 4; ++j) ((unsigned*)p)[lane + 64 * j] = pk4_fp8(r.v[j].x, r.v[j].y, r.v[j].z, r.v[j].w);
}
__device__ __forceinline__ void row_add_moe(RowV& r, const unsigned char* ys, int row, const float* gate, int lane) {
#pragma unroll
    for (int j = 0; j < 4; ++j) { f32x4 s = (f32x4){0.f, 0.f, 0.f, 0.f};
#pragma unroll
        for (int k = 0; k < 4; ++k) { const int w = ((const int*)(ys + (size_t)(row * 4 + k) * 1024))[lane + 64 * j];
            s.x += __builtin_amdgcn_cvt_f32_fp8(w, 0); s.y += __builtin_amdgcn_cvt_f32_fp8(w, 1); s.z += __builtin_amdgcn_cvt_f32_fp8(w, 2); s.w += __builtin_amdgcn_cvt_f32_fp8(w, 3); }
        const f32x4 gv = ((const f32x4*)gate)[lane + 64 * j]; r.v[j] = r.v[j] + gv * s * (1.f / YS_SCALE); }
}
struct ModC { int key; f32x4 gs[4], sh[4];
    __device__ __forceinline__ void get(const Frame& F, int layer, int row, const float* g, int lane) { const int k = mod_row(row); if (k == key) return; key = k;
        const f32x4* shp = (const f32x4*)mod_ptr(F, layer, row, 0); const f32x4* scp = (const f32x4*)mod_ptr(F, layer, row, 1);
#pragma unroll
        for (int j = 0; j < 4; ++j) { gs[j] = ((const f32x4*)g)[lane + 64 * j] * (scp[lane + 64 * j] + 1.0f); sh[j] = shp[lane + 64 * j]; } }
    __device__ __forceinline__ void apply(RowV& r, float rstd) const {
#pragma unroll
        for (int j = 0; j < 4; ++j) r.v[j] = r.v[j] * rstd * gs[j] + sh[j]; } };
struct GateC { int key; f32x4 gt[4];
    __device__ __forceinline__ void get(const Frame& F, int layer, int row, int lane) { const int k = mod_row(row); if (k == key) return; key = k; const f32x4* gp = (const f32x4*)mod_ptr(F, layer, row, 5);
#pragma unroll
        for (int j = 0; j < 4; ++j) gt[j] = gp[lane + 64 * j] * (1.f / YS_SCALE); }
    __device__ __forceinline__ void add_moe(RowV& r, const unsigned char* ys, int row, int lane) const {
#pragma unroll
        for (int j = 0; j < 4; ++j) { f32x4 s = (f32x4){0.f, 0.f, 0.f, 0.f};
#pragma unroll
            for (int k = 0; k < 4; ++k) { const int w = ((const int*)(ys + (size_t)(row * 4 + k) * 1024))[lane + 64 * j];
                s.x += __builtin_amdgcn_cvt_f32_fp8(w, 0); s.y += __builtin_amdgcn_cvt_f32_fp8(w, 1); s.z += __builtin_amdgcn_cvt_f32_fp8(w, 2); s.w += __builtin_amdgcn_cvt_f32_fp8(w, 3); }
            r.v[j] = r.v[j] + gt[j] * s; } } };
__device__ __forceinline__ const float* src_row_l0(const Frame& F, int row) { return row < NLAT ? F.in[I_X] + (size_t)row * 1024 : F.in[I_CTX] + (size_t)(row - NLAT) * 1024; }

__device__ __forceinline__ void p_norm1_l0(Frame& F) {
    const int gw = F.bid * 8 + F.wave, NGW = F.G * 8;
    ModC mc; mc.key = -1;
    for (int row = gw; row < NTOK; row += NGW) {
        RowV r; row_load(r, src_row_l0(F, row), F.lane);
        const float rstd = 1.f / sqrtf(row_ss(r) * (1.f / 1024.f) + 1e-6f);
        mc.get(F, 0, row, F.in[I_N1G], F.lane); mc.apply(r, rstd);
        row_store_bf16(r, wsp<bf16>(F, WS_H) + (size_t)row * 1024, F.lane);
    }
}
__device__ __forceinline__ void p_combine_norm1_l1(Frame& F) {
    const int gw = F.bid * 8 + F.wave, NGW = F.G * 8;
    ModC mc; mc.key = -1; GateC gc; gc.key = -1;
    for (int row = gw; row < NTOK; row += NGW) {
        bf16* xp = wsp<bf16>(F, WS_X1) + (size_t)row * 1024;
        RowV r; row_load_bf16x(r, xp, F.lane);
        gc.get(F, 0, row, F.lane); gc.add_moe(r, wsp<const unsigned char>(F, WS_YS), row, F.lane);
        row_store_bf16(r, xp, F.lane);
        const float rstd = 1.f / sqrtf(row_ss(r) * (1.f / 1024.f) + 1e-6f);
        mc.get(F, 1, row, F.in[I_N1G] + 1024, F.lane); mc.apply(r, rstd);
        row_store_fp8(r, wsp<unsigned char>(F, WS_H) + (size_t)row * 1024, F.lane);
    }
}
__device__ __forceinline__ void p_final(Frame& F) {
    const int gw = F.bid * 8 + F.wave, NGW = F.G * 8;
    GateC gc; gc.key = -1; f32x4 fg[4];
#pragma unroll
    for (int j = 0; j < 4; ++j) fg[j] = ((const f32x4*)F.in[I_FNG])[F.lane + 64 * j];
    for (int row = gw; row < NLAT; row += NGW) {
        RowV r; row_load_bf16x(r, wsp<const bf16>(F, WS_X1) + (size_t)row * 1024, F.lane);
        gc.get(F, 1, row, F.lane); gc.add_moe(r, wsp<const unsigned char>(F, WS_YS), row, F.lane);
        const float rstd = 1.f / sqrtf(row_ss(r) * (1.f / 1024.f) + 1e-6f);
#pragma unroll
        for (int j = 0; j < 4; ++j) ((f32x4*)(F.out + (size_t)row * 1024))[F.lane + 64 * j] = r.v[j] * rstd * fg[j];
    }
}

constexpr int RT_WS = 2064;
constexpr int RT_WHI = 0, RT_WLO = 32 * RT_WS;
constexpr int RT_TAB = 2 * 32 * RT_WS;
constexpr int RT_TABSZ = 8320;
constexpr int RT_LDS_CNT = RT_TAB + 2 * RT_TABSZ;
__device__ __forceinline__ void vb_tiles(int vb, int ntok, int& t0, int& nt) { const int ntile = ntok >> 5, q = ntile >> 8, r = ntile & 255; if (vb < r) { t0 = vb * (q + 1); nt = q + 1; } else { t0 = r * (q + 1) + (vb - r) * q; nt = q; } }
__device__ __forceinline__ void p_norm2_route(Frame& F, const int layer, const int ntok) {
    LAS unsigned char* L = F.lds;
    LAS int* cnt = (LAS int*)(L + RT_LDS_CNT);
    const int tid = F.tid, lane = F.lane, wave = F.wave, t = lane & 31, hi = lane >> 5;
    const float* rw = F.in[I_RW] + (size_t)layer * 1024 * 32;
    for (int idx = tid; idx < 1024 * 32; idx += 512) { const int k = idx >> 5, e = idx & 31; const float w = rw[idx]; const unsigned h = f2bf(w); const unsigned l = f2bf(w - bf2f(h));
        *(LAS unsigned short*)(L + RT_WHI + e * RT_WS + k * 2) = (unsigned short)h; *(LAS unsigned short*)(L + RT_WLO + e * RT_WS + k * 2) = (unsigned short)l; }
    unsigned char* rt = F.ws + WS_ROUTE;
    const float* g2 = F.in[I_N2G] + layer * 1024;
    const bf16* X = wsp<const bf16>(F, WS_X1); unsigned char* H8 = wsp<unsigned char>(F, WS_H);
    for (int vb = F.bid; vb < 256; vb += F.G) {
        int t0, nt; vb_tiles(vb, ntok, t0, nt);
        const int mr0 = mod_row(t0 * 32), mr1 = mod_row((t0 + nt) * 32 - 1);
        __syncthreads();
        if (tid < 32) cnt[tid] = 0;
        for (int sl = 0; sl < 2; ++sl) { const int mr = sl ? mr1 : mr0; LAS float* tb = (LAS float*)(L + RT_TAB + sl * RT_TABSZ);
            const float* shp = wsp<const float>(F, WS_MOD) + ((size_t)(layer * 9 + mr) * 6 + 3) * 1024; const float* scp = shp + 1024;
            for (int k = tid; k < 1024; k += 512) { tb[k] = g2[k] * (1.f + scp[k]); tb[1024 + k] = shp[k]; } }
        __syncthreads();
        for (int sl = 0; sl < 2; ++sl) { LAS float* tb = (LAS float*)(L + RT_TAB + sl * RT_TABSZ); LAS float* red = (LAS float*)(L + RT_LDS_CNT + 256);
            const int e = tid & 31, kp = tid >> 5; float sacc = 0.f;
            for (int k = kp * 64; k < kp * 64 + 64; ++k) sacc += tb[1024 + k] * rw[k * 32 + e];
            red[kp * 32 + e] = sacc; __syncthreads();
            if (tid < 32) { float c = F.in[I_RB][layer * 32 + tid]; for (int i = 0; i < 16; ++i) c += red[i * 32 + tid]; tb[2048 + tid] = c; }
            __syncthreads(); }
        for (int ti = wave; ti < nt; ti += 8) {
            const int tile = t0 + ti, row = tile * 32 + t; const int sl = (mod_row(tile * 32) == mr0) ? 0 : 1;
            const LAS float* tb = (const LAS float*)(L + RT_TAB + sl * RT_TABSZ);
            const bf16* xp = X + (size_t)row * 1024 + hi * 8;
            f32x16 acc;
#pragma unroll
            for (int r = 0; r < 16; ++r) acc[r] = 0.f;
            float ss = 0.f;
#pragma unroll 4
            for (int s = 0; s < 64; ++s) {
                const u32x4 xw = *(const u32x4*)(xp + s * 16); const f32x4 x0 = {bflo(xw.x), bfhi(xw.x), bflo(xw.y), bfhi(xw.y)}, x1 = {bflo(xw.z), bfhi(xw.z), bflo(xw.w), bfhi(xw.w)};
                const f32x4 g0 = *(const LAS f32x4*)(tb + s * 16 + hi * 8), g1 = *(const LAS f32x4*)(tb + s * 16 + hi * 8 + 4);
                ss += (x0.x * x0.x + x0.y * x0.y) + (x0.z * x0.z + x0.w * x0.w) + (x1.x * x1.x + x1.y * x1.y) + (x1.z * x1.z + x1.w * x1.w);
                const f32x4 y0 = x0 * g0, y1 = x1 * g1;
                u32x4 hh; hh.x = cvt_pk_bf16(y0.x, y0.y); hh.y = cvt_pk_bf16(y0.z, y0.w); hh.z = cvt_pk_bf16(y1.x, y1.y); hh.w = cvt_pk_bf16(y1.z, y1.w);
                u32x4 ll; ll.x = cvt_pk_bf16(y0.x - bflo(hh.x), y0.y - bfhi(hh.x)); ll.y = cvt_pk_bf16(y0.z - bflo(hh.y), y0.w - bfhi(hh.y)); ll.z = cvt_pk_bf16(y1.x - bflo(hh.z), y1.y - bfhi(hh.z)); ll.w = cvt_pk_bf16(y1.z - bflo(hh.w), y1.w - bfhi(hh.w));
                const bf16x8 xh = __builtin_bit_cast(bf16x8, hh), xl = __builtin_bit_cast(bf16x8, ll);
                const bf16x8 wh = *(const LAS bf16x8*)(L + RT_WHI + t * RT_WS + (s * 16 + hi * 8) * 2), wl = *(const LAS bf16x8*)(L + RT_WLO + t * RT_WS + (s * 16 + hi * 8) * 2);
                acc = __builtin_amdgcn_mfma_f32_32x32x16_bf16(wh, xh, acc, 0, 0, 0);
                acc = __builtin_amdgcn_mfma_f32_32x32x16_bf16(wh, xl, acc, 0, 0, 0);
                acc = __builtin_amdgcn_mfma_f32_32x32x16_bf16(wl, xh, acc, 0, 0, 0);
            }
            { auto rr = __builtin_amdgcn_permlane32_swap(__float_as_uint(ss), __float_as_uint(ss), false, false); ss = __uint_as_float(rr[0]) + __uint_as_float(rr[1]); }
            const float rstd = 1.f / sqrtf(ss * (1.f / 1024.f) + 1e-6f);
            float lg[32];
#pragma unroll
            for (int r = 0; r < 16; ++r) { auto rr = __builtin_amdgcn_permlane32_swap(__float_as_uint(acc[r]), __float_as_uint(acc[r]), false, false);
                const int e0 = (r & 3) + 8 * (r >> 2); lg[e0] = __uint_as_float(rr[0]) * rstd + tb[2048 + e0]; lg[e0 + 4] = __uint_as_float(rr[1]) * rstd + tb[2048 + e0 + 4]; }
            int se[4]; float sv[4];
#pragma unroll
            for (int k = 0; k < 4; ++k) { float best = lg[0]; int bi = 0;
#pragma unroll
                for (int e = 1; e < 32; ++e) { const bool gt = lg[e] > best; best = gt ? lg[e] : best; bi = gt ? e : bi; }
                se[k] = bi; sv[k] = best;
#pragma unroll
                for (int e = 0; e < 32; ++e) lg[e] = (e == bi) ? -3.0e38f : lg[e]; }
            const float e1 = __expf(sv[1] - sv[0]), e2 = __expf(sv[2] - sv[0]), e3 = __expf(sv[3] - sv[0]); const float inv = 1.f / (1.f + e1 + e2 + e3);
            if (hi == 0) {
                const float gk[4] = {inv, e1 * inv, e2 * inv, e3 * inv};
#pragma unroll
                for (int k = 0; k < 4; ++k) { const int pos = __hip_atomic_fetch_add(cnt + se[k], 1, __ATOMIC_RELAXED, __HIP_MEMORY_SCOPE_WORKGROUP);
                    rt[RT_E + (size_t)row * 4 + k] = (unsigned char)se[k]; ((unsigned short*)(rt + RT_POS))[(size_t)row * 4 + k] = (unsigned short)pos; ((float*)(rt + RT_GATE))[(size_t)row * 4 + k] = gk[k]; }
            }
            unsigned char* hp = H8 + (size_t)row * 1024 + hi * 8;
#pragma unroll 4
            for (int s = 0; s < 64; ++s) {
                const u32x4 xw = *(const u32x4*)(xp + s * 16); const f32x4 x0 = {bflo(xw.x), bfhi(xw.x), bflo(xw.y), bfhi(xw.y)}, x1 = {bflo(xw.z), bfhi(xw.z), bflo(xw.w), bfhi(xw.w)};
                const f32x4 g0 = *(const LAS f32x4*)(tb + s * 16 + hi * 8), g1 = *(const LAS f32x4*)(tb + s * 16 + hi * 8 + 4);
                const f32x4 h0 = *(const LAS f32x4*)(tb + 1024 + s * 16 + hi * 8), h1 = *(const LAS f32x4*)(tb + 1024 + s * 16 + hi * 8 + 4);
                const f32x4 y0 = x0 * rstd * g0 + h0, y1 = x1 * rstd * g1 + h1;
                *(u32x2*)(hp + s * 16) = (u32x2){pk4_fp8(y0.x, y0.y, y0.z, y0.w), pk4_fp8(y1.x, y1.y, y1.z, y1.w)};
            }
        }
        __syncthreads();
        if (tid < 32) ((unsigned*)(rt + RT_HIST))[vb * 32 + tid] = (unsigned)cnt[tid];
    }
    __syncthreads();
}
constexpr int MT_OFF = 131072 + 1024;
__device__ __forceinline__ void moe_tables(Frame& F) {
    LAS int* tab = (LAS int*)(F.lds + MT_OFF);
    LAS int* part = (LAS int*)(F.lds + MT_OFF + 8192 + 256);
    const unsigned* hist = (const unsigned*)(F.ws + WS_ROUTE + RT_HIST);
    { const int e = F.tid & 31, p = F.tid >> 5; int c = 0;
#pragma unroll
      for (int i = 0; i < 16; ++i) c += (int)hist[(p * 16 + i) * 32 + e];
      part[p * 32 + e] = c; }
    __syncthreads();
    if (F.tid < 32) { int c = 0;
#pragma unroll
        for (int p = 0; p < 16; ++p) c += part[p * 32 + F.tid];
        tab[32 + F.tid] = c; }
    __syncthreads();
    if (F.tid == 0) { int s = 0; for (int e = 0; e < 32; ++e) { tab[e] = s; s += ((tab[32 + e] + 255) >> 8) << 8; } tab[64] = s >> 8; }
    __syncthreads();
    if (F.tid < 32) { const int s0 = tab[F.tid] >> 8, nb = (tab[32 + F.tid] + 255) >> 8; for (int i = 0; i < nb; ++i) tab[128 + s0 + i] = F.tid; }
    __syncthreads();
}
__device__ __forceinline__ void p_moe_scatter(Frame& F, const int ntok) {
    moe_tables(F);
    LAS int* tab = (LAS int*)(F.lds + MT_OFF);
    LAS int* base = (LAS int*)(F.lds + MT_OFF + 8192);
    const unsigned* hist = (const unsigned*)(F.ws + WS_ROUTE + RT_HIST);
    const unsigned char* rt = F.ws + WS_ROUTE;
    unsigned* stok = wsp<unsigned>(F, WS_SORT); unsigned* sdst = stok + MAXSLOT; float* sgate = (float*)(sdst + MAXSLOT);
    for (int vb = F.bid; vb < 256; vb += F.G) {
        int t0, nt; vb_tiles(vb, ntok, t0, nt);
        if (F.tid < 32) { const LAS int* part = (const LAS int*)(F.lds + MT_OFF + 8192 + 256); int c = 0; for (int p = 0; p < (vb >> 4); ++p) c += part[p * 32 + F.tid];
            for (int b = vb & ~15; b < vb; ++b) c += (int)hist[b * 32 + F.tid]; base[F.tid] = tab[F.tid] + c; }
        __syncthreads();
        for (int i = F.tid; i < nt * 128; i += 512) {
            const int row = t0 * 32 + (i >> 2), k = i & 3; const size_t a = (size_t)row * 4 + k;
            const int e = rt[RT_E + a], pos = ((const unsigned short*)(rt + RT_POS))[a];
            const int slot = base[e] + pos;
            stok[slot] = (unsigned)row; sdst[slot] = (unsigned)(row * 4 + k); sgate[slot] = ((const float*)(rt + RT_GATE))[a];
        }
        if (vb < 32) { const int e = vb, c = tab[32 + e], s0 = tab[e] + c, s1 = tab[e] + (((c + 255) >> 8) << 8);
            for (int s = s0 + F.tid; s < s1; s += 512) { stok[s] = 0u; sdst[s] = (unsigned)YS_DUMMY; sgate[s] = 0.f; } }
        __syncthreads();
    }
}

namespace pg8 {
struct DenseSched {
    int nM, nN, nwg, G, c, KB; const bf16* Bt;
    __device__ __forceinline__ void init(int M, int N, int KB_, const void* Bt_, int G_, int c_) { nM = M / BM; nN = N / BM; nwg = nM * nN; G = G_; c = c_; KB = KB_; Bt = (const bf16*)Bt_; }
    __device__ __forceinline__ bool next(int i, Unit& u) const {
        const long L = (long)i * G + c; if (L >= nwg) return false;
        int wgid = (int)L; { const int q = nwg / 8, r = nwg % 8, xcd = wgid % 8, off = wgid / 8; wgid = (xcd < r ? xcd * (q + 1) : r * (q + 1) + (xcd - r) * q) + off; }
        const int nig = 8 * nN, gid = wgid / nig, fm = gid * 8, gsz = (nM - fm) < 8 ? (nM - fm) : 8;
        u.pm = fm + ((wgid % nig) % gsz); u.pn = (wgid % nig) / gsz; return true;
    }
    __device__ __forceinline__ void a_offs(const Unit& u, unsigned (&ao)[2][2], const int (&R)[2], const int (&C)[2]) const {
#pragma unroll
        for (int h = 0; h < 2; ++h)
#pragma unroll
            for (int i = 0; i < 2; ++i) ao[h][i] = (unsigned)((u.pm * BM + h * HALF + R[i]) * KB + C[i] * 2);
    }
    __device__ __forceinline__ const char* b_tile(const Unit& u) const { return (const char*)Bt + (size_t)u.pn * BM * KB; }
};
template <bool GATHER> struct MoeSched {
    int nrb, npn, G, c; const LAS int* blk_e; const unsigned* tok; const unsigned char* Wt; size_t wstride;
    __device__ __forceinline__ bool next(int i, Unit& u) const {
        if ((G & 7) != 0 || ((G >> 3) % npn) != 0) { const long L = (long)i * G + c; if (L >= (long)nrb * npn) return false; u.pm = (int)(L / npn); u.pn = (int)(L % npn); return true; }
        const int x = c & 7, y = c >> 3, per = (G >> 3) / npn;
        u.pm = (i * 8 + x) * per + y / npn; u.pn = y % npn; return u.pm < nrb;
    }
    __device__ __forceinline__ void a_offs(const Unit& u, unsigned (&ao)[2][2], const int (&R)[2], const int (&C)[2]) const {
#pragma unroll
        for (int h = 0; h < 2; ++h)
#pragma unroll
            for (int i = 0; i < 2; ++i) { const int slot = u.pm * BM + h * HALF + R[i]; const unsigned row = GATHER ? tok[slot] : (unsigned)slot; ao[h][i] = row * 1024u + (unsigned)C[i] * 2u; }
    }
    __device__ __forceinline__ const char* b_tile(const Unit& u) const { return (const char*)(Wt + (size_t)blk_e[u.pm] * wstride + (size_t)u.pn * BM * 1024); }
};

struct MapPlain { bf16* O; int ld; __device__ __forceinline__ bf16* operator()(int row, int col) const { return O + (size_t)row * ld + col; } };
constexpr float ATT_QPRE = 0.8329403702157812f;
struct EpiQ8 {
    static constexpr bool PERM = true; unsigned char* Q8; const f32x2* ROPE;
    __device__ __forceinline__ void operator()(const f32x4 (&acc)[2][2][4][2], const Unit& u, int wr, int wc, int fr, int fq) const {
#pragma unroll
        for (int ai = 0; ai < 2; ++ai)
#pragma unroll
            for (int m = 0; m < 4; ++m) { const int row = u.pm * BM + ai * HALF + wr * 64 + m * 16 + fr; const int b = row >> 13, t = row & 8191;
#pragma unroll
                for (int bj = 0; bj < 2; ++bj) { const int col = u.pn * BM + bj * HALF + wc * 32 + 8 * fq; float v[8];
#pragma unroll
                    for (int e = 0; e < 4; ++e) { v[e] = acc[ai][bj][m][0][e]; v[4 + e] = acc[ai][bj][m][1][e]; }
                    int h, d;
                    if (u.pn < 4) { h = col >> 7; d = col & 127; }
                    else { h = (col - 1024) >> 6; const int dr = (col - 1024) & 63; d = 128 + dr;
                        const f32x2* cs = ROPE + t * 32 + ((dr >> 5) << 4) + (dr & 8);
#pragma unroll
                        for (int e = 0; e < 8; ++e) { auto rr = __builtin_amdgcn_permlane32_swap(__float_as_uint(v[e]), __float_as_uint(v[e]), false, false);
                            const float pr = __uint_as_float(fq < 2 ? rr[1] : rr[0]); const f32x2 c = cs[e]; v[e] = (fq >= 2) ? v[e] * c.x + pr * c.y : v[e] * c.x - pr * c.y; } }
                    *(u32x2*)(Q8 + ((size_t)((b * 8 + h) * SEQ + t)) * QKD + d) = (u32x2){pk4_fp8(v[0] * ATT_QPRE, v[1] * ATT_QPRE, v[2] * ATT_QPRE, v[3] * ATT_QPRE), pk4_fp8(v[4] * ATT_QPRE, v[5] * ATT_QPRE, v[6] * ATT_QPRE, v[7] * ATT_QPRE)}; } }
    }
};
struct EpiKV8 {
    static constexpr bool PERM = true; unsigned char* K8; unsigned char* VT;
    __device__ __forceinline__ void operator()(const f32x4 (&acc)[2][2][4][2], const Unit& u, int wr, int wc, int fr, int fq) const {
#pragma unroll
        for (int ai = 0; ai < 2; ++ai)
#pragma unroll
            for (int m = 0; m < 4; ++m) { const int row = u.pm * BM + ai * HALF + wr * 64 + m * 16 + fr;
                const int b = row < NLAT ? (row >> 13) : ((row - NLAT) >> 8), key = row < NLAT ? CTXL + (row & 8191) : ((row - NLAT) & 255), h = u.pn;
                { const f32x4 v0 = acc[ai][0][m][0], v1 = acc[ai][0][m][1];
                  *(u32x2*)(K8 + ((size_t)((b * 8 + h) * NKEY + key)) * K8ROW + wc * 32 + 8 * fq) = (u32x2){pk4_fp8(v0[0], v0[1], v0[2], v0[3]), pk4_fp8(v1[0], v1[1], v1[2], v1[3])}; }
                { const int k6 = key & 63, kk = k6 & 31, p = 32 * ((kk >> 2) & 1) + (k6 >> 5) * 16 + (kk & 3) + 4 * (kk >> 3);
                  unsigned char* tb = VT + ((size_t)(b * 8 + h) * (NKEY / 64) + (key >> 6)) * 8192 + (p & 15); const int c0 = wc * 32 + 8 * fq, ch = p >> 4;
                  const unsigned w0 = pk4_fp8(acc[ai][1][m][0][0], acc[ai][1][m][0][1], acc[ai][1][m][0][2], acc[ai][1][m][0][3]), w1 = pk4_fp8(acc[ai][1][m][1][0], acc[ai][1][m][1][1], acc[ai][1][m][1][2], acc[ai][1][m][1][3]);
#pragma unroll
                  for (int e = 0; e < 8; ++e) { const int c = c0 + e; tb[c * 64 + ((ch ^ ((c >> 2) & 3)) << 4)] = (unsigned char)(((e < 4 ? w0 : w1) >> (8 * (e & 3))) & 0xffu); } } }
    }
};
template <class Map> struct EpiBf16 {
    static constexpr bool PERM = true; Map map;
    __device__ __forceinline__ void operator()(const f32x4 (&acc)[2][2][4][2], const Unit& u, int wr, int wc, int fr, int fq) const {
#pragma unroll
        for (int ai = 0; ai < 2; ++ai)
#pragma unroll
            for (int m = 0; m < 4; ++m) { const int row = u.pm * BM + ai * HALF + wr * 64 + m * 16 + fr;
#pragma unroll
                for (int bj = 0; bj < 2; ++bj) { const int col = u.pn * BM + bj * HALF + wc * 32 + 8 * fq; const f32x4 v0 = acc[ai][bj][m][0], v1 = acc[ai][bj][m][1];
                    u32x4 w; w.x = cvt_pk_bf16(v0[0], v0[1]); w.y = cvt_pk_bf16(v0[2], v0[3]); w.z = cvt_pk_bf16(v1[0], v1[1]); w.w = cvt_pk_bf16(v1[2], v1[3]);
                    *(u32x4*)map(row, col) = w; } }
    }
};
struct EpiF32 {
    static constexpr bool PERM = false; float* C; int ldc;
    __device__ __forceinline__ void operator()(const f32x4 (&acc)[2][2][4][2], const Unit& u, int wr, int wc, int fr, int fq) const {
#pragma unroll
        for (int ai = 0; ai < 2; ++ai)
#pragma unroll
            for (int m = 0; m < 4; ++m) { float* rowp = C + (size_t)(u.pm * BM + ai * HALF + wr * 64 + m * 16 + fr) * ldc + u.pn * BM + wc * 32 + 4 * fq;
#pragma unroll
                for (int bj = 0; bj < 2; ++bj)
#pragma unroll
                    for (int n = 0; n < 2; ++n) *(f32x4*)(rowp + bj * HALF + n * 16) = acc[ai][bj][m][n]; }
    }
};
struct EpiResid {
    static constexpr bool PERM = false; bf16* X1; const float* xlat; const float* xctx; const float* mod; int layer;
    __device__ __forceinline__ void operator()(const f32x4 (&acc)[2][2][4][2], const Unit& u, int wr, int wc, int fr, int fq) const {
#pragma unroll
        for (int ai = 0; ai < 2; ++ai)
#pragma unroll
            for (int m = 0; m < 4; ++m) { const int row = u.pm * BM + ai * HALF + wr * 64 + m * 16 + fr; const int col0 = u.pn * BM + wc * 32 + 4 * fq;
                const float* bp = row < NLAT ? xlat + (size_t)row * 1024 : xctx + (size_t)(row - NLAT) * 1024;
                const float* gp = mod + ((size_t)(layer * 9 + (row < NLAT ? (row >> 13) : 8)) * 6 + 2) * 1024;
                bf16* op = X1 + (size_t)row * 1024;
#pragma unroll
                for (int bj = 0; bj < 2; ++bj)
#pragma unroll
                    for (int n = 0; n < 2; ++n) { const int c = col0 + bj * HALF + n * 16; f32x4 base;
                        if (layer == 0) base = *(const f32x4*)(bp + c); else { const u32x2 bw = *(const u32x2*)(op + c); base = (f32x4){bflo(bw.x), bfhi(bw.x), bflo(bw.y), bfhi(bw.y)}; }
                        const f32x4 v = base + *(const f32x4*)(gp + c) * acc[ai][bj][m][n];
                        *(u32x2*)(op + c) = (u32x2){cvt_pk_bf16(v.x, v.y), cvt_pk_bf16(v.z, v.w)}; } }
    }
};
struct EpiSwiglu {
    static constexpr bool PERM = true; unsigned char* ACT; const float* bgu; const LAS int* blk_e;
    __device__ __forceinline__ void operator()(const f32x4 (&acc)[2][2][4][2], const Unit& u, int wr, int wc, int fr, int fq) const {
        const int e = blk_e[u.pm]; const int c0 = u.pn * 128 + wc * 32 + 8 * fq;
        const float* bg = bgu + (size_t)e * 2048 + c0;
        f32x4 bgl[2], bln[2];
#pragma unroll
        for (int n = 0; n < 2; ++n) { bgl[n] = *(const f32x4*)(bg + 4 * n); bln[n] = *(const f32x4*)(bg + 1024 + 4 * n); }
#pragma unroll
        for (int ai = 0; ai < 2; ++ai)
#pragma unroll
            for (int m = 0; m < 4; ++m) { const int slot = u.pm * BM + ai * HALF + wr * 64 + m * 16 + fr; float o[8];
#pragma unroll
                for (int n = 0; n < 2; ++n)
#pragma unroll
                    for (int j = 0; j < 4; ++j) { const float xg = fminf(acc[ai][0][m][n][j] + bgl[n][j], 7.0f); const float xl = fminf(fmaxf(acc[ai][1][m][n][j] + bln[n][j], -7.0f), 7.0f);
                        o[n * 4 + j] = xg * __builtin_amdgcn_rcpf(1.f + __expf(-1.702f * xg)) * (xl + 1.0f); }
                *(u32x2*)(ACT + (size_t)slot * 1024 + c0) = (u32x2){pk4_fp8(o[0], o[1], o[2], o[3]), pk4_fp8(o[4], o[5], o[6], o[7])}; }
    }
};
struct EpiDown {
    static constexpr bool PERM = true; unsigned char* YS; const float* bdn; const LAS int* blk_e; const unsigned* dst; const float* gate;
    __device__ __forceinline__ void operator()(const f32x4 (&acc)[2][2][4][2], const Unit& u, int wr, int wc, int fr, int fq) const {
        const int e = blk_e[u.pm]; const int c0 = u.pn * BM + wc * 32 + 8 * fq;
        f32x4 bv[2][2];
#pragma unroll
        for (int bj = 0; bj < 2; ++bj)
#pragma unroll
            for (int n = 0; n < 2; ++n) bv[bj][n] = *(const f32x4*)(bdn + (size_t)e * 1024 + c0 + bj * HALF + 4 * n);
#pragma unroll
        for (int ai = 0; ai < 2; ++ai)
#pragma unroll
            for (int m = 0; m < 4; ++m) { const int slot = u.pm * BM + ai * HALF + wr * 64 + m * 16 + fr; const float g = gate[slot] * YS_SCALE; unsigned char* op = YS + (size_t)dst[slot] * 1024 + c0;
#pragma unroll
                for (int bj = 0; bj < 2; ++bj) { const f32x4 v0 = (acc[ai][bj][m][0] + bv[bj][0]) * g, v1 = (acc[ai][bj][m][1] + bv[bj][1]) * g;
                    *(u32x2*)(op + bj * HALF) = (u32x2){pk4_fp8(v0[0], v0[1], v0[2], v0[3]), pk4_fp8(v1[0], v1[1], v1[2], v1[3])}; } }
    }
};
}

__device__ __forceinline__ float ldbf(const bf16* p) { return bf2f((unsigned)*p); }
__device__ __forceinline__ void seq_pos(int row, bool& hp, bool& hn) { if (row < NLAT) { const int t = row & 8191; hp = t > 0; hn = t < SEQ - 1; } else { const int t = (row - NLAT) & 255; hp = t > 0; hn = t < CTXL - 1; } }

__device__ __forceinline__ void p_alr(Frame& F) {
    const int gw = F.bid * 8 + F.wave, NGW = F.G * 8;
    const bf16* P = wsp<const bf16>(F, WS_P); bf16* A = wsp<bf16>(F, WS_ALR); const float* mu = F.in[I_MU];
    for (int row = gw; row < NTOK; row += NGW) {
        bool hp, hn; seq_pos(row, hp, hn);
        const bf16* pr = P + (size_t)row * PW + RW0 + 1536;
#pragma unroll
        for (int q = 0; q < 6; ++q) { const int c = F.lane + 64 * q; float o = 0.f;
            if (c < 288) { const float p0 = ldbf(pr + c), pm = hp ? ldbf(pr + c - PW) : 0.f, pn = hn ? ldbf(pr + c + PW) : 0.f;
                const float xs = p0 + mu[1536 + c] * (pm - p0) + mu[RW_COLS + 1536 + c] * (pn - p0);
                o = c < 64 ? (1.f - 2.f * __builtin_amdgcn_rcpf(1.f + __expf(2.f * xs))) : (c < 128 ? xs : __builtin_amdgcn_rcpf(1.f + __expf(-xs))); }
            A[(size_t)row * LRK + c] = (bf16)f2bf(o); }
    }
}

constexpr int GL_QRAW = 0, GL_KRAW = 8192, GL_GDS = 16384, GL_QD = 20480, GL_KI = 29696, GL_KE = 38912, GL_AT = 48128, GL_VT = 57344, GL_ST = 61952, GL_GSUM = 71168, GL_DEC = 73216;
constexpr int GL_RS = 144;
__device__ __forceinline__ bf16x8 lds_frag(const LAS unsigned char* base, int row, int kbyte) { return *(const LAS bf16x8*)(base + row * GL_RS + kbyte); }
constexpr int GW_UNIT = 24832;
constexpr int GW_QD = 0, GW_KE = 8192, GW_AT = 16384, GW_DEC = 24576;
#define GLA_ROWF(b, dir, n, i) ((n) < 4 ? NLAT + (b) * 256 + ((dir) ? 3 - (n) : (n)) * 64 + ((dir) ? 63 - (i) : (i)) : (b) * 8192 + ((dir) ? 127 - ((n) - 4) : ((n) - 4)) * 64 + ((dir) ? 63 - (i) : (i)))
__device__ __forceinline__ void p_gla_pre(Frame& F) {
    LAS unsigned char* L = F.lds;
    const bf16* P = wsp<const bf16>(F, WS_P); unsigned char* GW = F.ws + WS_X1;
    const int tid = F.tid, lane = F.lane, wave = F.wave, r32 = lane & 31, hi = lane >> 5;
    const int dk = lane, tg = wave;
    constexpr int NU = NB * 4 * 2 * 132;
    bf16x8 qv, kv, gv;
#define GP_LOAD(u) do { const int n_ = (u) % 132, d_ = ((u) / 132) & 1, h_ = ((u) / 264) & 3, b_ = (u) / 1056; const bf16* rp = P + (size_t)GLA_ROWF(b_, d_, n_, tid >> 3) * PW; \
        qv = *(const bf16x8*)(rp + h_ * 64 + (tid & 7) * 8); kv = *(const bf16x8*)(rp + 256 + h_ * 64 + (tid & 7) * 8); \
        if (tid < 128) gv = *(const bf16x8*)(P + (size_t)GLA_ROWF(b_, d_, n_, tid >> 1) * PW + 1536 + (tid & 1) * 8); } while (0)
    if (F.bid < NU) GP_LOAD(F.bid);
    for (int u = F.bid; u < NU; u += F.G) {
        const int dir = (u / 132) & 1, h = (u / 264) & 3;
        float gkw[16];
#pragma unroll
        for (int r = 0; r < 16; ++r) gkw[r] = F.in[I_GKUP][(size_t)(dir * 16 + r) * 256 + h * 64 + dk];
        const float gkb = F.in[I_GKB][dir * 256 + h * 64 + dk];
        unsigned char* gw = GW + (size_t)u * GW_UNIT;
        *(LAS bf16x8*)(L + GL_QRAW + (tid >> 3) * 128 + (tid & 7) * 16) = qv;
        *(LAS bf16x8*)(L + GL_KRAW + (tid >> 3) * 128 + (tid & 7) * 16) = kv;
        if (tid < 128) { LAS float* gp = (LAS float*)(L + GL_GDS) + (tid >> 1) * 16 + (tid & 1) * 8;
#pragma unroll
            for (int e = 0; e < 8; ++e) gp[e] = bf2f((unsigned)(unsigned short)gv[e]); }
        __syncthreads();
        if (u + F.G < NU) GP_LOAD(u + F.G);
        float Gl[8]; float cum = 0.f;
#pragma unroll
        for (int ii = 0; ii < 8; ++ii) { const LAS float* gp = (const LAS float*)(L + GL_GDS) + (tg * 8 + ii) * 16; float x = gkb;
#pragma unroll
            for (int r = 0; r < 16; ++r) x += gp[r] * gkw[r];
            const float ls = fminf(x, 0.f) - __logf(1.f + __expf(-fabsf(x)));
            cum += ls * (1.f / 16.f); Gl[ii] = cum; }
        ((LAS float*)(L + GL_GSUM))[tg * 64 + dk] = cum;
        __syncthreads();
        float off = 0.f, tot = 0.f;
#pragma unroll
        for (int t2 = 0; t2 < 8; ++t2) { const float gs = ((const LAS float*)(L + GL_GSUM))[t2 * 64 + dk]; tot += gs; off += (t2 < tg) ? gs : 0.f; }
        unsigned kep[4]; const float etot = __expf(tot);
#pragma unroll
        for (int ii = 0; ii < 8; ii += 2) { float kev[2];
#pragma unroll
            for (int z = 0; z < 2; ++z) { const int i = tg * 8 + ii + z; const float G = off + Gl[ii + z];
                const float q = bf2f((unsigned)*(const LAS unsigned short*)(L + GL_QRAW + i * 128 + dk * 2)), k = bf2f((unsigned)*(const LAS unsigned short*)(L + GL_KRAW + i * 128 + dk * 2));
                const float eg = __expf(G), ieg = __builtin_amdgcn_rcpf(eg);
                const unsigned short qd = (unsigned short)f2bf(q * 0.125f * eg);
                *(LAS unsigned short*)(L + GL_QD + i * GL_RS + dk * 2) = qd; *(unsigned short*)(gw + GW_QD + i * 128 + dk * 2) = qd;
                *(LAS unsigned short*)(L + GL_KI + i * GL_RS + dk * 2) = (unsigned short)f2bf(k * ieg);
                kev[z] = k * (etot * ieg); }
            kep[ii >> 1] = cvt_pk_bf16(kev[0], kev[1]); }
        *(u32x4*)(gw + GW_KE + dk * 128 + tg * 16) = (u32x4){kep[0], kep[1], kep[2], kep[3]};
        if (tg == 0) ((float*)(gw + GW_DEC))[dk] = etot;
        __syncthreads();
        if (wave < 4) { const int tj = wave & 1, ti = wave >> 1;
            f32x16 acc;
#pragma unroll
            for (int r = 0; r < 16; ++r) acc[r] = 0.f;
            if (!(ti == 0 && tj == 1)) {
#pragma unroll
                for (int ks = 0; ks < 4; ++ks) acc = __builtin_amdgcn_mfma_f32_32x32x16_bf16(lds_frag(L + GL_KI, tj * 32 + r32, ks * 32 + hi * 16), lds_frag(L + GL_QD, ti * 32 + r32, ks * 32 + hi * 16), acc, 0, 0, 0);
            }
            const int i = ti * 32 + r32;
#pragma unroll
            for (int g = 0; g < 4; ++g) { const int j0 = tj * 32 + 8 * g + 4 * hi; float v4[4];
#pragma unroll
                for (int z = 0; z < 4; ++z) v4[z] = (j0 + z <= i) ? acc[4 * g + z] : 0.f;
                *(u32x2*)(gw + GW_AT + i * 128 + j0 * 2) = (u32x2){cvt_pk_bf16(v4[0], v4[1]), cvt_pk_bf16(v4[2], v4[3])}; } }
        __syncthreads();
    }
#undef GP_LOAD
}
__device__ __forceinline__ void p_gla_scan(Frame& F) {
    LAS unsigned char* L = F.lds;
    const bf16* P = wsp<const bf16>(F, WS_P); const unsigned char* GW = F.ws + WS_X1;
    const int tid = F.tid, lane = F.lane, wave = F.wave, r32 = lane & 31, hi = lane >> 5;
    for (int id = F.bid; id < 256; id += F.G) {
        const int b = id >> 5, h = (id >> 3) & 3, dir = (id >> 2) & 1, vs = id & 3;
        const unsigned char* gwb = GW + (size_t)(((b * 4 + h) * 2 + dir) * 132) * GW_UNIT;
        f32x16 Sacc;
#pragma unroll
        for (int r = 0; r < 16; ++r) Sacc[r] = 0.f;
        for (int i = tid; i < 4608 / 4; i += 512) ((LAS unsigned*)(L + GL_ST))[i] = 0u;
        u32x4 t0, t1, t2, dv; bf16x8 vv;
#define GS_LOAD(n) do { const unsigned char* gu = gwb + (size_t)(n) * GW_UNIT + tid * 16; t0 = *(const u32x4*)(gu); t1 = *(const u32x4*)(gu + 8192); t2 = *(const u32x4*)(gu + 16384); \
        if (tid < 16) dv = *(const u32x4*)(gwb + (size_t)(n) * GW_UNIT + GW_DEC + tid * 16); \
        if (tid < 256) vv = *(const bf16x8*)(P + (size_t)GLA_ROWF(b, dir, n, tid >> 2) * PW + 512 + h * 128 + vs * 32 + (tid & 3) * 8); } while (0)
        GS_LOAD(0);
        __syncthreads();
        for (int n = 0; n < 132; ++n) {
            { const int row = tid >> 3, c16 = (tid & 7) * 16;
              *(LAS u32x4*)(L + GL_QD + row * GL_RS + c16) = t0; *(LAS u32x4*)(L + GL_KE + row * GL_RS + c16) = t1; *(LAS u32x4*)(L + GL_AT + row * GL_RS + c16) = t2; }
            if (tid < 16) *(LAS u32x4*)(L + GL_DEC + tid * 16) = dv;
            if (tid < 256) { const int i = tid >> 2;
#pragma unroll
                for (int e = 0; e < 8; ++e) *(LAS unsigned short*)(L + GL_VT + ((tid & 3) * 8 + e) * GL_RS + i * 2) = (unsigned short)vv[e]; }
            __syncthreads();
            if (n + 1 < 132) GS_LOAD(n + 1);
            const LAS unsigned char* STc = L + GL_ST + (n & 1) * 4608; LAS unsigned char* STn = L + GL_ST + ((n + 1) & 1) * 4608;
            if (wave < 2) {
                const int ti = wave; f32x16 acc;
#pragma unroll
                for (int r = 0; r < 16; ++r) acc[r] = 0.f;
#pragma unroll
                for (int ks = 0; ks < 4; ++ks) acc = __builtin_amdgcn_mfma_f32_32x32x16_bf16(lds_frag(L + GL_AT, ti * 32 + r32, ks * 32 + hi * 16), lds_frag(L + GL_VT, r32, ks * 32 + hi * 16), acc, 0, 0, 0);
#pragma unroll
                for (int ks = 0; ks < 4; ++ks) acc = __builtin_amdgcn_mfma_f32_32x32x16_bf16(lds_frag(L + GL_QD, ti * 32 + r32, ks * 32 + hi * 16), lds_frag(STc, r32, ks * 32 + hi * 16), acc, 0, 0, 0);
                bf16* O = wsp<bf16>(F, WS_GLAO) + (size_t)dir * NTOK * 512 + h * 128 + vs * 32 + r32;
#pragma unroll
                for (int r = 0; r < 16; ++r) { const int i = ti * 32 + (r & 3) + 8 * (r >> 2) + 4 * hi; O[(size_t)GLA_ROWF(b, dir, n, i) * 512] = (bf16)f2bf(acc[r]); }
            } else if (wave < 4) {
                const int dt = wave - 2;
#pragma unroll
                for (int g = 0; g < 4; ++g) { const f32x4 dvv = *(const LAS f32x4*)(L + GL_DEC + (dt * 32 + 8 * g + 4 * hi) * 4);
#pragma unroll
                    for (int z = 0; z < 4; ++z) Sacc[4 * g + z] *= dvv[z]; }
#pragma unroll
                for (int ks = 0; ks < 4; ++ks) Sacc = __builtin_amdgcn_mfma_f32_32x32x16_bf16(lds_frag(L + GL_KE, dt * 32 + r32, ks * 32 + hi * 16), lds_frag(L + GL_VT, r32, ks * 32 + hi * 16), Sacc, 0, 0, 0);
#pragma unroll
                for (int g = 0; g < 4; ++g) *(LAS u32x2*)(STn + r32 * GL_RS + (dt * 32 + 8 * g + 4 * hi) * 2) = (u32x2){cvt_pk_bf16(Sacc[4 * g], Sacc[4 * g + 1]), cvt_pk_bf16(Sacc[4 * g + 2], Sacc[4 * g + 3])};
            }
            __syncthreads();
        }
#undef GS_LOAD
    }
}
__device__ __forceinline__ void wave_sum4(float& a, float& b, float& c, float& d) {
#define WS4_STEP(ctl) "v_add_f32_dpp %0, %0, %0 " ctl "\n\tv_add_f32_dpp %1, %1, %1 " ctl "\n\tv_add_f32_dpp %2, %2, %2 " ctl "\n\tv_add_f32_dpp %3, %3, %3 " ctl "\n\t"
    asm volatile("s_nop 1\n\t"
                 WS4_STEP("quad_perm:[1,0,3,2] row_mask:0xf bank_mask:0xf")
                 WS4_STEP("quad_perm:[2,3,0,1] row_mask:0xf bank_mask:0xf")
                 WS4_STEP("row_half_mirror row_mask:0xf bank_mask:0xf")
                 WS4_STEP("row_mirror row_mask:0xf bank_mask:0xf")
                 WS4_STEP("row_bcast:15 row_mask:0xa bank_mask:0xf")
                 WS4_STEP("row_bcast:31 row_mask:0xc bank_mask:0xf")
                 "s_nop 0"
                 : "+v"(a), "+v"(b), "+v"(c), "+v"(d));
#undef WS4_STEP
    a = __builtin_bit_cast(float, __builtin_amdgcn_readlane(__builtin_bit_cast(int, a), 63)); b = __builtin_bit_cast(float, __builtin_amdgcn_readlane(__builtin_bit_cast(int, b), 63));
    c = __builtin_bit_cast(float, __builtin_amdgcn_readlane(__builtin_bit_cast(int, c), 63)); d = __builtin_bit_cast(float, __builtin_amdgcn_readlane(__builtin_bit_cast(int, d), 63));
}
#define LDS_BARRIER() asm volatile("s_waitcnt lgkmcnt(0)\n\ts_barrier" ::: "memory")
__device__ __forceinline__ void red16x2(float& a, float& b) {
    asm volatile("s_nop 1\n\t"
                 "v_add_f32_dpp %0, %0, %0 quad_perm:[1,0,3,2] row_mask:0xf bank_mask:0xf\n\t"
                 "v_add_f32_dpp %1, %1, %1 quad_perm:[1,0,3,2] row_mask:0xf bank_mask:0xf\n\t"
                 "s_nop 0\n\t"
                 "v_add_f32_dpp %0, %0, %0 quad_perm:[2,3,0,1] row_mask:0xf bank_mask:0xf\n\t"
                 "v_add_f32_dpp %1, %1, %1 quad_perm:[2,3,0,1] row_mask:0xf bank_mask:0xf\n\t"
                 "s_nop 0\n\t"
                 "v_add_f32_dpp %0, %0, %0 row_half_mirror row_mask:0xf bank_mask:0xf\n\t"
                 "v_add_f32_dpp %1, %1, %1 row_half_mirror row_mask:0xf bank_mask:0xf\n\t"
                 "s_nop 0\n\t"
                 "v_add_f32_dpp %0, %0, %0 row_mirror row_mask:0xf bank_mask:0xf\n\t"
                 "v_add_f32_dpp %1, %1, %1 row_mirror row_mask:0xf bank_mask:0xf"
                 : "+v"(a), "+v"(b));
}
__device__ __forceinline__ void red8x2(float& a, float& b) {
    asm volatile("s_nop 1\n\t"
                 "v_add_f32_dpp %0, %0, %0 quad_perm:[1,0,3,2] row_mask:0xf bank_mask:0xf\n\t"
                 "v_add_f32_dpp %1, %1, %1 quad_perm:[1,0,3,2] row_mask:0xf bank_mask:0xf\n\t"
                 "s_nop 0\n\t"
                 "v_add_f32_dpp %0, %0, %0 quad_perm:[2,3,0,1] row_mask:0xf bank_mask:0xf\n\t"
                 "v_add_f32_dpp %1, %1, %1 quad_perm:[2,3,0,1] row_mask:0xf bank_mask:0xf\n\t"
                 "s_nop 0\n\t"
                 "v_add_f32_dpp %0, %0, %0 row_half_mirror row_mask:0xf bank_mask:0xf\n\t"
                 "v_add_f32_dpp %1, %1, %1 row_half_mirror row_mask:0xf bank_mask:0xf"
                 : "+v"(a), "+v"(b));
}
constexpr int RW_T = 32;
constexpr int RW_SS = 392;
constexpr int RW_BUF = RW_T * RW_SS * 4;
constexpr int RW_YB = 2 * RW_BUF;
constexpr int RW_YBSZ = 32 * 33 * 4;
__device__ __forceinline__ void p_rwkv_scan(Frame& F) {
    LAS unsigned char* L = F.lds;
    const bf16* P = wsp<const bf16>(F, WS_P); const bf16* LO = wsp<const bf16>(F, WS_LOUT);
    const int lane = F.lane, wave = F.wave;
    constexpr int NRD = (CTXL + SEQ) / RW_T;
    for (int id = F.bid; id < 256; id += F.G) {
        const int b = id >> 5, h = (id >> 2) & 7, dir = (id >> 1) & 1, rh = id & 1;
#define RW_ROW(s) ((s) < 256 ? NLAT + b * 256 + (dir ? 255 - (s) : (s)) : b * 8192 + (dir ? 8191 - ((s) - 256) : ((s) - 256)))
        if (wave >= 4) {
            const int pw = wave - 4, hj = h * 64 + lane;
            const float* mu = F.in[I_MU];
            const float cpr = mu[hj], cnr = mu[RW_COLS + hj], cpk = mu[512 + hj], cnk = mu[RW_COLS + 512 + hj], cpv = mu[1024 + hj], cnv = mu[RW_COLS + 1024 + hj];
            const float w0v = F.in[I_W0][dir * 512 + hj], a0v = F.in[I_A0][dir * 512 + hj], kkc = F.in[I_KK][hj], kac = F.in[I_KA][hj], rkc = F.in[I_RK][hj];
            unsigned xa[30], la[16], xb[30], lb[16];
#define RW_LOAD(rd, X, Lr) do { const int s0_ = (rd) * RW_T + pw * 8; const bool lo_ok = (s0_ != 0) && (s0_ != 256), hi_ok = (s0_ + 8 != 256) && (s0_ + 8 != NKEY); \
                const long sgn_ = dir ? -(long)PW : (long)PW; const bf16* pr0 = P + (size_t)RW_ROW(s0_) * PW + RW0 + hj; \
                _Pragma("unroll") for (int pp = -1; pp < 9; ++pp) { const int pc = (pp < 0 && !lo_ok) ? 0 : ((pp > 7 && !hi_ok) ? 7 : pp); const bf16* pr = pr0 + sgn_ * pc; \
                    X[3 * (pp + 1)] = pr[0]; X[3 * (pp + 1) + 1] = pr[512]; X[3 * (pp + 1) + 2] = pr[1024]; } \
                const long sgl_ = dir ? -(long)LRN : (long)LRN; const bf16* lr0 = LO + (size_t)RW_ROW(s0_) * LRN + dir * 512 + hj; \
                _Pragma("unroll") for (int pp = 0; pp < 8; ++pp) { Lr[2 * pp] = lr0[sgl_ * pp]; Lr[2 * pp + 1] = lr0[sgl_ * pp + 1024]; } } while (0)
#define RW_FEAT(rd, X, Lr) do { const int s0_ = (rd) * RW_T + pw * 8; const bool lo_ok = (s0_ != 0) && (s0_ != 256), hi_ok = (s0_ + 8 != 256) && (s0_ + 8 != NKEY); \
                const int row0_ = RW_ROW(s0_); \
                _Pragma("unroll") for (int q = 0; q < 8; ++q) { const int st = pw * 8 + q; \
                const bool vlo = (q > 0) || lo_ok, vhi = (q < 7) || hi_ok; const bool hp = dir ? vhi : vlo, hn = dir ? vlo : vhi; \
                  \
                const unsigned pr_ = dir ? X[3 * (q + 2)] : X[3 * q], nr_ = dir ? X[3 * q] : X[3 * (q + 2)], pk_ = dir ? X[3 * (q + 2) + 1] : X[3 * q + 1], nk_ = dir ? X[3 * q + 1] : X[3 * (q + 2) + 1], pv_ = dir ? X[3 * (q + 2) + 2] : X[3 * q + 2], nv_ = dir ? X[3 * q + 2] : X[3 * (q + 2) + 2]; \
                const float r0 = bf2f(X[3 * (q + 1)]), k0 = bf2f(X[3 * (q + 1) + 1]), v0 = bf2f(X[3 * (q + 1) + 2]); \
                const float xr = r0 + cpr * ((hp ? bf2f(pr_) : 0.f) - r0) + cnr * ((hn ? bf2f(nr_) : 0.f) - r0); \
                const float xk = k0 + cpk * ((hp ? bf2f(pk_) : 0.f) - k0) + cnk * ((hn ? bf2f(nk_) : 0.f) - k0); \
                const float xv = v0 + cpv * ((hp ? bf2f(pv_) : 0.f) - v0) + cnv * ((hn ? bf2f(nv_) : 0.f) - v0); \
                  \
                const float sg = __builtin_amdgcn_rcpf(1.f + __expf(-(w0v + bf2f(Lr[2 * q])))); \
                const float wdec = __expf(-0.60653066f * sg); \
                const float alr = __builtin_amdgcn_rcpf(1.f + __expf(-(a0v + bf2f(Lr[2 * q + 1])))); \
                const float kkv = xk * kkc; const float kd = xk * (1.f + (alr - 1.f) * kac); \
                float n2 = kkv * kkv, bon = xr * kd * rkc, kr = kd * xr, br = kkv * alr * xr; \
                wave_sum4(n2, bon, kr, br); \
                const float rn = __builtin_amdgcn_rsqf(fmaxf(n2, 1e-24f)); const float kk = kkv * rn; const float bb = kk * alr; br *= rn; \
                if (rh == 0 && lane == 0) wsp<float>(F, WS_BONUS)[((size_t)dir * NTOK + (dir ? row0_ - q : row0_ + q)) * 8 + h] = bon; \
                LAS float* o = (LAS float*)(L + ((rd) & 1) * RW_BUF) + st * RW_SS; \
                o[lane] = wdec; o[64 + lane] = -kk; o[128 + lane] = bb; o[192 + lane] = kd; o[256 + lane] = wdec * xr; o[320 + lane] = xv; \
                if (lane == 0) { o[384] = br; o[385] = kr; } } } while (0)
#define RW_YOUT(rd) do { const LAS float* yb = (const LAS float*)(L + RW_YB + ((rd) & 1) * RW_YBSZ); _Pragma("unroll") for (int e = 0; e < 2; ++e) { const int pt = pw * 64 + lane, st = (pt >> 4) + 16 * e, r2 = (pt & 15) * 2; const int s = (rd) * RW_T + st; \
                *(unsigned*)(wsp<bf16>(F, WS_RWY) + ((size_t)dir * NTOK + RW_ROW(s)) * 512 + h * 64 + rh * 32 + r2) = cvt_pk_bf16(yb[r2 * 33 + st], yb[(r2 + 1) * 33 + st]); } } while (0)
            RW_LOAD(0, xa, la); RW_LOAD(1, xb, lb); RW_FEAT(0, xa, la);
            LDS_BARRIER();
            for (int rd = 0; rd < NRD; rd += 2) {
                if (rd + 2 < NRD) RW_LOAD(rd + 2, xa, la);
                RW_FEAT(rd + 1, xb, lb);
                if (rd > 0) RW_YOUT(rd - 1);
                LDS_BARRIER();
                if (rd + 3 < NRD) RW_LOAD(rd + 3, xb, lb);
                if (rd + 2 < NRD) RW_FEAT(rd + 2, xa, la);
                RW_YOUT(rd);
                LDS_BARRIER();
            }
            RW_YOUT(NRD - 1);
#undef RW_LOAD
#undef RW_FEAT
#undef RW_YOUT
        } else {
            const int rowl = wave * 8 + (lane >> 3), jl = lane & 7;
            float s[8];
#pragma unroll
            for (int e = 0; e < 8; ++e) s[e] = 0.f;
            LDS_BARRIER();
            for (int rd = 0; rd < NRD; ++rd) {
                const LAS float* sb = (const LAS float*)(L + (rd & 1) * RW_BUF);
                LAS float* yb = (LAS float*)(L + RW_YB + (rd & 1) * RW_YBSZ);
                float yk = 0.f;
                f32x4 w[2], a[2], bq[2], k[2], q[2], nw[2], na[2], nb[2], nk[2], nq[2]; float vv, nvv; f32x2 sc, nsc;
#define RW_OPS(W, A, B, K, Q, V, S, st) do { const LAS float* p = sb + (st) * RW_SS + 8 * jl; _Pragma("unroll") for (int e = 0; e < 2; ++e) { W[e] = *(const LAS f32x4*)(p + 4 * e); A[e] = *(const LAS f32x4*)(p + 64 + 4 * e); \
                    B[e] = *(const LAS f32x4*)(p + 128 + 4 * e); K[e] = *(const LAS f32x4*)(p + 192 + 4 * e); Q[e] = *(const LAS f32x4*)(p + 256 + 4 * e); } \
                    V = sb[(st) * RW_SS + 320 + rh * 32 + rowl]; S = *(const LAS f32x2*)(sb + (st) * RW_SS + 384); } while (0)
                RW_OPS(w, a, bq, k, q, vv, sc, 0);
#pragma unroll
                for (int st = 0; st < RW_T; ++st) {
                    if (st + 1 < RW_T) RW_OPS(nw, na, nb, nk, nq, nvv, nsc, st + 1);
                    float pa = 0.f, pa2 = 0.f, py = 0.f, py2 = 0.f, t[8];
#pragma unroll
                    for (int e = 0; e < 2; ++e) { pa += s[4 * e] * a[e].x; pa2 += s[4 * e + 1] * a[e].y; pa += s[4 * e + 2] * a[e].z; pa2 += s[4 * e + 3] * a[e].w;
                        py += s[4 * e] * q[e].x; py2 += s[4 * e + 1] * q[e].y; py += s[4 * e + 2] * q[e].z; py2 += s[4 * e + 3] * q[e].w;
                        t[4 * e] = s[4 * e] * w[e].x + vv * k[e].x; t[4 * e + 1] = s[4 * e + 1] * w[e].y + vv * k[e].y; t[4 * e + 2] = s[4 * e + 2] * w[e].z + vv * k[e].z; t[4 * e + 3] = s[4 * e + 3] * w[e].w + vv * k[e].w; }
                    pa += pa2; py += py2;
                    red8x2(pa, py);
#pragma unroll
                    for (int e = 0; e < 2; ++e) { s[4 * e] = t[4 * e] + pa * bq[e].x; s[4 * e + 1] = t[4 * e + 1] + pa * bq[e].y; s[4 * e + 2] = t[4 * e + 2] + pa * bq[e].z; s[4 * e + 3] = t[4 * e + 3] + pa * bq[e].w; }
                    const float y = py + pa * sc.x + vv * sc.y;
                    yk = (jl == (st & 7)) ? y : yk;
                    if ((st & 7) == 7) yb[rowl * 33 + (st - 7) + jl] = yk;
#pragma unroll
                    for (int e = 0; e < 2; ++e) { w[e] = nw[e]; a[e] = na[e]; bq[e] = nb[e]; k[e] = nk[e]; q[e] = nq[e]; }
                    vv = nvv; sc = nsc;
                    __builtin_amdgcn_sched_barrier(0);
                }
#undef RW_OPS
                LDS_BARRIER();
            }
        }
#undef RW_ROW
        VM_WAIT(); __syncthreads();
    }
}

__device__ __forceinline__ void p_mix_finish(Frame& F) {
    const int gw = F.bid * 8 + F.wave, NGW = F.G * 8, lane = F.lane;
    const bf16* P = wsp<const bf16>(F, WS_P); const bf16* LO = wsp<const bf16>(F, WS_LOUT);
    const bf16* GO = wsp<const bf16>(F, WS_GLAO); const bf16* RY = wsp<const bf16>(F, WS_RWY); const float* BON = wsp<const float>(F, WS_BONUS);
    bf16* MIX = wsp<bf16>(F, WS_H);
    const int c0 = lane * 8;
    float gng[8], lnw[8], lnb[8], cpv[8], cnv[8];
#pragma unroll
    for (int e = 0; e < 8; ++e) { gng[e] = F.in[I_GNG][(c0 + e) & 127]; lnw[e] = F.in[I_LNW][c0 + e]; lnb[e] = F.in[I_LNB][c0 + e]; cpv[e] = F.in[I_MU][1024 + c0 + e]; cnv[e] = F.in[I_MU][RW_COLS + 1024 + c0 + e]; }
    for (int row = gw; row < NTOK; row += NGW) {
        { const u32x4 a = *(const u32x4*)(GO + (size_t)row * 512 + c0), bb = *(const u32x4*)(GO + ((size_t)NTOK + row) * 512 + c0), og = *(const u32x4*)(P + (size_t)row * PW + 1024 + c0);
          float o[8]; float ss = 0.f;
#pragma unroll
          for (int e = 0; e < 4; ++e) { o[2 * e] = bflo(a[e]) + bflo(bb[e]); o[2 * e + 1] = bfhi(a[e]) + bfhi(bb[e]); ss += o[2 * e] * o[2 * e] + o[2 * e + 1] * o[2 * e + 1]; }
          ss += __shfl_xor(ss, 1); ss += __shfl_xor(ss, 2); ss += __shfl_xor(ss, 4); ss += __shfl_xor(ss, 8);
          const float rstd = 1.f / sqrtf(ss * (1.f / 128.f) + 1e-6f);
          float y[8];
#pragma unroll
          for (int e = 0; e < 4; ++e) { const float g0 = bflo(og[e]), g1 = bfhi(og[e]);
              y[2 * e] = o[2 * e] * rstd * gng[2 * e] * (g0 * __builtin_amdgcn_rcpf(1.f + __expf(-g0))); y[2 * e + 1] = o[2 * e + 1] * rstd * gng[2 * e + 1] * (g1 * __builtin_amdgcn_rcpf(1.f + __expf(-g1))); }
          *(u32x4*)(MIX + (size_t)row * 1024 + c0) = (u32x4){cvt_pk_bf16(y[0], y[1]), cvt_pk_bf16(y[2], y[3]), cvt_pk_bf16(y[4], y[5]), cvt_pk_bf16(y[6], y[7])}; }
        { bool hp, hn; seq_pos(row, hp, hn);
          const u32x4 a = *(const u32x4*)(RY + (size_t)row * 512 + c0), bb = *(const u32x4*)(RY + ((size_t)NTOK + row) * 512 + c0);
          const bf16* pv = P + (size_t)row * PW + RW0 + 1024 + c0;
          const u32x4 v0 = *(const u32x4*)pv; u32x4 vm = (u32x4){0u, 0u, 0u, 0u}, vn = (u32x4){0u, 0u, 0u, 0u};
          if (hp) vm = *(const u32x4*)(pv - PW); if (hn) vn = *(const u32x4*)(pv + PW);
          const u32x4 gg = *(const u32x4*)(LO + (size_t)row * LRN + 2048 + c0);
          const int hd = lane >> 3; const float bon = BON[(size_t)row * 8 + hd] + BON[((size_t)NTOK + row) * 8 + hd];
          float yv[8]; float sm = 0.f;
#pragma unroll
          for (int e = 0; e < 4; ++e) { yv[2 * e] = bflo(a[e]) + bflo(bb[e]); yv[2 * e + 1] = bfhi(a[e]) + bfhi(bb[e]); sm += yv[2 * e] + yv[2 * e + 1]; }
          sm += __shfl_xor(sm, 1); sm += __shfl_xor(sm, 2); sm += __shfl_xor(sm, 4);
          const float mean = sm * (1.f / 64.f); float sv = 0.f;
#pragma unroll
          for (int e = 0; e < 8; ++e) { const float d = yv[e] - mean; sv += d * d; }
          sv += __shfl_xor(sv, 1); sv += __shfl_xor(sv, 2); sv += __shfl_xor(sv, 4);
          const float rstd = 1.f / sqrtf(sv * (1.f / 64.f) + 64e-5f);
          float o[8];
#pragma unroll
          for (int e = 0; e < 8; ++e) { const unsigned w0 = v0[e >> 1], wm = vm[e >> 1], wn = vn[e >> 1];
              const float p0 = (e & 1) ? bfhi(w0) : bflo(w0), pm = (e & 1) ? bfhi(wm) : bflo(wm), pn = (e & 1) ? bfhi(wn) : bflo(wn);
              const float xv = p0 + cpv[e] * (pm - p0) + cnv[e] * (pn - p0);
              const float g = (e & 1) ? bfhi(gg[e >> 1]) : bflo(gg[e >> 1]);
              o[e] = ((yv[e] - mean) * rstd * lnw[e] + lnb[e] + bon * xv) * g; }
          *(u32x4*)(MIX + (size_t)row * 1024 + 512 + c0) = (u32x4){cvt_pk_bf16(o[0], o[1]), cvt_pk_bf16(o[2], o[3]), cvt_pk_bf16(o[4], o[5]), cvt_pk_bf16(o[6], o[7])}; }
    }
}

__device__ __forceinline__ void p_mla_prep(Frame& F) {
    const int gw = F.bid * 8 + F.wave, NGW = F.G * 8, lane = F.lane;
    const bf16* C = wsp<const bf16>(F, WS_C); bf16* QN = wsp<bf16>(F, WS_QN); bf16* KVN = wsp<bf16>(F, WS_KVN); unsigned char* K8 = wsp<unsigned char>(F, WS_K8);
    const f32x2* ROPE = wsp<const f32x2>(F, WS_ROPE);
    const f32x4 qg = ((const f32x4*)F.in[I_QNORM])[lane]; const f32x4 kg = ((const f32x4*)F.in[I_KVNORM])[lane & 31];
    for (int row = gw; row < NTOK; row += NGW) {
        const bf16* cr = C + (size_t)row * 512;
        const u32x2 cqw = ((const u32x2*)cr)[lane], ckw = ((const u32x2*)(cr + 256))[lane & 31];
        const f32x4 cq = {bflo(cqw.x), bfhi(cqw.x), bflo(cqw.y), bfhi(cqw.y)};
        const f32x4 ck = {bflo(ckw.x), bfhi(ckw.x), bflo(ckw.y), bfhi(ckw.y)};
        const float xr = bflo((unsigned)cr[384 + lane]);
        const float ssq = wave_sum((cq.x * cq.x + cq.y * cq.y) + (cq.z * cq.z + cq.w * cq.w));
        const float ssk = wave_sum(lane < 32 ? (ck.x * ck.x + ck.y * ck.y) + (ck.z * ck.z + ck.w * ck.w) : 0.f);
        if (row < NLAT) { const float rs = 1.f / sqrtf(ssq * (1.f / 256.f) + 1e-6f);
            ((u32x2*)(QN + (size_t)row * 256))[lane] = (u32x2){cvt_pk_bf16(cq.x * rs * qg.x, cq.y * rs * qg.y), cvt_pk_bf16(cq.z * rs * qg.z, cq.w * rs * qg.w)}; }
        { const float rs = 1.f / sqrtf(ssk * (1.f / 128.f) + 1e-6f);
          u32x2 w = (u32x2){0u, 0u};
          if (lane < 32) w = (u32x2){cvt_pk_bf16(ck.x * rs * kg.x, ck.y * rs * kg.y), cvt_pk_bf16(ck.z * rs * kg.z, ck.w * rs * kg.w)};
          ((u32x2*)(KVN + (size_t)row * 256))[lane] = w; }
        float kr = xr; int b, key;
        const float pr = __shfl_xor(xr, 16);
        if (row < NLAT) { b = row >> 13; const int t = row & 8191; key = CTXL + t;
            const f32x2 cs = ROPE[t * 32 + ((lane >> 5) << 4) + (lane & 15)];
            kr = (lane & 16) ? xr * cs.x + pr * cs.y : xr * cs.x - pr * cs.y;
        } else { b = (row - NLAT) >> 8; key = (row - NLAT) & 255; }
        const unsigned char kb = (unsigned char)(pk4_fp8(kr, 0.f, 0.f, 0.f) & 0xffu);
#pragma unroll
        for (int h = 0; h < 8; ++h) K8[((size_t)((b * 8 + h) * NKEY + key)) * K8ROW + 128 + lane] = kb;
    }
}
__host__ __device__ constexpr int att_kperm(int p) { const int hi = p >> 5, j = p & 31, r = j & 15; return (j >> 4) * 32 + (r & 3) + 8 * (r >> 2) + 4 * hi; }

namespace att {
constexpr float SCALE = 0.07216878364870322f;
constexpr float THR = 2.f;
constexpr float PLOG2 = 5.f;
constexpr int KSLOT = 16384, KTILE = 64 * K8ROW, VSLOT = 8192;
constexpr int LDS_K = 0, LDS_V = 4 * KSLOT, LDS_WS = LDS_V + 4 * VSLOT, LDS_Q = LDS_WS + 2048;
constexpr int NT = NKEY / 64;
constexpr int ONE = 0x7F7F7F7F;
constexpr int QSCL = 0x7C7C7C7C;
__device__ __forceinline__ int crow(int r, int hi) { return (r & 3) + 8 * (r >> 2) + 4 * hi; }
constexpr float PMAXSUM = 416.f, PTARGET = 64.f;
__device__ __forceinline__ void partialSM(f32x16& p0, f32x16& p1, float moff) {
#pragma unroll
    for (int r = 0; r < 16; ++r) p0[r] -= moff;
#pragma unroll
    for (int r = 0; r < 16; ++r) p1[r] -= moff;
#pragma unroll
    for (int r = 0; r < 16; ++r) p0[r] = __builtin_amdgcn_exp2f(p0[r]);
}
__device__ __forceinline__ void finishSM(f32x16& p0, f32x16& p1, float& moff, float& alpha, float& l_reg, i32x8& pa) {
#pragma unroll
    for (int r = 0; r < 16; ++r) p1[r] = __builtin_amdgcn_exp2f(p1[r]);
    float ps = 0;
#pragma unroll
    for (int r = 0; r < 16; ++r) ps += p0[r];
#pragma unroll
    for (int r = 0; r < 16; ++r) ps += p1[r];
    { auto rr = __builtin_amdgcn_permlane32_swap(__float_as_uint(ps), __float_as_uint(ps), false, false); ps = __uint_as_float(rr[0]) + __uint_as_float(rr[1]); }
    alpha = 1.f;
    if (__builtin_expect(__any(ps > PMAXSUM), 0)) {
        alpha = ps > PMAXSUM ? PTARGET * __builtin_amdgcn_rcpf(ps) : 1.f;
        ps *= alpha; moff -= __builtin_amdgcn_logf(alpha);
#pragma unroll
        for (int g = 0; g < 4; ++g) { pa[g] = (int)pk4_fp8(p0[4 * g] * alpha, p0[4 * g + 1] * alpha, p0[4 * g + 2] * alpha, p0[4 * g + 3] * alpha); pa[4 + g] = (int)pk4_fp8(p1[4 * g] * alpha, p1[4 * g + 1] * alpha, p1[4 * g + 2] * alpha, p1[4 * g + 3] * alpha); }
    } else {
#pragma unroll
        for (int g = 0; g < 4; ++g) { pa[g] = (int)pk4_fp8(p0[4 * g], p0[4 * g + 1], p0[4 * g + 2], p0[4 * g + 3]); pa[4 + g] = (int)pk4_fp8(p1[4 * g], p1[4 * g + 1], p1[4 * g + 2], p1[4 * g + 3]); }
    }
    l_reg = l_reg * alpha + ps;
}
__device__ __forceinline__ i32x8 ld32(const LAS unsigned char* p0, const LAS unsigned char* p1) { return __builtin_shufflevector(*(const LAS i32x4*)p0, *(const LAS i32x4*)p1, 0, 1, 2, 3, 4, 5, 6, 7); }
__device__ __forceinline__ void qkt(f32x16& p0, f32x16& p1, const LAS unsigned char* Ks, const LAS unsigned char* Qs, int r32, int hi) {
#pragma unroll
    for (int r = 0; r < 16; ++r) { p0[r] = 0.f; p1[r] = 0.f; }
#pragma unroll
    for (int m = 0; m < 3; ++m) { const LAS unsigned char* k0 = Ks + r32 * K8ROW + m * 64 + hi * 32; const LAS unsigned char* k1 = k0 + 32 * K8ROW;
        const i32x8 a0 = ld32(k0, k0 + 16), a1 = ld32(k1, k1 + 16), qm = ld32(Qs + m * 2048, Qs + m * 2048 + 1024);
        p0 = __builtin_amdgcn_mfma_scale_f32_32x32x64_f8f6f4(a0, qm, p0, 0, 0, 0, ONE, 0, QSCL);
        p1 = __builtin_amdgcn_mfma_scale_f32_32x32x64_f8f6f4(a1, qm, p1, 0, 0, 0, ONE, 0, QSCL); }
}
__device__ __forceinline__ void pv(f32x16 (&o)[4], const LAS unsigned char* Vs, const i32x8 pa, int r32, int hi) {
#pragma unroll
    for (int d0 = 0; d0 < 4; ++d0) { const int c = d0 * 32 + r32, sw = (c >> 2) & 3; const LAS unsigned char* vr = Vs + c * 64;
        const i32x8 vb = ld32(vr + (((2 * hi) ^ sw) << 4), vr + (((2 * hi + 1) ^ sw) << 4));
        o[d0] = __builtin_amdgcn_mfma_scale_f32_32x32x64_f8f6f4(pa, vb, o[d0], 0, 0, 0, ONE, 0, ONE); }
}
__device__ __forceinline__ int pk4n(float a, float b, float c, float d, int w) { w = __builtin_amdgcn_cvt_pk_fp8_f32(a, b, w, false); w = __builtin_amdgcn_cvt_pk_fp8_f32(c, d, w, true); return w; }
#define ATT_MMA(a, b, c) __builtin_amdgcn_mfma_scale_f32_32x32x64_f8f6f4(a, b, c, 0, 0, 0, ONE, 0, ONE)
#define ATT_MMQ(a, b, c) __builtin_amdgcn_mfma_scale_f32_32x32x64_f8f6f4(a, b, c, 0, 0, 0, ONE, 0, QSCL)
#define ATT_EXP(P, i0, n) do { _Pragma("unroll") for (int _r = (i0); _r < (i0) + (n); ++_r) P[_r] = __builtin_amdgcn_exp2f(P[_r]); } while (0)
__device__ __forceinline__ void half_step(f32x16& X0, f32x16& X1, f32x16& Y0, f32x16& Y1, const LAS unsigned char* Ks, const LAS unsigned char* Vs, const LAS unsigned char* Qs, f32x16 (&o)[4],
                                          float& moff, float& l_reg, i32x8& pa, bool& offs, LAS float* al_l, int r32, int hi) {
    f32x16 zz;
#pragma unroll
    for (int r = 0; r < 16; ++r) zz[r] = 0.f;
    SBAR();
    const LAS unsigned char* k0 = Ks + r32 * K8ROW + hi * 32; const LAS unsigned char* k1 = k0 + 32 * K8ROW;
#define ATT_Q(m) ld32(Qs + (m) * 2048, Qs + (m) * 2048 + 1024)
#define ATT_V(d0) ld32(Vs + ((d0) * 32 + r32) * 64 + (((2 * hi) ^ ((((d0) * 32 + r32) >> 2) & 3)) << 4), Vs + ((d0) * 32 + r32) * 64 + (((2 * hi + 1) ^ ((((d0) * 32 + r32) >> 2) & 3)) << 4))
    const i32x8 q0 = ATT_Q(0); const i32x8 ka0 = ld32(k0, k0 + 16), kb0 = ld32(k1, k1 + 16);
    const i32x8 q1 = ATT_Q(1); const i32x8 ka1 = ld32(k0 + 64, k0 + 80);
    ATT_EXP(X1, 0, 4); SBAR();
    Y0 = ATT_MMQ(ka0, q0, zz); SBAR();
    const i32x8 kb1 = ld32(k1 + 64, k1 + 80);
    ATT_EXP(X1, 4, 4); SBAR();
    Y1 = ATT_MMQ(kb0, q0, zz); SBAR();
    const i32x8 q2 = ATT_Q(2); const i32x8 ka2 = ld32(k0 + 128, k0 + 144);
    ATT_EXP(X1, 8, 4); SBAR();
    Y0 = ATT_MMQ(ka1, q1, Y0); SBAR();
    const i32x8 kb2 = ld32(k1 + 128, k1 + 144);
    ATT_EXP(X1, 12, 4); SBAR();
    Y1 = ATT_MMQ(kb1, q1, Y1); SBAR();
    f32x2 sa = {X0[0], X0[1]}, sb = {X1[0], X1[1]};
#pragma unroll
    for (int r = 1; r < 8; ++r) { sa += (f32x2){X0[2 * r], X0[2 * r + 1]}; sb += (f32x2){X1[2 * r], X1[2 * r + 1]}; }
    sa += sb; float ps = sa.x + sa.y;
    { auto rr = __builtin_amdgcn_permlane32_swap(__float_as_uint(ps), __float_as_uint(ps), false, false); ps = __uint_as_float(rr[0]) + __uint_as_float(rr[1]); }
    SBAR();
    Y0 = ATT_MMQ(ka2, q2, Y0); SBAR();
    i32x8 vb[4];
    vb[0] = ATT_V(0); vb[1] = ATT_V(1);
#pragma unroll
    for (int g = 0; g < 4; ++g) pa[g] = pk4n(X0[4 * g], X0[4 * g + 1], X0[4 * g + 2], X0[4 * g + 3], pa[g]);
    SBAR();
    Y1 = ATT_MMQ(kb2, q2, Y1); SBAR();
#pragma unroll
    for (int g = 0; g < 4; ++g) pa[4 + g] = pk4n(X1[4 * g], X1[4 * g + 1], X1[4 * g + 2], X1[4 * g + 3], pa[4 + g]);
    asm volatile("" :: "v"(Y0), "v"(Y1), "v"(pa));
    SBAR();
    if (__builtin_expect(__any(ps > PMAXSUM), 0)) {
        const float alpha = ps > PMAXSUM ? PTARGET * __builtin_amdgcn_rcpf(ps) : 1.f;
        ps *= alpha; moff -= __builtin_amdgcn_logf(alpha); l_reg *= alpha; offs = true;
#pragma unroll
        for (int g = 0; g < 4; ++g) { pa[g] = (int)pk4_fp8(X0[4 * g] * alpha, X0[4 * g + 1] * alpha, X0[4 * g + 2] * alpha, X0[4 * g + 3] * alpha); pa[4 + g] = (int)pk4_fp8(X1[4 * g] * alpha, X1[4 * g + 1] * alpha, X1[4 * g + 2] * alpha, X1[4 * g + 3] * alpha); }
        if (hi == 0) al_l[r32] = alpha;
        asm volatile("s_waitcnt lgkmcnt(0)" ::: "memory");
#pragma unroll
        for (int d = 0; d < 4; ++d)
#pragma unroll
            for (int r = 0; r < 16; ++r) o[d][r] *= al_l[crow(r, hi)];
    }
    l_reg += ps;
#define ATT_SUB(P) do { _Pragma("unroll") for (int _r = 0; _r < 16; ++_r) P[_r] -= moff; } while (0)
#define ATT_R2(S0, S1) do { SBAR(); \
    o[0] = ATT_MMA(pa, vb[0], o[0]); SBAR(); vb[2] = ATT_V(2); S0; ATT_EXP(Y0, 0, 3); SBAR(); \
    o[1] = ATT_MMA(pa, vb[1], o[1]); SBAR(); vb[3] = ATT_V(3); ATT_EXP(Y0, 3, 5); SBAR(); \
    o[2] = ATT_MMA(pa, vb[2], o[2]); SBAR(); ATT_EXP(Y0, 8, 5); SBAR(); \
    o[3] = ATT_MMA(pa, vb[3], o[3]); SBAR(); ATT_EXP(Y0, 13, 3); S1; \
    asm volatile("" :: "v"(o[0]), "v"(o[1]), "v"(o[2]), "v"(o[3]), "v"(Y0), "v"(Y1));     \
    SBAR(); } while (0)
    if (__builtin_expect(offs, 0)) ATT_R2(ATT_SUB(Y0), ATT_SUB(Y1)); else ATT_R2((void)0, (void)0);
#undef ATT_R2
#undef ATT_SUB
}
__device__ __forceinline__ void glds16(const void* gsrc, LAS unsigned char* lds_wave_base) { unsigned keep; const unsigned dst = (unsigned)__builtin_amdgcn_readfirstlane((int)(uintptr_t)lds_wave_base);
    asm volatile("s_mov_b32 %0, m0\n\ts_mov_b32 m0, %2\n\ts_nop 0\n\tglobal_load_lds_dwordx4 %1, off\n\ts_mov_b32 m0, %0" : "=&s"(keep) : "v"(gsrc), "s"(dst) : "memory"); }

__device__ __forceinline__ void unit(const unsigned char* __restrict__ Qb, const unsigned char* __restrict__ Kh, const unsigned char* __restrict__ Vh, unsigned char* __restrict__ Ob, LAS unsigned char* lds, int tid) {
    const int wid = __builtin_amdgcn_readfirstlane(tid >> 6), lane = tid & 63, r32 = lane & 31, hi = lane >> 5;
    LAS float* ws = (LAS float*)(lds + LDS_WS) + wid * 64; LAS float* li_l = ws; LAS float* al_l = ws + 32;
    float l_reg = 0.f; f32x16 o[4];
#pragma unroll
    for (int d = 0; d < 4; ++d)
#pragma unroll
        for (int r = 0; r < 16; ++r) o[d][r] = 0.f;
    const unsigned char* Qw = Qb + (size_t)(wid * 32 + r32) * QKD + hi * 32;
#pragma unroll
    for (int m = 0; m < 3; ++m) { *(LAS i32x4*)(lds + LDS_Q + wid * 6144 + m * 2048 + lane * 16) = *(const i32x4*)(Qw + m * 64); *(LAS i32x4*)(lds + LDS_Q + wid * 6144 + m * 2048 + 1024 + lane * 16) = *(const i32x4*)(Qw + m * 64 + 16); }
    const LAS unsigned char* Qs = lds + LDS_Q + wid * 6144 + lane * 16;
    const unsigned pofs = (unsigned)(wid * 1024 + lane * 16);
#define DMA_K(j, slot) do { _Pragma("unroll") for (int _i = 0; _i < 2; ++_i) glds16(Kh + (size_t)(j) * KTILE + _i * 8192 + pofs, lds + LDS_K + (slot) * KSLOT + _i * 8192 + wid * 1024); } while (0)
#define DMA_V(j, slot) glds16(Vh + (size_t)(j) * VSLOT + pofs, lds + LDS_V + (slot) * VSLOT + wid * 1024)
#define WAITBAR(n) asm volatile("s_waitcnt vmcnt(" #n ")\n\ts_barrier" ::: "memory")
#define RESC(a) do { if (__any((a) < 1.f)) { if (hi == 0) al_l[r32] = (a); asm volatile("s_waitcnt lgkmcnt(0)" ::: "memory"); \
    _Pragma("unroll") for (int d = 0; d < 4; ++d) _Pragma("unroll") for (int r = 0; r < 16; ++r) o[d][r] *= al_l[crow(r, hi)]; } } while (0)
    f32x16 pA0, pA1, pB0, pB1; float moff = 0.f, al; i32x8 pa = {0, 0, 0, 0, 0, 0, 0, 0}; bool offs = false;
    if (wid >= 4) __builtin_amdgcn_s_setprio(1);
    asm volatile("s_barrier" ::: "memory");
    DMA_K(0, 0); DMA_K(1, 1); DMA_K(2, 2); DMA_V(0, 0); DMA_V(1, 1);
    WAITBAR(6);
    qkt(pA0, pA1, lds + LDS_K, Qs, r32, hi); partialSM(pA0, pA1, moff);
    WAITBAR(0);
    for (int j = 1; j + 1 < NT; j += 2) {
        DMA_K(j + 2, (j + 2) & 3); if (j + 3 < NT) DMA_K(j + 3, (j + 3) & 3);
        DMA_V(j + 1, (j + 1) & 3); DMA_V(j + 2, (j + 2) & 3);
        half_step(pA0, pA1, pB0, pB1, lds + LDS_K + (j & 3) * KSLOT, lds + LDS_V + ((j - 1) & 3) * VSLOT, Qs, o, moff, l_reg, pa, offs, al_l, r32, hi);
        half_step(pB0, pB1, pA0, pA1, lds + LDS_K + ((j + 1) & 3) * KSLOT, lds + LDS_V + (j & 3) * VSLOT, Qs, o, moff, l_reg, pa, offs, al_l, r32, hi);
        WAITBAR(0);
    }
    int vs = (NT - 2) & 3;
    SBAR(); qkt(pB0, pB1, lds + LDS_K + ((NT - 1) & 3) * KSLOT, Qs, r32, hi);
    finishSM(pA0, pA1, moff, al, l_reg, pa); SBAR();
    RESC(al);
    pv(o, lds + LDS_V + vs * VSLOT, pa, r32, hi); partialSM(pB0, pB1, moff);
    vs = (NT - 1) & 3;
    finishSM(pB0, pB1, moff, al, l_reg, pa); SBAR();
    RESC(al);
    pv(o, lds + LDS_V + vs * VSLOT, pa, r32, hi);
    __builtin_amdgcn_s_setprio(0);
    if (hi == 0) li_l[r32] = l_reg; asm volatile("s_waitcnt lgkmcnt(0)" ::: "memory");
    float rli[16];
#pragma unroll
    for (int r = 0; r < 16; ++r) rli[r] = __builtin_amdgcn_rcpf(li_l[crow(r, hi)]);
    unsigned char* Ow = Ob + (size_t)(wid * 32) * 1024;
#pragma unroll
    for (int r = 0; r < 16; ++r) { const int orow = crow(r, hi);
#pragma unroll
        for (int d0 = 0; d0 < 4; ++d0) Ow[(size_t)orow * 1024 + d0 * 32 + r32] = (unsigned char)(pk4_fp8(o[d0][r] * rli[r], 0.f, 0.f, 0.f) & 0xffu); }
#undef DMA_K
#undef DMA_V
#undef WAITBAR
#undef RESC
}
}
__device__ __forceinline__ void p_attention(Frame& F) {
    const unsigned char* Q8 = wsp<const unsigned char>(F, WS_Q8); const unsigned char* K8 = wsp<const unsigned char>(F, WS_K8); const unsigned char* VT = wsp<const unsigned char>(F, WS_V8T); unsigned char* O = wsp<unsigned char>(F, WS_H);
    for (int u = F.bid; u < NB * MH * 32; u += F.G) {
        const int pair = (u >> 8) * 8 + (u & 7), qb = (u & 255) >> 3, b = pair >> 3, h = pair & 7;
        att::unit(Q8 + ((size_t)pair * SEQ + qb * 256) * QKD, K8 + (size_t)pair * NKEY * K8ROW, VT + (size_t)pair * att::NT * att::VSLOT, O + ((size_t)(b * SEQ + qb * 256)) * 1024 + h * 128, F.lds, F.tid);
    }
    VM_WAIT(); __syncthreads();
}

constexpr int N_PHASES = 24;
struct Args { const float* in[37]; float* out; unsigned char* ws; int ph_lo, ph_hi, pad0, pad1; };
__global__ void __launch_bounds__(512, 2) mk_fwd(Args args) {
    extern __shared__ __attribute__((aligned(16))) unsigned char lds_raw[];
    Frame F;
    F.lds = (LAS unsigned char*)lds_raw;
    F.tid = threadIdx.x; F.lane = F.tid & 63; F.wave = __builtin_amdgcn_readfirstlane(F.tid >> 6);
    F.G = gridDim.x; F.bid = blockIdx.x;
    F.in = (const float* const __attribute__((address_space(4)))*)__builtin_amdgcn_kernarg_segment_ptr();
    F.out = args.out; F.ws = args.ws;
    volatile LAS unsigned* MISC = (volatile LAS unsigned*)(F.lds + MISC_OFF);
    if (F.tid < 64) MISC[F.tid] = 0u;
    __syncthreads();
    const int lo = args.ph_lo, hi = args.ph_hi;
    XcdBarrier bar; bar.bar = (unsigned*)(F.ws + WS_CTL) + CW_BAR; bar.x = 0; bar.st = nullptr;
    if (hi - lo > 1) bar = xcd_barrier_post((unsigned*)(F.ws + WS_CTL) + CW_BAR, MISC + 8);
#ifndef ONLY_PHASE
#define ONLY_PHASE -1
#endif
#define IN(k) ((ONLY_PHASE < 0 || ONLY_PHASE == (k)) && lo <= (k) && (k) < hi)
#define SEAM(k) do { if (IN(k) && IN((k) + 1)) xcd_barrier(bar); } while (0)
    LAS unsigned char* ring = F.lds;
    const LAS int* blk_e = (const LAS int*)(F.lds + MT_OFF) + 128;
    const LAS int* mtab = (const LAS int*)(F.lds + MT_OFF);

    if (IN(0)) { p0_mod(F); p0_rope(F); p0_convert(F); } SEAM(0);
    if (IN(1)) { p_norm1_l0(F); } SEAM(1);
    if (IN(2)) {
        pg8::DenseSched S; S.init(NTOK, PW, 2048, wsp<const bf16>(F, WS_WIN), F.G, F.bid);
        pg8::EpiBf16<pg8::MapPlain> E{pg8::MapPlain{wsp<bf16>(F, WS_P), PW}};
        pg8::gemm_phase(ring, wsp<const bf16>(F, WS_H), 2048, S, E);
        { const int slot = F.bid - S.nwg % F.G; if (slot >= 0) p_fill_convert(F, slot, F.G - S.nwg % F.G, 0, FILL_A); }
    } SEAM(2);
    if (IN(3)) { p_alr(F); p_gla_pre(F); } SEAM(3);
    if (IN(4)) {
        pg8::DenseSched S; S.init(NTOK, LRN, LRK * 2, wsp<const bf16>(F, WS_WLR), F.G, F.bid);
        pg8::EpiBf16<pg8::MapPlain> E{pg8::MapPlain{wsp<bf16>(F, WS_LOUT), LRN}};
        pg8::gemm_phase(ring, wsp<const bf16>(F, WS_ALR), LRK * 2, S, E);
        { const int slot = F.bid - S.nwg % F.G; if (slot >= 0) p_fill_convert(F, slot, F.G - S.nwg % F.G, FILL_A, FILL_B); }
    } SEAM(4);
    if (IN(5)) { p_gla_scan(F); p_rwkv_scan(F); } SEAM(5);
    if (IN(6)) { p_mix_finish(F); } SEAM(6);
    if (IN(7)) {
        pg8::DenseSched S; S.init(NTOK, 1024, 2048, wsp<const bf16>(F, WS_WOUT), F.G, F.bid);
        pg8::EpiResid E{wsp<bf16>(F, WS_X1), F.in[I_X], F.in[I_CTX], wsp<const float>(F, WS_MOD), 0};
        pg8::gemm_phase(ring, wsp<const bf16>(F, WS_H), 2048, S, E);
        { const int slot = F.bid - S.nwg % F.G; if (slot >= 0) p_fill_convert(F, slot, F.G - S.nwg % F.G, FILL_B, FILL_C); }
    } SEAM(7);
    if (IN(8)) { p_norm2_route(F, 0, NTOK); } SEAM(8);
    if (IN(9)) { p_moe_scatter(F, NTOK); } SEAM(9);
    if (IN(10)) {
        moe_tables(F);
        pg8::MoeSched<true> S{mtab[64], 8, F.G, F.bid, blk_e, wsp<const unsigned>(F, WS_SORT), wsp<const unsigned char>(F, WS_WGU), (size_t)2048 * 1024};
        pg8::EpiSwiglu E{wsp<unsigned char>(F, WS_ACT), F.in[I_GUB], blk_e};
        pg8::gemm_phase<pg8::EpiSwiglu, pg8::MoeSched<true>, true>(ring, wsp<const unsigned char>(F, WS_H), 1024, S, E);
    } SEAM(10);
    if (IN(11)) {
        moe_tables(F);
        pg8::MoeSched<false> S{mtab[64], 4, F.G, F.bid, blk_e, nullptr, wsp<const unsigned char>(F, WS_WDN), (size_t)1024 * 1024};
        pg8::EpiDown E{wsp<unsigned char>(F, WS_YS), F.in[I_DNB], blk_e, wsp<const unsigned>(F, WS_SORT) + MAXSLOT, (const float*)(wsp<const unsigned>(F, WS_SORT) + 2 * MAXSLOT)};
        pg8::gemm_phase<pg8::EpiDown, pg8::MoeSched<false>, true>(ring, wsp<const unsigned char>(F, WS_ACT), 1024, S, E);
    } SEAM(11);
    if (IN(12)) { p_combine_norm1_l1(F); } SEAM(12);
    if (IN(13)) {
        pg8::DenseSched S; S.init(NTOK, 512, 1024, wsp<const unsigned char>(F, WS_WODIN), F.G, F.bid);
        pg8::EpiBf16<pg8::MapPlain> E{pg8::MapPlain{wsp<bf16>(F, WS_C), 512}};
        pg8::gemm_phase<pg8::EpiBf16<pg8::MapPlain>, pg8::DenseSched, true>(ring, wsp<const unsigned char>(F, WS_H), 1024, S, E);
        { const int slot = F.bid - S.nwg % F.G; if (slot >= 0) p_fill_convert(F, slot, F.G - S.nwg % F.G, FILL_C, FILL_D); }
    } SEAM(13);
    if (IN(14)) { p_mla_prep(F); } SEAM(14);
    if (IN(15)) {
        { pg8::DenseSched S; S.init(NLAT, 1536, 512, wsp<const bf16>(F, WS_WQUP), F.G, F.bid);
          pg8::EpiQ8 E{wsp<unsigned char>(F, WS_Q8), wsp<const f32x2>(F, WS_ROPE)};
          pg8::gemm_phase(ring, wsp<const bf16>(F, WS_QN), 512, S, E); }
        { pg8::DenseSched S; S.init(NTOK, 2048, 512, wsp<const bf16>(F, WS_WKVUP), F.G, F.bid);
          pg8::EpiKV8 E{wsp<unsigned char>(F, WS_K8), wsp<unsigned char>(F, WS_V8T)};
          pg8::gemm_phase(ring, wsp<const bf16>(F, WS_KVN), 512, S, E);
          { const int slot = F.bid - S.nwg % F.G; if (slot >= 0) p_fill_convert(F, slot, F.G - S.nwg % F.G, FILL_D, FILL_E); } }
    } SEAM(15);
    if (IN(17)) { p_attention(F); } SEAM(17);
    if (IN(18)) {
        pg8::DenseSched S; S.init(NLAT, 1024, 1024, wsp<const unsigned char>(F, WS_WODOUT), F.G, F.bid);
        pg8::EpiResid E{wsp<bf16>(F, WS_X1), F.in[I_X], F.in[I_CTX], wsp<const float>(F, WS_MOD), 1};
        pg8::gemm_phase<pg8::EpiResid, pg8::DenseSched, true>(ring, wsp<const unsigned char>(F, WS_H), 1024, S, E);
    } SEAM(18);
    if (IN(19)) { p_norm2_route(F, 1, NLAT); } SEAM(19);
    if (IN(20)) { p_moe_scatter(F, NLAT); } SEAM(20);
    if (IN(21)) {
        moe_tables(F);
        pg8::MoeSched<true> S{mtab[64], 8, F.G, F.bid, blk_e, wsp<const unsigned>(F, WS_SORT), wsp<const unsigned char>(F, WS_WGU) + (size_t)32 * 2048 * 1024, (size_t)2048 * 1024};
        pg8::EpiSwiglu E{wsp<unsigned char>(F, WS_ACT), F.in[I_GUB] + 32 * 2048, blk_e};
        pg8::gemm_phase<pg8::EpiSwiglu, pg8::MoeSched<true>, true>(ring, wsp<const unsigned char>(F, WS_H), 1024, S, E);
    } SEAM(21);
    if (IN(22)) {
        moe_tables(F);
        pg8::MoeSched<false> S{mtab[64], 4, F.G, F.bid, blk_e, nullptr, wsp<const unsigned char>(F, WS_WDN) + (size_t)32 * 1024 * 1024, (size_t)1024 * 1024};
        pg8::EpiDown E{wsp<unsigned char>(F, WS_YS), F.in[I_DNB] + 32 * 1024, blk_e, wsp<const unsigned>(F, WS_SORT) + MAXSLOT, (const float*)(wsp<const unsigned>(F, WS_SORT) + 2 * MAXSLOT)};
        pg8::gemm_phase<pg8::EpiDown, pg8::MoeSched<false>, true>(ring, wsp<const unsigned char>(F, WS_ACT), 1024, S, E);
    } SEAM(22);
    if (IN(23)) { p_final(F); }
#undef IN
#undef SEAM
}

extern "C" void kernel_launch(void* const* d_in, const int* in_sizes, int n_in, void* d_out, int out_size, void* d_ws, size_t ws_size, hipStream_t stream) {
    static int grid = 0;
    if (grid == 0) {
        if (n_in != 37 || out_size != NLAT * DM || ws_size < WS_END) { fprintf(stderr, "kernel_launch: built for 37 inputs, %d outputs, >= %zu bytes of workspace; got n_in %d, out %d, ws %zu\n", NLAT * DM, (size_t)WS_END, n_in, out_size, ws_size); grid = -1; return; }
        int dev = 0, cus = 0, per_cu = 0;
        if (hipGetDevice(&dev) != hipSuccess || hipDeviceGetAttribute(&cus, hipDeviceAttributeMultiprocessorCount, dev) != hipSuccess) { grid = -1; return; }
        if (hipFuncSetAttribute((const void*)mk_fwd, hipFuncAttributeMaxDynamicSharedMemorySize, LDS_BYTES) != hipSuccess) { fprintf(stderr, "kernel_launch: hipFuncSetAttribute failed\n"); grid = -1; return; }
        if (hipOccupancyMaxActiveBlocksPerMultiprocessor(&per_cu, (const void*)mk_fwd, 512, LDS_BYTES) != hipSuccess || per_cu < 1) fprintf(stderr, "kernel_launch: occupancy query says %d\n", per_cu);
        (void)hipGetLastError();
        grid = cus;
    }
    if (grid < 0) return;
    if (hipMemsetAsync((char*)d_ws + WS_CTL, 0, CTL_ZERO_BYTES, stream) != hipSuccess) return;
    Args a{};
    for (int i = 0; i < 37; ++i) a.in[i] = (const float*)d_in[i];
    a.out = (float*)d_out; a.ws = (unsigned char*)d_ws;
#if MK_N_LAUNCHES == 1
    a.ph_lo = 0; a.ph_hi = N_PHASES;
    hipLaunchKernelGGL(mk_fwd, dim3(grid), dim3(512), LDS_BYTES, stream, a);
#else
    for (int p = 0; p < N_PHASES; ++p) { a.ph_lo = p; a.ph_hi = p + 1; hipLaunchKernelGGL(mk_fwd, dim3(grid), dim3(512), LDS_BYTES, stream, a); }
#endif
    const hipError_t le = hipPeekAtLastError();
    if (le != hipSuccess) fprintf(stderr, "kernel_launch: launch failed: %s\n", hipGetErrorName(le));
}
```

```cpp
#include <hip/hip_runtime.h>
#include <cstdio>
#include <cstdint>

#ifndef MK_N_LAUNCHES
#define MK_N_LAUNCHES 1
#endif

#define GAS __attribute__((address_space(1)))
#define LAS __attribute__((address_space(3)))
typedef unsigned short bf16;
typedef short bf16x8 __attribute__((ext_vector_type(8)));
typedef short s16x4 __attribute__((ext_vector_type(4)));
typedef float f32x4 __attribute__((ext_vector_type(4)));
typedef float f32x2 __attribute__((ext_vector_type(2)));
typedef float f32x16 __attribute__((ext_vector_type(16)));
typedef unsigned u32x4 __attribute__((ext_vector_type(4)));
typedef unsigned u32x2 __attribute__((ext_vector_type(2)));
typedef int i32x4 __attribute__((ext_vector_type(4)));
typedef int i32x8 __attribute__((ext_vector_type(8)));
typedef GAS unsigned gu32;
#define RLX_AGENT __ATOMIC_RELAXED, __HIP_MEMORY_SCOPE_AGENT
#define LDS_WAIT() asm volatile("s_waitcnt lgkmcnt(0)" ::: "memory")
#define VM_WAIT() asm volatile("s_waitcnt vmcnt(0)" ::: "memory")
#define SBAR() __builtin_amdgcn_sched_barrier(0)

constexpr int DM = 1024, NB = 8, SEQ = 8192, CTXL = 256;
constexpr int NLAT = NB * SEQ;
constexpr int NCTX = NB * CTXL;
constexpr int NTOK = NLAT + NCTX;
constexpr int GLA_COLS = 1552, RW_COLS = 1824, RW0 = 1664, PW = 3584;
constexpr int LRK = 384, LRN = 2560;
constexpr int NE = 32, TOPK = 4, DE = 1024;
constexpr int NASG0 = NTOK * TOPK;
constexpr int MAXSLOT = NASG0 + NE * 256;
constexpr int YS_DUMMY = NASG0;
constexpr int NKEY = CTXL + SEQ;
constexpr float YS_SCALE = 16.f;
constexpr int MH = 8, QKD = 192, VD = 128;

constexpr size_t MiB = 1u << 20;
constexpr size_t WS_CTL = 0, CTL_ZERO_BYTES = 1 * MiB;
constexpr size_t WS_MOD = 1 * MiB;
constexpr size_t WS_ROPE = 2 * MiB;
constexpr size_t WS_WIN = 4 * MiB;
constexpr size_t WS_WOUT = 11 * MiB;
constexpr size_t WS_WLR = 13 * MiB;
constexpr size_t WS_WODIN = 15 * MiB;
constexpr size_t WS_WQUP = 16 * MiB;
constexpr size_t WS_WKVUP = 17 * MiB;
constexpr size_t WS_WODOUT = 18 * MiB;
constexpr size_t WS_ROUTE = 20 * MiB;
constexpr size_t WS_WGU = 24 * MiB;
constexpr size_t WS_WDN = 280 * MiB;
constexpr size_t WS_X1 = 408 * MiB;
constexpr size_t WS_H = 672 * MiB;
constexpr size_t WS_ARENA = 804 * MiB;
constexpr size_t WS_P = WS_ARENA;
constexpr size_t WS_LOUT = WS_P + 462 * MiB;
constexpr size_t WS_GLAO = WS_LOUT + 330 * MiB;
constexpr size_t WS_RWY = WS_GLAO + 132 * MiB;
constexpr size_t WS_ALR = WS_RWY + 132 * MiB;
constexpr size_t WS_BONUS = WS_ALR + 50 * MiB;
constexpr size_t WS_ACT = WS_ARENA;
constexpr size_t WS_YS = WS_ACT + 544 * MiB;
constexpr size_t WS_C = WS_ARENA;
constexpr size_t WS_QN = WS_C + 132 * MiB;
constexpr size_t WS_KVN = WS_QN + 32 * MiB;
constexpr size_t WS_Q8 = WS_KVN + 33 * MiB;
constexpr size_t WS_QR = WS_Q8 + 101 * MiB;
constexpr size_t WS_K8 = WS_QR + 64 * MiB;
constexpr size_t WS_V8T = WS_K8 + 108 * MiB;
constexpr size_t WS_V = WS_V8T + 67 * MiB;
constexpr size_t WS_END = 2048 * MiB;
static_assert(WS_BONUS + 5 * MiB <= WS_END && WS_YS + 529 * MiB <= WS_END && WS_V + 132 * MiB <= WS_END, "d_ws map");
constexpr int K8ROW = 208;
constexpr size_t RT_E = 0;
constexpr size_t RT_POS = 512 * 1024;
constexpr size_t RT_GATE = 1024 * 1024 + 512 * 1024;
constexpr size_t RT_HIST = 3 * MiB;
constexpr size_t RT_TOK = 3 * MiB + 64 * 1024;
constexpr size_t WS_SORT = WS_YS + 529 * MiB;
static_assert(WS_SORT + 4 * MiB <= WS_END, "sort lists");

constexpr int CW_TMO = 0, CW_CODE = 1;
constexpr int CW_BAR = 4096;

constexpr int RING_BYTES = 131072;
constexpr int LDS_BYTES = 163840;
constexpr int MISC_OFF = 163840 - 256;

__device__ __forceinline__ unsigned f2bf(float f) { unsigned u = __builtin_bit_cast(unsigned, f); return (u + 0x7fffu + ((u >> 16) & 1u)) >> 16; }
__device__ __forceinline__ float bf2f(unsigned h) { return __builtin_bit_cast(float, h << 16); }
typedef __bf16 bf16x2v __attribute__((ext_vector_type(2)));
__device__ __forceinline__ unsigned cvt_pk_bf16(float lo, float hi) { const f32x2 v = {lo, hi}; const bf16x2v r = __builtin_convertvector(v, bf16x2v); return __builtin_bit_cast(unsigned, r); }
__device__ __forceinline__ unsigned pk4_fp8(float a, float b, float c, float d) { unsigned w = 0u; w = (unsigned)__builtin_amdgcn_cvt_pk_fp8_f32(a, b, (int)w, false); w = (unsigned)__builtin_amdgcn_cvt_pk_fp8_f32(c, d, (int)w, true); return w; }
__device__ __forceinline__ float bflo(unsigned w) { return __builtin_bit_cast(float, w << 16); }
__device__ __forceinline__ float bfhi(unsigned w) { return __builtin_bit_cast(float, w & 0xffff0000u); }
__device__ __forceinline__ float wave_sum(float v) {
#pragma unroll
    for (int o = 1; o < 64; o <<= 1) v += __shfl_xor(v, o);
    return v;
}
__device__ __forceinline__ float sigmoidf_(float x) { return 1.f / (1.f + __expf(-x)); }

namespace pg8 {
constexpr int BM = 256, BK = 64, HALF = 128, HTB = HALF * BK * 2, STAGE_BYTES = 8 * HTB;
__host__ __device__ __forceinline__ int lds_byte(int r, int c) { const int st = (r >> 4) * 2 + (c >> 5), rr = r & 15, cc = c & 31, ob = rr * 64 + cc * 2; return st * 1024 + (ob ^ (((ob >> 9) & 1) << 5)); }
__host__ __device__ __forceinline__ void stage_rc(int b, int& R, int& C) { const int st = b / 1024, sb = b % 1024, swz = sb ^ (((sb >> 9) & 1) << 5); R = (st >> 1) * 16 + swz / 64; C = (st & 1) * 32 + (swz % 64) / 2; }
__host__ __device__ __forceinline__ int perm32(int rho) { const int n = rho >> 4, i = rho & 15; return 8 * (i >> 2) + 4 * n + (i & 3); }
struct Unit { int pm, pn; };

template <class Epi, class Sched, bool FP8 = false>
__device__ __forceinline__ void gemm_phase(LAS unsigned char* lds, const void* Abase, const int KBc, const Sched& S, const Epi& E) {
    int K = KBc; asm volatile("" : "+s"(K));
    const int tid = threadIdx.x, wid = __builtin_amdgcn_readfirstlane(tid >> 6), lane = tid & 63, wr = wid >> 2, wc = wid & 3, fr = lane & 15, fq = lane >> 4;
    const int nt = K / 128;
    int sR[2], sC[2]; unsigned voffB[2];
#pragma unroll
    for (int i = 0; i < 2; ++i) { int R, C; stage_rc(tid * 16 + i * 8192, R, C); const int Rb = Epi::PERM ? ((R & ~31) + perm32(R & 31)) : R; sR[i] = R; sC[i] = C; voffB[i] = (unsigned)(Rb * K + C * 2); }
    const size_t kstep = (size_t)(BK * 2);
    const size_t hstep = (size_t)HALF * K;
    const unsigned ldsw = (unsigned)wid * 1024u;
    const int aoff = lds_byte(wr * 64 + fr, fq * 8), boff = lds_byte(wc * 32 + fr, fq * 8);
    const char* Ab = (const char*)Abase;
#define PG8_SA(b, h) (((b) * 2 + (h)) * HTB)
#define PG8_SB(b, h) ((4 + (b) * 2 + (h)) * HTB)
#define PG8_STAGE(bufoff, gbase, voff) do { _Pragma("unroll") for (int _i = 0; _i < 2; ++_i) \
        __builtin_amdgcn_global_load_lds((const unsigned*)((const char*)(gbase) + (voff)[_i]), (LAS unsigned*)(lds + (bufoff) + ldsw + _i * 8192), 16, 0, 0); } while (0)
#define PG8_STAGEA(bufoff, kb, ao, h) do { _Pragma("unroll") for (int _i = 0; _i < 2; ++_i) \
        __builtin_amdgcn_global_load_lds((const unsigned*)((Ab + (kb)) + (ao)[h][_i]), (LAS unsigned*)(lds + (bufoff) + ldsw + _i * 8192), 16, 0, 0); } while (0)
#define PG8_STAGEA2(bufoff, kb, h) do { _Pragma("unroll") for (int _i = 0; _i < 2; ++_i) \
        __builtin_amdgcn_global_load_lds((const unsigned*)((Ab + (kb)) + (last ? nao[h][_i] : cao[h][_i])), (LAS unsigned*)(lds + (bufoff) + ldsw + _i * 8192), 16, 0, 0); } while (0)
#define PG8_LD8(p) __builtin_shufflevector(*(const LAS i32x4*)(p), *(const LAS i32x4*)((p) + 1024), 0, 1, 2, 3, 4, 5, 6, 7)
#define PG8_LDA(dst, b, h) do { _Pragma("unroll") for (int m = 0; m < 4; ++m) dst[m] = PG8_LD8(lds + PG8_SA(b, h) + aoff + m * 2048); } while (0)
#define PG8_LDB(dst, b, h) do { _Pragma("unroll") for (int n = 0; n < 2; ++n) dst[n] = PG8_LD8(lds + PG8_SB(b, h) + boff + n * 2048); } while (0)
#define PG8_MMA(ai, bj, At, Bt) do { __builtin_amdgcn_s_setprio(1); _Pragma("unroll") for (int m = 0; m < 4; ++m) _Pragma("unroll") for (int n = 0; n < 2; ++n) { \
        if constexpr (FP8) asm volatile("v_mfma_scale_f32_16x16x128_f8f6f4 %0, %1, %2, %0, %3, %4 op_sel_hi:[0,0,0]" : "+v"(acc[ai][bj][m][n]) : "v"(Bt[n]), "v"(At[m]), "v"(scl_w), "v"(scl_x)); \
        else { acc[ai][bj][m][n] = __builtin_amdgcn_mfma_f32_16x16x32_bf16(__builtin_bit_cast(bf16x8, __builtin_shufflevector(Bt[n], Bt[n], 0, 1, 2, 3)), __builtin_bit_cast(bf16x8, __builtin_shufflevector(At[m], At[m], 0, 1, 2, 3)), acc[ai][bj][m][n], 0, 0, 0); \
               acc[ai][bj][m][n] = __builtin_amdgcn_mfma_f32_16x16x32_bf16(__builtin_bit_cast(bf16x8, __builtin_shufflevector(Bt[n], Bt[n], 4, 5, 6, 7)), __builtin_bit_cast(bf16x8, __builtin_shufflevector(At[m], At[m], 4, 5, 6, 7)), acc[ai][bj][m][n], 0, 0, 0); } } \
        __builtin_amdgcn_s_setprio(0); } while (0)
#define PG8_WAIT_V(n) asm volatile("s_waitcnt vmcnt(" #n ")" ::: "memory")
#define PG8_WAIT_L(n) asm volatile("s_waitcnt lgkmcnt(" #n ")" ::: "memory")
#define PG8_BAR __builtin_amdgcn_s_barrier()
#define PG8_SCHED __builtin_amdgcn_sched_barrier(0)
    Unit cur, nxt; int ui = 0;
    if (!S.next(0, cur)) return;
    int ntc = S.ktiles(cur, nt);
    f32x4 acc[2][2][4][2];
#pragma unroll
    for (int a = 0; a < 2; ++a)
#pragma unroll
        for (int b = 0; b < 2; ++b)
#pragma unroll
            for (int m = 0; m < 4; ++m)
#pragma unroll
                for (int n = 0; n < 2; ++n) acc[a][b][m][n] = (f32x4){0.f, 0.f, 0.f, 0.f};
    i32x8 At[4], B0[2], B1[2];
    int scl_w = 0x7A7A7A7A, scl_x = 0x7F7F7F7F;
    asm volatile("" : "+v"(scl_w), "+v"(scl_x));
    unsigned cao[2][2], nao[2][2];
    S.a_offs(cur, cao, sR, sC);
    const char* cB = S.b_tile(cur);
    PG8_STAGE(PG8_SB(0, 0), cB, voffB); PG8_STAGE(PG8_SB(0, 1), cB + hstep, voffB); PG8_STAGEA(PG8_SA(0, 0), 0, cao, 0); PG8_STAGEA(PG8_SA(0, 1), 0, cao, 1);
    if (wr == 1) PG8_BAR;
    PG8_WAIT_V(2); PG8_BAR;
    PG8_STAGE(PG8_SB(1, 0), cB + kstep, voffB); PG8_STAGEA(PG8_SA(1, 0), kstep, cao, 0); PG8_STAGE(PG8_SB(1, 1), cB + hstep + kstep, voffB);
    PG8_WAIT_V(6); PG8_BAR;
    for (;;) {
        const bool has_next = S.next(ui + 1, nxt);
        const char* nB = cB;
        if (has_next) { S.a_offs(nxt, nao, sR, sC); nB = S.b_tile(nxt); }
        else {
#pragma unroll
            for (int h = 0; h < 2; ++h)
#pragma unroll
                for (int i = 0; i < 2; ++i) nao[h][i] = cao[h][i];
        }
        for (int t = 0; t < ntc; t += 2) {
            const bool last = (t == ntc - 2);
            const size_t a1k = (size_t)(t + 1) * kstep;
            const size_t a2k = last ? 0 : (size_t)(t + 2) * kstep; const char* b2 = last ? nB : cB + (size_t)(t + 2) * kstep;
            const size_t a3k = a2k + kstep; const char* b3 = b2 + kstep;
            PG8_LDB(B0, 0, 0); PG8_LDB(B1, 0, 1); PG8_SCHED; PG8_LDA(At, 0, 0); PG8_STAGEA(PG8_SA(1, 1), a1k, cao, 1);
            PG8_WAIT_V(8); PG8_WAIT_L(0); PG8_BAR; PG8_MMA(0, 0, At, B0); PG8_MMA(0, 1, At, B1); PG8_BAR; PG8_SCHED;
            PG8_LDA(At, 0, 1); PG8_STAGE(PG8_SB(0, 0), b2, voffB); PG8_STAGE(PG8_SB(0, 1), b2 + hstep, voffB); PG8_STAGEA2(PG8_SA(0, 0), a2k, 0);
            PG8_WAIT_V(8); PG8_WAIT_L(0); PG8_BAR; PG8_MMA(1, 0, At, B0); PG8_MMA(1, 1, At, B1); PG8_BAR; PG8_SCHED;
            PG8_LDB(B0, 1, 0); PG8_LDB(B1, 1, 1); PG8_SCHED; PG8_LDA(At, 1, 0); PG8_STAGEA2(PG8_SA(0, 1), a2k, 1);
            PG8_WAIT_V(8); PG8_WAIT_L(0); PG8_BAR; PG8_MMA(0, 0, At, B0); PG8_MMA(0, 1, At, B1); PG8_BAR; PG8_SCHED;
            PG8_LDA(At, 1, 1); PG8_STAGE(PG8_SB(1, 0), b3, voffB); PG8_STAGE(PG8_SB(1, 1), b3 + hstep, voffB); PG8_STAGEA2(PG8_SA(1, 0), a3k, 0);
            PG8_WAIT_V(8); PG8_WAIT_L(0); PG8_BAR; PG8_MMA(1, 0, At, B0); PG8_MMA(1, 1, At, B1); PG8_BAR; PG8_SCHED;
        }
        if (wr == 0) PG8_BAR;
        if constexpr (FP8) asm volatile("s_nop 15\n\ts_nop 7" ::: "memory");
        E(acc, cur, wr, wc, fr, fq);
        if (!has_next) break;
#pragma unroll
        for (int a = 0; a < 2; ++a)
#pragma unroll
            for (int b = 0; b < 2; ++b)
#pragma unroll
                for (int m = 0; m < 4; ++m)
#pragma unroll
                    for (int n = 0; n < 2; ++n) acc[a][b][m][n] = (f32x4){0.f, 0.f, 0.f, 0.f};
        cur = nxt; cB = nB; ++ui; ntc = S.ktiles(cur, nt);
#pragma unroll
        for (int h = 0; h < 2; ++h)
#pragma unroll
            for (int i = 0; i < 2; ++i) cao[h][i] = nao[h][i];
        if (wr == 1) PG8_BAR;
    }
    PG8_WAIT_V(0);
    PG8_BAR;
#undef PG8_SA
#undef PG8_SB
#undef PG8_STAGE
#undef PG8_STAGEA
#undef PG8_STAGEA2
#undef PG8_LDA
#undef PG8_LDB
#undef PG8_MMA
#undef PG8_WAIT_V
#undef PG8_WAIT_L
#undef PG8_BAR
#undef PG8_SCHED
}
}

#define XB_TMO      128
#define XB_XCNT(j)  (256  + 64 * (j))
#define XB_XSUB(j)  (1280 + 64 * (j))
#define XB_XGEN(j)  (2304 + 64 * (j))
#define XB_TOP      3328
#define XB_TOPGEN   3392
#define XCD_BAR_WORDS 3456
#define XB_SPIN_CAP (1u << 22)
__device__ __forceinline__ unsigned xb_ld(unsigned* p)              { return __hip_atomic_load(p, __ATOMIC_RELAXED, __HIP_MEMORY_SCOPE_AGENT); }
__device__ __forceinline__ unsigned xb_add(unsigned* p, unsigned v) { return __hip_atomic_fetch_add(p, v, __ATOMIC_RELAXED, __HIP_MEMORY_SCOPE_AGENT); }
__device__ __forceinline__ unsigned xb_xcc_id() { return (unsigned)__builtin_amdgcn_s_getreg((3 << 11) | 20) & 0xFu; }
#define XB_SPIN(cond, bar) do { unsigned _sp = 0; while (cond) { __builtin_amdgcn_s_sleep(1); \
    if ((++_sp & 255u) == 0u) { if (xb_ld(&(bar)[XB_TMO])) break; if (_sp > XB_SPIN_CAP) { atomicAdd(&(bar)[XB_TMO], 1u); break; } } } } while (0)
struct XcdBarrier { unsigned* bar; unsigned x; volatile LAS unsigned* st; };
__device__ __forceinline__ XcdBarrier xcd_barrier_post(unsigned* bar, volatile LAS unsigned* st) {
    XcdBarrier b; b.bar = bar; b.x = xb_xcc_id(); b.st = st;
    if (threadIdx.x == 0) (void)xb_add(&bar[XB_XCNT(b.x)], 1u);
    return b;
}
__device__ __forceinline__ void xcd_barrier_complete(unsigned* bar, unsigned x, unsigned& nloc, unsigned& nx) {
    const unsigned G = gridDim.x * gridDim.y * gridDim.z;
    unsigned sum, cnt, mine, sp = 0u;
    for (;;) {
        sum = 0u; cnt = 0u; mine = 0u;
#pragma unroll
        for (unsigned j = 0; j < 16; ++j) { const unsigned c = xb_ld(&bar[XB_XCNT(j)]); sum += c; cnt += (c > 0u) ? 1u : 0u; mine = (j == x) ? c : mine; }
        if (sum == G) break;
        __builtin_amdgcn_s_sleep(1);
        if ((++sp & 255u) == 0u) { if (xb_ld(&bar[XB_TMO])) break; if (sp > XB_SPIN_CAP) { atomicAdd(&bar[XB_TMO], 1u); break; } }
    }
    nloc = mine > 0u ? mine : 1u; nx = cnt > 0u ? cnt : 1u;
}
__device__ __forceinline__ void xcd_barrier(const XcdBarrier& b) {
    asm volatile("s_waitcnt vmcnt(0)" ::: "memory");
    __syncthreads();
    if (threadIdx.x == 0) {
        unsigned* bar = b.bar;
        __builtin_amdgcn_s_waitcnt(0);
        unsigned nloc = b.st[0], nx = b.st[1];
        if (nloc == 0u) { xcd_barrier_complete(bar, b.x, nloc, nx); b.st[0] = nloc; b.st[1] = nx; }
        const unsigned old = xb_add(&bar[XB_XSUB(b.x)], 1u);
        const unsigned gen = old / nloc;
        if (old + 1u == (gen + 1u) * nloc) {
            __builtin_amdgcn_fence(__ATOMIC_RELEASE, "agent");
            asm volatile("s_waitcnt vmcnt(0)" ::: "memory");
            const unsigned og = xb_add(&bar[XB_TOP], 1u);
            const unsigned tg = og / nx;
            if (og + 1u == (tg + 1u) * nx) xb_add(&bar[XB_TOPGEN], 1u);
            else XB_SPIN(xb_ld(&bar[XB_TOPGEN]) == tg, bar);
            __builtin_amdgcn_fence(__ATOMIC_ACQUIRE, "agent");
            xb_add(&bar[XB_XGEN(b.x)], 1u);
            asm volatile("s_waitcnt vmcnt(0)" ::: "memory");
        } else {
            XB_SPIN(xb_ld(&bar[XB_XGEN(b.x)]) == gen, bar);
            __builtin_amdgcn_fence(__ATOMIC_ACQUIRE, "agent");
            asm volatile("s_waitcnt vmcnt(0)" ::: "memory");
        }
    }
    __syncthreads();
}

struct Frame {
    LAS unsigned char* lds;
    int tid, lane, wave, G, bid;
    const float* const __attribute__((address_space(4)))* in;
    float* out;
    unsigned char* ws;
};
enum { I_X = 0, I_C, I_CTX, I_CCTX, I_ADAW, I_ADAB, I_N1G, I_N2G, I_EVWIN, I_EVWOUT, I_GKUP, I_GKB, I_GNG, I_MU, I_W0, I_W2, I_A0, I_A2, I_KK, I_KA, I_RK, I_G2, I_LNW, I_LNB,
       I_ODWIN, I_QNORM, I_WQUP, I_KVNORM, I_WKVUP, I_ODWOUT, I_RW, I_RB, I_GUW, I_GUB, I_DNW, I_DNB, I_FNG };
template <class T> __device__ __forceinline__ T* wsp(const Frame& F, size_t off) { return (T*)(F.ws + off); }
__device__ __forceinline__ int mod_row(int row) { return row < NLAT ? (row >> 13) : 8; }
__device__ __forceinline__ const float* mod_ptr(const Frame& F, int layer, int row, int which) { return wsp<const float>(F, WS_MOD) + ((size_t)(layer * 9 + mod_row(row)) * 6 + which) * 1024; }

__device__ __forceinline__ void p0_mod(Frame& F) {
    LAS float* s = (LAS float*)F.lds;
    LAS float* red = (LAS float*)(F.lds + 9 * 1024 * 4);
    const float* c = F.in[I_C]; const float* cc = F.in[I_CCTX]; const float* W = F.in[I_ADAW]; const float* Bv = F.in[I_ADAB];
    for (int idx = F.tid; idx < 9 * 1024; idx += 512) { const int r = idx >> 10, k = idx & 1023; const float v = r < 8 ? c[r * 1024 + k] : cc[k]; s[idx] = v / (1.f + __expf(-v)); }
    __syncthreads();
    for (int item = F.bid; item < 192; item += F.G) {
        const int l = item / 96, n0 = (item % 96) * 64;
        float acc[9];
#pragma unroll
        for (int r = 0; r < 9; ++r) acc[r] = 0.f;
        const float* wp = W + ((size_t)l * 1024 + F.wave * 128) * 6144 + n0 + F.lane;
        for (int k = 0; k < 128; ++k) { const float wv = wp[(size_t)k * 6144];
#pragma unroll
            for (int r = 0; r < 9; ++r) acc[r] += s[r * 1024 + F.wave * 128 + k] * wv; }
#pragma unroll
        for (int r = 0; r < 9; ++r) red[(F.wave * 9 + r) * 64 + F.lane] = acc[r];
        __syncthreads();
        for (int idx = F.tid; idx < 576; idx += 512) { const int r = idx >> 6, ln = idx & 63; float v = Bv[l * 6144 + n0 + ln];
#pragma unroll
            for (int w = 0; w < 8; ++w) v += red[(w * 9 + r) * 64 + ln];
            wsp<float>(F, WS_MOD)[(size_t)(l * 9 + r) * 6144 + n0 + ln] = v; }
        __syncthreads();
    }
}
__device__ __forceinline__ void p0_rope(Frame& F) {
    for (int idx = F.bid * 512 + F.tid; idx < SEQ * 32; idx += F.G * 512) {
        const int t = idx >> 5, i = idx & 31;
        const float fr = (float)pow(10000.0, -(double)(i & 15) / 16.0);
        const float pos = (float)(i < 16 ? (t >> 6) : (t & 63));
        const float ang = pos * fr;
        const double a = (double)ang;
        wsp<f32x2>(F, WS_ROPE)[idx] = (f32x2){(float)cos(a), (float)sin(a)};
    }
}
template <class V> __device__ __forceinline__ void cvt_item(const V& val, bf16* dst, int K, int item, int nblk, LAS float* scr, int lane) {
    const int kb = item / nblk, nb = item % nblk, k0 = 64 * kb, n0 = 32 * nb;
#pragma unroll 8
    for (int i = 0; i < 32; ++i) { const int kk = 2 * i + (lane >> 5); scr[kk * 33 + (lane & 31)] = val(n0 + (lane & 31), k0 + kk); }
    LDS_WAIT(); asm volatile("" ::: "memory");
    const int c = lane & 7;
#pragma unroll
    for (int j = 0; j < 4; ++j) { const int n = (lane >> 3) + 8 * j; const LAS float* sp = scr + (8 * c) * 33 + n;
        u32x4 o; o.x = f2bf(sp[0 * 33]) | (f2bf(sp[1 * 33]) << 16); o.y = f2bf(sp[2 * 33]) | (f2bf(sp[3 * 33]) << 16); o.z = f2bf(sp[4 * 33]) | (f2bf(sp[5 * 33]) << 16); o.w = f2bf(sp[6 * 33]) | (f2bf(sp[7 * 33]) << 16);
        *(u32x4*)(dst + (size_t)(n0 + n) * K + k0 + 8 * c) = o; }
    LDS_WAIT(); asm volatile("" ::: "memory");
}
template <class V> __device__ __forceinline__ void cvt_item_fp8(const V& val, unsigned char* dst, int K, int item, int nblk, LAS float* scr, int lane) {
    const int kb = item / nblk, nb = item % nblk, k0 = 64 * kb, n0 = 32 * nb;
#pragma unroll 8
    for (int i = 0; i < 32; ++i) { const int kk = 2 * i + (lane >> 5); scr[kk * 33 + (lane & 31)] = 32.f * val(n0 + (lane & 31), k0 + kk); }
    LDS_WAIT(); asm volatile("" ::: "memory");
    const int c = lane & 7;
#pragma unroll
    for (int j = 0; j < 4; ++j) { const int n = (lane >> 3) + 8 * j; const LAS float* sp = scr + (8 * c) * 33 + n;
        *(u32x2*)(dst + (size_t)(n0 + n) * K + k0 + 8 * c) = (u32x2){pk4_fp8(sp[0 * 33], sp[1 * 33], sp[2 * 33], sp[3 * 33]), pk4_fp8(sp[4 * 33], sp[5 * 33], sp[6 * 33], sp[7 * 33])}; }
    LDS_WAIT(); asm volatile("" ::: "memory");
}
template <class V4> __device__ __forceinline__ void cvt_item_fp8_wide(const V4& col4, const float* W, int ld, unsigned char* dst, int K, int item, int nblk, LAS float* scr, int lane) {
    const int kb = item / nblk, nb = item % nblk, k0 = 64 * kb, n0 = 64 * nb;
    const float* src = W + (size_t)(k0 + (lane >> 4)) * ld + col4(n0 + (lane & 15) * 4);
#pragma unroll
    for (int i = 0; i < 16; ++i) { const f32x4 v = *(const f32x4*)(src + (size_t)(4 * i) * ld); LAS float* sp = scr + (4 * i + (lane >> 4)) * 68 + (lane & 15) * 4; *(LAS f32x4*)sp = v; }
    LDS_WAIT(); asm volatile("" ::: "memory");
    const int nl = lane >> 2, part = lane & 3;
#pragma unroll
    for (int j = 0; j < 4; ++j) { const int n = nl + 16 * j; const LAS float* sp = scr + (part * 16) * 68 + n; unsigned o[4];
#pragma unroll
        for (int e = 0; e < 4; ++e) o[e] = pk4_fp8(32.f * sp[(4 * e) * 68], 32.f * sp[(4 * e + 1) * 68], 32.f * sp[(4 * e + 2) * 68], 32.f * sp[(4 * e + 3) * 68]);
        *(u32x4*)(dst + (size_t)(n0 + n) * K + k0 + part * 16) = (u32x4){o[0], o[1], o[2], o[3]}; }
    LDS_WAIT(); asm volatile("" ::: "memory");
}
struct C4Gu { __device__ __forceinline__ int operator()(int n) const { return ((n & 128) ? 1024 : 0) + (n >> 8) * 128 + (n & 127); } };
struct C4Id { __device__ __forceinline__ int operator()(int n) const { return n; } };
struct VPlain { const float* W; int ldn, Nr, Kr; __device__ __forceinline__ float operator()(int n, int k) const { return (n < Nr && k < Kr) ? W[(size_t)k * ldn + n] : 0.f; } };
struct VWin { const float* W; __device__ __forceinline__ float operator()(int n, int k) const { const int col = n < GLA_COLS ? n : ((n >= RW0 && n < RW0 + RW_COLS) ? n - (RW0 - GLA_COLS) : -1); return col >= 0 ? W[(size_t)k * (GLA_COLS + RW_COLS) + col] : 0.f; } };
struct VQup { const float* W; __device__ __forceinline__ float operator()(int n, int k) const { const int col = n < 1024 ? (n >> 7) * 192 + (n & 127) : ((n - 1024) >> 6) * 192 + 128 + ((n - 1024) & 63); return W[(size_t)k * 1536 + col]; } };
struct VGu { const float* W; __device__ __forceinline__ float operator()(int n, int k) const { const int col = ((n & 128) ? 1024 : 0) + (n >> 8) * 128 + (n & 127); return W[(size_t)k * 2048 + col]; } };
struct VLr { const float *w2, *a2, *g2; __device__ __forceinline__ float operator()(int n, int k) const {
        if (n < 1024) return k < 64 ? w2[((size_t)(n >> 9) * 64 + k) * 512 + (n & 511)] : 0.f;
        if (n < 2048) return (k >= 64 && k < 128) ? a2[((size_t)((n - 1024) >> 9) * 64 + (k - 64)) * 512 + (n & 511)] : 0.f;
        return (k >= 128 && k < 288) ? g2[(size_t)(k - 128) * 512 + (n - 2048)] : 0.f; } };
__device__ __forceinline__ void p0_convert(Frame& F) {
    LAS float* scrw = (LAS float*)(F.lds + F.wave * 17408);
    LAS float* scr = scrw;
    const int gw = F.bid * 8 + F.wave, NGW = F.G * 8;
    constexpr int I_WIN = (1024 / 64) * (PW / 32), I_SQ = (1024 / 64) * (1024 / 32), I_LR = (LRK / 64) * (LRN / 32), I_ODIN = (1024 / 64) * (512 / 32), I_QUP = (256 / 64) * (1536 / 32), I_KVUP = (256 / 64) * (2048 / 32);
    constexpr int I_GU1 = (1024 / 64) * (2048 / 64), I_DN1 = (1024 / 64) * (1024 / 64);
    constexpr int NSMALL = I_WIN + I_SQ + I_LR + I_ODIN + I_QUP + I_KVUP + I_SQ;
    constexpr int NITEMS = NSMALL + 32 * I_GU1 + 32 * I_DN1;
    for (int it = gw; it < NITEMS; it += NGW) {
        int r = it;
        if (r < I_WIN) { cvt_item(VWin{F.in[I_EVWIN]}, wsp<bf16>(F, WS_WIN), 1024, r, PW / 32, scr, F.lane); continue; } r -= I_WIN;
        if (r < I_SQ) { cvt_item(VPlain{F.in[I_EVWOUT], 1024, 1024, 1024}, wsp<bf16>(F, WS_WOUT), 1024, r, 32, scr, F.lane); continue; } r -= I_SQ;
        if (r < I_LR) { cvt_item(VLr{F.in[I_W2], F.in[I_A2], F.in[I_G2]}, wsp<bf16>(F, WS_WLR), LRK, r, LRN / 32, scr, F.lane); continue; } r -= I_LR;
        if (r < I_ODIN) { cvt_item_fp8(VPlain{F.in[I_ODWIN], 448, 448, 1024}, wsp<unsigned char>(F, WS_WODIN), 1024, r, 16, scr, F.lane); continue; } r -= I_ODIN;
        if (r < I_QUP) { cvt_item(VQup{F.in[I_WQUP]}, wsp<bf16>(F, WS_WQUP), 256, r, 48, scr, F.lane); continue; } r -= I_QUP;
        if (r < I_KVUP) { cvt_item(VPlain{F.in[I_WKVUP], 2048, 2048, 128}, wsp<bf16>(F, WS_WKVUP), 256, r, 64, scr, F.lane); continue; } r -= I_KVUP;
        if (r < I_SQ) { cvt_item_fp8(VPlain{F.in[I_ODWOUT], 1024, 1024, 1024}, wsp<unsigned char>(F, WS_WODOUT), 1024, r, 32, scr, F.lane); continue; } r -= I_SQ;
        if (r < 32 * I_GU1) { const int le = r / I_GU1, ri = r % I_GU1; cvt_item_fp8_wide(C4Gu{}, F.in[I_GUW] + (size_t)le * 1024 * 2048, 2048, wsp<unsigned char>(F, WS_WGU) + (size_t)le * 2048 * 1024, 1024, ri, 32, scrw, F.lane); continue; } r -= 32 * I_GU1;
        { const int le = r / I_DN1, ri = r % I_DN1; cvt_item_fp8_wide(C4Id{}, F.in[I_DNW] + (size_t)le * 1024 * 1024, 1024, wsp<unsigned char>(F, WS_WDN) + (size_t)le * 1024 * 1024, 1024, ri, 16, scrw, F.lane); }
    }
}

constexpr int FILL_N = 32 * 512 + 32 * 256, FILL_A = 6144, FILL_B = 9216, FILL_C = 19840, FILL_D = 21760, FILL_E = FILL_N;
__device__ __forceinline__ void p_fill_convert(Frame& F, int slot, int nslots, int i0, int i1) {
    LAS float* scrw = (LAS float*)(F.lds + F.wave * 17408);
    for (int i = i0 + slot * 8 + F.wave; i < i1; i += nslots * 8) {
        if (i < 32 * 512) { const int le = 32 + (i >> 9), ri = i & 511; cvt_item_fp8_wide(C4Gu{}, F.in[I_GUW] + (size_t)le * 1024 * 2048, 2048, wsp<unsigned char>(F, WS_WGU) + (size_t)le * 2048 * 1024, 1024, ri, 32, scrw, F.lane); }
        else { const int j = i - 32 * 512; const int le = 32 + (j >> 8), ri = j & 255; cvt_item_fp8_wide(C4Id{}, F.in[I_DNW] + (size_t)le * 1024 * 1024, 1024, wsp<unsigned char>(F, WS_WDN) + (size_t)le * 1024 * 1024, 1024, ri, 16, scrw, F.lane); }
    }
}

struct RowV { f32x4 v[4]; };
__device__ __forceinline__ void row_load(RowV& r, const float* p, int lane) {
#pragma unroll
    for (int j = 0; j < 4; ++j) r.v[j] = ((const f32x4*)p)[lane + 64 * j];
}
__device__ __forceinline__ float row_ss(const RowV& r) {
    float s = 0.f;
#pragma unroll
    for (int j = 0; j < 4; ++j) s += (r.v[j].x * r.v[j].x + r.v[j].y * r.v[j].y) + (r.v[j].z * r.v[j].z + r.v[j].w * r.v[j].w);
    return wave_sum(s);
}
__device__ __forceinline__ void row_modulate(RowV& r, float rstd, const float* g, const float* sh, const float* sc, int lane) {
#pragma unroll
    for (int j = 0; j < 4; ++j) { const f32x4 gv = ((const f32x4*)g)[lane + 64 * j], shv = ((const f32x4*)sh)[lane + 64 * j], scv = ((const f32x4*)sc)[lane + 64 * j];
        r.v[j] = r.v[j] * rstd * gv * (scv + 1.0f) + shv; }
}
__device__ __forceinline__ void row_store_bf16(const RowV& r, bf16* p, int lane) {
#pragma unroll
    for (int j = 0; j < 4; ++j) { u32x2 w; w.x = cvt_pk_bf16(r.v[j].x, r.v[j].y); w.y = cvt_pk_bf16(r.v[j].z, r.v[j].w); ((u32x2*)p)[lane + 64 * j] = w; }
}
__device__ __forceinline__ void row_load_bf16x(RowV& r, const bf16* p, int lane) {
#pragma unroll
    for (int j = 0; j < 4; ++j) { const u32x2 w = ((const u32x2*)p)[lane + 64 * j]; r.v[j] = (f32x4){bflo(w.x), bfhi(w.x), bflo(w.y), bfhi(w.y)}; }
}
__device__ __forceinline__ void row_store_fp8(const RowV& r, unsigned char* p, int lane) {
#pragma unroll
    for (int j = 0; j < 4; ++j) ((unsigned*)p)[lane + 64 * j] = pk4_fp8(r.v[j].x, r.v[j].y, r.v[j].z, r.v[j].w);
}
__device__ __forceinline__ void row_add_moe(RowV& r, const unsigned char* ys, int row, const float* gate, int lane) {
#pragma unroll
    for (int j = 0; j < 4; ++j) { f32x4 s = (f32x4){0.f, 0.f, 0.f, 0.f};
#pragma unroll
        for (int k = 0; k < 4; ++k) { const int w = ((const int*)(ys + (size_t)(row * 4 + k) * 1024))[lane + 64 * j];
            s.x += __builtin_amdgcn_cvt_f32_fp8(w, 0); s.y += __builtin_amdgcn_cvt_f32_fp8(w, 1); s.z += __builtin_amdgcn_cvt_f32_fp8(w, 2); s.w += __builtin_amdgcn_cvt_f32_fp8(w, 3); }
        const f32x4 gv = ((const f32x4*)gate)[lane + 64 * j]; r.v[j] = r.v[j] + gv * s * (1.f / YS_SCALE); }
}
__device__ __forceinline__ const float* src_row_l0(const Frame& F, int row) { return row < NLAT ? F.in[I_X] + (size_t)row * 1024 : F.in[I_CTX] + (size_t)(row - NLAT) * 1024; }

__device__ __forceinline__ void p_norm1_l0(Frame& F) {
    const int gw = F.bid * 8 + F.wave, NGW = F.G * 8;
    for (int row = gw; row < NTOK; row += NGW) {
        RowV r; row_load(r, src_row_l0(F, row), F.lane);
        const float rstd = 1.f / sqrtf(row_ss(r) * (1.f / 1024.f) + 1e-6f);
        row_modulate(r, rstd, F.in[I_N1G], mod_ptr(F, 0, row, 0), mod_ptr(F, 0, row, 1), F.lane);
        row_store_bf16(r, wsp<bf16>(F, WS_H) + (size_t)row * 1024, F.lane);
    }
}
__device__ __forceinline__ void p_combine_norm1_l1(Frame& F) {
    const int gw = F.bid * 8 + F.wave, NGW = F.G * 8;
    for (int row = gw; row < NTOK; row += NGW) {
        bf16* xp = wsp<bf16>(F, WS_X1) + (size_t)row * 1024;
        RowV r; row_load_bf16x(r, xp, F.lane);
        row_add_moe(r, wsp<const unsigned char>(F, WS_YS), row, mod_ptr(F, 0, row, 5), F.lane);
        row_store_bf16(r, xp, F.lane);
        const float rstd = 1.f / sqrtf(row_ss(r) * (1.f / 1024.f) + 1e-6f);
        row_modulate(r, rstd, F.in[I_N1G] + 1024, mod_ptr(F, 1, row, 0), mod_ptr(F, 1, row, 1), F.lane);
        row_store_fp8(r, wsp<unsigned char>(F, WS_H) + (size_t)row * 1024, F.lane);
    }
}
__device__ __forceinline__ void p_final(Frame& F) {
    const int gw = F.bid * 8 + F.wave, NGW = F.G * 8;
    for (int row = gw; row < NLAT; row += NGW) {
        RowV r; row_load_bf16x(r, wsp<const bf16>(F, WS_X1) + (size_t)row * 1024, F.lane);
        row_add_moe(r, wsp<const unsigned char>(F, WS_YS), row, mod_ptr(F, 1, row, 5), F.lane);
        const float rstd = 1.f / sqrtf(row_ss(r) * (1.f / 1024.f) + 1e-6f);
#pragma unroll
        for (int j = 0; j < 4; ++j) { const f32x4 gv = ((const f32x4*)F.in[I_FNG])[F.lane + 64 * j]; ((f32x4*)(F.out + (size_t)row * 1024))[F.lane + 64 * j] = r.v[j] * rstd * gv; }
    }
}

constexpr int RT_WS = 2064;
constexpr int RT_WHI = 0, RT_WLO = 32 * RT_WS;
constexpr int RT_TAB = 2 * 32 * RT_WS;
constexpr int RT_TABSZ = 8320;
constexpr int RT_LDS_CNT = RT_TAB + 2 * RT_TABSZ;
__device__ __forceinline__ void vb_tiles(int vb, int ntok, int& t0, int& nt) { const int ntile = ntok >> 5, q = ntile >> 8, r = ntile & 255; if (vb < r) { t0 = vb * (q + 1); nt = q + 1; } else { t0 = r * (q + 1) + (vb - r) * q; nt = q; } }
__device__ __forceinline__ void p_norm2_route(Frame& F, const int layer, const int ntok) {
    LAS unsigned char* L = F.lds;
    LAS int* cnt = (LAS int*)(L + RT_LDS_CNT);
    const int tid = F.tid, lane = F.lane, wave = F.wave, t = lane & 31, hi = lane >> 5;
    const float* rw = F.in[I_RW] + (size_t)layer * 1024 * 32;
    for (int idx = tid; idx < 1024 * 32; idx += 512) { const int k = idx >> 5, e = idx & 31; const float w = rw[idx]; const unsigned h = f2bf(w); const unsigned l = f2bf(w - bf2f(h));
        *(LAS unsigned short*)(L + RT_WHI + e * RT_WS + k * 2) = (unsigned short)h; *(LAS unsigned short*)(L + RT_WLO + e * RT_WS + k * 2) = (unsigned short)l; }
    unsigned char* rt = F.ws + WS_ROUTE;
    const float* g2 = F.in[I_N2G] + layer * 1024;
    const bf16* X = wsp<const bf16>(F, WS_X1); unsigned char* H8 = wsp<unsigned char>(F, WS_H);
    for (int vb = F.bid; vb < 256; vb += F.G) {
        int t0, nt; vb_tiles(vb, ntok, t0, nt);
        const int mr0 = mod_row(t0 * 32), mr1 = mod_row((t0 + nt) * 32 - 1);
        __syncthreads();
        if (tid < 32) cnt[tid] = 0;
        for (int sl = 0; sl < 2; ++sl) { const int mr = sl ? mr1 : mr0; LAS float* tb = (LAS float*)(L + RT_TAB + sl * RT_TABSZ);
            const float* shp = wsp<const float>(F, WS_MOD) + ((size_t)(layer * 9 + mr) * 6 + 3) * 1024; const float* scp = shp + 1024;
            for (int k = tid; k < 1024; k += 512) { tb[k] = g2[k] * (1.f + scp[k]); tb[1024 + k] = shp[k]; } }
        __syncthreads();
        for (int sl = 0; sl < 2; ++sl) { LAS float* tb = (LAS float*)(L + RT_TAB + sl * RT_TABSZ); LAS float* red = (LAS float*)(L + RT_LDS_CNT + 256);
            const int e = tid & 31, kp = tid >> 5; float sacc = 0.f;
            for (int k = kp * 64; k < kp * 64 + 64; ++k) sacc += tb[1024 + k] * rw[k * 32 + e];
            red[kp * 32 + e] = sacc; __syncthreads();
            if (tid < 32) { float c = F.in[I_RB][layer * 32 + tid]; for (int i = 0; i < 16; ++i) c += red[i * 32 + tid]; tb[2048 + tid] = c; }
            __syncthreads(); }
        for (int ti = wave; ti < nt; ti += 8) {
            const int tile = t0 + ti, row = tile * 32 + t; const int sl = (mod_row(tile * 32) == mr0) ? 0 : 1;
            const LAS float* tb = (const LAS float*)(L + RT_TAB + sl * RT_TABSZ);
            const bf16* xp = X + (size_t)row * 1024 + hi * 8;
            f32x16 acc;
#pragma unroll
            for (int r = 0; r < 16; ++r) acc[r] = 0.f;
            float ss = 0.f;
#pragma unroll 4
            for (int s = 0; s < 64; ++s) {
                const u32x4 xw = *(const u32x4*)(xp + s * 16); const f32x4 x0 = {bflo(xw.x), bfhi(xw.x), bflo(xw.y), bfhi(xw.y)}, x1 = {bflo(xw.z), bfhi(xw.z), bflo(xw.w), bfhi(xw.w)};
                const f32x4 g0 = *(const LAS f32x4*)(tb + s * 16 + hi * 8), g1 = *(const LAS f32x4*)(tb + s * 16 + hi * 8 + 4);
                ss += (x0.x * x0.x + x0.y * x0.y) + (x0.z * x0.z + x0.w * x0.w) + (x1.x * x1.x + x1.y * x1.y) + (x1.z * x1.z + x1.w * x1.w);
                const f32x4 y0 = x0 * g0, y1 = x1 * g1;
                u32x4 hh; hh.x = cvt_pk_bf16(y0.x, y0.y); hh.y = cvt_pk_bf16(y0.z, y0.w); hh.z = cvt_pk_bf16(y1.x, y1.y); hh.w = cvt_pk_bf16(y1.z, y1.w);
                u32x4 ll; ll.x = cvt_pk_bf16(y0.x - bflo(hh.x), y0.y - bfhi(hh.x)); ll.y = cvt_pk_bf16(y0.z - bflo(hh.y), y0.w - bfhi(hh.y)); ll.z = cvt_pk_bf16(y1.x - bflo(hh.z), y1.y - bfhi(hh.z)); ll.w = cvt_pk_bf16(y1.z - bflo(hh.w), y1.w - bfhi(hh.w));
                const bf16x8 xh = __builtin_bit_cast(bf16x8, hh), xl = __builtin_bit_cast(bf16x8, ll);
                const bf16x8 wh = *(const LAS bf16x8*)(L + RT_WHI + t * RT_WS + (s * 16 + hi * 8) * 2), wl = *(const LAS bf16x8*)(L + RT_WLO + t * RT_WS + (s * 16 + hi * 8) * 2);
                acc = __builtin_amdgcn_mfma_f32_32x32x16_bf16(wh, xh, acc, 0, 0, 0);
                acc = __builtin_amdgcn_mfma_f32_32x32x16_bf16(wh, xl, acc, 0, 0, 0);
                acc = __builtin_amdgcn_mfma_f32_32x32x16_bf16(wl, xh, acc, 0, 0, 0);
            }
            { auto rr = __builtin_amdgcn_permlane32_swap(__float_as_uint(ss), __float_as_uint(ss), false, false); ss = __uint_as_float(rr[0]) + __uint_as_float(rr[1]); }
            const float rstd = 1.f / sqrtf(ss * (1.f / 1024.f) + 1e-6f);
            float lg[32];
#pragma unroll
            for (int r = 0; r < 16; ++r) { auto rr = __builtin_amdgcn_permlane32_swap(__float_as_uint(acc[r]), __float_as_uint(acc[r]), false, false);
                const int e0 = (r & 3) + 8 * (r >> 2); lg[e0] = __uint_as_float(rr[0]) * rstd + tb[2048 + e0]; lg[e0 + 4] = __uint_as_float(rr[1]) * rstd + tb[2048 + e0 + 4]; }
            int se[4]; float sv[4];
#pragma unroll
            for (int k = 0; k < 4; ++k) { float best = lg[0]; int bi = 0;
#pragma unroll
                for (int e = 1; e < 32; ++e) { const bool gt = lg[e] > best; best = gt ? lg[e] : best; bi = gt ? e : bi; }
                se[k] = bi; sv[k] = best;
#pragma unroll
                for (int e = 0; e < 32; ++e) lg[e] = (e == bi) ? -3.0e38f : lg[e]; }
            const float e1 = __expf(sv[1] - sv[0]), e2 = __expf(sv[2] - sv[0]), e3 = __expf(sv[3] - sv[0]); const float inv = 1.f / (1.f + e1 + e2 + e3);
            if (hi == 0) {
                const float gk[4] = {inv, e1 * inv, e2 * inv, e3 * inv};
#pragma unroll
                for (int k = 0; k < 4; ++k) { const int pos = __hip_atomic_fetch_add(cnt + se[k], 1, __ATOMIC_RELAXED, __HIP_MEMORY_SCOPE_WORKGROUP);
                    rt[RT_E + (size_t)row * 4 + k] = (unsigned char)se[k]; ((unsigned short*)(rt + RT_POS))[(size_t)row * 4 + k] = (unsigned short)pos; ((float*)(rt + RT_GATE))[(size_t)row * 4 + k] = gk[k]; }
            }
            unsigned char* hp = H8 + (size_t)row * 1024 + hi * 8;
#pragma unroll 4
            for (int s = 0; s < 64; ++s) {
                const u32x4 xw = *(const u32x4*)(xp + s * 16); const f32x4 x0 = {bflo(xw.x), bfhi(xw.x), bflo(xw.y), bfhi(xw.y)}, x1 = {bflo(xw.z), bfhi(xw.z), bflo(xw.w), bfhi(xw.w)};
                const f32x4 g0 = *(const LAS f32x4*)(tb + s * 16 + hi * 8), g1 = *(const LAS f32x4*)(tb + s * 16 + hi * 8 + 4);
                const f32x4 h0 = *(const LAS f32x4*)(tb + 1024 + s * 16 + hi * 8), h1 = *(const LAS f32x4*)(tb + 1024 + s * 16 + hi * 8 + 4);
                const f32x4 y0 = x0 * rstd * g0 + h0, y1 = x1 * rstd * g1 + h1;
                *(u32x2*)(hp + s * 16) = (u32x2){pk4_fp8(y0.x, y0.y, y0.z, y0.w), pk4_fp8(y1.x, y1.y, y1.z, y1.w)};
            }
        }
        __syncthreads();
        if (tid < 32) ((unsigned*)(rt + RT_HIST))[vb * 32 + tid] = (unsigned)cnt[tid];
    }
    __syncthreads();
}
constexpr int MT_OFF = 131072 + 1024;
__device__ __forceinline__ void moe_tables(Frame& F) {
    LAS int* tab = (LAS int*)(F.lds + MT_OFF);
    LAS int* part = (LAS int*)(F.lds + MT_OFF + 8192 + 256);
    const unsigned* hist = (const unsigned*)(F.ws + WS_ROUTE + RT_HIST);
    { const int e = F.tid & 31, p = F.tid >> 5; int c = 0;
#pragma unroll
      for (int i = 0; i < 16; ++i) c += (int)hist[(p * 16 + i) * 32 + e];
      part[p * 32 + e] = c; }
    __syncthreads();
    if (F.tid < 32) { int c = 0;
#pragma unroll
        for (int p = 0; p < 16; ++p) c += part[p * 32 + F.tid];
        tab[32 + F.tid] = c; }
    __syncthreads();
    if (F.tid == 0) { int s = 0; for (int e = 0; e < 32; ++e) { tab[e] = s; s += ((tab[32 + e] + 255) >> 8) << 8; } tab[64] = s >> 8; }
    __syncthreads();
    if (F.tid < 32) { const int s0 = tab[F.tid] >> 8, nb = (tab[32 + F.tid] + 255) >> 8; for (int i = 0; i < nb; ++i) tab[128 + s0 + i] = F.tid; }
    __syncthreads();
}
__device__ __forceinline__ void p_moe_scatter(Frame& F, const int ntok) {
    moe_tables(F);
    LAS int* tab = (LAS int*)(F.lds + MT_OFF);
    LAS int* base = (LAS int*)(F.lds + MT_OFF + 8192);
    const unsigned* hist = (const unsigned*)(F.ws + WS_ROUTE + RT_HIST);
    const unsigned char* rt = F.ws + WS_ROUTE;
    unsigned* stok = wsp<unsigned>(F, WS_SORT); unsigned* sdst = stok + MAXSLOT; float* sgate = (float*)(sdst + MAXSLOT);
    for (int vb = F.bid; vb < 256; vb += F.G) {
        int t0, nt; vb_tiles(vb, ntok, t0, nt);
        if (F.tid < 32) { const LAS int* part = (const LAS int*)(F.lds + MT_OFF + 8192 + 256); int c = 0; for (int p = 0; p < (vb >> 4); ++p) c += part[p * 32 + F.tid];
            for (int b = vb & ~15; b < vb; ++b) c += (int)hist[b * 32 + F.tid]; base[F.tid] = tab[F.tid] + c; }
        __syncthreads();
        for (int i = F.tid; i < nt * 128; i += 512) {
            const int row = t0 * 32 + (i >> 2), k = i & 3; const size_t a = (size_t)row * 4 + k;
            const int e = rt[RT_E + a], pos = ((const unsigned short*)(rt + RT_POS))[a];
            const int slot = base[e] + pos;
            stok[slot] = (unsigned)row; sdst[slot] = (unsigned)(row * 4 + k); sgate[slot] = ((const float*)(rt + RT_GATE))[a];
        }
        if (vb < 32) { const int e = vb, c = tab[32 + e], s0 = tab[e] + c, s1 = tab[e] + (((c + 255) >> 8) << 8);
            for (int s = s0 + F.tid; s < s1; s += 512) { stok[s] = 0u; sdst[s] = (unsigned)YS_DUMMY; sgate[s] = 0.f; } }
        __syncthreads();
    }
}

namespace pg8 {
struct DenseSched {
    int nM, nN, nwg, G, c, KB; const bf16* Bt;
    __device__ __forceinline__ void init(int M, int N, int KB_, const void* Bt_, int G_, int c_) { nM = M / BM; nN = N / BM; nwg = nM * nN; G = G_; c = c_; KB = KB_; Bt = (const bf16*)Bt_; }
    __device__ __forceinline__ bool next(int i, Unit& u) const {
        const long L = (long)i * G + c; if (L >= nwg) return false;
        int wgid = (int)L; { const int q = nwg / 8, r = nwg % 8, xcd = wgid % 8, off = wgid / 8; wgid = (xcd < r ? xcd * (q + 1) : r * (q + 1) + (xcd - r) * q) + off; }
        const int nig = 8 * nN, gid = wgid / nig, fm = gid * 8, gsz = (nM - fm) < 8 ? (nM - fm) : 8;
        u.pm = fm + ((wgid % nig) % gsz); u.pn = (wgid % nig) / gsz; return true;
    }
    __device__ __forceinline__ void a_offs(const Unit& u, unsigned (&ao)[2][2], const int (&R)[2], const int (&C)[2]) const {
#pragma unroll
        for (int h = 0; h < 2; ++h)
#pragma unroll
            for (int i = 0; i < 2; ++i) ao[h][i] = (unsigned)((u.pm * BM + h * HALF + R[i]) * KB + C[i] * 2);
    }
    __device__ __forceinline__ const char* b_tile(const Unit& u) const { return (const char*)Bt + (size_t)u.pn * BM * KB; }
    __device__ __forceinline__ int ktiles(const Unit&, int ntdef) const { return ntdef; }
};
struct LrSched : DenseSched {
    __device__ __forceinline__ unsigned koff(const Unit& u) const { return u.pn < 8 ? 0u : 256u; }
    __device__ __forceinline__ void a_offs(const Unit& u, unsigned (&ao)[2][2], const int (&R)[2], const int (&C)[2]) const { DenseSched::a_offs(u, ao, R, C);
#pragma unroll
        for (int h = 0; h < 2; ++h)
#pragma unroll
            for (int i = 0; i < 2; ++i) ao[h][i] += koff(u); }
    __device__ __forceinline__ const char* b_tile(const Unit& u) const { return DenseSched::b_tile(u) + koff(u); }
    __device__ __forceinline__ int ktiles(const Unit& u, int) const { return u.pn < 8 ? 2 : 4; }
};
template <bool GATHER> struct MoeSched {
    int nrb, npn, G, c; const LAS int* blk_e; const unsigned* tok; const unsigned char* Wt; size_t wstride;
    __device__ __forceinline__ bool next(int i, Unit& u) const {
        if ((G & 7) != 0 || ((G >> 3) % npn) != 0) { const long L = (long)i * G + c; if (L >= (long)nrb * npn) return false; u.pm = (int)(L / npn); u.pn = (int)(L % npn); return true; }
        const int x = c & 7, y = c >> 3, per = (G >> 3) / npn;
        u.pm = (i * 8 + x) * per + y / npn; u.pn = y % npn; return u.pm < nrb;
    }
    __device__ __forceinline__ void a_offs(const Unit& u, unsigned (&ao)[2][2], const int (&R)[2], const int (&C)[2]) const {
#pragma unroll
        for (int h = 0; h < 2; ++h)
#pragma unroll
            for (int i = 0; i < 2; ++i) { const int slot = u.pm * BM + h * HALF + R[i]; const unsigned row = GATHER ? tok[slot] : (unsigned)slot; ao[h][i] = row * 1024u + (unsigned)C[i] * 2u; }
    }
    __device__ __forceinline__ const char* b_tile(const Unit& u) const { return (const char*)(Wt + (size_t)blk_e[u.pm] * wstride + (size_t)u.pn * BM * 1024); }
    __device__ __forceinline__ int ktiles(const Unit&, int ntdef) const { return ntdef; }
};

struct MapPlain { bf16* O; int ld; __device__ __forceinline__ bf16* operator()(int row, int col) const { return O + (size_t)row * ld + col; } };
constexpr float ATT_QPRE = 0.8329403702157812f;
struct EpiQ8 {
    static constexpr bool PERM = true; unsigned char* Q8; const f32x2* ROPE;
    __device__ __forceinline__ void operator()(const f32x4 (&acc)[2][2][4][2], const Unit& u, int wr, int wc, int fr, int fq) const {
#pragma unroll
        for (int ai = 0; ai < 2; ++ai)
#pragma unroll
            for (int m = 0; m < 4; ++m) { const int row = u.pm * BM + ai * HALF + wr * 64 + m * 16 + fr; const int b = row >> 13, t = row & 8191;
#pragma unroll
                for (int bj = 0; bj < 2; ++bj) { const int col = u.pn * BM + bj * HALF + wc * 32 + 8 * fq; float v[8];
#pragma unroll
                    for (int e = 0; e < 4; ++e) { v[e] = acc[ai][bj][m][0][e]; v[4 + e] = acc[ai][bj][m][1][e]; }
                    int h, d;
                    if (u.pn < 4) { h = col >> 7; d = col & 127; }
                    else { h = (col - 1024) >> 6; const int dr = (col - 1024) & 63; d = 128 + dr;
                        const f32x2* cs = ROPE + t * 32 + ((dr >> 5) << 4) + (dr & 8);
#pragma unroll
                        for (int e = 0; e < 8; ++e) { auto rr = __builtin_amdgcn_permlane32_swap(__float_as_uint(v[e]), __float_as_uint(v[e]), false, false);
                            const float pr = __uint_as_float(fq < 2 ? rr[1] : rr[0]); const f32x2 c = cs[e]; v[e] = (fq >= 2) ? v[e] * c.x + pr * c.y : v[e] * c.x - pr * c.y; } }
                    *(u32x2*)(Q8 + ((size_t)((b * 8 + h) * SEQ + t)) * QKD + d) = (u32x2){pk4_fp8(v[0] * ATT_QPRE, v[1] * ATT_QPRE, v[2] * ATT_QPRE, v[3] * ATT_QPRE), pk4_fp8(v[4] * ATT_QPRE, v[5] * ATT_QPRE, v[6] * ATT_QPRE, v[7] * ATT_QPRE)}; } }
    }
};
struct EpiKV8 {
    static constexpr bool PERM = true; unsigned char* K8; unsigned char* VT;
    __device__ __forceinline__ void operator()(const f32x4 (&acc)[2][2][4][2], const Unit& u, int wr, int wc, int fr, int fq) const {
#pragma unroll
        for (int ai = 0; ai < 2; ++ai)
#pragma unroll
            for (int m = 0; m < 4; ++m) { const int row = u.pm * BM + ai * HALF + wr * 64 + m * 16 + fr;
                const int b = row < NLAT ? (row >> 13) : ((row - NLAT) >> 8), key = row < NLAT ? CTXL + (row & 8191) : ((row - NLAT) & 255), h = u.pn;
                { const f32x4 v0 = acc[ai][0][m][0], v1 = acc[ai][0][m][1];
                  *(u32x2*)(K8 + ((size_t)((b * 8 + h) * NKEY + key)) * K8ROW + wc * 32 + 8 * fq) = (u32x2){pk4_fp8(v0[0], v0[1], v0[2], v0[3]), pk4_fp8(v1[0], v1[1], v1[2], v1[3])}; }
                { const int k6 = key & 63, kk = k6 & 31, p = 32 * ((kk >> 2) & 1) + (k6 >> 5) * 16 + (kk & 3) + 4 * (kk >> 3);
                  unsigned char* tb = VT + ((size_t)(b * 8 + h) * (NKEY / 64) + (key >> 6)) * 8192 + (p & 15); const int c0 = wc * 32 + 8 * fq, ch = p >> 4;
                  const unsigned w0 = pk4_fp8(acc[ai][1][m][0][0], acc[ai][1][m][0][1], acc[ai][1][m][0][2], acc[ai][1][m][0][3]), w1 = pk4_fp8(acc[ai][1][m][1][0], acc[ai][1][m][1][1], acc[ai][1][m][1][2], acc[ai][1][m][1][3]);
#pragma unroll
                  for (int e = 0; e < 8; ++e) { const int c = c0 + e; tb[c * 64 + ((ch ^ ((c >> 2) & 3)) << 4)] = (unsigned char)(((e < 4 ? w0 : w1) >> (8 * (e & 3))) & 0xffu); } } }
    }
};
template <class Map> struct EpiBf16 {
    static constexpr bool PERM = true; Map map;
    __device__ __forceinline__ void operator()(const f32x4 (&acc)[2][2][4][2], const Unit& u, int wr, int wc, int fr, int fq) const {
#pragma unroll
        for (int ai = 0; ai < 2; ++ai)
#pragma unroll
            for (int m = 0; m < 4; ++m) { const int row = u.pm * BM + ai * HALF + wr * 64 + m * 16 + fr;
#pragma unroll
                for (int bj = 0; bj < 2; ++bj) { const int col = u.pn * BM + bj * HALF + wc * 32 + 8 * fq; const f32x4 v0 = acc[ai][bj][m][0], v1 = acc[ai][bj][m][1];
                    u32x4 w; w.x = cvt_pk_bf16(v0[0], v0[1]); w.y = cvt_pk_bf16(v0[2], v0[3]); w.z = cvt_pk_bf16(v1[0], v1[1]); w.w = cvt_pk_bf16(v1[2], v1[3]);
                    *(u32x4*)map(row, col) = w; } }
    }
};
struct EpiF32 {
    static constexpr bool PERM = false; float* C; int ldc;
    __device__ __forceinline__ void operator()(const f32x4 (&acc)[2][2][4][2], const Unit& u, int wr, int wc, int fr, int fq) const {
#pragma unroll
        for (int ai = 0; ai < 2; ++ai)
#pragma unroll
            for (int m = 0; m < 4; ++m) { float* rowp = C + (size_t)(u.pm * BM + ai * HALF + wr * 64 + m * 16 + fr) * ldc + u.pn * BM + wc * 32 + 4 * fq;
#pragma unroll
                for (int bj = 0; bj < 2; ++bj)
#pragma unroll
                    for (int n = 0; n < 2; ++n) *(f32x4*)(rowp + bj * HALF + n * 16) = acc[ai][bj][m][n]; }
    }
};
struct EpiResid {
    static constexpr bool PERM = false; bf16* X1; const float* xlat; const float* xctx; const float* mod; int layer;
    __device__ __forceinline__ void operator()(const f32x4 (&acc)[2][2][4][2], const Unit& u, int wr, int wc, int fr, int fq) const {
#pragma unroll
        for (int ai = 0; ai < 2; ++ai)
#pragma unroll
            for (int m = 0; m < 4; ++m) { const int row = u.pm * BM + ai * HALF + wr * 64 + m * 16 + fr; const int col0 = u.pn * BM + wc * 32 + 4 * fq;
                const float* bp = row < NLAT ? xlat + (size_t)row * 1024 : xctx + (size_t)(row - NLAT) * 1024;
                const float* gp = mod + ((size_t)(layer * 9 + (row < NLAT ? (row >> 13) : 8)) * 6 + 2) * 1024;
                bf16* op = X1 + (size_t)row * 1024;
#pragma unroll
                for (int bj = 0; bj < 2; ++bj)
#pragma unroll
                    for (int n = 0; n < 2; ++n) { const int c = col0 + bj * HALF + n * 16; f32x4 base;
                        if (layer == 0) base = *(const f32x4*)(bp + c); else { const u32x2 bw = *(const u32x2*)(op + c); base = (f32x4){bflo(bw.x), bfhi(bw.x), bflo(bw.y), bfhi(bw.y)}; }
                        const f32x4 v = base + *(const f32x4*)(gp + c) * acc[ai][bj][m][n];
                        *(u32x2*)(op + c) = (u32x2){cvt_pk_bf16(v.x, v.y), cvt_pk_bf16(v.z, v.w)}; } }
    }
};
struct EpiSwiglu {
    static constexpr bool PERM = true; unsigned char* ACT; const float* bgu; const LAS int* blk_e;
    __device__ __forceinline__ void operator()(const f32x4 (&acc)[2][2][4][2], const Unit& u, int wr, int wc, int fr, int fq) const {
        const int e = blk_e[u.pm]; const int c0 = u.pn * 128 + wc * 32 + 8 * fq;
        const float* bg = bgu + (size_t)e * 2048 + c0;
        f32x4 bgl[2], bln[2];
#pragma unroll
        for (int n = 0; n < 2; ++n) { bgl[n] = *(const f32x4*)(bg + 4 * n); bln[n] = *(const f32x4*)(bg + 1024 + 4 * n); }
#pragma unroll
        for (int ai = 0; ai < 2; ++ai)
#pragma unroll
            for (int m = 0; m < 4; ++m) { const int slot = u.pm * BM + ai * HALF + wr * 64 + m * 16 + fr; float o[8];
#pragma unroll
                for (int n = 0; n < 2; ++n)
#pragma unroll
                    for (int j = 0; j < 4; ++j) { const float xg = fminf(acc[ai][0][m][n][j] + bgl[n][j], 7.0f); const float xl = fminf(fmaxf(acc[ai][1][m][n][j] + bln[n][j], -7.0f), 7.0f);
                        o[n * 4 + j] = xg * __builtin_amdgcn_rcpf(1.f + __expf(-1.702f * xg)) * (xl + 1.0f); }
                *(u32x2*)(ACT + (size_t)slot * 1024 + c0) = (u32x2){pk4_fp8(o[0], o[1], o[2], o[3]), pk4_fp8(o[4], o[5], o[6], o[7])}; }
    }
};
struct EpiDown {
    static constexpr bool PERM = true; unsigned char* YS; const float* bdn; const LAS int* blk_e; const unsigned* dst; const float* gate;
    __device__ __forceinline__ void operator()(const f32x4 (&acc)[2][2][4][2], const Unit& u, int wr, int wc, int fr, int fq) const {
        const int e = blk_e[u.pm]; const int c0 = u.pn * BM + wc * 32 + 8 * fq;
        f32x4 bv[2][2];
#pragma unroll
        for (int bj = 0; bj < 2; ++bj)
#pragma unroll
            for (int n = 0; n < 2; ++n) bv[bj][n] = *(const f32x4*)(bdn + (size_t)e * 1024 + c0 + bj * HALF + 4 * n);
#pragma unroll
        for (int ai = 0; ai < 2; ++ai)
#pragma unroll
            for (int m = 0; m < 4; ++m) { const int slot = u.pm * BM + ai * HALF + wr * 64 + m * 16 + fr; const float g = gate[slot] * YS_SCALE; unsigned char* op = YS + (size_t)dst[slot] * 1024 + c0;
#pragma unroll
                for (int bj = 0; bj < 2; ++bj) { const f32x4 v0 = (acc[ai][bj][m][0] + bv[bj][0]) * g, v1 = (acc[ai][bj][m][1] + bv[bj][1]) * g;
                    *(u32x2*)(op + bj * HALF) = (u32x2){pk4_fp8(v0[0], v0[1], v0[2], v0[3]), pk4_fp8(v1[0], v1[1], v1[2], v1[3])}; } }
    }
};
}

__device__ __forceinline__ float ldbf(const bf16* p) { return bf2f((unsigned)*p); }
__device__ __forceinline__ void seq_pos(int row, bool& hp, bool& hn) { if (row < NLAT) { const int t = row & 8191; hp = t > 0; hn = t < SEQ - 1; } else { const int t = (row - NLAT) & 255; hp = t > 0; hn = t < CTXL - 1; } }

__device__ __forceinline__ void p_alr(Frame& F) {
    const int gw = F.bid * 8 + F.wave, NGW = F.G * 8;
    const bf16* P = wsp<const bf16>(F, WS_P); bf16* A = wsp<bf16>(F, WS_ALR); const float* mu = F.in[I_MU];
    for (int row = gw; row < NTOK; row += NGW) {
        bool hp, hn; seq_pos(row, hp, hn);
        const bf16* pr = P + (size_t)row * PW + RW0 + 1536;
#pragma unroll
        for (int q = 0; q < 6; ++q) { const int c = F.lane + 64 * q; float o = 0.f;
            if (c < 288) { const float p0 = ldbf(pr + c), pm = hp ? ldbf(pr + c - PW) : 0.f, pn = hn ? ldbf(pr + c + PW) : 0.f;
                const float xs = p0 + mu[1536 + c] * (pm - p0) + mu[RW_COLS + 1536 + c] * (pn - p0);
                o = c < 64 ? (1.f - 2.f * __builtin_amdgcn_rcpf(1.f + __expf(2.f * xs))) : (c < 128 ? xs : __builtin_amdgcn_rcpf(1.f + __expf(-xs))); }
            A[(size_t)row * LRK + c] = (bf16)f2bf(o); }
    }
}

constexpr int GL_QRAW = 0, GL_KRAW = 8192, GL_GDS = 16384, GL_QD = 20480, GL_KI = 29696, GL_KE = 38912, GL_AT = 48128, GL_VT = 57344, GL_ST = 61952, GL_GSUM = 71168, GL_DEC = 73216;
constexpr int GL_RS = 144;
__device__ __forceinline__ bf16x8 lds_frag(const LAS unsigned char* base, int row, int kbyte) { return *(const LAS bf16x8*)(base + row * GL_RS + kbyte); }
constexpr int GW_UNIT = 24832;
constexpr int GW_QD = 0, GW_KE = 8192, GW_AT = 16384, GW_DEC = 24576;
#define GLA_ROWF(b, dir, n, i) ((n) < 4 ? NLAT + (b) * 256 + ((dir) ? 3 - (n) : (n)) * 64 + ((dir) ? 63 - (i) : (i)) : (b) * 8192 + ((dir) ? 127 - ((n) - 4) : ((n) - 4)) * 64 + ((dir) ? 63 - (i) : (i)))
__device__ __forceinline__ void p_gla_pre(Frame& F) {
    LAS unsigned char* L = F.lds;
    const bf16* P = wsp<const bf16>(F, WS_P); unsigned char* GW = F.ws + WS_X1;
    const int tid = F.tid, lane = F.lane, wave = F.wave, r32 = lane & 31, hi = lane >> 5;
    const int dk = lane, tg = wave;
    constexpr int NU = NB * 4 * 2 * 132;
    bf16x8 qv, kv, gv;
#define GP_LOAD(u) do { const int n_ = (u) % 132, d_ = ((u) / 132) & 1, h_ = ((u) / 264) & 3, b_ = (u) / 1056; const bf16* rp = P + (size_t)GLA_ROWF(b_, d_, n_, tid >> 3) * PW; \
        qv = *(const bf16x8*)(rp + h_ * 64 + (tid & 7) * 8); kv = *(const bf16x8*)(rp + 256 + h_ * 64 + (tid & 7) * 8); \
        if (tid < 128) gv = *(const bf16x8*)(P + (size_t)GLA_ROWF(b_, d_, n_, tid >> 1) * PW + 1536 + (tid & 1) * 8); } while (0)
    if (F.bid < NU) GP_LOAD(F.bid);
    for (int u = F.bid; u < NU; u += F.G) {
        const int dir = (u / 132) & 1, h = (u / 264) & 3;
        float gkw[16];
#pragma unroll
        for (int r = 0; r < 16; ++r) gkw[r] = F.in[I_GKUP][(size_t)(dir * 16 + r) * 256 + h * 64 + dk];
        const float gkb = F.in[I_GKB][dir * 256 + h * 64 + dk];
        unsigned char* gw = GW + (size_t)u * GW_UNIT;
        *(LAS bf16x8*)(L + GL_QRAW + (tid >> 3) * 128 + (tid & 7) * 16) = qv;
        *(LAS bf16x8*)(L + GL_KRAW + (tid >> 3) * 128 + (tid & 7) * 16) = kv;
        if (tid < 128) { LAS float* gp = (LAS float*)(L + GL_GDS) + (tid >> 1) * 16 + (tid & 1) * 8;
#pragma unroll
            for (int e = 0; e < 8; ++e) gp[e] = bf2f((unsigned)(unsigned short)gv[e]); }
        __syncthreads();
        if (u + F.G < NU) GP_LOAD(u + F.G);
        float Gl[8]; float cum = 0.f;
#pragma unroll
        for (int ii = 0; ii < 8; ++ii) { const LAS float* gp = (const LAS float*)(L + GL_GDS) + (tg * 8 + ii) * 16; float x = gkb;
#pragma unroll
            for (int r = 0; r < 16; ++r) x += gp[r] * gkw[r];
            const float ls = fminf(x, 0.f) - __logf(1.f + __expf(-fabsf(x)));
            cum += ls * (1.f / 16.f); Gl[ii] = cum; }
        ((LAS float*)(L + GL_GSUM))[tg * 64 + dk] = cum;
        __syncthreads();
        float off = 0.f, tot = 0.f;
#pragma unroll
        for (int t2 = 0; t2 < 8; ++t2) { const float gs = ((const LAS float*)(L + GL_GSUM))[t2 * 64 + dk]; tot += gs; off += (t2 < tg) ? gs : 0.f; }
        unsigned kep[4]; const float etot = __expf(tot);
#pragma unroll
        for (int ii = 0; ii < 8; ii += 2) { float kev[2];
#pragma unroll
            for (int z = 0; z < 2; ++z) { const int i = tg * 8 + ii + z; const float G = off + Gl[ii + z];
                const float q = bf2f((unsigned)*(const LAS unsigned short*)(L + GL_QRAW + i * 128 + dk * 2)), k = bf2f((unsigned)*(const LAS unsigned short*)(L + GL_KRAW + i * 128 + dk * 2));
                const float eg = __expf(G), ieg = __builtin_amdgcn_rcpf(eg);
                const unsigned short qd = (unsigned short)f2bf(q * 0.125f * eg);
                *(LAS unsigned short*)(L + GL_QD + i * GL_RS + dk * 2) = qd; *(unsigned short*)(gw + GW_QD + i * 128 + dk * 2) = qd;
                *(LAS unsigned short*)(L + GL_KI + i * GL_RS + dk * 2) = (unsigned short)f2bf(k * ieg);
                kev[z] = k * (etot * ieg); }
            kep[ii >> 1] = cvt_pk_bf16(kev[0], kev[1]); }
        *(u32x4*)(gw + GW_KE + dk * 128 + tg * 16) = (u32x4){kep[0], kep[1], kep[2], kep[3]};
        if (tg == 0) ((float*)(gw + GW_DEC))[dk] = etot;
        __syncthreads();
        if (wave < 4) { const int tj = wave & 1, ti = wave >> 1;
            f32x16 acc;
#pragma unroll
            for (int r = 0; r < 16; ++r) acc[r] = 0.f;
            if (!(ti == 0 && tj == 1)) {
#pragma unroll
                for (int ks = 0; ks < 4; ++ks) acc = __builtin_amdgcn_mfma_f32_32x32x16_bf16(lds_frag(L + GL_KI, tj * 32 + r32, ks * 32 + hi * 16), lds_frag(L + GL_QD, ti * 32 + r32, ks * 32 + hi * 16), acc, 0, 0, 0);
            }
            const int i = ti * 32 + r32;
#pragma unroll
            for (int g = 0; g < 4; ++g) { const int j0 = tj * 32 + 8 * g + 4 * hi; float v4[4];
#pragma unroll
                for (int z = 0; z < 4; ++z) v4[z] = (j0 + z <= i) ? acc[4 * g + z] : 0.f;
                *(u32x2*)(gw + GW_AT + i * 128 + j0 * 2) = (u32x2){cvt_pk_bf16(v4[0], v4[1]), cvt_pk_bf16(v4[2], v4[3])}; } }
        __syncthreads();
    }
#undef GP_LOAD
}
__device__ __forceinline__ void p_gla_scan(Frame& F) {
    LAS unsigned char* L = F.lds;
    const bf16* P = wsp<const bf16>(F, WS_P); const unsigned char* GW = F.ws + WS_X1;
    const int tid = F.tid, lane = F.lane, wave = F.wave, r32 = lane & 31, hi = lane >> 5;
    for (int id = F.bid; id < 256; id += F.G) {
        const int b = id >> 5, h = (id >> 3) & 3, dir = (id >> 2) & 1, vs = id & 3;
        const unsigned char* gwb = GW + (size_t)(((b * 4 + h) * 2 + dir) * 132) * GW_UNIT;
        f32x16 Sacc;
#pragma unroll
        for (int r = 0; r < 16; ++r) Sacc[r] = 0.f;
        for (int i = tid; i < 4608 / 4; i += 512) ((LAS unsigned*)(L + GL_ST))[i] = 0u;
        u32x4 t0, t1, t2, dv; bf16x8 vv;
#define GS_LOAD(n) do { const unsigned char* gu = gwb + (size_t)(n) * GW_UNIT + tid * 16; t0 = *(const u32x4*)(gu); t1 = *(const u32x4*)(gu + 8192); t2 = *(const u32x4*)(gu + 16384); \
        if (tid < 16) dv = *(const u32x4*)(gwb + (size_t)(n) * GW_UNIT + GW_DEC + tid * 16); \
        if (tid < 256) vv = *(const bf16x8*)(P + (size_t)GLA_ROWF(b, dir, n, tid >> 2) * PW + 512 + h * 128 + vs * 32 + (tid & 3) * 8); } while (0)
        GS_LOAD(0);
        __syncthreads();
        for (int n = 0; n < 132; ++n) {
            { const int row = tid >> 3, c16 = (tid & 7) * 16;
              *(LAS u32x4*)(L + GL_QD + row * GL_RS + c16) = t0; *(LAS u32x4*)(L + GL_KE + row * GL_RS + c16) = t1; *(LAS u32x4*)(L + GL_AT + row * GL_RS + c16) = t2; }
            if (tid < 16) *(LAS u32x4*)(L + GL_DEC + tid * 16) = dv;
            if (tid < 256) { const int i = tid >> 2;
#pragma unroll
                for (int e = 0; e < 8; ++e) *(LAS unsigned short*)(L + GL_VT + ((tid & 3) * 8 + e) * GL_RS + i * 2) = (unsigned short)vv[e]; }
            __syncthreads();
            if (n + 1 < 132) GS_LOAD(n + 1);
            const LAS unsigned char* STc = L + GL_ST + (n & 1) * 4608; LAS unsigned char* STn = L + GL_ST + ((n + 1) & 1) * 4608;
            if (wave < 2) {
                const int ti = wave; f32x16 acc;
#pragma unroll
                for (int r = 0; r < 16; ++r) acc[r] = 0.f;
#pragma unroll
                for (int ks = 0; ks < 4; ++ks) acc = __builtin_amdgcn_mfma_f32_32x32x16_bf16(lds_frag(L + GL_AT, ti * 32 + r32, ks * 32 + hi * 16), lds_frag(L + GL_VT, r32, ks * 32 + hi * 16), acc, 0, 0, 0);
#pragma unroll
                for (int ks = 0; ks < 4; ++ks) acc = __builtin_amdgcn_mfma_f32_32x32x16_bf16(lds_frag(L + GL_QD, ti * 32 + r32, ks * 32 + hi * 16), lds_frag(STc, r32, ks * 32 + hi * 16), acc, 0, 0, 0);
                bf16* O = wsp<bf16>(F, WS_GLAO) + (size_t)dir * NTOK * 512 + h * 128 + vs * 32 + r32;
#pragma unroll
                for (int r = 0; r < 16; ++r) { const int i = ti * 32 + (r & 3) + 8 * (r >> 2) + 4 * hi; O[(size_t)GLA_ROWF(b, dir, n, i) * 512] = (bf16)f2bf(acc[r]); }
            } else if (wave < 4) {
                const int dt = wave - 2;
#pragma unroll
                for (int g = 0; g < 4; ++g) { const f32x4 dvv = *(const LAS f32x4*)(L + GL_DEC + (dt * 32 + 8 * g + 4 * hi) * 4);
#pragma unroll
                    for (int z = 0; z < 4; ++z) Sacc[4 * g + z] *= dvv[z]; }
#pragma unroll
                for (int ks = 0; ks < 4; ++ks) Sacc = __builtin_amdgcn_mfma_f32_32x32x16_bf16(lds_frag(L + GL_KE, dt * 32 + r32, ks * 32 + hi * 16), lds_frag(L + GL_VT, r32, ks * 32 + hi * 16), Sacc, 0, 0, 0);
#pragma unroll
                for (int g = 0; g < 4; ++g) *(LAS u32x2*)(STn + r32 * GL_RS + (dt * 32 + 8 * g + 4 * hi) * 2) = (u32x2){cvt_pk_bf16(Sacc[4 * g], Sacc[4 * g + 1]), cvt_pk_bf16(Sacc[4 * g + 2], Sacc[4 * g + 3])};
            }
            __syncthreads();
        }
#undef GS_LOAD
    }
}
__device__ __forceinline__ void wave_sum4(float& a, float& b, float& c, float& d) {
#define WS4_STEP(ctl) "v_add_f32_dpp %0, %0, %0 " ctl "\n\tv_add_f32_dpp %1, %1, %1 " ctl "\n\tv_add_f32_dpp %2, %2, %2 " ctl "\n\tv_add_f32_dpp %3, %3, %3 " ctl "\n\t"
    asm volatile("s_nop 1\n\t"
                 WS4_STEP("quad_perm:[1,0,3,2] row_mask:0xf bank_mask:0xf")
                 WS4_STEP("quad_perm:[2,3,0,1] row_mask:0xf bank_mask:0xf")
                 WS4_STEP("row_half_mirror row_mask:0xf bank_mask:0xf")
                 WS4_STEP("row_mirror row_mask:0xf bank_mask:0xf")
                 WS4_STEP("row_bcast:15 row_mask:0xa bank_mask:0xf")
                 WS4_STEP("row_bcast:31 row_mask:0xc bank_mask:0xf")
                 "s_nop 0"
                 : "+v"(a), "+v"(b), "+v"(c), "+v"(d));
#undef WS4_STEP
    a = __builtin_bit_cast(float, __builtin_amdgcn_readlane(__builtin_bit_cast(int, a), 63)); b = __builtin_bit_cast(float, __builtin_amdgcn_readlane(__builtin_bit_cast(int, b), 63));
    c = __builtin_bit_cast(float, __builtin_amdgcn_readlane(__builtin_bit_cast(int, c), 63)); d = __builtin_bit_cast(float, __builtin_amdgcn_readlane(__builtin_bit_cast(int, d), 63));
}
#define LDS_BARRIER() asm volatile("s_waitcnt lgkmcnt(0)\n\ts_barrier" ::: "memory")
__device__ __forceinline__ void red16x2(float& a, float& b) {
    asm volatile("s_nop 1\n\t"
                 "v_add_f32_dpp %0, %0, %0 quad_perm:[1,0,3,2] row_mask:0xf bank_mask:0xf\n\t"
                 "v_add_f32_dpp %1, %1, %1 quad_perm:[1,0,3,2] row_mask:0xf bank_mask:0xf\n\t"
                 "s_nop 0\n\t"
                 "v_add_f32_dpp %0, %0, %0 quad_perm:[2,3,0,1] row_mask:0xf bank_mask:0xf\n\t"
                 "v_add_f32_dpp %1, %1, %1 quad_perm:[2,3,0,1] row_mask:0xf bank_mask:0xf\n\t"
                 "s_nop 0\n\t"
                 "v_add_f32_dpp %0, %0, %0 row_half_mirror row_mask:0xf bank_mask:0xf\n\t"
                 "v_add_f32_dpp %1, %1, %1 row_half_mirror row_mask:0xf bank_mask:0xf\n\t"
                 "s_nop 0\n\t"
                 "v_add_f32_dpp %0, %0, %0 row_mirror row_mask:0xf bank_mask:0xf\n\t"
                 "v_add_f32_dpp %1, %1, %1 row_mirror row_mask:0xf bank_mask:0xf"
                 : "+v"(a), "+v"(b));
}
__device__ __forceinline__ void red8x2(float& a, float& b) {
    asm volatile("s_nop 1\n\t"
                 "v_add_f32_dpp %0, %0, %0 quad_perm:[1,0,3,2] row_mask:0xf bank_mask:0xf\n\t"
                 "v_add_f32_dpp %1, %1, %1 quad_perm:[1,0,3,2] row_mask:0xf bank_mask:0xf\n\t"
                 "s_nop 0\n\t"
                 "v_add_f32_dpp %0, %0, %0 quad_perm:[2,3,0,1] row_mask:0xf bank_mask:0xf\n\t"
                 "v_add_f32_dpp %1, %1, %1 quad_perm:[2,3,0,1] row_mask:0xf bank_mask:0xf\n\t"
                 "s_nop 0\n\t"
                 "v_add_f32_dpp %0, %0, %0 row_half_mirror row_mask:0xf bank_mask:0xf\n\t"
                 "v_add_f32_dpp %1, %1, %1 row_half_mirror row_mask:0xf bank_mask:0xf"
                 : "+v"(a), "+v"(b));
}
constexpr int RW_T = 32;
constexpr int RW_SS = 392;
constexpr int RW_BUF = RW_T * RW_SS * 4;
constexpr int RW_YB = 2 * RW_BUF;
constexpr int RW_YBSZ = 32 * 33 * 4;
__device__ __forceinline__ void p_rwkv_scan(Frame& F) {
    LAS unsigned char* L = F.lds;
    const bf16* P = wsp<const bf16>(F, WS_P); const bf16* LO = wsp<const bf16>(F, WS_LOUT);
    const int lane = F.lane, wave = F.wave;
    constexpr int NRD = (CTXL + SEQ) / RW_T;
    for (int id = F.bid; id < 256; id += F.G) {
        const int b = id >> 5, h = (id >> 2) & 7, dir = (id >> 1) & 1, rh = id & 1;
#define RW_ROW(s) ((s) < 256 ? NLAT + b * 256 + (dir ? 255 - (s) : (s)) : b * 8192 + (dir ? 8191 - ((s) - 256) : ((s) - 256)))
        if (wave >= 4) {
            const int pw = wave - 4, hj = h * 64 + lane;
            const float* mu = F.in[I_MU];
            const float cpr = mu[hj], cnr = mu[RW_COLS + hj], cpk = mu[512 + hj], cnk = mu[RW_COLS + 512 + hj], cpv = mu[1024 + hj], cnv = mu[RW_COLS + 1024 + hj];
            const float w0v = F.in[I_W0][dir * 512 + hj], a0v = F.in[I_A0][dir * 512 + hj], kkc = F.in[I_KK][hj], kac = F.in[I_KA][hj], rkc = F.in[I_RK][hj];
            unsigned xa[30], la[16], xb[30], lb[16];
#define RW_LOAD(rd, X, Lr) do { const int s0_ = (rd) * RW_T + pw * 8; const bool lo_ok = (s0_ != 0) && (s0_ != 256), hi_ok = (s0_ + 8 != 256) && (s0_ + 8 != NKEY); \
                const long sgn_ = dir ? -(long)PW : (long)PW; const bf16* pr0 = P + (size_t)RW_ROW(s0_) * PW + RW0 + hj; \
                _Pragma("unroll") for (int pp = -1; pp < 9; ++pp) { const int pc = (pp < 0 && !lo_ok) ? 0 : ((pp > 7 && !hi_ok) ? 7 : pp); const bf16* pr = pr0 + sgn_ * pc; \
                    X[3 * (pp + 1)] = pr[0]; X[3 * (pp + 1) + 1] = pr[512]; X[3 * (pp + 1) + 2] = pr[1024]; } \
                const long sgl_ = dir ? -(long)LRN : (long)LRN; const bf16* lr0 = LO + (size_t)RW_ROW(s0_) * LRN + dir * 512 + hj; \
                _Pragma("unroll") for (int pp = 0; pp < 8; ++pp) { Lr[2 * pp] = lr0[sgl_ * pp]; Lr[2 * pp + 1] = lr0[sgl_ * pp + 1024]; } } while (0)
#define RW_FEAT(rd, X, Lr) do { const int s0_ = (rd) * RW_T + pw * 8; const bool lo_ok = (s0_ != 0) && (s0_ != 256), hi_ok = (s0_ + 8 != 256) && (s0_ + 8 != NKEY); \
                const int row0_ = RW_ROW(s0_); \
                _Pragma("unroll") for (int q = 0; q < 8; ++q) { const int st = pw * 8 + q; \
                const bool vlo = (q > 0) || lo_ok, vhi = (q < 7) || hi_ok; const bool hp = dir ? vhi : vlo, hn = dir ? vlo : vhi; \
                  \
                const unsigned pr_ = dir ? X[3 * (q + 2)] : X[3 * q], nr_ = dir ? X[3 * q] : X[3 * (q + 2)], pk_ = dir ? X[3 * (q + 2) + 1] : X[3 * q + 1], nk_ = dir ? X[3 * q + 1] : X[3 * (q + 2) + 1], pv_ = dir ? X[3 * (q + 2) + 2] : X[3 * q + 2], nv_ = dir ? X[3 * q + 2] : X[3 * (q + 2) + 2]; \
                const float r0 = bf2f(X[3 * (q + 1)]), k0 = bf2f(X[3 * (q + 1) + 1]), v0 = bf2f(X[3 * (q + 1) + 2]); \
                const float xr = r0 + cpr * ((hp ? bf2f(pr_) : 0.f) - r0) + cnr * ((hn ? bf2f(nr_) : 0.f) - r0); \
                const float xk = k0 + cpk * ((hp ? bf2f(pk_) : 0.f) - k0) + cnk * ((hn ? bf2f(nk_) : 0.f) - k0); \
                const float xv = v0 + cpv * ((hp ? bf2f(pv_) : 0.f) - v0) + cnv * ((hn ? bf2f(nv_) : 0.f) - v0); \
                  \
                const float sg = __builtin_amdgcn_rcpf(1.f + __expf(-(w0v + bf2f(Lr[2 * q])))); \
                const float wdec = __expf(-0.60653066f * sg); \
                const float alr = __builtin_amdgcn_rcpf(1.f + __expf(-(a0v + bf2f(Lr[2 * q + 1])))); \
                const float kkv = xk * kkc; const float kd = xk * (1.f + (alr - 1.f) * kac); \
                float n2 = kkv * kkv, bon = xr * kd * rkc, kr = kd * xr, br = kkv * alr * xr; \
                wave_sum4(n2, bon, kr, br); \
                const float rn = __builtin_amdgcn_rsqf(fmaxf(n2, 1e-24f)); const float kk = kkv * rn; const float bb = kk * alr; br *= rn; \
                if (rh == 0 && lane == 0) wsp<float>(F, WS_BONUS)[((size_t)dir * NTOK + (dir ? row0_ - q : row0_ + q)) * 8 + h] = bon; \
                LAS float* o = (LAS float*)(L + ((rd) & 1) * RW_BUF) + st * RW_SS; \
                o[lane] = wdec; o[64 + lane] = -kk; o[128 + lane] = bb; o[192 + lane] = kd; o[256 + lane] = wdec * xr; o[320 + lane] = xv; \
                if (lane == 0) { o[384] = br; o[385] = kr; } } } while (0)
#define RW_YOUT(rd) do { const LAS float* yb = (const LAS float*)(L + RW_YB + ((rd) & 1) * RW_YBSZ); _Pragma("unroll") for (int e = 0; e < 2; ++e) { const int pt = pw * 64 + lane, st = (pt >> 4) + 16 * e, r2 = (pt & 15) * 2; const int s = (rd) * RW_T + st; \
                *(unsigned*)(wsp<bf16>(F, WS_RWY) + ((size_t)dir * NTOK + RW_ROW(s)) * 512 + h * 64 + rh * 32 + r2) = cvt_pk_bf16(yb[r2 * 33 + st], yb[(r2 + 1) * 33 + st]); } } while (0)
            RW_LOAD(0, xa, la); RW_LOAD(1, xb, lb); RW_FEAT(0, xa, la);
            LDS_BARRIER();
            for (int rd = 0; rd < NRD; rd += 2) {
                if (rd + 2 < NRD) RW_LOAD(rd + 2, xa, la);
                RW_FEAT(rd + 1, xb, lb);
                if (rd > 0) RW_YOUT(rd - 1);
                LDS_BARRIER();
                if (rd + 3 < NRD) RW_LOAD(rd + 3, xb, lb);
                if (rd + 2 < NRD) RW_FEAT(rd + 2, xa, la);
                RW_YOUT(rd);
                LDS_BARRIER();
            }
            RW_YOUT(NRD - 1);
#undef RW_LOAD
#undef RW_FEAT
#undef RW_YOUT
        } else {
            const int rowl = wave * 8 + (lane >> 3), jl = lane & 7;
            float s[8];
#pragma unroll
            for (int e = 0; e < 8; ++e) s[e] = 0.f;
            LDS_BARRIER();
            for (int rd = 0; rd < NRD; ++rd) {
                const LAS float* sb = (const LAS float*)(L + (rd & 1) * RW_BUF);
                LAS float* yb = (LAS float*)(L + RW_YB + (rd & 1) * RW_YBSZ);
                float yk = 0.f;
                f32x4 w[2], a[2], bq[2], k[2], q[2], nw[2], na[2], nb[2], nk[2], nq[2]; float vv, nvv; f32x2 sc, nsc;
#define RW_OPS(W, A, B, K, Q, V, S, st) do { const LAS float* p = sb + (st) * RW_SS + 8 * jl; _Pragma("unroll") for (int e = 0; e < 2; ++e) { W[e] = *(const LAS f32x4*)(p + 4 * e); A[e] = *(const LAS f32x4*)(p + 64 + 4 * e); \
                    B[e] = *(const LAS f32x4*)(p + 128 + 4 * e); K[e] = *(const LAS f32x4*)(p + 192 + 4 * e); Q[e] = *(const LAS f32x4*)(p + 256 + 4 * e); } \
                    V = sb[(st) * RW_SS + 320 + rh * 32 + rowl]; S = *(const LAS f32x2*)(sb + (st) * RW_SS + 384); } while (0)
                RW_OPS(w, a, bq, k, q, vv, sc, 0);
#pragma unroll
                for (int st = 0; st < RW_T; ++st) {
                    if (st + 1 < RW_T) RW_OPS(nw, na, nb, nk, nq, nvv, nsc, st + 1);
                    float pa = 0.f, pa2 = 0.f, py = 0.f, py2 = 0.f, t[8];
#pragma unroll
                    for (int e = 0; e < 2; ++e) { pa += s[4 * e] * a[e].x; pa2 += s[4 * e + 1] * a[e].y; pa += s[4 * e + 2] * a[e].z; pa2 += s[4 * e + 3] * a[e].w;
                        py += s[4 * e] * q[e].x; py2 += s[4 * e + 1] * q[e].y; py += s[4 * e + 2] * q[e].z; py2 += s[4 * e + 3] * q[e].w;
                        t[4 * e] = s[4 * e] * w[e].x + vv * k[e].x; t[4 * e + 1] = s[4 * e + 1] * w[e].y + vv * k[e].y; t[4 * e + 2] = s[4 * e + 2] * w[e].z + vv * k[e].z; t[4 * e + 3] = s[4 * e + 3] * w[e].w + vv * k[e].w; }
                    pa += pa2; py += py2;
                    red8x2(pa, py);
#pragma unroll
                    for (int e = 0; e < 2; ++e) { s[4 * e] = t[4 * e] + pa * bq[e].x; s[4 * e + 1] = t[4 * e + 1] + pa * bq[e].y; s[4 * e + 2] = t[4 * e + 2] + pa * bq[e].z; s[4 * e + 3] = t[4 * e + 3] + pa * bq[e].w; }
                    const float y = py + pa * sc.x + vv * sc.y;
                    yk = (jl == (st & 7)) ? y : yk;
                    if ((st & 7) == 7) yb[rowl * 33 + (st - 7) + jl] = yk;
#pragma unroll
                    for (int e = 0; e < 2; ++e) { w[e] = nw[e]; a[e] = na[e]; bq[e] = nb[e]; k[e] = nk[e]; q[e] = nq[e]; }
                    vv = nvv; sc = nsc;
                    __builtin_amdgcn_sched_barrier(0);
                }
#undef RW_OPS
                LDS_BARRIER();
            }
        }
#undef RW_ROW
        VM_WAIT(); __syncthreads();
    }
}

__device__ __forceinline__ void p_mix_finish(Frame& F) {
    const int gw = F.bid * 8 + F.wave, NGW = F.G * 8, lane = F.lane;
    const bf16* P = wsp<const bf16>(F, WS_P); const bf16* LO = wsp<const bf16>(F, WS_LOUT);
    const bf16* GO = wsp<const bf16>(F, WS_GLAO); const bf16* RY = wsp<const bf16>(F, WS_RWY); const float* BON = wsp<const float>(F, WS_BONUS);
    bf16* MIX = wsp<bf16>(F, WS_H);
    const int c0 = lane * 8;
    float gng[8], lnw[8], lnb[8], cpv[8], cnv[8];
#pragma unroll
    for (int e = 0; e < 8; ++e) { gng[e] = F.in[I_GNG][(c0 + e) & 127]; lnw[e] = F.in[I_LNW][c0 + e]; lnb[e] = F.in[I_LNB][c0 + e]; cpv[e] = F.in[I_MU][1024 + c0 + e]; cnv[e] = F.in[I_MU][RW_COLS + 1024 + c0 + e]; }
    for (int row = gw; row < NTOK; row += NGW) {
        { const u32x4 a = *(const u32x4*)(GO + (size_t)row * 512 + c0), bb = *(const u32x4*)(GO + ((size_t)NTOK + row) * 512 + c0), og = *(const u32x4*)(P + (size_t)row * PW + 1024 + c0);
          float o[8]; float ss = 0.f;
#pragma unroll
          for (int e = 0; e < 4; ++e) { o[2 * e] = bflo(a[e]) + bflo(bb[e]); o[2 * e + 1] = bfhi(a[e]) + bfhi(bb[e]); ss += o[2 * e] * o[2 * e] + o[2 * e + 1] * o[2 * e + 1]; }
          ss += __shfl_xor(ss, 1); ss += __shfl_xor(ss, 2); ss += __shfl_xor(ss, 4); ss += __shfl_xor(ss, 8);
          const float rstd = 1.f / sqrtf(ss * (1.f / 128.f) + 1e-6f);
          float y[8];
#pragma unroll
          for (int e = 0; e < 4; ++e) { const float g0 = bflo(og[e]), g1 = bfhi(og[e]);
              y[2 * e] = o[2 * e] * rstd * gng[2 * e] * (g0 * __builtin_amdgcn_rcpf(1.f + __expf(-g0))); y[2 * e + 1] = o[2 * e + 1] * rstd * gng[2 * e + 1] * (g1 * __builtin_amdgcn_rcpf(1.f + __expf(-g1))); }
          *(u32x4*)(MIX + (size_t)row * 1024 + c0) = (u32x4){cvt_pk_bf16(y[0], y[1]), cvt_pk_bf16(y[2], y[3]), cvt_pk_bf16(y[4], y[5]), cvt_pk_bf16(y[6], y[7])}; }
        { bool hp, hn; seq_pos(row, hp, hn);
          const u32x4 a = *(const u32x4*)(RY + (size_t)row * 512 + c0), bb = *(const u32x4*)(RY + ((size_t)NTOK + row) * 512 + c0);
          const bf16* pv = P + (size_t)row * PW + RW0 + 1024 + c0;
          const u32x4 v0 = *(const u32x4*)pv; u32x4 vm = (u32x4){0u, 0u, 0u, 0u}, vn = (u32x4){0u, 0u, 0u, 0u};
          if (hp) vm = *(const u32x4*)(pv - PW); if (hn) vn = *(const u32x4*)(pv + PW);
          const u32x4 gg = *(const u32x4*)(LO + (size_t)row * LRN + 2048 + c0);
          const int hd = lane >> 3; const float bon = BON[(size_t)row * 8 + hd] + BON[((size_t)NTOK + row) * 8 + hd];
          float yv[8]; float sm = 0.f;
#pragma unroll
          for (int e = 0; e < 4; ++e) { yv[2 * e] = bflo(a[e]) + bflo(bb[e]); yv[2 * e + 1] = bfhi(a[e]) + bfhi(bb[e]); sm += yv[2 * e] + yv[2 * e + 1]; }
          sm += __shfl_xor(sm, 1); sm += __shfl_xor(sm, 2); sm += __shfl_xor(sm, 4);
          const float mean = sm * (1.f / 64.f); float sv = 0.f;
#pragma unroll
          for (int e = 0; e < 8; ++e) { const float d = yv[e] - mean; sv += d * d; }
          sv += __shfl_xor(sv, 1); sv += __shfl_xor(sv, 2); sv += __shfl_xor(sv, 4);
          const float rstd = 1.f / sqrtf(sv * (1.f / 64.f) + 64e-5f);
          float o[8];
#pragma unroll
          for (int e = 0; e < 8; ++e) { const unsigned w0 = v0[e >> 1], wm = vm[e >> 1], wn = vn[e >> 1];
              const float p0 = (e & 1) ? bfhi(w0) : bflo(w0), pm = (e & 1) ? bfhi(wm) : bflo(wm), pn = (e & 1) ? bfhi(wn) : bflo(wn);
              const float xv = p0 + cpv[e] * (pm - p0) + cnv[e] * (pn - p0);
              const float g = (e & 1) ? bfhi(gg[e >> 1]) : bflo(gg[e >> 1]);
              o[e] = ((yv[e] - mean) * rstd * lnw[e] + lnb[e] + bon * xv) * g; }
          *(u32x4*)(MIX + (size_t)row * 1024 + 512 + c0) = (u32x4){cvt_pk_bf16(o[0], o[1]), cvt_pk_bf16(o[2], o[3]), cvt_pk_bf16(o[4], o[5]), cvt_pk_bf16(o[6], o[7])}; }
    }
}

__device__ __forceinline__ void p_mla_prep(Frame& F) {
    const int gw = F.bid * 8 + F.wave, NGW = F.G * 8, lane = F.lane;
    const bf16* C = wsp<const bf16>(F, WS_C); bf16* QN = wsp<bf16>(F, WS_QN); bf16* KVN = wsp<bf16>(F, WS_KVN); unsigned char* K8 = wsp<unsigned char>(F, WS_K8);
    const f32x2* ROPE = wsp<const f32x2>(F, WS_ROPE);
    const f32x4 qg = ((const f32x4*)F.in[I_QNORM])[lane]; const f32x4 kg = ((const f32x4*)F.in[I_KVNORM])[lane & 31];
    for (int row = gw; row < NTOK; row += NGW) {
        const bf16* cr = C + (size_t)row * 512;
        const u32x2 cqw = ((const u32x2*)cr)[lane], ckw = ((const u32x2*)(cr + 256))[lane & 31];
        const f32x4 cq = {bflo(cqw.x), bfhi(cqw.x), bflo(cqw.y), bfhi(cqw.y)};
        const f32x4 ck = {bflo(ckw.x), bfhi(ckw.x), bflo(ckw.y), bfhi(ckw.y)};
        const float xr = bflo((unsigned)cr[384 + lane]);
        const float ssq = wave_sum((cq.x * cq.x + cq.y * cq.y) + (cq.z * cq.z + cq.w * cq.w));
        const float ssk = wave_sum(lane < 32 ? (ck.x * ck.x + ck.y * ck.y) + (ck.z * ck.z + ck.w * ck.w) : 0.f);
        if (row < NLAT) { const float rs = 1.f / sqrtf(ssq * (1.f / 256.f) + 1e-6f);
            ((u32x2*)(QN + (size_t)row * 256))[lane] = (u32x2){cvt_pk_bf16(cq.x * rs * qg.x, cq.y * rs * qg.y), cvt_pk_bf16(cq.z * rs * qg.z, cq.w * rs * qg.w)}; }
        { const float rs = 1.f / sqrtf(ssk * (1.f / 128.f) + 1e-6f);
          u32x2 w = (u32x2){0u, 0u};
          if (lane < 32) w = (u32x2){cvt_pk_bf16(ck.x * rs * kg.x, ck.y * rs * kg.y), cvt_pk_bf16(ck.z * rs * kg.z, ck.w * rs * kg.w)};
          ((u32x2*)(KVN + (size_t)row * 256))[lane] = w; }
        float kr = xr; int b, key;
        const float pr = __shfl_xor(xr, 16);
        if (row < NLAT) { b = row >> 13; const int t = row & 8191; key = CTXL + t;
            const f32x2 cs = ROPE[t * 32 + ((lane >> 5) << 4) + (lane & 15)];
            kr = (lane & 16) ? xr * cs.x + pr * cs.y : xr * cs.x - pr * cs.y;
        } else { b = (row - NLAT) >> 8; key = (row - NLAT) & 255; }
        const unsigned char kb = (unsigned char)(pk4_fp8(kr, 0.f, 0.f, 0.f) & 0xffu);
#pragma unroll
        for (int h = 0; h < 8; ++h) K8[((size_t)((b * 8 + h) * NKEY + key)) * K8ROW + 128 + lane] = kb;
    }
}
__host__ __device__ constexpr int att_kperm(int p) { const int hi = p >> 5, j = p & 31, r = j & 15; return (j >> 4) * 32 + (r & 3) + 8 * (r >> 2) + 4 * hi; }

namespace att {
constexpr float SCALE = 0.07216878364870322f;
constexpr float THR = 2.f;
constexpr float PLOG2 = 5.f;
constexpr int KSLOT = 16384, KTILE = 64 * K8ROW, VSLOT = 8192;
constexpr int LDS_K = 0, LDS_V = 4 * KSLOT, LDS_WS = LDS_V + 4 * VSLOT, LDS_Q = LDS_WS + 2048;
constexpr int NT = NKEY / 64;
constexpr int ONE = 0x7F7F7F7F;
constexpr int QSCL = 0x7C7C7C7C;
__device__ __forceinline__ int crow(int r, int hi) { return (r & 3) + 8 * (r >> 2) + 4 * hi; }
constexpr float PMAXSUM = 416.f, PTARGET = 64.f;
__device__ __forceinline__ void partialSM(f32x16& p0, f32x16& p1, float moff) {
#pragma unroll
    for (int r = 0; r < 16; ++r) p0[r] -= moff;
#pragma unroll
    for (int r = 0; r < 16; ++r) p1[r] -= moff;
#pragma unroll
    for (int r = 0; r < 16; ++r) p0[r] = __builtin_amdgcn_exp2f(p0[r]);
}
__device__ __forceinline__ void finishSM(f32x16& p0, f32x16& p1, float& moff, float& alpha, float& l_reg, i32x8& pa) {
#pragma unroll
    for (int r = 0; r < 16; ++r) p1[r] = __builtin_amdgcn_exp2f(p1[r]);
    float ps = 0;
#pragma unroll
    for (int r = 0; r < 16; ++r) ps += p0[r];
#pragma unroll
    for (int r = 0; r < 16; ++r) ps += p1[r];
    { auto rr = __builtin_amdgcn_permlane32_swap(__float_as_uint(ps), __float_as_uint(ps), false, false); ps = __uint_as_float(rr[0]) + __uint_as_float(rr[1]); }
    alpha = 1.f;
    if (__builtin_expect(__any(ps > PMAXSUM), 0)) {
        alpha = ps > PMAXSUM ? PTARGET * __builtin_amdgcn_rcpf(ps) : 1.f;
        ps *= alpha; moff -= __builtin_amdgcn_logf(alpha);
#pragma unroll
        for (int g = 0; g < 4; ++g) { pa[g] = (int)pk4_fp8(p0[4 * g] * alpha, p0[4 * g + 1] * alpha, p0[4 * g + 2] * alpha, p0[4 * g + 3] * alpha); pa[4 + g] = (int)pk4_fp8(p1[4 * g] * alpha, p1[4 * g + 1] * alpha, p1[4 * g + 2] * alpha, p1[4 * g + 3] * alpha); }
    } else {
#pragma unroll
        for (int g = 0; g < 4; ++g) { pa[g] = (int)pk4_fp8(p0[4 * g], p0[4 * g + 1], p0[4 * g + 2], p0[4 * g + 3]); pa[4 + g] = (int)pk4_fp8(p1[4 * g], p1[4 * g + 1], p1[4 * g + 2], p1[4 * g + 3]); }
    }
    l_reg = l_reg * alpha + ps;
}
__device__ __forceinline__ i32x8 ld32(const LAS unsigned char* p0, const LAS unsigned char* p1) { return __builtin_shufflevector(*(const LAS i32x4*)p0, *(const LAS i32x4*)p1, 0, 1, 2, 3, 4, 5, 6, 7); }
__device__ __forceinline__ void qkt(f32x16& p0, f32x16& p1, const LAS unsigned char* Ks, const LAS unsigned char* Qs, int r32, int hi) {
#pragma unroll
    for (int r = 0; r < 16; ++r) { p0[r] = 0.f; p1[r] = 0.f; }
#pragma unroll
    for (int m = 0; m < 3; ++m) { const LAS unsigned char* k0 = Ks + r32 * K8ROW + m * 64 + hi * 32; const LAS unsigned char* k1 = k0 + 32 * K8ROW;
        const i32x8 a0 = ld32(k0, k0 + 16), a1 = ld32(k1, k1 + 16), qm = ld32(Qs + m * 2048, Qs + m * 2048 + 1024);
        p0 = __builtin_amdgcn_mfma_scale_f32_32x32x64_f8f6f4(a0, qm, p0, 0, 0, 0, ONE, 0, QSCL);
        p1 = __builtin_amdgcn_mfma_scale_f32_32x32x64_f8f6f4(a1, qm, p1, 0, 0, 0, ONE, 0, QSCL); }
}
__device__ __forceinline__ void pv(f32x16 (&o)[4], const LAS unsigned char* Vs, const i32x8 pa, int r32, int hi) {
#pragma unroll
    for (int d0 = 0; d0 < 4; ++d0) { const int c = d0 * 32 + r32, sw = (c >> 2) & 3; const LAS unsigned char* vr = Vs + c * 64;
        const i32x8 vb = ld32(vr + (((2 * hi) ^ sw) << 4), vr + (((2 * hi + 1) ^ sw) << 4));
        o[d0] = __builtin_amdgcn_mfma_scale_f32_32x32x64_f8f6f4(pa, vb, o[d0], 0, 0, 0, ONE, 0, ONE); }
}
__device__ __forceinline__ int pk4n(float a, float b, float c, float d, int w) { w = __builtin_amdgcn_cvt_pk_fp8_f32(a, b, w, false); w = __builtin_amdgcn_cvt_pk_fp8_f32(c, d, w, true); return w; }
#define ATT_MMA(a, b, c) __builtin_amdgcn_mfma_scale_f32_32x32x64_f8f6f4(a, b, c, 0, 0, 0, ONE, 0, ONE)
#define ATT_MMQ(a, b, c) __builtin_amdgcn_mfma_scale_f32_32x32x64_f8f6f4(a, b, c, 0, 0, 0, ONE, 0, QSCL)
#define ATT_EXP(P, i0, n) do { _Pragma("unroll") for (int _r = (i0); _r < (i0) + (n); ++_r) P[_r] = __builtin_amdgcn_exp2f(P[_r]); } while (0)
__device__ __forceinline__ void half_step(f32x16& X0, f32x16& X1, f32x16& Y0, f32x16& Y1, const LAS unsigned char* Ks, const LAS unsigned char* Vs, const LAS unsigned char* Qs, f32x16 (&o)[4],
                                          float& moff, float& l_reg, i32x8& pa, bool& offs, LAS float* al_l, int r32, int hi) {
    f32x16 zz;
#pragma unroll
    for (int r = 0; r < 16; ++r) zz[r] = 0.f;
    SBAR();
    const LAS unsigned char* k0 = Ks + r32 * K8ROW + hi * 32; const LAS unsigned char* k1 = k0 + 32 * K8ROW;
#define ATT_Q(m) ld32(Qs + (m) * 2048, Qs + (m) * 2048 + 1024)
#define ATT_V(d0) ld32(Vs + ((d0) * 32 + r32) * 64 + (((2 * hi) ^ ((((d0) * 32 + r32) >> 2) & 3)) << 4), Vs + ((d0) * 32 + r32) * 64 + (((2 * hi + 1) ^ ((((d0) * 32 + r32) >> 2) & 3)) << 4))
    const i32x8 q0 = ATT_Q(0); const i32x8 ka0 = ld32(k0, k0 + 16), kb0 = ld32(k1, k1 + 16);
    const i32x8 q1 = ATT_Q(1); const i32x8 ka1 = ld32(k0 + 64, k0 + 80);
    ATT_EXP(X1, 0, 4); SBAR();
    Y0 = ATT_MMQ(ka0, q0, zz); SBAR();
    const i32x8 kb1 = ld32(k1 + 64, k1 + 80);
    ATT_EXP(X1, 4, 4); SBAR();
    Y1 = ATT_MMQ(kb0, q0, zz); SBAR();
    const i32x8 q2 = ATT_Q(2); const i32x8 ka2 = ld32(k0 + 128, k0 + 144);
    ATT_EXP(X1, 8, 4); SBAR();
    Y0 = ATT_MMQ(ka1, q1, Y0); SBAR();
    const i32x8 kb2 = ld32(k1 + 128, k1 + 144);
    ATT_EXP(X1, 12, 4); SBAR();
    Y1 = ATT_MMQ(kb1, q1, Y1); SBAR();
    f32x2 sa = {X0[0], X0[1]}, sb = {X1[0], X1[1]};
#pragma unroll
    for (int r = 1; r < 8; ++r) { sa += (f32x2){X0[2 * r], X0[2 * r + 1]}; sb += (f32x2){X1[2 * r], X1[2 * r + 1]}; }
    sa += sb; float ps = sa.x + sa.y;
    { auto rr = __builtin_amdgcn_permlane32_swap(__float_as_uint(ps), __float_as_uint(ps), false, false); ps = __uint_as_float(rr[0]) + __uint_as_float(rr[1]); }
    SBAR();
    Y0 = ATT_MMQ(ka2, q2, Y0); SBAR();
    i32x8 vb[4];
    vb[0] = ATT_V(0); vb[1] = ATT_V(1);
#pragma unroll
    for (int g = 0; g < 4; ++g) pa[g] = pk4n(X0[4 * g], X0[4 * g + 1], X0[4 * g + 2], X0[4 * g + 3], pa[g]);
    SBAR();
    Y1 = ATT_MMQ(kb2, q2, Y1); SBAR();
#pragma unroll
    for (int g = 0; g < 4; ++g) pa[4 + g] = pk4n(X1[4 * g], X1[4 * g + 1], X1[4 * g + 2], X1[4 * g + 3], pa[4 + g]);
    asm volatile("" :: "v"(Y0), "v"(Y1), "v"(pa));
    SBAR();
    if (__builtin_expect(__any(ps > PMAXSUM), 0)) {
        const float alpha = ps > PMAXSUM ? PTARGET * __builtin_amdgcn_rcpf(ps) : 1.f;
        ps *= alpha; moff -= __builtin_amdgcn_logf(alpha); l_reg *= alpha; offs = true;
#pragma unroll
        for (int g = 0; g < 4; ++g) { pa[g] = (int)pk4_fp8(X0[4 * g] * alpha, X0[4 * g + 1] * alpha, X0[4 * g + 2] * alpha, X0[4 * g + 3] * alpha); pa[4 + g] = (int)pk4_fp8(X1[4 * g] * alpha, X1[4 * g + 1] * alpha, X1[4 * g + 2] * alpha, X1[4 * g + 3] * alpha); }
        if (hi == 0) al_l[r32] = alpha;
        asm volatile("s_waitcnt lgkmcnt(0)" ::: "memory");
#pragma unroll
        for (int d = 0; d < 4; ++d)
#pragma unroll
            for (int r = 0; r < 16; ++r) o[d][r] *= al_l[crow(r, hi)];
    }
    l_reg += ps;
#define ATT_SUB(P) do { _Pragma("unroll") for (int _r = 0; _r < 16; ++_r) P[_r] -= moff; } while (0)
#define ATT_R2(S0, S1) do { SBAR(); \
    o[0] = ATT_MMA(pa, vb[0], o[0]); SBAR(); vb[2] = ATT_V(2); S0; ATT_EXP(Y0, 0, 3); SBAR(); \
    o[1] = ATT_MMA(pa, vb[1], o[1]); SBAR(); vb[3] = ATT_V(3); ATT_EXP(Y0, 3, 5); SBAR(); \
    o[2] = ATT_MMA(pa, vb[2], o[2]); SBAR(); ATT_EXP(Y0, 8, 5); SBAR(); \
    o[3] = ATT_MMA(pa, vb[3], o[3]); SBAR(); ATT_EXP(Y0, 13, 3); S1; \
    asm volatile("" :: "v"(o[0]), "v"(o[1]), "v"(o[2]), "v"(o[3]), "v"(Y0), "v"(Y1));     \
    SBAR(); } while (0)
    if (__builtin_expect(offs, 0)) ATT_R2(ATT_SUB(Y0), ATT_SUB(Y1)); else ATT_R2((void)0, (void)0);
#undef ATT_R2
#undef ATT_SUB
}
__device__ __forceinline__ void glds16(const void* gsrc, LAS unsigned char* lds_wave_base) { unsigned keep; const unsigned dst = (unsigned)__builtin_amdgcn_readfirstlane((int)(uintptr_t)lds_wave_base);
    asm volatile("s_mov_b32 %0, m0\n\ts_mov_b32 m0, %2\n\ts_nop 0\n\tglobal_load_lds_dwordx4 %1, off\n\ts_mov_b32 m0, %0" : "=&s"(keep) : "v"(gsrc), "s"(dst) : "memory"); }

__device__ __forceinline__ void unit(const unsigned char* __restrict__ Qb, const unsigned char* __restrict__ Kh, const unsigned char* __restrict__ Vh, unsigned char* __restrict__ Ob, LAS unsigned char* lds, int tid) {
    const int wid = __builtin_amdgcn_readfirstlane(tid >> 6), lane = tid & 63, r32 = lane & 31, hi = lane >> 5;
    LAS float* ws = (LAS float*)(lds + LDS_WS) + wid * 64; LAS float* li_l = ws; LAS float* al_l = ws + 32;
    float l_reg = 0.f; f32x16 o[4];
#pragma unroll
    for (int d = 0; d < 4; ++d)
#pragma unroll
        for (int r = 0; r < 16; ++r) o[d][r] = 0.f;
    const unsigned char* Qw = Qb + (size_t)(wid * 32 + r32) * QKD + hi * 32;
#pragma unroll
    for (int m = 0; m < 3; ++m) { *(LAS i32x4*)(lds + LDS_Q + wid * 6144 + m * 2048 + lane * 16) = *(const i32x4*)(Qw + m * 64); *(LAS i32x4*)(lds + LDS_Q + wid * 6144 + m * 2048 + 1024 + lane * 16) = *(const i32x4*)(Qw + m * 64 + 16); }
    const LAS unsigned char* Qs = lds + LDS_Q + wid * 6144 + lane * 16;
    const unsigned pofs = (unsigned)(wid * 1024 + lane * 16);
#define DMA_K(j, slot) do { _Pragma("unroll") for (int _i = 0; _i < 2; ++_i) glds16(Kh + (size_t)(j) * KTILE + _i * 8192 + pofs, lds + LDS_K + (slot) * KSLOT + _i * 8192 + wid * 1024); } while (0)
#define DMA_V(j, slot) glds16(Vh + (size_t)(j) * VSLOT + pofs, lds + LDS_V + (slot) * VSLOT + wid * 1024)
#define WAITBAR(n) asm volatile("s_waitcnt vmcnt(" #n ")\n\ts_barrier" ::: "memory")
#define RESC(a) do { if (__any((a) < 1.f)) { if (hi == 0) al_l[r32] = (a); asm volatile("s_waitcnt lgkmcnt(0)" ::: "memory"); \
    _Pragma("unroll") for (int d = 0; d < 4; ++d) _Pragma("unroll") for (int r = 0; r < 16; ++r) o[d][r] *= al_l[crow(r, hi)]; } } while (0)
    f32x16 pA0, pA1, pB0, pB1; float moff = 0.f, al; i32x8 pa = {0, 0, 0, 0, 0, 0, 0, 0}; bool offs = false;
    if (wid >= 4) __builtin_amdgcn_s_setprio(1);
    asm volatile("s_barrier" ::: "memory");
    DMA_K(0, 0); DMA_K(1, 1); DMA_K(2, 2); DMA_V(0, 0); DMA_V(1, 1);
    WAITBAR(6);
    qkt(pA0, pA1, lds + LDS_K, Qs, r32, hi); partialSM(pA0, pA1, moff);
    WAITBAR(0);
    for (int j = 1; j + 1 < NT; j += 2) {
        DMA_K(j + 2, (j + 2) & 3); if (j + 3 < NT) DMA_K(j + 3, (j + 3) & 3);
        DMA_V(j + 1, (j + 1) & 3); DMA_V(j + 2, (j + 2) & 3);
        half_step(pA0, pA1, pB0, pB1, lds + LDS_K + (j & 3) * KSLOT, lds + LDS_V + ((j - 1) & 3) * VSLOT, Qs, o, moff, l_reg, pa, offs, al_l, r32, hi);
        half_step(pB0, pB1, pA0, pA1, lds + LDS_K + ((j + 1) & 3) * KSLOT, lds + LDS_V + (j & 3) * VSLOT, Qs, o, moff, l_reg, pa, offs, al_l, r32, hi);
        WAITBAR(0);
    }
    int vs = (NT - 2) & 3;
    SBAR(); qkt(pB0, pB1, lds + LDS_K + ((NT - 1) & 3) * KSLOT, Qs, r32, hi);
    finishSM(pA0, pA1, moff, al, l_reg, pa); SBAR();
    RESC(al);
    pv(o, lds + LDS_V + vs * VSLOT, pa, r32, hi); partialSM(pB0, pB1, moff);
    vs = (NT - 1) & 3;
    finishSM(pB0, pB1, moff, al, l_reg, pa); SBAR();
    RESC(al);
    pv(o, lds + LDS_V + vs * VSLOT, pa, r32, hi);
    __builtin_amdgcn_s_setprio(0);
    if (hi == 0) li_l[r32] = l_reg; asm volatile("s_waitcnt lgkmcnt(0)" ::: "memory");
    float rli[16];
#pragma unroll
    for (int r = 0; r < 16; ++r) rli[r] = __builtin_amdgcn_rcpf(li_l[crow(r, hi)]);
    unsigned char* Ow = Ob + (size_t)(wid * 32) * 1024;
#pragma unroll
    for (int r = 0; r < 16; ++r) { const int orow = crow(r, hi);
#pragma unroll
        for (int d0 = 0; d0 < 4; ++d0) Ow[(size_t)orow * 1024 + d0 * 32 + r32] = (unsigned char)(pk4_fp8(o[d0][r] * rli[r], 0.f, 0.f, 0.f) & 0xffu); }
#undef DMA_K
#undef DMA_V
#undef WAITBAR
#undef RESC
}
}
__device__ __forceinline__ void p_attention(Frame& F) {
    const unsigned char* Q8 = wsp<const unsigned char>(F, WS_Q8); const unsigned char* K8 = wsp<const unsigned char>(F, WS_K8); const unsigned char* VT = wsp<const unsigned char>(F, WS_V8T); unsigned char* O = wsp<unsigned char>(F, WS_H);
    for (int u = F.bid; u < NB * MH * 32; u += F.G) {
        const int pair = (u >> 8) * 8 + (u & 7), qb = (u & 255) >> 3, b = pair >> 3, h = pair & 7;
        att::unit(Q8 + ((size_t)pair * SEQ + qb * 256) * QKD, K8 + (size_t)pair * NKEY * K8ROW, VT + (size_t)pair * att::NT * att::VSLOT, O + ((size_t)(b * SEQ + qb * 256)) * 1024 + h * 128, F.lds, F.tid);
    }
    VM_WAIT(); __syncthreads();
}

constexpr int N_PHASES = 24;
struct Args { const float* in[37]; float* out; unsigned char* ws; int ph_lo, ph_hi, pad0, pad1; };
__global__ void __launch_bounds__(512, 2) mk_fwd(Args args) {
    extern __shared__ __attribute__((aligned(16))) unsigned char lds_raw[];
    Frame F;
    F.lds = (LAS unsigned char*)lds_raw;
    F.tid = threadIdx.x; F.lane = F.tid & 63; F.wave = __builtin_amdgcn_readfirstlane(F.tid >> 6);
    F.G = gridDim.x; F.bid = blockIdx.x;
    F.in = (const float* const __attribute__((address_space(4)))*)__builtin_amdgcn_kernarg_segment_ptr();
    F.out = args.out; F.ws = args.ws;
    volatile LAS unsigned* MISC = (volatile LAS unsigned*)(F.lds + MISC_OFF);
    if (F.tid < 64) MISC[F.tid] = 0u;
    __syncthreads();
    const int lo = args.ph_lo, hi = args.ph_hi;
    XcdBarrier bar; bar.bar = (unsigned*)(F.ws + WS_CTL) + CW_BAR; bar.x = 0; bar.st = nullptr;
    if (hi - lo > 1) bar = xcd_barrier_post((unsigned*)(F.ws + WS_CTL) + CW_BAR, MISC + 8);
#ifndef ONLY_PHASE
#define ONLY_PHASE -1
#endif
#define IN(k) ((ONLY_PHASE < 0 || ONLY_PHASE == (k)) && lo <= (k) && (k) < hi)
#define SEAM(k) do { if (IN(k) && IN((k) + 1)) xcd_barrier(bar); } while (0)
    LAS unsigned char* ring = F.lds;
    const LAS int* blk_e = (const LAS int*)(F.lds + MT_OFF) + 128;
    const LAS int* mtab = (const LAS int*)(F.lds + MT_OFF);

    if (IN(0)) { p0_mod(F); p0_rope(F); p0_convert(F); } SEAM(0);
    if (IN(1)) { p_norm1_l0(F); } SEAM(1);
    if (IN(2)) {
        pg8::DenseSched S; S.init(NTOK, PW, 2048, wsp<const bf16>(F, WS_WIN), F.G, F.bid);
        pg8::EpiBf16<pg8::MapPlain> E{pg8::MapPlain{wsp<bf16>(F, WS_P), PW}};
        pg8::gemm_phase(ring, wsp<const bf16>(F, WS_H), 2048, S, E);
        { const int slot = F.bid - S.nwg % F.G; if (slot >= 0) p_fill_convert(F, slot, F.G - S.nwg % F.G, 0, FILL_A); }
    } SEAM(2);
    if (IN(3)) { p_alr(F); p_gla_pre(F); } SEAM(3);
    if (IN(4)) {
        pg8::LrSched S; S.init(NTOK, LRN, LRK * 2, wsp<const bf16>(F, WS_WLR), F.G, F.bid);
        pg8::EpiBf16<pg8::MapPlain> E{pg8::MapPlain{wsp<bf16>(F, WS_LOUT), LRN}};
        pg8::gemm_phase(ring, wsp<const bf16>(F, WS_ALR), LRK * 2, S, E);
        { const int slot = F.bid - S.nwg % F.G; if (slot >= 0) p_fill_convert(F, slot, F.G - S.nwg % F.G, FILL_A, FILL_B); }
    } SEAM(4);
    if (IN(5)) { p_gla_scan(F); p_rwkv_scan(F); } SEAM(5);
    if (IN(6)) { p_mix_finish(F); } SEAM(6);
    if (IN(7)) {
        pg8::DenseSched S; S.init(NTOK, 1024, 2048, wsp<const bf16>(F, WS_WOUT), F.G, F.bid);
        pg8::EpiResid E{wsp<bf16>(F, WS_X1), F.in[I_X], F.in[I_CTX], wsp<const float>(F, WS_MOD), 0};
        pg8::gemm_phase(ring, wsp<const bf16>(F, WS_H), 2048, S, E);
        { const int slot = F.bid - S.nwg % F.G; if (slot >= 0) p_fill_convert(F, slot, F.G - S.nwg % F.G, FILL_B, FILL_C); }
    } SEAM(7);
    if (IN(8)) { p_norm2_route(F, 0, NTOK); } SEAM(8);
    if (IN(9)) { p_moe_scatter(F, NTOK); } SEAM(9);
    if (IN(10)) {
        moe_tables(F);
        pg8::MoeSched<true> S{mtab[64], 8, F.G, F.bid, blk_e, wsp<const unsigned>(F, WS_SORT), wsp<const unsigned char>(F, WS_WGU), (size_t)2048 * 1024};
        pg8::EpiSwiglu E{wsp<unsigned char>(F, WS_ACT), F.in[I_GUB], blk_e};
        pg8::gemm_phase<pg8::EpiSwiglu, pg8::MoeSched<true>, true>(ring, wsp<const unsigned char>(F, WS_H), 1024, S, E);
    } SEAM(10);
    if (IN(11)) {
        moe_tables(F);
        pg8::MoeSched<false> S{mtab[64], 4, F.G, F.bid, blk_e, nullptr, wsp<const unsigned char>(F, WS_WDN), (size_t)1024 * 1024};
        pg8::EpiDown E{wsp<unsigned char>(F, WS_YS), F.in[I_DNB], blk_e, wsp<const unsigned>(F, WS_SORT) + MAXSLOT, (const float*)(wsp<const unsigned>(F, WS_SORT) + 2 * MAXSLOT)};
        pg8::gemm_phase<pg8::EpiDown, pg8::MoeSched<false>, true>(ring, wsp<const unsigned char>(F, WS_ACT), 1024, S, E);
    } SEAM(11);
    if (IN(12)) { p_combine_norm1_l1(F); } SEAM(12);
    if (IN(13)) {
        pg8::DenseSched S; S.init(NTOK, 512, 1024, wsp<const unsigned char>(F, WS_WODIN), F.G, F.bid);
        pg8::EpiBf16<pg8::MapPlain> E{pg8::MapPlain{wsp<bf16>(F, WS_C), 512}};
        pg8::gemm_phase<pg8::EpiBf16<pg8::MapPlain>, pg8::DenseSched, true>(ring, wsp<const unsigned char>(F, WS_H), 1024, S, E);
        { const int slot = F.bid - S.nwg % F.G; if (slot >= 0) p_fill_convert(F, slot, F.G - S.nwg % F.G, FILL_C, FILL_D); }
    } SEAM(13);
    if (IN(14)) { p_mla_prep(F); } SEAM(14);
    if (IN(15)) {
        { pg8::DenseSched S; S.init(NLAT, 1536, 512, wsp<const bf16>(F, WS_WQUP), F.G, F.bid);
          pg8::EpiQ8 E{wsp<unsigned char>(F, WS_Q8), wsp<const f32x2>(F, WS_ROPE)};
          pg8::gemm_phase(ring, wsp<const bf16>(F, WS_QN), 512, S, E); }
        { pg8::DenseSched S; S.init(NTOK, 2048, 512, wsp<const bf16>(F, WS_WKVUP), F.G, F.bid);
          pg8::EpiKV8 E{wsp<unsigned char>(F, WS_K8), wsp<unsigned char>(F, WS_V8T)};
          pg8::gemm_phase(ring, wsp<const bf16>(F, WS_KVN), 512, S, E);
          { const int slot = F.bid - S.nwg % F.G; if (slot >= 0) p_fill_convert(F, slot, F.G - S.nwg % F.G, FILL_D, FILL_E); } }
    } SEAM(15);
    if (IN(17)) { p_attention(F); } SEAM(17);
    if (IN(18)) {
        pg8::DenseSched S; S.init(NLAT, 1024, 1024, wsp<const unsigned char>(F, WS_WODOUT), F.G, F.bid);
        pg8::EpiResid E{wsp<bf16>(F, WS_X1), F.in[I_X], F.in[I_CTX], wsp<const float>(F, WS_MOD), 1};
        pg8::gemm_phase<pg8::EpiResid, pg8::DenseSched, true>(ring, wsp<const unsigned char>(F, WS_H), 1024, S, E);
    } SEAM(18);
    if (IN(19)) { p_norm2_route(F, 1, NLAT); } SEAM(19);
    if (IN(20)) { p_moe_scatter(F, NLAT); } SEAM(20);
    if (IN(21)) {
        moe_tables(F);
        pg8::MoeSched<true> S{mtab[64], 8, F.G, F.bid, blk_e, wsp<const unsigned>(F, WS_SORT), wsp<const unsigned char>(F, WS_WGU) + (size_t)32 * 2048 * 1024, (size_t)2048 * 1024};
        pg8::EpiSwiglu E{wsp<unsigned char>(F, WS_ACT), F.in[I_GUB] + 32 * 2048, blk_e};
        pg8::gemm_phase<pg8::EpiSwiglu, pg8::MoeSched<true>, true>(ring, wsp<const unsigned char>(F, WS_H), 1024, S, E);
    } SEAM(21);
    if (IN(22)) {
        moe_tables(F);
        pg8::MoeSched<false> S{mtab[64], 4, F.G, F.bid, blk_e, nullptr, wsp<const unsigned char>(F, WS_WDN) + (size_t)32 * 1024 * 1024, (size_t)1024 * 1024};
        pg8::EpiDown E{wsp<unsigned char>(F, WS_YS), F.in[I_DNB] + 32 * 1024, blk_e, wsp<const unsigned>(F, WS_SORT) + MAXSLOT, (const float*)(wsp<const unsigned>(F, WS_SORT) + 2 * MAXSLOT)};
        pg8::gemm_phase<pg8::EpiDown, pg8::MoeSched<false>, true>(ring, wsp<const unsigned char>(F, WS_ACT), 1024, S, E);
    } SEAM(22);
    if (IN(23)) { p_final(F); }
#undef IN
#undef SEAM
}

extern "C" void kernel_launch(void* const* d_in, const int* in_sizes, int n_in, void* d_out, int out_size, void* d_ws, size_t ws_size, hipStream_t stream) {
    static int grid = 0;
    if (grid == 0) {
        if (n_in != 37 || out_size != NLAT * DM || ws_size < WS_END) { fprintf(stderr, "kernel_launch: built for 37 inputs, %d outputs, >= %zu bytes of workspace; got n_in %d, out %d, ws %zu\n", NLAT * DM, (size_t)WS_END, n_in, out_size, ws_size); grid = -1; return; }
        int dev = 0, cus = 0, per_cu = 0;
        if (hipGetDevice(&dev) != hipSuccess || hipDeviceGetAttribute(&cus, hipDeviceAttributeMultiprocessorCount, dev) != hipSuccess) { grid = -1; return; }
        if (hipFuncSetAttribute((const void*)mk_fwd, hipFuncAttributeMaxDynamicSharedMemorySize, LDS_BYTES) != hipSuccess) { fprintf(stderr, "kernel_launch: hipFuncSetAttribute failed\n"); grid = -1; return; }
        if (hipOccupancyMaxActiveBlocksPerMultiprocessor(&per_cu, (const void*)mk_fwd, 512, LDS_BYTES) != hipSuccess || per_cu < 1) fprintf(stderr, "kernel_launch: occupancy query says %d\n", per_cu);
        (void)hipGetLastError();
        grid = cus;
    }
    if (grid < 0) return;
    if (hipMemsetAsync((char*)d_ws + WS_CTL, 0, CTL_ZERO_BYTES, stream) != hipSuccess) return;
    Args a{};
    for (int i = 0; i < 37; ++i) a.in[i] = (const float*)d_in[i];
    a.out = (float*)d_out; a.ws = (unsigned char*)d_ws;
#if MK_N_LAUNCHES == 1
    a.ph_lo = 0; a.ph_hi = N_PHASES;
    hipLaunchKernelGGL(mk_fwd, dim3(grid), dim3(512), LDS_BYTES, stream, a);
#else
    for (int p = 0; p < N_PHASES; ++p) { a.ph_lo = p; a.ph_hi = p + 1; hipLaunchKernelGGL(mk_fwd, dim3(grid), dim3(512), LDS_BYTES, stream, a); }
#endif
    const hipError_t le = hipPeekAtLastError();
    if (le != hipSuccess) fprintf(stderr, "kernel_launch: launch failed: %s\n", hipGetErrorName(le));
}
```

```cpp
#include <hip/hip_runtime.h>
#include <cstdio>
#include <cstdint>

#ifndef MK_N_LAUNCHES
#define MK_N_LAUNCHES 1
#endif

#define GAS __attribute__((address_space(1)))
#define LAS __attribute__((address_space(3)))
typedef unsigned short bf16;
typedef short bf16x8 __attribute__((ext_vector_type(8)));
typedef short s16x4 __attribute__((ext_vector_type(4)));
typedef float f32x4 __attribute__((ext_vector_type(4)));
typedef float f32x2 __attribute__((ext_vector_type(2)));
typedef float f32x16 __attribute__((ext_vector_type(16)));
typedef unsigned u32x4 __attribute__((ext_vector_type(4)));
typedef unsigned u32x2 __attribute__((ext_vector_type(2)));
typedef int i32x4 __attribute__((ext_vector_type(4)));
typedef int i32x8 __attribute__((ext_vector_type(8)));
typedef GAS unsigned gu32;
#define RLX_AGENT __ATOMIC_RELAXED, __HIP_MEMORY_SCOPE_AGENT
#define LDS_WAIT() asm volatile("s_waitcnt lgkmcnt(0)" ::: "memory")
#define VM_WAIT() asm volatile("s_waitcnt vmcnt(0)" ::: "memory")
#define SBAR() __builtin_amdgcn_sched_barrier(0)

constexpr int DM = 1024, NB = 8, SEQ = 8192, CTXL = 256;
constexpr int NLAT = NB * SEQ;
constexpr int NCTX = NB * CTXL;
constexpr int NTOK = NLAT + NCTX;
constexpr int GLA_COLS = 1552, RW_COLS = 1824, RW0 = 1664, PW = 3584;
constexpr int LRK = 384, LRN = 2560;
constexpr int NE = 32, TOPK = 4, DE = 1024;
constexpr int NASG0 = NTOK * TOPK;
constexpr int MAXSLOT = NASG0 + NE * 256;
constexpr int YS_DUMMY = NASG0;
constexpr int NKEY = CTXL + SEQ;
constexpr float YS_SCALE = 16.f;
constexpr int MH = 8, QKD = 192, VD = 128;

constexpr size_t MiB = 1u << 20;
constexpr size_t WS_CTL = 0, CTL_ZERO_BYTES = 1 * MiB;
constexpr size_t WS_MOD = 1 * MiB;
constexpr size_t WS_ROPE = 2 * MiB;
constexpr size_t WS_WIN = 4 * MiB;
constexpr size_t WS_WOUT = 11 * MiB;
constexpr size_t WS_WLR = 13 * MiB;
constexpr size_t WS_WODIN = 15 * MiB;
constexpr size_t WS_WQUP = 16 * MiB;
constexpr size_t WS_WKVUP = 17 * MiB;
constexpr size_t WS_WODOUT = 18 * MiB;
constexpr size_t WS_ROUTE = 20 * MiB;
constexpr size_t WS_WGU = 24 * MiB;
constexpr size_t WS_WDN = 280 * MiB;
constexpr size_t WS_X1 = 408 * MiB;
constexpr size_t WS_H = 672 * MiB;
constexpr size_t WS_ARENA = 804 * MiB;
constexpr size_t WS_P = WS_ARENA;
constexpr size_t WS_LOUT = WS_P + 462 * MiB;
constexpr size_t WS_GLAO = WS_LOUT + 330 * MiB;
constexpr size_t WS_RWY = WS_GLAO + 132 * MiB;
constexpr size_t WS_ALR = WS_RWY + 132 * MiB;
constexpr size_t WS_BONUS = WS_ALR + 50 * MiB;
constexpr size_t WS_ACT = WS_ARENA;
constexpr size_t WS_YS = WS_ACT + 544 * MiB;
constexpr size_t WS_C = WS_ARENA;
constexpr size_t WS_QN = WS_C + 132 * MiB;
constexpr size_t WS_KVN = WS_QN + 32 * MiB;
constexpr size_t WS_Q8 = WS_KVN + 33 * MiB;
constexpr size_t WS_QR = WS_Q8 + 101 * MiB;
constexpr size_t WS_K8 = WS_QR + 64 * MiB;
constexpr size_t WS_V8T = WS_K8 + 108 * MiB;
constexpr size_t WS_V = WS_V8T + 67 * MiB;
constexpr size_t WS_END = 2048 * MiB;
static_assert(WS_BONUS + 5 * MiB <= WS_END && WS_YS + 529 * MiB <= WS_END && WS_V + 132 * MiB <= WS_END, "d_ws map");
constexpr int K8ROW = 208;
constexpr size_t RT_E = 0;
constexpr size_t RT_POS = 512 * 1024;
constexpr size_t RT_GATE = 1024 * 1024 + 512 * 1024;
constexpr size_t RT_HIST = 3 * MiB;
constexpr size_t RT_TOK = 3 * MiB + 64 * 1024;
constexpr size_t WS_SORT = WS_YS + 529 * MiB;
static_assert(WS_SORT + 4 * MiB <= WS_END, "sort lists");

constexpr int CW_TMO = 0, CW_CODE = 1;
constexpr int CW_BAR = 4096;

constexpr int RING_BYTES = 131072;
constexpr int LDS_BYTES = 163840;
constexpr int MISC_OFF = 163840 - 256;

__device__ __forceinline__ unsigned f2bf(float f) { unsigned u = __builtin_bit_cast(unsigned, f); return (u + 0x7fffu + ((u >> 16) & 1u)) >> 16; }
__device__ __forceinline__ float bf2f(unsigned h) { return __builtin_bit_cast(float, h << 16); }
typedef __bf16 bf16x2v __attribute__((ext_vector_type(2)));
__device__ __forceinline__ unsigned cvt_pk_bf16(float lo, float hi) { const f32x2 v = {lo, hi}; const bf16x2v r = __builtin_convertvector(v, bf16x2v); return __builtin_bit_cast(unsigned, r); }
__device__ __forceinline__ unsigned pk4_fp8(float a, float b, float c, float d) { unsigned w = 0u; w = (unsigned)__builtin_amdgcn_cvt_pk_fp8_f32(a, b, (int)w, false); w = (unsigned)__builtin_amdgcn_cvt_pk_fp8_f32(c, d, (int)w, true); return w; }
__device__ __forceinline__ float bflo(unsigned w) { return __builtin_bit_cast(float, w << 16); }
__device__ __forceinline__ float bfhi(unsigned w) { return __builtin_bit_cast(float, w & 0xffff0000u); }
__device__ __forceinline__ float wave_sum(float v) {
#pragma unroll
    for (int o = 1; o < 64; o <<= 1) v += __shfl_xor(v, o);
    return v;
}
__device__ __forceinline__ float sigmoidf_(float x) { return 1.f / (1.f + __expf(-x)); }

namespace pg8 {
constexpr int BM = 256, BK = 64, HALF = 128, HTB = HALF * BK * 2, STAGE_BYTES = 8 * HTB;
__host__ __device__ __forceinline__ int lds_byte(int r, int c) { const int st = (r >> 4) * 2 + (c >> 5), rr = r & 15, cc = c & 31, ob = rr * 64 + cc * 2; return st * 1024 + (ob ^ (((ob >> 9) & 1) << 5)); }
__host__ __device__ __forceinline__ void stage_rc(int b, int& R, int& C) { const int st = b / 1024, sb = b % 1024, swz = sb ^ (((sb >> 9) & 1) << 5); R = (st >> 1) * 16 + swz / 64; C = (st & 1) * 32 + (swz % 64) / 2; }
__host__ __device__ __forceinline__ int perm32(int rho) { const int n = rho >> 4, i = rho & 15; return 8 * (i >> 2) + 4 * n + (i & 3); }
struct Unit { int pm, pn; };

template <class Epi, class Sched, bool FP8 = false>
__device__ __forceinline__ void gemm_phase(LAS unsigned char* lds, const void* Abase, const int KBc, const Sched& S, const Epi& E) {
    int K = KBc; asm volatile("" : "+s"(K));
    const int tid = threadIdx.x, wid = __builtin_amdgcn_readfirstlane(tid >> 6), lane = tid & 63, wr = wid >> 2, wc = wid & 3, fr = lane & 15, fq = lane >> 4;
    const int nt = K / 128;
    int sR[2], sC[2]; unsigned voffB[2];
#pragma unroll
    for (int i = 0; i < 2; ++i) { int R, C; stage_rc(tid * 16 + i * 8192, R, C); const int Rb = Epi::PERM ? ((R & ~31) + perm32(R & 31)) : R; sR[i] = R; sC[i] = C; voffB[i] = (unsigned)(Rb * K + C * 2); }
    const size_t kstep = (size_t)(BK * 2);
    const size_t hstep = (size_t)HALF * K;
    const unsigned ldsw = (unsigned)wid * 1024u;
    const int aoff = lds_byte(wr * 64 + fr, fq * 8), boff = lds_byte(wc * 32 + fr, fq * 8);
    const char* Ab = (const char*)Abase;
#define PG8_SA(b, h) (((b) * 2 + (h)) * HTB)
#define PG8_SB(b, h) ((4 + (b) * 2 + (h)) * HTB)
#define PG8_STAGE(bufoff, gbase, voff) do { _Pragma("unroll") for (int _i = 0; _i < 2; ++_i) \
        __builtin_amdgcn_global_load_lds((const unsigned*)((const char*)(gbase) + (voff)[_i]), (LAS unsigned*)(lds + (bufoff) + ldsw + _i * 8192), 16, 0, 0); } while (0)
#define PG8_STAGEA(bufoff, kb, ao, h) do { _Pragma("unroll") for (int _i = 0; _i < 2; ++_i) \
        __builtin_amdgcn_global_load_lds((const unsigned*)((Ab + (kb)) + (ao)[h][_i]), (LAS unsigned*)(lds + (bufoff) + ldsw + _i * 8192), 16, 0, 0); } while (0)
#define PG8_STAGEA2(bufoff, kb, h) do { _Pragma("unroll") for (int _i = 0; _i < 2; ++_i) \
        __builtin_amdgcn_global_load_lds((const unsigned*)((Ab + (kb)) + (last ? nao[h][_i] : cao[h][_i])), (LAS unsigned*)(lds + (bufoff) + ldsw + _i * 8192), 16, 0, 0); } while (0)
#define PG8_LD8(p) __builtin_shufflevector(*(const LAS i32x4*)(p), *(const LAS i32x4*)((p) + 1024), 0, 1, 2, 3, 4, 5, 6, 7)
#define PG8_LDA(dst, b, h) do { _Pragma("unroll") for (int m = 0; m < 4; ++m) dst[m] = PG8_LD8(lds + PG8_SA(b, h) + aoff + m * 2048); } while (0)
#define PG8_LDB(dst, b, h) do { _Pragma("unroll") for (int n = 0; n < 2; ++n) dst[n] = PG8_LD8(lds + PG8_SB(b, h) + boff + n * 2048); } while (0)
#define PG8_MMA(ai, bj, At, Bt) do { __builtin_amdgcn_s_setprio(1); _Pragma("unroll") for (int m = 0; m < 4; ++m) _Pragma("unroll") for (int n = 0; n < 2; ++n) { \
        if constexpr (FP8) asm volatile("v_mfma_scale_f32_16x16x128_f8f6f4 %0, %1, %2, %0, %3, %4 op_sel_hi:[0,0,0]" : "+v"(acc[ai][bj][m][n]) : "v"(Bt[n]), "v"(At[m]), "v"(scl_w), "v"(scl_x)); \
        else { acc[ai][bj][m][n] = __builtin_amdgcn_mfma_f32_16x16x32_bf16(__builtin_bit_cast(bf16x8, __builtin_shufflevector(Bt[n], Bt[n], 0, 1, 2, 3)), __builtin_bit_cast(bf16x8, __builtin_shufflevector(At[m], At[m], 0, 1, 2, 3)), acc[ai][bj][m][n], 0, 0, 0); \
               acc[ai][bj][m][n] = __builtin_amdgcn_mfma_f32_16x16x32_bf16(__builtin_bit_cast(bf16x8, __builtin_shufflevector(Bt[n], Bt[n], 4, 5, 6, 7)), __builtin_bit_cast(bf16x8, __builtin_shufflevector(At[m], At[m], 4, 5, 6, 7)), acc[ai][bj][m][n], 0, 0, 0); } } \
        __builtin_amdgcn_s_setprio(0); } while (0)
#define PG8_WAIT_V(n) asm volatile("s_waitcnt vmcnt(" #n ")" ::: "memory")
#define PG8_WAIT_L(n) asm volatile("s_waitcnt lgkmcnt(" #n ")" ::: "memory")
#define PG8_BAR __builtin_amdgcn_s_barrier()
#define PG8_SCHED __builtin_amdgcn_sched_barrier(0)
    Unit cur, nxt; int ui = 0;
    if (!S.next(0, cur)) return;
    int ntc = S.ktiles(cur, nt);
    f32x4 acc[2][2][4][2];
#pragma unroll
    for (int a = 0; a < 2; ++a)
#pragma unroll
        for (int b = 0; b < 2; ++b)
#pragma unroll
            for (int m = 0; m < 4; ++m)
#pragma unroll
                for (int n = 0; n < 2; ++n) acc[a][b][m][n] = (f32x4){0.f, 0.f, 0.f, 0.f};
    i32x8 At[4], B0[2], B1[2];
    int scl_w = 0x7A7A7A7A, scl_x = 0x7F7F7F7F;
    asm volatile("" : "+v"(scl_w), "+v"(scl_x));
    unsigned cao[2][2], nao[2][2];
    S.a_offs(cur, cao, sR, sC);
    const char* cB = S.b_tile(cur);
    PG8_STAGE(PG8_SB(0, 0), cB, voffB); PG8_STAGE(PG8_SB(0, 1), cB + hstep, voffB); PG8_STAGEA(PG8_SA(0, 0), 0, cao, 0); PG8_STAGEA(PG8_SA(0, 1), 0, cao, 1);
    if (wr == 1) PG8_BAR;
    PG8_WAIT_V(2); PG8_BAR;
    PG8_STAGE(PG8_SB(1, 0), cB + kstep, voffB); PG8_STAGEA(PG8_SA(1, 0), kstep, cao, 0); PG8_STAGE(PG8_SB(1, 1), cB + hstep + kstep, voffB);
    PG8_WAIT_V(6); PG8_BAR;
    for (;;) {
        const bool has_next = S.next(ui + 1, nxt);
        const char* nB = cB;
        if (has_next) { S.a_offs(nxt, nao, sR, sC); nB = S.b_tile(nxt); }
        else {
#pragma unroll
            for (int h = 0; h < 2; ++h)
#pragma unroll
                for (int i = 0; i < 2; ++i) nao[h][i] = cao[h][i];
        }
        for (int t = 0; t < ntc; t += 2) {
            const bool last = (t == ntc - 2);
            const size_t a1k = (size_t)(t + 1) * kstep;
            const size_t a2k = last ? 0 : (size_t)(t + 2) * kstep; const char* b2 = last ? nB : cB + (size_t)(t + 2) * kstep;
            const size_t a3k = a2k + kstep; const char* b3 = b2 + kstep;
            PG8_LDB(B0, 0, 0); PG8_LDB(B1, 0, 1); PG8_SCHED; PG8_LDA(At, 0, 0); PG8_STAGEA(PG8_SA(1, 1), a1k, cao, 1);
            PG8_WAIT_V(8); PG8_WAIT_L(0); PG8_BAR; PG8_MMA(0, 0, At, B0); PG8_MMA(0, 1, At, B1); PG8_BAR; PG8_SCHED;
            PG8_LDA(At, 0, 1); PG8_STAGE(PG8_SB(0, 0), b2, voffB); PG8_STAGE(PG8_SB(0, 1), b2 + hstep, voffB); PG8_STAGEA2(PG8_SA(0, 0), a2k, 0);
            PG8_WAIT_V(8); PG8_WAIT_L(0); PG8_BAR; PG8_MMA(1, 0, At, B0); PG8_MMA(1, 1, At, B1); PG8_BAR; PG8_SCHED;
            PG8_LDB(B0, 1, 0); PG8_LDB(B1, 1, 1); PG8_SCHED; PG8_LDA(At, 1, 0); PG8_STAGEA2(PG8_SA(0, 1), a2k, 1);
            PG8_WAIT_V(8); PG8_WAIT_L(0); PG8_BAR; PG8_MMA(0, 0, At, B0); PG8_MMA(0, 1, At, B1); PG8_BAR; PG8_SCHED;
            PG8_LDA(At, 1, 1); PG8_STAGE(PG8_SB(1, 0), b3, voffB); PG8_STAGE(PG8_SB(1, 1), b3 + hstep, voffB); PG8_STAGEA2(PG8_SA(1, 0), a3k, 0);
            PG8_WAIT_V(8); PG8_WAIT_L(0); PG8_BAR; PG8_MMA(1, 0, At, B0); PG8_MMA(1, 1, At, B1); PG8_BAR; PG8_SCHED;
        }
        if (wr == 0) PG8_BAR;
        if constexpr (FP8) asm volatile("s_nop 15\n\ts_nop 7" ::: "memory");
        E(acc, cur, wr, wc, fr, fq);
        if (!has_next) break;
#pragma unroll
        for (int a = 0; a < 2; ++a)
#pragma unroll
            for (int b = 0; b < 2; ++b)
#pragma unroll
                for (int m = 0; m < 4; ++m)
#pragma unroll
                    for (int n = 0; n < 2; ++n) acc[a][b][m][n] = (f32x4){0.f, 0.f, 0.f, 0.f};
        cur = nxt; cB = nB; ++ui; ntc = S.ktiles(cur, nt);
#pragma unroll
        for (int h = 0; h < 2; ++h)
#pragma unroll
            for (int i = 0; i < 2; ++i) cao[h][i] = nao[h][i];
        if (wr == 1) PG8_BAR;
    }
    PG8_WAIT_V(0);
    PG8_BAR;
#undef PG8_SA
#undef PG8_SB
#undef PG8_STAGE
#undef PG8_STAGEA
#undef PG8_STAGEA2
#undef PG8_LDA
#undef PG8_LDB
#undef PG8_MMA
#undef PG8_WAIT_V
#undef PG8_WAIT_L
#undef PG8_BAR
#undef PG8_SCHED
}
}

#define XB_TMO      128
#define XB_XCNT(j)  (256  + 64 * (j))
#define XB_XSUB(j)  (1280 + 64 * (j))
#define XB_XGEN(j)  (2304 + 64 * (j))
#define XB_TOP      3328
#define XB_TOPGEN   3392
#define XCD_BAR_WORDS 3456
#define XB_SPIN_CAP (1u << 22)
__device__ __forceinline__ unsigned xb_ld(unsigned* p)              { return __hip_atomic_load(p, __ATOMIC_RELAXED, __HIP_MEMORY_SCOPE_AGENT); }
__device__ __forceinline__ unsigned xb_add(unsigned* p, unsigned v) { return __hip_atomic_fetch_add(p, v, __ATOMIC_RELAXED, __HIP_MEMORY_SCOPE_AGENT); }
__device__ __forceinline__ unsigned xb_xcc_id() { return (unsigned)__builtin_amdgcn_s_getreg((3 << 11) | 20) & 0xFu; }
#define XB_SPIN(cond, bar) do { unsigned _sp = 0; while (cond) { __builtin_amdgcn_s_sleep(1); \
    if ((++_sp & 255u) == 0u) { if (xb_ld(&(bar)[XB_TMO])) break; if (_sp > XB_SPIN_CAP) { atomicAdd(&(bar)[XB_TMO], 1u); break; } } } } while (0)
struct XcdBarrier { unsigned* bar; unsigned x; volatile LAS unsigned* st; };
__device__ __forceinline__ XcdBarrier xcd_barrier_post(unsigned* bar, volatile LAS unsigned* st) {
    XcdBarrier b; b.bar = bar; b.x = xb_xcc_id(); b.st = st;
    if (threadIdx.x == 0) (void)xb_add(&bar[XB_XCNT(b.x)], 1u);
    return b;
}
__device__ __forceinline__ void xcd_barrier_complete(unsigned* bar, unsigned x, unsigned& nloc, unsigned& nx) {
    const unsigned G = gridDim.x * gridDim.y * gridDim.z;
    unsigned sum, cnt, mine, sp = 0u;
    for (;;) {
        sum = 0u; cnt = 0u; mine = 0u;
#pragma unroll
        for (unsigned j = 0; j < 16; ++j) { const unsigned c = xb_ld(&bar[XB_XCNT(j)]); sum += c; cnt += (c > 0u) ? 1u : 0u; mine = (j == x) ? c : mine; }
        if (sum == G) break;
        __builtin_amdgcn_s_sleep(1);
        if ((++sp & 255u) == 0u) { if (xb_ld(&bar[XB_TMO])) break; if (sp > XB_SPIN_CAP) { atomicAdd(&bar[XB_TMO], 1u); break; } }
    }
    nloc = mine > 0u ? mine : 1u; nx = cnt > 0u ? cnt : 1u;
}
__device__ __forceinline__ void xcd_barrier(const XcdBarrier& b) {
    asm volatile("s_waitcnt vmcnt(0)" ::: "memory");
    __syncthreads();
    if (threadIdx.x == 0) {
        unsigned* bar = b.bar;
        __builtin_amdgcn_s_waitcnt(0);
        unsigned nloc = b.st[0], nx = b.st[1];
        if (nloc == 0u) { xcd_barrier_complete(bar, b.x, nloc, nx); b.st[0] = nloc; b.st[1] = nx; }
        const unsigned old = xb_add(&bar[XB_XSUB(b.x)], 1u);
        const unsigned gen = old / nloc;
        if (old + 1u == (gen + 1u) * nloc) {
            __builtin_amdgcn_fence(__ATOMIC_RELEASE, "agent");
            asm volatile("s_waitcnt vmcnt(0)" ::: "memory");
            const unsigned og = xb_add(&bar[XB_TOP], 1u);
            const unsigned tg = og / nx;
            if (og + 1u == (tg + 1u) * nx) xb_add(&bar[XB_TOPGEN], 1u);
            else XB_SPIN(xb_ld(&bar[XB_TOPGEN]) == tg, bar);
            __builtin_amdgcn_fence(__ATOMIC_ACQUIRE, "agent");
            xb_add(&bar[XB_XGEN(b.x)], 1u);
            asm volatile("s_waitcnt vmcnt(0)" ::: "memory");
        } else {
            XB_SPIN(xb_ld(&bar[XB_XGEN(b.x)]) == gen, bar);
            __builtin_amdgcn_fence(__ATOMIC_ACQUIRE, "agent");
            asm volatile("s_waitcnt vmcnt(0)" ::: "memory");
        }
    }
    __syncthreads();
}

struct Frame {
    LAS unsigned char* lds;
    int tid, lane, wave, G, bid;
    const float* const __attribute__((address_space(4)))* in;
    float* out;
    unsigned char* ws;
};
enum { I_X = 0, I_C, I_CTX, I_CCTX, I_ADAW, I_ADAB, I_N1G, I_N2G, I_EVWIN, I_EVWOUT, I_GKUP, I_GKB, I_GNG, I_MU, I_W0, I_W2, I_A0, I_A2, I_KK, I_KA, I_RK, I_G2, I_LNW, I_LNB,
       I_ODWIN, I_QNORM, I_WQUP, I_KVNORM, I_WKVUP, I_ODWOUT, I_RW, I_RB, I_GUW, I_GUB, I_DNW, I_DNB, I_FNG };
template <class T> __device__ __forceinline__ T* wsp(const Frame& F, size_t off) { return (T*)(F.ws + off); }
__device__ __forceinline__ int mod_row(int row) { return row < NLAT ? (row >> 13) : 8; }
__device__ __forceinline__ const float* mod_ptr(const Frame& F, int layer, int row, int which) { return wsp<const float>(F, WS_MOD) + ((size_t)(layer * 9 + mod_row(row)) * 6 + which) * 1024; }

__device__ __forceinline__ void p0_mod(Frame& F) {
    LAS float* s = (LAS float*)F.lds;
    LAS float* red = (LAS float*)(F.lds + 9 * 1024 * 4);
    const float* c = F.in[I_C]; const float* cc = F.in[I_CCTX]; const float* W = F.in[I_ADAW]; const float* Bv = F.in[I_ADAB];
    for (int idx = F.tid; idx < 9 * 1024; idx += 512) { const int r = idx >> 10, k = idx & 1023; const float v = r < 8 ? c[r * 1024 + k] : cc[k]; s[idx] = v / (1.f + __expf(-v)); }
    __syncthreads();
    for (int item = F.bid; item < 192; item += F.G) {
        const int l = item / 96, n0 = (item % 96) * 64;
        float acc[9];
#pragma unroll
        for (int r = 0; r < 9; ++r) acc[r] = 0.f;
        const float* wp = W + ((size_t)l * 1024 + F.wave * 128) * 6144 + n0 + F.lane;
        for (int k = 0; k < 128; ++k) { const float wv = wp[(size_t)k * 6144];
#pragma unroll
            for (int r = 0; r < 9; ++r) acc[r] += s[r * 1024 + F.wave * 128 + k] * wv; }
#pragma unroll
        for (int r = 0; r < 9; ++r) red[(F.wave * 9 + r) * 64 + F.lane] = acc[r];
        __syncthreads();
        for (int idx = F.tid; idx < 576; idx += 512) { const int r = idx >> 6, ln = idx & 63; float v = Bv[l * 6144 + n0 + ln];
#pragma unroll
            for (int w = 0; w < 8; ++w) v += red[(w * 9 + r) * 64 + ln];
            wsp<float>(F, WS_MOD)[(size_t)(l * 9 + r) * 6144 + n0 + ln] = v; }
        __syncthreads();
    }
}
__device__ __forceinline__ void p0_rope(Frame& F) {
    for (int idx = F.bid * 512 + F.tid; idx < SEQ * 32; idx += F.G * 512) {
        const int t = idx >> 5, i = idx & 31;
        const float fr = (float)pow(10000.0, -(double)(i & 15) / 16.0);
        const float pos = (float)(i < 16 ? (t >> 6) : (t & 63));
        const float ang = pos * fr;
        const double a = (double)ang;
        wsp<f32x2>(F, WS_ROPE)[idx] = (f32x2){(float)cos(a), (float)sin(a)};
    }
}
template <class V> __device__ __forceinline__ void cvt_item(const V& val, bf16* dst, int K, int item, int nblk, LAS float* scr, int lane) {
    const int kb = item / nblk, nb = item % nblk, k0 = 64 * kb, n0 = 32 * nb;
#pragma unroll 8
    for (int i = 0; i < 32; ++i) { const int kk = 2 * i + (lane >> 5); scr[kk * 33 + (lane & 31)] = val(n0 + (lane & 31), k0 + kk); }
    LDS_WAIT(); asm volatile("" ::: "memory");
    const int c = lane & 7;
#pragma unroll
    for (int j = 0; j < 4; ++j) { const int n = (lane >> 3) + 8 * j; const LAS float* sp = scr + (8 * c) * 33 + n;
        u32x4 o; o.x = f2bf(sp[0 * 33]) | (f2bf(sp[1 * 33]) << 16); o.y = f2bf(sp[2 * 33]) | (f2bf(sp[3 * 33]) << 16); o.z = f2bf(sp[4 * 33]) | (f2bf(sp[5 * 33]) << 16); o.w = f2bf(sp[6 * 33]) | (f2bf(sp[7 * 33]) << 16);
        *(u32x4*)(dst + (size_t)(n0 + n) * K + k0 + 8 * c) = o; }
    LDS_WAIT(); asm volatile("" ::: "memory");
}
template <class V> __device__ __forceinline__ void cvt_item_fp8(const V& val, unsigned char* dst, int K, int item, int nblk, LAS float* scr, int lane) {
    const int kb = item / nblk, nb = item % nblk, k0 = 64 * kb, n0 = 32 * nb;
#pragma unroll 8
    for (int i = 0; i < 32; ++i) { const int kk = 2 * i + (lane >> 5); scr[kk * 33 + (lane & 31)] = 32.f * val(n0 + (lane & 31), k0 + kk); }
    LDS_WAIT(); asm volatile("" ::: "memory");
    const int c = lane & 7;
#pragma unroll
    for (int j = 0; j < 4; ++j) { const int n = (lane >> 3) + 8 * j; const LAS float* sp = scr + (8 * c) * 33 + n;
        *(u32x2*)(dst + (size_t)(n0 + n) * K + k0 + 8 * c) = (u32x2){pk4_fp8(sp[0 * 33], sp[1 * 33], sp[2 * 33], sp[3 * 33]), pk4_fp8(sp[4 * 33], sp[5 * 33], sp[6 * 33], sp[7 * 33])}; }
    LDS_WAIT(); asm volatile("" ::: "memory");
}
template <class V4> __device__ __forceinline__ void cvt_item_fp8_wide(const V4& col4, const float* W, int ld, unsigned char* dst, int K, int item, int nblk, LAS float* scr, int lane) {
    const int kb = item / nblk, nb = item % nblk, k0 = 64 * kb, n0 = 64 * nb;
    const float* src = W + (size_t)(k0 + (lane >> 4)) * ld + col4(n0 + (lane & 15) * 4);
#pragma unroll
    for (int i = 0; i < 16; ++i) { const f32x4 v = *(const f32x4*)(src + (size_t)(4 * i) * ld); LAS float* sp = scr + (4 * i + (lane >> 4)) * 68 + (lane & 15) * 4; *(LAS f32x4*)sp = v; }
    LDS_WAIT(); asm volatile("" ::: "memory");
    const int nl = lane >> 2, part = lane & 3;
#pragma unroll
    for (int j = 0; j < 4; ++j) { const int n = nl + 16 * j; const LAS float* sp = scr + (part * 16) * 68 + n; unsigned o[4];
#pragma unroll
        for (int e = 0; e < 4; ++e) o[e] = pk4_fp8(32.f * sp[(4 * e) * 68], 32.f * sp[(4 * e + 1) * 68], 32.f * sp[(4 * e + 2) * 68], 32.f * sp[(4 * e + 3) * 68]);
        *(u32x4*)(dst + (size_t)(n0 + n) * K + k0 + part * 16) = (u32x4){o[0], o[1], o[2], o[3]}; }
    LDS_WAIT(); asm volatile("" ::: "memory");
}
struct C4Gu { __device__ __forceinline__ int operator()(int n) const { return ((n & 128) ? 1024 : 0) + (n >> 8) * 128 + (n & 127); } };
struct C4Id { __device__ __forceinline__ int operator()(int n) const { return n; } };
struct VPlain { const float* W; int ldn, Nr, Kr; __device__ __forceinline__ float operator()(int n, int k) const { return (n < Nr && k < Kr) ? W[(size_t)k * ldn + n] : 0.f; } };
struct VWin { const float* W; __device__ __forceinline__ float operator()(int n, int k) const { const int col = n < GLA_COLS ? n : ((n >= RW0 && n < RW0 + RW_COLS) ? n - (RW0 - GLA_COLS) : -1); return col >= 0 ? W[(size_t)k * (GLA_COLS + RW_COLS) + col] : 0.f; } };
struct VQup { const float* W; __device__ __forceinline__ float operator()(int n, int k) const { const int col = n < 1024 ? (n >> 7) * 192 + (n & 127) : ((n - 1024) >> 6) * 192 + 128 + ((n - 1024) & 63); return W[(size_t)k * 1536 + col]; } };
struct VGu { const float* W; __device__ __forceinline__ float operator()(int n, int k) const { const int col = ((n & 128) ? 1024 : 0) + (n >> 8) * 128 + (n & 127); return W[(size_t)k * 2048 + col]; } };
struct VLr { const float *w2, *a2, *g2; __device__ __forceinline__ float operator()(int n, int k) const {
        if (n < 1024) return k < 64 ? w2[((size_t)(n >> 9) * 64 + k) * 512 + (n & 511)] : 0.f;
        if (n < 2048) return (k >= 64 && k < 128) ? a2[((size_t)((n - 1024) >> 9) * 64 + (k - 64)) * 512 + (n & 511)] : 0.f;
        return (k >= 128 && k < 288) ? g2[(size_t)(k - 128) * 512 + (n - 2048)] : 0.f; } };
__device__ __forceinline__ void p0_convert(Frame& F) {
    LAS float* scrw = (LAS float*)(F.lds + F.wave * 17408);
    LAS float* scr = scrw;
    const int gw = F.bid * 8 + F.wave, NGW = F.G * 8;
    constexpr int I_WIN = (1024 / 64) * (PW / 32), I_SQ = (1024 / 64) * (1024 / 32), I_LR = (LRK / 64) * (LRN / 32), I_ODIN = (1024 / 64) * (512 / 32), I_QUP = (256 / 64) * (1536 / 32), I_KVUP = (256 / 64) * (2048 / 32);
    constexpr int I_GU1 = (1024 / 64) * (2048 / 64), I_DN1 = (1024 / 64) * (1024 / 64);
    constexpr int NSMALL = I_WIN + I_SQ + I_LR + I_ODIN + I_QUP + I_KVUP + I_SQ;
    constexpr int NITEMS = NSMALL + 32 * I_GU1 + 32 * I_DN1;
    for (int it = gw; it < NITEMS; it += NGW) {
        int r = it;
        if (r < I_WIN) { cvt_item(VWin{F.in[I_EVWIN]}, wsp<bf16>(F, WS_WIN), 1024, r, PW / 32, scr, F.lane); continue; } r -= I_WIN;
        if (r < I_SQ) { cvt_item(VPlain{F.in[I_EVWOUT], 1024, 1024, 1024}, wsp<bf16>(F, WS_WOUT), 1024, r, 32, scr, F.lane); continue; } r -= I_SQ;
        if (r < I_LR) { cvt_item(VLr{F.in[I_W2], F.in[I_A2], F.in[I_G2]}, wsp<bf16>(F, WS_WLR), LRK, r, LRN / 32, scr, F.lane); continue; } r -= I_LR;
        if (r < I_ODIN) { cvt_item_fp8(VPlain{F.in[I_ODWIN], 448, 448, 1024}, wsp<unsigned char>(F, WS_WODIN), 1024, r, 16, scr, F.lane); continue; } r -= I_ODIN;
        if (r < I_QUP) { cvt_item(VQup{F.in[I_WQUP]}, wsp<bf16>(F, WS_WQUP), 256, r, 48, scr, F.lane); continue; } r -= I_QUP;
        if (r < I_KVUP) { cvt_item(VPlain{F.in[I_WKVUP], 2048, 2048, 128}, wsp<bf16>(F, WS_WKVUP), 256, r, 64, scr, F.lane); continue; } r -= I_KVUP;
        if (r < I_SQ) { cvt_item_fp8(VPlain{F.in[I_ODWOUT], 1024, 1024, 1024}, wsp<unsigned char>(F, WS_WODOUT), 1024, r, 32, scr, F.lane); continue; } r -= I_SQ;
        if (r < 32 * I_GU1) { const int le = r / I_GU1, ri = r % I_GU1; cvt_item_fp8_wide(C4Gu{}, F.in[I_GUW] + (size_t)le * 1024 * 2048, 2048, wsp<unsigned char>(F, WS_WGU) + (size_t)le * 2048 * 1024, 1024, ri, 32, scrw, F.lane); continue; } r -= 32 * I_GU1;
        { const int le = r / I_DN1, ri = r % I_DN1; cvt_item_fp8_wide(C4Id{}, F.in[I_DNW] + (size_t)le * 1024 * 1024, 1024, wsp<unsigned char>(F, WS_WDN) + (size_t)le * 1024 * 1024, 1024, ri, 16, scrw, F.lane); }
    }
}

constexpr int FILL_N = 32 * 512 + 32 * 256, FILL_A = 6144, FILL_B = 9216, FILL_C = 19840, FILL_D = 21760, FILL_E = FILL_N;
__device__ __forceinline__ void p_fill_convert(Frame& F, int slot, int nslots, int i0, int i1) {
    LAS float* scrw = (LAS float*)(F.lds + F.wave * 17408);
    for (int i = i0 + slot * 8 + F.wave; i < i1; i += nslots * 8) {
        if (i < 32 * 512) { const int le = 32 + (i >> 9), ri = i & 511; cvt_item_fp8_wide(C4Gu{}, F.in[I_GUW] + (size_t)le * 1024 * 2048, 2048, wsp<unsigned char>(F, WS_WGU) + (size_t)le * 2048 * 1024, 1024, ri, 32, scrw, F.lane); }
        else { const int j = i - 32 * 512; const int le = 32 + (j >> 8), ri = j & 255; cvt_item_fp8_wide(C4Id{}, F.in[I_DNW] + (size_t)le * 1024 * 1024, 1024, wsp<unsigned char>(F, WS_WDN) + (size_t)le * 1024 * 1024, 1024, ri, 16, scrw, F.lane); }
    }
}

struct RowV { f32x4 v[4]; };
__device__ __forceinline__ void row_load(RowV& r, const float* p, int lane) {
#pragma unroll
    for (int j = 0; j < 4; ++j) r.v[j] = ((const f32x4*)p)[lane + 64 * j];
}
__device__ __forceinline__ float row_ss(const RowV& r) {
    float s = 0.f;
#pragma unroll
    for (int j = 0; j < 4; ++j) s += (r.v[j].x * r.v[j].x + r.v[j].y * r.v[j].y) + (r.v[j].z * r.v[j].z + r.v[j].w * r.v[j].w);
    return wave_sum(s);
}
__device__ __forceinline__ void row_modulate(RowV& r, float rstd, const float* g, const float* sh, const float* sc, int lane) {
#pragma unroll
    for (int j = 0; j < 4; ++j) { const f32x4 gv = ((const f32x4*)g)[lane + 64 * j], shv = ((const f32x4*)sh)[lane + 64 * j], scv = ((const f32x4*)sc)[lane + 64 * j];
        r.v[j] = r.v[j] * rstd * gv * (scv + 1.0f) + shv; }
}
__device__ __forceinline__ void row_store_bf16(const RowV& r, bf16* p, int lane) {
#pragma unroll
    for (int j = 0; j < 4; ++j) { u32x2 w; w.x = cvt_pk_bf16(r.v[j].x, r.v[j].y); w.y = cvt_pk_bf16(r.v[j].z, r.v[j].w); ((u32x2*)p)[lane + 64 * j] = w; }
}
__device__ __forceinline__ void row_load_bf16x(RowV& r, const bf16* p, int lane) {
#pragma unroll
    for (int j = 0; j < 4; ++j) { const u32x2 w = ((const u32x2*)p)[lane + 64 * j]; r.v[j] = (f32x4){bflo(w.x), bfhi(w.x), bflo(w.y), bfhi(w.y)}; }
}
__device__ __forceinline__ void row_store_fp8(const RowV& r, unsigned char* p, int lane) {
#pragma unroll
    for (int j = 0; j < 4; ++j) ((unsigned*)p)[lane + 64 * j] = pk4_fp8(r.v[j].x, r.v[j].y, r.v[j].z, r.v[j].w);
}
__device__ __forceinline__ void row_add_moe(RowV& r, const unsigned char* ys, int row, const float* gate, int lane) {
#pragma unroll
    for (int j = 0; j < 4; ++j) { f32x4 s = (f32x4){0.f, 0.f, 0.f, 0.f};
#pragma unroll
        for (int k = 0; k < 4; ++k) { const int w = ((const int*)(ys + (size_t)(row * 4 + k) * 1024))[lane + 64 * j];
            s.x += __builtin_amdgcn_cvt_f32_fp8(w, 0); s.y += __builtin_amdgcn_cvt_f32_fp8(w, 1); s.z += __builtin_amdgcn_cvt_f32_fp8(w, 2); s.w += __builtin_amdgcn_cvt_f32_fp8(w, 3); }
        const f32x4 gv = ((const f32x4*)gate)[lane + 64 * j]; r.v[j] = r.v[j] + gv * s * (1.f / YS_SCALE); }
}
__device__ __forceinline__ const float* src_row_l0(const Frame& F, int row) { return row < NLAT ? F.in[I_X] + (size_t)row * 1024 : F.in[I_CTX] + (size_t)(row - NLAT) * 1024; }

__device__ __forceinline__ void p_norm1_l0(Frame& F) {
    const int gw = F.bid * 8 + F.wave, NGW = F.G * 8;
    for (int row = gw; row < NTOK; row += NGW) {
        RowV r; row_load(r, src_row_l0(F, row), F.lane);
        const float rstd = 1.f / sqrtf(row_ss(r) * (1.f / 1024.f) + 1e-6f);
        row_modulate(r, rstd, F.in[I_N1G], mod_ptr(F, 0, row, 0), mod_ptr(F, 0, row, 1), F.lane);
        row_store_bf16(r, wsp<bf16>(F, WS_H) + (size_t)row * 1024, F.lane);
    }
}
__device__ __forceinline__ void p_combine_norm1_l1(Frame& F) {
    const int gw = F.bid * 8 + F.wave, NGW = F.G * 8;
    for (int row = gw; row < NTOK; row += NGW) {
        bf16* xp = wsp<bf16>(F, WS_X1) + (size_t)row * 1024;
        RowV r; row_load_bf16x(r, xp, F.lane);
        row_add_moe(r, wsp<const unsigned char>(F, WS_YS), row, mod_ptr(F, 0, row, 5), F.lane);
        row_store_bf16(r, xp, F.lane);
        const float rstd = 1.f / sqrtf(row_ss(r) * (1.f / 1024.f) + 1e-6f);
        row_modulate(r, rstd, F.in[I_N1G] + 1024, mod_ptr(F, 1, row, 0), mod_ptr(F, 1, row, 1), F.lane);
        row_store_fp8(r, wsp<unsigned char>(F, WS_H) + (size_t)row * 1024, F.lane);
    }
}
__device__ __forceinline__ void p_final(Frame& F) {
    const int gw = F.bid * 8 + F.wave, NGW = F.G * 8;
    for (int row = gw; row < NLAT; row += NGW) {
        RowV r; row_load_bf16x(r, wsp<const bf16>(F, WS_X1) + (size_t)row * 1024, F.lane);
        row_add_moe(r, wsp<const unsigned char>(F, WS_YS), row, mod_ptr(F, 1, row, 5), F.lane);
        const float rstd = 1.f / sqrtf(row_ss(r) * (1.f / 1024.f) + 1e-6f);
#pragma unroll
        for (int j = 0; j < 4; ++j) { const f32x4 gv = ((const f32x4*)F.in[I_FNG])[F.lane + 64 * j]; ((f32x4*)(F.out + (size_t)row * 1024))[F.lane + 64 * j] = r.v[j] * rstd * gv; }
    }
}

constexpr int RT_WS = 2064;
constexpr int RT_WHI = 0, RT_WLO = 32 * RT_WS;
constexpr int RT_TAB = 2 * 32 * RT_WS;
constexpr int RT_TABSZ = 8320;
constexpr int RT_LDS_CNT = RT_TAB + 2 * RT_TABSZ;
__device__ __forceinline__ void vb_tiles(int vb, int ntok, int& t0, int& nt) { const int ntile = ntok >> 5, q = ntile >> 8, r = ntile & 255; if (vb < r) { t0 = vb * (q + 1); nt = q + 1; } else { t0 = r * (q + 1) + (vb - r) * q; nt = q; } }
__device__ __forceinline__ void p_norm2_route(Frame& F, const int layer, const int ntok) {
    LAS unsigned char* L = F.lds;
    LAS int* cnt = (LAS int*)(L + RT_LDS_CNT);
    const int tid = F.tid, lane = F.lane, wave = F.wave, t = lane & 31, hi = lane >> 5;
    const float* rw = F.in[I_RW] + (size_t)layer * 1024 * 32;
    for (int idx = tid; idx < 1024 * 32; idx += 512) { const int k = idx >> 5, e = idx & 31; const float w = rw[idx]; const unsigned h = f2bf(w); const unsigned l = f2bf(w - bf2f(h));
        *(LAS unsigned short*)(L + RT_WHI + e * RT_WS + k * 2) = (unsigned short)h; *(LAS unsigned short*)(L + RT_WLO + e * RT_WS + k * 2) = (unsigned short)l; }
    unsigned char* rt = F.ws + WS_ROUTE;
    const float* g2 = F.in[I_N2G] + layer * 1024;
    const bf16* X = wsp<const bf16>(F, WS_X1); unsigned char* H8 = wsp<unsigned char>(F, WS_H);
    for (int vb = F.bid; vb < 256; vb += F.G) {
        int t0, nt; vb_tiles(vb, ntok, t0, nt);
        const int mr0 = mod_row(t0 * 32), mr1 = mod_row((t0 + nt) * 32 - 1);
        __syncthreads();
        if (tid < 32) cnt[tid] = 0;
        for (int sl = 0; sl < 2; ++sl) { const int mr = sl ? mr1 : mr0; LAS float* tb = (LAS float*)(L + RT_TAB + sl * RT_TABSZ);
            const float* shp = wsp<const float>(F, WS_MOD) + ((size_t)(layer * 9 + mr) * 6 + 3) * 1024; const float* scp = shp + 1024;
            for (int k = tid; k < 1024; k += 512) { tb[k] = g2[k] * (1.f + scp[k]); tb[1024 + k] = shp[k]; } }
        __syncthreads();
        for (int sl = 0; sl < 2; ++sl) { LAS float* tb = (LAS float*)(L + RT_TAB + sl * RT_TABSZ); LAS float* red = (LAS float*)(L + RT_LDS_CNT + 256);
            const int e = tid & 31, kp = tid >> 5; float sacc = 0.f;
            for (int k = kp * 64; k < kp * 64 + 64; ++k) sacc += tb[1024 + k] * rw[k * 32 + e];
            red[kp * 32 + e] = sacc; __syncthreads();
            if (tid < 32) { float c = F.in[I_RB][layer * 32 + tid]; for (int i = 0; i < 16; ++i) c += red[i * 32 + tid]; tb[2048 + tid] = c; }
            __syncthreads(); }
        for (int ti = wave; ti < nt; ti += 8) {
            const int tile = t0 + ti, row = tile * 32 + t; const int sl = (mod_row(tile * 32) == mr0) ? 0 : 1;
            const LAS float* tb = (const LAS float*)(L + RT_TAB + sl * RT_TABSZ);
            const bf16* xp = X + (size_t)row * 1024 + hi * 8;
            f32x16 acc;
#pragma unroll
            for (int r = 0; r < 16; ++r) acc[r] = 0.f;
            float ss = 0.f;
#pragma unroll 4
            for (int s = 0; s < 64; ++s) {
                const u32x4 xw = *(const u32x4*)(xp + s * 16); const f32x4 x0 = {bflo(xw.x), bfhi(xw.x), bflo(xw.y), bfhi(xw.y)}, x1 = {bflo(xw.z), bfhi(xw.z), bflo(xw.w), bfhi(xw.w)};
                const f32x4 g0 = *(const LAS f32x4*)(tb + s * 16 + hi * 8), g1 = *(const LAS f32x4*)(tb + s * 16 + hi * 8 + 4);
                ss += (x0.x * x0.x + x0.y * x0.y) + (x0.z * x0.z + x0.w * x0.w) + (x1.x * x1.x + x1.y * x1.y) + (x1.z * x1.z + x1.w * x1.w);
                const f32x4 y0 = x0 * g0, y1 = x1 * g1;
                u32x4 hh; hh.x = cvt_pk_bf16(y0.x, y0.y); hh.y = cvt_pk_bf16(y0.z, y0.w); hh.z = cvt_pk_bf16(y1.x, y1.y); hh.w = cvt_pk_bf16(y1.z, y1.w);
                u32x4 ll; ll.x = cvt_pk_bf16(y0.x - bflo(hh.x), y0.y - bfhi(hh.x)); ll.y = cvt_pk_bf16(y0.z - bflo(hh.y), y0.w - bfhi(hh.y)); ll.z = cvt_pk_bf16(y1.x - bflo(hh.z), y1.y - bfhi(hh.z)); ll.w = cvt_pk_bf16(y1.z - bflo(hh.w), y1.w - bfhi(hh.w));
                const bf16x8 xh = __builtin_bit_cast(bf16x8, hh), xl = __builtin_bit_cast(bf16x8, ll);
                const bf16x8 wh = *(const LAS bf16x8*)(L + RT_WHI + t * RT_WS + (s * 16 + hi * 8) * 2), wl = *(const LAS bf16x8*)(L + RT_WLO + t * RT_WS + (s * 16 + hi * 8) * 2);
                acc = __builtin_amdgcn_mfma_f32_32x32x16_bf16(wh, xh, acc, 0, 0, 0);
                acc = __builtin_amdgcn_mfma_f32_32x32x16_bf16(wh, xl, acc, 0, 0, 0);
                acc = __builtin_amdgcn_mfma_f32_32x32x16_bf16(wl, xh, acc, 0, 0, 0);
            }
            { auto rr = __builtin_amdgcn_permlane32_swap(__float_as_uint(ss), __float_as_uint(ss), false, false); ss = __uint_as_float(rr[0]) + __uint_as_float(rr[1]); }
            const float rstd = 1.f / sqrtf(ss * (1.f / 1024.f) + 1e-6f);
            float lg[32];
#pragma unroll
            for (int r = 0; r < 16; ++r) { auto rr = __builtin_amdgcn_permlane32_swap(__float_as_uint(acc[r]), __float_as_uint(acc[r]), false, false);
                const int e0 = (r & 3) + 8 * (r >> 2); lg[e0] = __uint_as_float(rr[0]) * rstd + tb[2048 + e0]; lg[e0 + 4] = __uint_as_float(rr[1]) * rstd + tb[2048 + e0 + 4]; }
            int se[4]; float sv[4];
#pragma unroll
            for (int k = 0; k < 4; ++k) { float best = lg[0]; int bi = 0;
#pragma unroll
                for (int e = 1; e < 32; ++e) { const bool gt = lg[e] > best; best = gt ? lg[e] : best; bi = gt ? e : bi; }
                se[k] = bi; sv[k] = best;
#pragma unroll
                for (int e = 0; e < 32; ++e) lg[e] = (e == bi) ? -3.0e38f : lg[e]; }
            const float e1 = __expf(sv[1] - sv[0]), e2 = __expf(sv[2] - sv[0]), e3 = __expf(sv[3] - sv[0]); const float inv = 1.f / (1.f + e1 + e2 + e3);
            if (hi == 0) {
                const float gk[4] = {inv, e1 * inv, e2 * inv, e3 * inv};
#pragma unroll
                for (int k = 0; k < 4; ++k) { const int pos = __hip_atomic_fetch_add(cnt + se[k], 1, __ATOMIC_RELAXED, __HIP_MEMORY_SCOPE_WORKGROUP);
                    rt[RT_E + (size_t)row * 4 + k] = (unsigned char)se[k]; ((unsigned short*)(rt + RT_POS))[(size_t)row * 4 + k] = (unsigned short)pos; ((float*)(rt + RT_GATE))[(size_t)row * 4 + k] = gk[k]; }
            }
            unsigned char* hp = H8 + (size_t)row * 1024 + hi * 8;
#pragma unroll 4
            for (int s = 0; s < 64; ++s) {
                const u32x4 xw = *(const u32x4*)(xp + s * 16); const f32x4 x0 = {bflo(xw.x), bfhi(xw.x), bflo(xw.y), bfhi(xw.y)}, x1 = {bflo(xw.z), bfhi(xw.z), bflo(xw.w), bfhi(xw.w)};
                const f32x4 g0 = *(const LAS f32x4*)(tb + s * 16 + hi * 8), g1 = *(const LAS f32x4*)(tb + s * 16 + hi * 8 + 4);
                const f32x4 h0 = *(const LAS f32x4*)(tb + 1024 + s * 16 + hi * 8), h1 = *(const LAS f32x4*)(tb + 1024 + s * 16 + hi * 8 + 4);
                const f32x4 y0 = x0 * rstd * g0 + h0, y1 = x1 * rstd * g1 + h1;
                *(u32x2*)(hp + s * 16) = (u32x2){pk4_fp8(y0.x, y0.y, y0.z, y0.w), pk4_fp8(y1.x, y1.y, y1.z, y1.w)};
            }
        }
        __syncthreads();
        if (tid < 32) ((unsigned*)(rt + RT_HIST))[vb * 32 + tid] = (unsigned)cnt[tid];
    }
    __syncthreads();
}
constexpr int MT_OFF = 131072 + 1024;
__device__ __forceinline__ void moe_tables(Frame& F) {
    LAS int* tab = (LAS int*)(F.lds + MT_OFF);
    LAS int* part = (LAS int*)(F.lds + MT_OFF + 8192 + 256);
    const unsigned* hist = (const unsigned*)(F.ws + WS_ROUTE + RT_HIST);
    { const int e = F.tid & 31, p = F.tid >> 5; int c = 0;
#pragma unroll
      for (int i = 0; i < 16; ++i) c += (int)hist[(p * 16 + i) * 32 + e];
      part[p * 32 + e] = c; }
    __syncthreads();
    if (F.tid < 32) { int c = 0;
#pragma unroll
        for (int p = 0; p < 16; ++p) c += part[p * 32 + F.tid];
        tab[32 + F.tid] = c; }
    __syncthreads();
    if (F.tid == 0) { int s = 0; for (int e = 0; e < 32; ++e) { tab[e] = s; s += ((tab[32 + e] + 255) >> 8) << 8; } tab[64] = s >> 8; }
    __syncthreads();
    if (F.tid < 32) { const int s0 = tab[F.tid] >> 8, nb = (tab[32 + F.tid] + 255) >> 8; for (int i = 0; i < nb; ++i) tab[128 + s0 + i] = F.tid; }
    __syncthreads();
}
__device__ __forceinline__ void p_moe_scatter(Frame& F, const int ntok) {
    moe_tables(F);
    LAS int* tab = (LAS int*)(F.lds + MT_OFF);
    LAS int* base = (LAS int*)(F.lds + MT_OFF + 8192);
    const unsigned* hist = (const unsigned*)(F.ws + WS_ROUTE + RT_HIST);
    const unsigned char* rt = F.ws + WS_ROUTE;
    unsigned* stok = wsp<unsigned>(F, WS_SORT); unsigned* sdst = stok + MAXSLOT; float* sgate = (float*)(sdst + MAXSLOT);
    for (int vb = F.bid; vb < 256; vb += F.G) {
        int t0, nt; vb_tiles(vb, ntok, t0, nt);
        if (F.tid < 32) { const LAS int* part = (const LAS int*)(F.lds + MT_OFF + 8192 + 256); int c = 0; for (int p = 0; p < (vb >> 4); ++p) c += part[p * 32 + F.tid];
            for (int b = vb & ~15; b < vb; ++b) c += (int)hist[b * 32 + F.tid]; base[F.tid] = tab[F.tid] + c; }
        __syncthreads();
        for (int i = F.tid; i < nt * 128; i += 512) {
            const int row = t0 * 32 + (i >> 2), k = i & 3; const size_t a = (size_t)row * 4 + k;
            const int e = rt[RT_E + a], pos = ((const unsigned short*)(rt + RT_POS))[a];
            const int slot = base[e] + pos;
            stok[slot] = (unsigned)row; sdst[slot] = (unsigned)(row * 4 + k); sgate[slot] = ((const float*)(rt + RT_GATE))[a];
        }
        if (vb < 32) { const int e = vb, c = tab[32 + e], s0 = tab[e] + c, s1 = tab[e] + (((c + 255) >> 8) << 8);
            for (int s = s0 + F.tid; s < s1; s += 512) { stok[s] = 0u; sdst[s] = (unsigned)YS_DUMMY; sgate[s] = 0.f; } }
        __syncthreads();
    }
}

namespace pg8 {
struct DenseSched {
    int nM, nN, nwg, G, c, KB; const bf16* Bt;
    __device__ __forceinline__ void init(int M, int N, int KB_, const void* Bt_, int G_, int c_) { nM = M / BM; nN = N / BM; nwg = nM * nN; G = G_; c = c_; KB = KB_; Bt = (const bf16*)Bt_; }
    __device__ __forceinline__ bool next(int i, Unit& u) const {
        const long L = (long)i * G + c; if (L >= nwg) return false;
        int wgid = (int)L; { const int q = nwg / 8, r = nwg % 8, xcd = wgid % 8, off = wgid / 8; wgid = (xcd < r ? xcd * (q + 1) : r * (q + 1) + (xcd - r) * q) + off; }
        const int nig = 8 * nN, gid = wgid / nig, fm = gid * 8, gsz = (nM - fm) < 8 ? (nM - fm) : 8;
        u.pm = fm + ((wgid % nig) % gsz); u.pn = (wgid % nig) / gsz; return true;
    }
    __device__ __forceinline__ void a_offs(const Unit& u, unsigned (&ao)[2][2], const int (&R)[2], const int (&C)[2]) const {
#pragma unroll
        for (int h = 0; h < 2; ++h)
#pragma unroll
            for (int i = 0; i < 2; ++i) ao[h][i] = (unsigned)((u.pm * BM + h * HALF + R[i]) * KB + C[i] * 2);
    }
    __device__ __forceinline__ const char* b_tile(const Unit& u) const { return (const char*)Bt + (size_t)u.pn * BM * KB; }
    __device__ __forceinline__ int ktiles(const Unit&, int ntdef) const { return ntdef; }
};
struct LrSched : DenseSched {
    __device__ __forceinline__ unsigned koff(const Unit& u) const { return u.pn < 8 ? 0u : 256u; }
    __device__ __forceinline__ void a_offs(const Unit& u, unsigned (&ao)[2][2], const int (&R)[2], const int (&C)[2]) const { DenseSched::a_offs(u, ao, R, C);
#pragma unroll
        for (int h = 0; h < 2; ++h)
#pragma unroll
            for (int i = 0; i < 2; ++i) ao[h][i] += koff(u); }
    __device__ __forceinline__ const char* b_tile(const Unit& u) const { return DenseSched::b_tile(u) + koff(u); }
    __device__ __forceinline__ int ktiles(const Unit& u, int) const { return u.pn < 8 ? 2 : 4; }
};
struct KvSched : DenseSched { __device__ __forceinline__ int ktiles(const Unit&, int) const { int n = 2; asm volatile("" : "+s"(n)); return n; } };
template <bool GATHER> struct MoeSched {
    int nrb, npn, G, c; const LAS int* blk_e; const unsigned* tok; const unsigned char* Wt; size_t wstride;
    __device__ __forceinline__ bool next(int i, Unit& u) const {
        if ((G & 7) != 0 || ((G >> 3) % npn) != 0) { const long L = (long)i * G + c; if (L >= (long)nrb * npn) return false; u.pm = (int)(L / npn); u.pn = (int)(L % npn); return true; }
        const int x = c & 7, y = c >> 3, per = (G >> 3) / npn;
        u.pm = (i * 8 + x) * per + y / npn; u.pn = y % npn; return u.pm < nrb;
    }
    __device__ __forceinline__ void a_offs(const Unit& u, unsigned (&ao)[2][2], const int (&R)[2], const int (&C)[2]) const {
#pragma unroll
        for (int h = 0; h < 2; ++h)
#pragma unroll
            for (int i = 0; i < 2; ++i) { const int slot = u.pm * BM + h * HALF + R[i]; const unsigned row = GATHER ? tok[slot] : (unsigned)slot; ao[h][i] = row * 1024u + (unsigned)C[i] * 2u; }
    }
    __device__ __forceinline__ const char* b_tile(const Unit& u) const { return (const char*)(Wt + (size_t)blk_e[u.pm] * wstride + (size_t)u.pn * BM * 1024); }
    __device__ __forceinline__ int ktiles(const Unit&, int ntdef) const { return ntdef; }
};

struct MapPlain { bf16* O; int ld; __device__ __forceinline__ bf16* operator()(int row, int col) const { return O + (size_t)row * ld + col; } };
constexpr float ATT_QPRE = 0.8329403702157812f;
struct EpiQ8 {
    static constexpr bool PERM = true; unsigned char* Q8; const f32x2* ROPE;
    __device__ __forceinline__ void operator()(const f32x4 (&acc)[2][2][4][2], const Unit& u, int wr, int wc, int fr, int fq) const {
#pragma unroll
        for (int ai = 0; ai < 2; ++ai)
#pragma unroll
            for (int m = 0; m < 4; ++m) { const int row = u.pm * BM + ai * HALF + wr * 64 + m * 16 + fr; const int b = row >> 13, t = row & 8191;
#pragma unroll
                for (int bj = 0; bj < 2; ++bj) { const int col = u.pn * BM + bj * HALF + wc * 32 + 8 * fq; float v[8];
#pragma unroll
                    for (int e = 0; e < 4; ++e) { v[e] = acc[ai][bj][m][0][e]; v[4 + e] = acc[ai][bj][m][1][e]; }
                    int h, d;
                    if (u.pn < 4) { h = col >> 7; d = col & 127; }
                    else { h = (col - 1024) >> 6; const int dr = (col - 1024) & 63; d = 128 + dr;
                        const f32x2* cs = ROPE + t * 32 + ((dr >> 5) << 4) + (dr & 8);
#pragma unroll
                        for (int e = 0; e < 8; ++e) { auto rr = __builtin_amdgcn_permlane32_swap(__float_as_uint(v[e]), __float_as_uint(v[e]), false, false);
                            const float pr = __uint_as_float(fq < 2 ? rr[1] : rr[0]); const f32x2 c = cs[e]; v[e] = (fq >= 2) ? v[e] * c.x + pr * c.y : v[e] * c.x - pr * c.y; } }
                    *(u32x2*)(Q8 + ((size_t)((b * 8 + h) * SEQ + t)) * QKD + d) = (u32x2){pk4_fp8(v[0] * ATT_QPRE, v[1] * ATT_QPRE, v[2] * ATT_QPRE, v[3] * ATT_QPRE), pk4_fp8(v[4] * ATT_QPRE, v[5] * ATT_QPRE, v[6] * ATT_QPRE, v[7] * ATT_QPRE)}; } }
    }
};
struct EpiKV8 {
    static constexpr bool PERM = true; unsigned char* K8; unsigned char* VT;
    __device__ __forceinline__ void operator()(const f32x4 (&acc)[2][2][4][2], const Unit& u, int wr, int wc, int fr, int fq) const {
#pragma unroll
        for (int ai = 0; ai < 2; ++ai)
#pragma unroll
            for (int m = 0; m < 4; ++m) { const int row = u.pm * BM + ai * HALF + wr * 64 + m * 16 + fr;
                const int b = row < NLAT ? (row >> 13) : ((row - NLAT) >> 8), key = row < NLAT ? CTXL + (row & 8191) : ((row - NLAT) & 255), h = u.pn;
                { const f32x4 v0 = acc[ai][0][m][0], v1 = acc[ai][0][m][1];
                  *(u32x2*)(K8 + ((size_t)((b * 8 + h) * NKEY + key)) * K8ROW + wc * 32 + 8 * fq) = (u32x2){pk4_fp8(v0[0], v0[1], v0[2], v0[3]), pk4_fp8(v1[0], v1[1], v1[2], v1[3])}; }
                { const int k6 = key & 63, kk = k6 & 31, p = 32 * ((kk >> 2) & 1) + (k6 >> 5) * 16 + (kk & 3) + 4 * (kk >> 3);
                  unsigned char* tb = VT + ((size_t)(b * 8 + h) * (NKEY / 64) + (key >> 6)) * 8192 + (p & 15); const int c0 = wc * 32 + 8 * fq, ch = p >> 4;
                  const unsigned w0 = pk4_fp8(acc[ai][1][m][0][0], acc[ai][1][m][0][1], acc[ai][1][m][0][2], acc[ai][1][m][0][3]), w1 = pk4_fp8(acc[ai][1][m][1][0], acc[ai][1][m][1][1], acc[ai][1][m][1][2], acc[ai][1][m][1][3]);
#pragma unroll
                  for (int e = 0; e < 8; ++e) { const int c = c0 + e; tb[c * 64 + ((ch ^ ((c >> 2) & 3)) << 4)] = (unsigned char)(((e < 4 ? w0 : w1) >> (8 * (e & 3))) & 0xffu); } } }
    }
};
template <class Map> struct EpiBf16 {
    static constexpr bool PERM = true; Map map;
    __device__ __forceinline__ void operator()(const f32x4 (&acc)[2][2][4][2], const Unit& u, int wr, int wc, int fr, int fq) const {
#pragma unroll
        for (int ai = 0; ai < 2; ++ai)
#pragma unroll
            for (int m = 0; m < 4; ++m) { const int row = u.pm * BM + ai * HALF + wr * 64 + m * 16 + fr;
#pragma unroll
                for (int bj = 0; bj < 2; ++bj) { const int col = u.pn * BM + bj * HALF + wc * 32 + 8 * fq; const f32x4 v0 = acc[ai][bj][m][0], v1 = acc[ai][bj][m][1];
                    u32x4 w; w.x = cvt_pk_bf16(v0[0], v0[1]); w.y = cvt_pk_bf16(v0[2], v0[3]); w.z = cvt_pk_bf16(v1[0], v1[1]); w.w = cvt_pk_bf16(v1[2], v1[3]);
                    *(u32x4*)map(row, col) = w; } }
    }
};
struct EpiF32 {
    static constexpr bool PERM = false; float* C; int ldc;
    __device__ __forceinline__ void operator()(const f32x4 (&acc)[2][2][4][2], const Unit& u, int wr, int wc, int fr, int fq) const {
#pragma unroll
        for (int ai = 0; ai < 2; ++ai)
#pragma unroll
            for (int m = 0; m < 4; ++m) { float* rowp = C + (size_t)(u.pm * BM + ai * HALF + wr * 64 + m * 16 + fr) * ldc + u.pn * BM + wc * 32 + 4 * fq;
#pragma unroll
                for (int bj = 0; bj < 2; ++bj)
#pragma unroll
                    for (int n = 0; n < 2; ++n) *(f32x4*)(rowp + bj * HALF + n * 16) = acc[ai][bj][m][n]; }
    }
};
struct EpiResid {
    static constexpr bool PERM = false; bf16* X1; const float* xlat; const float* xctx; const float* mod; int layer;
    __device__ __forceinline__ void operator()(const f32x4 (&acc)[2][2][4][2], const Unit& u, int wr, int wc, int fr, int fq) const {
#pragma unroll
        for (int ai = 0; ai < 2; ++ai)
#pragma unroll
            for (int m = 0; m < 4; ++m) { const int row = u.pm * BM + ai * HALF + wr * 64 + m * 16 + fr; const int col0 = u.pn * BM + wc * 32 + 4 * fq;
                const float* bp = row < NLAT ? xlat + (size_t)row * 1024 : xctx + (size_t)(row - NLAT) * 1024;
                const float* gp = mod + ((size_t)(layer * 9 + (row < NLAT ? (row >> 13) : 8)) * 6 + 2) * 1024;
                bf16* op = X1 + (size_t)row * 1024;
#pragma unroll
                for (int bj = 0; bj < 2; ++bj)
#pragma unroll
                    for (int n = 0; n < 2; ++n) { const int c = col0 + bj * HALF + n * 16; f32x4 base;
                        if (layer == 0) base = *(const f32x4*)(bp + c); else { const u32x2 bw = *(const u32x2*)(op + c); base = (f32x4){bflo(bw.x), bfhi(bw.x), bflo(bw.y), bfhi(bw.y)}; }
                        const f32x4 v = base + *(const f32x4*)(gp + c) * acc[ai][bj][m][n];
                        *(u32x2*)(op + c) = (u32x2){cvt_pk_bf16(v.x, v.y), cvt_pk_bf16(v.z, v.w)}; } }
    }
};
struct EpiSwiglu {
    static constexpr bool PERM = true; unsigned char* ACT; const float* bgu; const LAS int* blk_e;
    __device__ __forceinline__ void operator()(const f32x4 (&acc)[2][2][4][2], const Unit& u, int wr, int wc, int fr, int fq) const {
        const int e = blk_e[u.pm]; const int c0 = u.pn * 128 + wc * 32 + 8 * fq;
        const float* bg = bgu + (size_t)e * 2048 + c0;
        f32x4 bgl[2], bln[2];
#pragma unroll
        for (int n = 0; n < 2; ++n) { bgl[n] = *(const f32x4*)(bg + 4 * n); bln[n] = *(const f32x4*)(bg + 1024 + 4 * n); }
#pragma unroll
        for (int ai = 0; ai < 2; ++ai)
#pragma unroll
            for (int m = 0; m < 4; ++m) { const int slot = u.pm * BM + ai * HALF + wr * 64 + m * 16 + fr; float o[8];
#pragma unroll
                for (int n = 0; n < 2; ++n)
#pragma unroll
                    for (int j = 0; j < 4; ++j) { const float xg = fminf(acc[ai][0][m][n][j] + bgl[n][j], 7.0f); const float xl = fminf(fmaxf(acc[ai][1][m][n][j] + bln[n][j], -7.0f), 7.0f);
                        o[n * 4 + j] = xg * __builtin_amdgcn_rcpf(1.f + __expf(-1.702f * xg)) * (xl + 1.0f); }
                *(u32x2*)(ACT + (size_t)slot * 1024 + c0) = (u32x2){pk4_fp8(o[0], o[1], o[2], o[3]), pk4_fp8(o[4], o[5], o[6], o[7])}; }
    }
};
struct EpiDown {
    static constexpr bool PERM = true; unsigned char* YS; const float* bdn; const LAS int* blk_e; const unsigned* dst; const float* gate;
    __device__ __forceinline__ void operator()(const f32x4 (&acc)[2][2][4][2], const Unit& u, int wr, int wc, int fr, int fq) const {
        const int e = blk_e[u.pm]; const int c0 = u.pn * BM + wc * 32 + 8 * fq;
        f32x4 bv[2][2];
#pragma unroll
        for (int bj = 0; bj < 2; ++bj)
#pragma unroll
            for (int n = 0; n < 2; ++n) bv[bj][n] = *(const f32x4*)(bdn + (size_t)e * 1024 + c0 + bj * HALF + 4 * n);
#pragma unroll
        for (int ai = 0; ai < 2; ++ai)
#pragma unroll
            for (int m = 0; m < 4; ++m) { const int slot = u.pm * BM + ai * HALF + wr * 64 + m * 16 + fr; const float g = gate[slot] * YS_SCALE; unsigned char* op = YS + (size_t)dst[slot] * 1024 + c0;
#pragma unroll
                for (int bj = 0; bj < 2; ++bj) { const f32x4 v0 = (acc[ai][bj][m][0] + bv[bj][0]) * g, v1 = (acc[ai][bj][m][1] + bv[bj][1]) * g;
                    *(u32x2*)(op + bj * HALF) = (u32x2){pk4_fp8(v0[0], v0[1], v0[2], v0[3]), pk4_fp8(v1[0], v1[1], v1[2], v1[3])}; } }
    }
};
}

__device__ __forceinline__ float ldbf(const bf16* p) { return bf2f((unsigned)*p); }
__device__ __forceinline__ void seq_pos(int row, bool& hp, bool& hn) { if (row < NLAT) { const int t = row & 8191; hp = t > 0; hn = t < SEQ - 1; } else { const int t = (row - NLAT) & 255; hp = t > 0; hn = t < CTXL - 1; } }

__device__ __forceinline__ void p_alr(Frame& F) {
    const int gw = F.bid * 8 + F.wave, NGW = F.G * 8;
    const bf16* P = wsp<const bf16>(F, WS_P); bf16* A = wsp<bf16>(F, WS_ALR); const float* mu = F.in[I_MU];
    for (int row = gw; row < NTOK; row += NGW) {
        bool hp, hn; seq_pos(row, hp, hn);
        const bf16* pr = P + (size_t)row * PW + RW0 + 1536;
#pragma unroll
        for (int q = 0; q < 6; ++q) { const int c = F.lane + 64 * q; float o = 0.f;
            if (c < 288) { const float p0 = ldbf(pr + c), pm = hp ? ldbf(pr + c - PW) : 0.f, pn = hn ? ldbf(pr + c + PW) : 0.f;
                const float xs = p0 + mu[1536 + c] * (pm - p0) + mu[RW_COLS + 1536 + c] * (pn - p0);
                o = c < 64 ? (1.f - 2.f * __builtin_amdgcn_rcpf(1.f + __expf(2.f * xs))) : (c < 128 ? xs : __builtin_amdgcn_rcpf(1.f + __expf(-xs))); }
            A[(size_t)row * LRK + c] = (bf16)f2bf(o); }
    }
}

constexpr int GL_QRAW = 0, GL_KRAW = 8192, GL_GDS = 16384, GL_QD = 20480, GL_KI = 29696, GL_KE = 38912, GL_AT = 48128, GL_VT = 57344, GL_ST = 61952, GL_GSUM = 71168, GL_DEC = 73216;
constexpr int GL_RS = 144;
__device__ __forceinline__ bf16x8 lds_frag(const LAS unsigned char* base, int row, int kbyte) { return *(const LAS bf16x8*)(base + row * GL_RS + kbyte); }
constexpr int GW_UNIT = 24832;
constexpr int GW_QD = 0, GW_KE = 8192, GW_AT = 16384, GW_DEC = 24576;
#define GLA_ROWF(b, dir, n, i) ((n) < 4 ? NLAT + (b) * 256 + ((dir) ? 3 - (n) : (n)) * 64 + ((dir) ? 63 - (i) : (i)) : (b) * 8192 + ((dir) ? 127 - ((n) - 4) : ((n) - 4)) * 64 + ((dir) ? 63 - (i) : (i)))
__device__ __forceinline__ void p_gla_pre(Frame& F) {
    LAS unsigned char* L = F.lds;
    const bf16* P = wsp<const bf16>(F, WS_P); unsigned char* GW = F.ws + WS_X1;
    const int tid = F.tid, lane = F.lane, wave = F.wave, r32 = lane & 31, hi = lane >> 5;
    const int dk = lane, tg = wave;
    constexpr int NU = NB * 4 * 2 * 132;
    bf16x8 qv, kv, gv;
#define GP_LOAD(u) do { const int n_ = (u) % 132, d_ = ((u) / 132) & 1, h_ = ((u) / 264) & 3, b_ = (u) / 1056; const bf16* rp = P + (size_t)GLA_ROWF(b_, d_, n_, tid >> 3) * PW; \
        qv = *(const bf16x8*)(rp + h_ * 64 + (tid & 7) * 8); kv = *(const bf16x8*)(rp + 256 + h_ * 64 + (tid & 7) * 8); \
        if (tid < 128) gv = *(const bf16x8*)(P + (size_t)GLA_ROWF(b_, d_, n_, tid >> 1) * PW + 1536 + (tid & 1) * 8); } while (0)
    if (F.bid < NU) GP_LOAD(F.bid);
    for (int u = F.bid; u < NU; u += F.G) {
        const int dir = (u / 132) & 1, h = (u / 264) & 3;
        float gkw[16];
#pragma unroll
        for (int r = 0; r < 16; ++r) gkw[r] = F.in[I_GKUP][(size_t)(dir * 16 + r) * 256 + h * 64 + dk];
        const float gkb = F.in[I_GKB][dir * 256 + h * 64 + dk];
        unsigned char* gw = GW + (size_t)u * GW_UNIT;
        *(LAS bf16x8*)(L + GL_QRAW + (tid >> 3) * 128 + (tid & 7) * 16) = qv;
        *(LAS bf16x8*)(L + GL_KRAW + (tid >> 3) * 128 + (tid & 7) * 16) = kv;
        if (tid < 128) { LAS float* gp = (LAS float*)(L + GL_GDS) + (tid >> 1) * 16 + (tid & 1) * 8;
#pragma unroll
            for (int e = 0; e < 8; ++e) gp[e] = bf2f((unsigned)(unsigned short)gv[e]); }
        __syncthreads();
        if (u + F.G < NU) GP_LOAD(u + F.G);
        float Gl[8]; float cum = 0.f;
#pragma unroll
        for (int ii = 0; ii < 8; ++ii) { const LAS float* gp = (const LAS float*)(L + GL_GDS) + (tg * 8 + ii) * 16; float x = gkb;
#pragma unroll
            for (int r = 0; r < 16; ++r) x += gp[r] * gkw[r];
            const float ls = fminf(x, 0.f) - __logf(1.f + __expf(-fabsf(x)));
            cum += ls * (1.f / 16.f); Gl[ii] = cum; }
        ((LAS float*)(L + GL_GSUM))[tg * 64 + dk] = cum;
        __syncthreads();
        float off = 0.f, tot = 0.f;
#pragma unroll
        for (int t2 = 0; t2 < 8; ++t2) { const float gs = ((const LAS float*)(L + GL_GSUM))[t2 * 64 + dk]; tot += gs; off += (t2 < tg) ? gs : 0.f; }
        unsigned kep[4]; const float etot = __expf(tot);
#pragma unroll
        for (int ii = 0; ii < 8; ii += 2) { float kev[2];
#pragma unroll
            for (int z = 0; z < 2; ++z) { const int i = tg * 8 + ii + z; const float G = off + Gl[ii + z];
                const float q = bf2f((unsigned)*(const LAS unsigned short*)(L + GL_QRAW + i * 128 + dk * 2)), k = bf2f((unsigned)*(const LAS unsigned short*)(L + GL_KRAW + i * 128 + dk * 2));
                const float eg = __expf(G), ieg = __builtin_amdgcn_rcpf(eg);
                const unsigned short qd = (unsigned short)f2bf(q * 0.125f * eg);
                *(LAS unsigned short*)(L + GL_QD + i * GL_RS + dk * 2) = qd; *(unsigned short*)(gw + GW_QD + i * 128 + dk * 2) = qd;
                *(LAS unsigned short*)(L + GL_KI + i * GL_RS + dk * 2) = (unsigned short)f2bf(k * ieg);
                kev[z] = k * (etot * ieg); }
            kep[ii >> 1] = cvt_pk_bf16(kev[0], kev[1]); }
        *(u32x4*)(gw + GW_KE + dk * 128 + tg * 16) = (u32x4){kep[0], kep[1], kep[2], kep[3]};
        if (tg == 0) ((float*)(gw + GW_DEC))[dk] = etot;
        __syncthreads();
        if (wave < 4) { const int tj = wave & 1, ti = wave >> 1;
            f32x16 acc;
#pragma unroll
            for (int r = 0; r < 16; ++r) acc[r] = 0.f;
            if (!(ti == 0 && tj == 1)) {
#pragma unroll
                for (int ks = 0; ks < 4; ++ks) acc = __builtin_amdgcn_mfma_f32_32x32x16_bf16(lds_frag(L + GL_KI, tj * 32 + r32, ks * 32 + hi * 16), lds_frag(L + GL_QD, ti * 32 + r32, ks * 32 + hi * 16), acc, 0, 0, 0);
            }
            const int i = ti * 32 + r32;
#pragma unroll
            for (int g = 0; g < 4; ++g) { const int j0 = tj * 32 + 8 * g + 4 * hi; float v4[4];
#pragma unroll
                for (int z = 0; z < 4; ++z) v4[z] = (j0 + z <= i) ? acc[4 * g + z] : 0.f;
                *(u32x2*)(gw + GW_AT + i * 128 + j0 * 2) = (u32x2){cvt_pk_bf16(v4[0], v4[1]), cvt_pk_bf16(v4[2], v4[3])}; } }
        __syncthreads();
    }
#undef GP_LOAD
}
__device__ __forceinline__ void p_gla_scan(Frame& F) {
    LAS unsigned char* L = F.lds;
    const bf16* P = wsp<const bf16>(F, WS_P); const unsigned char* GW = F.ws + WS_X1;
    const int tid = F.tid, lane = F.lane, wave = F.wave, r32 = lane & 31, hi = lane >> 5;
    for (int id = F.bid; id < 256; id += F.G) {
        const int b = id >> 5, h = (id >> 3) & 3, dir = (id >> 2) & 1, vs = id & 3;
        const unsigned char* gwb = GW + (size_t)(((b * 4 + h) * 2 + dir) * 132) * GW_UNIT;
        f32x16 Sacc;
#pragma unroll
        for (int r = 0; r < 16; ++r) Sacc[r] = 0.f;
        for (int i = tid; i < 4608 / 4; i += 512) ((LAS unsigned*)(L + GL_ST))[i] = 0u;
        u32x4 t0, t1, t2, dv; bf16x8 vv;
#define GS_LOAD(n) do { const unsigned char* gu = gwb + (size_t)(n) * GW_UNIT + tid * 16; t0 = *(const u32x4*)(gu); t1 = *(const u32x4*)(gu + 8192); t2 = *(const u32x4*)(gu + 16384); \
        if (tid < 16) dv = *(const u32x4*)(gwb + (size_t)(n) * GW_UNIT + GW_DEC + tid * 16); \
        if (tid < 256) vv = *(const bf16x8*)(P + (size_t)GLA_ROWF(b, dir, n, tid >> 2) * PW + 512 + h * 128 + vs * 32 + (tid & 3) * 8); } while (0)
        GS_LOAD(0);
        __syncthreads();
        for (int n = 0; n < 132; ++n) {
            { const int row = tid >> 3, c16 = (tid & 7) * 16;
              *(LAS u32x4*)(L + GL_QD + row * GL_RS + c16) = t0; *(LAS u32x4*)(L + GL_KE + row * GL_RS + c16) = t1; *(LAS u32x4*)(L + GL_AT + row * GL_RS + c16) = t2; }
            if (tid < 16) *(LAS u32x4*)(L + GL_DEC + tid * 16) = dv;
            if (tid < 256) { const int i = tid >> 2;
#pragma unroll
                for (int e = 0; e < 8; ++e) *(LAS unsigned short*)(L + GL_VT + ((tid & 3) * 8 + e) * GL_RS + i * 2) = (unsigned short)vv[e]; }
            __syncthreads();
            if (n + 1 < 132) GS_LOAD(n + 1);
            const LAS unsigned char* STc = L + GL_ST + (n & 1) * 4608; LAS unsigned char* STn = L + GL_ST + ((n + 1) & 1) * 4608;
            if (wave < 2) {
                const int ti = wave; f32x16 acc;
#pragma unroll
                for (int r = 0; r < 16; ++r) acc[r] = 0.f;
#pragma unroll
                for (int ks = 0; ks < 4; ++ks) acc = __builtin_amdgcn_mfma_f32_32x32x16_bf16(lds_frag(L + GL_AT, ti * 32 + r32, ks * 32 + hi * 16), lds_frag(L + GL_VT, r32, ks * 32 + hi * 16), acc, 0, 0, 0);
#pragma unroll
                for (int ks = 0; ks < 4; ++ks) acc = __builtin_amdgcn_mfma_f32_32x32x16_bf16(lds_frag(L + GL_QD, ti * 32 + r32, ks * 32 + hi * 16), lds_frag(STc, r32, ks * 32 + hi * 16), acc, 0, 0, 0);
                bf16* O = wsp<bf16>(F, WS_GLAO) + (size_t)dir * NTOK * 512 + h * 128 + vs * 32 + r32;
#pragma unroll
                for (int r = 0; r < 16; ++r) { const int i = ti * 32 + (r & 3) + 8 * (r >> 2) + 4 * hi; O[(size_t)GLA_ROWF(b, dir, n, i) * 512] = (bf16)f2bf(acc[r]); }
            } else if (wave < 4) {
                const int dt = wave - 2;
#pragma unroll
                for (int g = 0; g < 4; ++g) { const f32x4 dvv = *(const LAS f32x4*)(L + GL_DEC + (dt * 32 + 8 * g + 4 * hi) * 4);
#pragma unroll
                    for (int z = 0; z < 4; ++z) Sacc[4 * g + z] *= dvv[z]; }
#pragma unroll
                for (int ks = 0; ks < 4; ++ks) Sacc = __builtin_amdgcn_mfma_f32_32x32x16_bf16(lds_frag(L + GL_KE, dt * 32 + r32, ks * 32 + hi * 16), lds_frag(L + GL_VT, r32, ks * 32 + hi * 16), Sacc, 0, 0, 0);
#pragma unroll
                for (int g = 0; g < 4; ++g) *(LAS u32x2*)(STn + r32 * GL_RS + (dt * 32 + 8 * g + 4 * hi) * 2) = (u32x2){cvt_pk_bf16(Sacc[4 * g], Sacc[4 * g + 1]), cvt_pk_bf16(Sacc[4 * g + 2], Sacc[4 * g + 3])};
            }
            __syncthreads();
        }
#undef GS_LOAD
    }
}
__device__ __forceinline__ void wave_sum4(float& a, float& b, float& c, float& d) {
#define WS4_STEP(ctl) "v_add_f32_dpp %0, %0, %0 " ctl "\n\tv_add_f32_dpp %1, %1, %1 " ctl "\n\tv_add_f32_dpp %2, %2, %2 " ctl "\n\tv_add_f32_dpp %3, %3, %3 " ctl "\n\t"
    asm volatile("s_nop 1\n\t"
                 WS4_STEP("quad_perm:[1,0,3,2] row_mask:0xf bank_mask:0xf")
                 WS4_STEP("quad_perm:[2,3,0,1] row_mask:0xf bank_mask:0xf")
                 WS4_STEP("row_half_mirror row_mask:0xf bank_mask:0xf")
                 WS4_STEP("row_mirror row_mask:0xf bank_mask:0xf")
                 WS4_STEP("row_bcast:15 row_mask:0xa bank_mask:0xf")
                 WS4_STEP("row_bcast:31 row_mask:0xc bank_mask:0xf")
                 "s_nop 0"
                 : "+v"(a), "+v"(b), "+v"(c), "+v"(d));
#undef WS4_STEP
    a = __builtin_bit_cast(float, __builtin_amdgcn_readlane(__builtin_bit_cast(int, a), 63)); b = __builtin_bit_cast(float, __builtin_amdgcn_readlane(__builtin_bit_cast(int, b), 63));
    c = __builtin_bit_cast(float, __builtin_amdgcn_readlane(__builtin_bit_cast(int, c), 63)); d = __builtin_bit_cast(float, __builtin_amdgcn_readlane(__builtin_bit_cast(int, d), 63));
}
#define LDS_BARRIER() asm volatile("s_waitcnt lgkmcnt(0)\n\ts_barrier" ::: "memory")
__device__ __forceinline__ void red16x2(float& a, float& b) {
    asm volatile("s_nop 1\n\t"
                 "v_add_f32_dpp %0, %0, %0 quad_perm:[1,0,3,2] row_mask:0xf bank_mask:0xf\n\t"
                 "v_add_f32_dpp %1, %1, %1 quad_perm:[1,0,3,2] row_mask:0xf bank_mask:0xf\n\t"
                 "s_nop 0\n\t"
                 "v_add_f32_dpp %0, %0, %0 quad_perm:[2,3,0,1] row_mask:0xf bank_mask:0xf\n\t"
                 "v_add_f32_dpp %1, %1, %1 quad_perm:[2,3,0,1] row_mask:0xf bank_mask:0xf\n\t"
                 "s_nop 0\n\t"
                 "v_add_f32_dpp %0, %0, %0 row_half_mirror row_mask:0xf bank_mask:0xf\n\t"
                 "v_add_f32_dpp %1, %1, %1 row_half_mirror row_mask:0xf bank_mask:0xf\n\t"
                 "s_nop 0\n\t"
                 "v_add_f32_dpp %0, %0, %0 row_mirror row_mask:0xf bank_mask:0xf\n\t"
                 "v_add_f32_dpp %1, %1, %1 row_mirror row_mask:0xf bank_mask:0xf"
                 : "+v"(a), "+v"(b));
}
__device__ __forceinline__ void red8x2(float& a, float& b) {
    asm volatile("s_nop 1\n\t"
                 "v_add_f32_dpp %0, %0, %0 quad_perm:[1,0,3,2] row_mask:0xf bank_mask:0xf\n\t"
                 "v_add_f32_dpp %1, %1, %1 quad_perm:[1,0,3,2] row_mask:0xf bank_mask:0xf\n\t"
                 "s_nop 0\n\t"
                 "v_add_f32_dpp %0, %0, %0 quad_perm:[2,3,0,1] row_mask:0xf bank_mask:0xf\n\t"
                 "v_add_f32_dpp %1, %1, %1 quad_perm:[2,3,0,1] row_mask:0xf bank_mask:0xf\n\t"
                 "s_nop 0\n\t"
                 "v_add_f32_dpp %0, %0, %0 row_half_mirror row_mask:0xf bank_mask:0xf\n\t"
                 "v_add_f32_dpp %1, %1, %1 row_half_mirror row_mask:0xf bank_mask:0xf"
                 : "+v"(a), "+v"(b));
}
constexpr int RW_T = 32;
constexpr int RW_SS = 392;
constexpr int RW_BUF = RW_T * RW_SS * 4;
constexpr int RW_YB = 2 * RW_BUF;
constexpr int RW_YBSZ = 32 * 33 * 4;
__device__ __forceinline__ void p_rwkv_scan(Frame& F) {
    LAS unsigned char* L = F.lds;
    const bf16* P = wsp<const bf16>(F, WS_P); const bf16* LO = wsp<const bf16>(F, WS_LOUT);
    const int lane = F.lane, wave = F.wave;
    constexpr int NRD = (CTXL + SEQ) / RW_T;
    for (int id = F.bid; id < 256; id += F.G) {
        const int b = id >> 5, h = (id >> 2) & 7, dir = (id >> 1) & 1, rh = id & 1;
#define RW_ROW(s) ((s) < 256 ? NLAT + b * 256 + (dir ? 255 - (s) : (s)) : b * 8192 + (dir ? 8191 - ((s) - 256) : ((s) - 256)))
        if (wave >= 4) {
            const int pw = wave - 4, hj = h * 64 + lane;
            const float* mu = F.in[I_MU];
            const float cpr = mu[hj], cnr = mu[RW_COLS + hj], cpk = mu[512 + hj], cnk = mu[RW_COLS + 512 + hj], cpv = mu[1024 + hj], cnv = mu[RW_COLS + 1024 + hj];
            const float w0v = F.in[I_W0][dir * 512 + hj], a0v = F.in[I_A0][dir * 512 + hj], kkc = F.in[I_KK][hj], kac = F.in[I_KA][hj], rkc = F.in[I_RK][hj];
            unsigned xa[30], la[16], xb[30], lb[16];
#define RW_LOAD(rd, X, Lr) do { const int s0_ = (rd) * RW_T + pw * 8; const bool lo_ok = (s0_ != 0) && (s0_ != 256), hi_ok = (s0_ + 8 != 256) && (s0_ + 8 != NKEY); \
                const long sgn_ = dir ? -(long)PW : (long)PW; const bf16* pr0 = P + (size_t)RW_ROW(s0_) * PW + RW0 + hj; \
                _Pragma("unroll") for (int pp = -1; pp < 9; ++pp) { const int pc = (pp < 0 && !lo_ok) ? 0 : ((pp > 7 && !hi_ok) ? 7 : pp); const bf16* pr = pr0 + sgn_ * pc; \
                    X[3 * (pp + 1)] = pr[0]; X[3 * (pp + 1) + 1] = pr[512]; X[3 * (pp + 1) + 2] = pr[1024]; } \
                const long sgl_ = dir ? -(long)LRN : (long)LRN; const bf16* lr0 = LO + (size_t)RW_ROW(s0_) * LRN + dir * 512 + hj; \
                _Pragma("unroll") for (int pp = 0; pp < 8; ++pp) { Lr[2 * pp] = lr0[sgl_ * pp]; Lr[2 * pp + 1] = lr0[sgl_ * pp + 1024]; } } while (0)
#define RW_FEAT(rd, X, Lr) do { const int s0_ = (rd) * RW_T + pw * 8; const bool lo_ok = (s0_ != 0) && (s0_ != 256), hi_ok = (s0_ + 8 != 256) && (s0_ + 8 != NKEY); \
                const int row0_ = RW_ROW(s0_); \
                _Pragma("unroll") for (int q = 0; q < 8; ++q) { const int st = pw * 8 + q; \
                const bool vlo = (q > 0) || lo_ok, vhi = (q < 7) || hi_ok; const bool hp = dir ? vhi : vlo, hn = dir ? vlo : vhi; \
                  \
                const unsigned pr_ = dir ? X[3 * (q + 2)] : X[3 * q], nr_ = dir ? X[3 * q] : X[3 * (q + 2)], pk_ = dir ? X[3 * (q + 2) + 1] : X[3 * q + 1], nk_ = dir ? X[3 * q + 1] : X[3 * (q + 2) + 1], pv_ = dir ? X[3 * (q + 2) + 2] : X[3 * q + 2], nv_ = dir ? X[3 * q + 2] : X[3 * (q + 2) + 2]; \
                const float r0 = bf2f(X[3 * (q + 1)]), k0 = bf2f(X[3 * (q + 1) + 1]), v0 = bf2f(X[3 * (q + 1) + 2]); \
                const float xr = r0 + cpr * ((hp ? bf2f(pr_) : 0.f) - r0) + cnr * ((hn ? bf2f(nr_) : 0.f) - r0); \
                const float xk = k0 + cpk * ((hp ? bf2f(pk_) : 0.f) - k0) + cnk * ((hn ? bf2f(nk_) : 0.f) - k0); \
                const float xv = v0 + cpv * ((hp ? bf2f(pv_) : 0.f) - v0) + cnv * ((hn ? bf2f(nv_) : 0.f) - v0); \
                  \
                const float sg = __builtin_amdgcn_rcpf(1.f + __expf(-(w0v + bf2f(Lr[2 * q])))); \
                const float wdec = __expf(-0.60653066f * sg); \
                const float alr = __builtin_amdgcn_rcpf(1.f + __expf(-(a0v + bf2f(Lr[2 * q + 1])))); \
                const float kkv = xk * kkc; const float kd = xk * (1.f + (alr - 1.f) * kac); \
                float n2 = kkv * kkv, bon = xr * kd * rkc, kr = kd * xr, br = kkv * alr * xr; \
                wave_sum4(n2, bon, kr, br); \
                const float rn = __builtin_amdgcn_rsqf(fmaxf(n2, 1e-24f)); const float kk = kkv * rn; const float bb = kk * alr; br *= rn; \
                if (rh == 0 && lane == 0) wsp<float>(F, WS_BONUS)[((size_t)dir * NTOK + (dir ? row0_ - q : row0_ + q)) * 8 + h] = bon; \
                LAS float* o = (LAS float*)(L + ((rd) & 1) * RW_BUF) + st * RW_SS; \
                o[lane] = wdec; o[64 + lane] = -kk; o[128 + lane] = bb; o[192 + lane] = kd; o[256 + lane] = wdec * xr; o[320 + lane] = xv; \
                if (lane == 0) { o[384] = br; o[385] = kr; } } } while (0)
#define RW_YOUT(rd) do { const LAS float* yb = (const LAS float*)(L + RW_YB + ((rd) & 1) * RW_YBSZ); _Pragma("unroll") for (int e = 0; e < 2; ++e) { const int pt = pw * 64 + lane, st = (pt >> 4) + 16 * e, r2 = (pt & 15) * 2; const int s = (rd) * RW_T + st; \
                *(unsigned*)(wsp<bf16>(F, WS_RWY) + ((size_t)dir * NTOK + RW_ROW(s)) * 512 + h * 64 + rh * 32 + r2) = cvt_pk_bf16(yb[r2 * 33 + st], yb[(r2 + 1) * 33 + st]); } } while (0)
            RW_LOAD(0, xa, la); RW_LOAD(1, xb, lb); RW_FEAT(0, xa, la);
            LDS_BARRIER();
            for (int rd = 0; rd < NRD; rd += 2) {
                if (rd + 2 < NRD) RW_LOAD(rd + 2, xa, la);
                RW_FEAT(rd + 1, xb, lb);
                if (rd > 0) RW_YOUT(rd - 1);
                LDS_BARRIER();
                if (rd + 3 < NRD) RW_LOAD(rd + 3, xb, lb);
                if (rd + 2 < NRD) RW_FEAT(rd + 2, xa, la);
                RW_YOUT(rd);
                LDS_BARRIER();
            }
            RW_YOUT(NRD - 1);
#undef RW_LOAD
#undef RW_FEAT
#undef RW_YOUT
        } else {
            const int rowl = wave * 8 + (lane >> 3), jl = lane & 7;
            float s[8];
#pragma unroll
            for (int e = 0; e < 8; ++e) s[e] = 0.f;
            LDS_BARRIER();
            for (int rd = 0; rd < NRD; ++rd) {
                const LAS float* sb = (const LAS float*)(L + (rd & 1) * RW_BUF);
                LAS float* yb = (LAS float*)(L + RW_YB + (rd & 1) * RW_YBSZ);
                float yk = 0.f;
                f32x4 w[2], a[2], bq[2], k[2], q[2], nw[2], na[2], nb[2], nk[2], nq[2]; float vv, nvv; f32x2 sc, nsc;
#define RW_OPS(W, A, B, K, Q, V, S, st) do { const LAS float* p = sb + (st) * RW_SS + 8 * jl; _Pragma("unroll") for (int e = 0; e < 2; ++e) { W[e] = *(const LAS f32x4*)(p + 4 * e); A[e] = *(const LAS f32x4*)(p + 64 + 4 * e); \
                    B[e] = *(const LAS f32x4*)(p + 128 + 4 * e); K[e] = *(const LAS f32x4*)(p + 192 + 4 * e); Q[e] = *(const LAS f32x4*)(p + 256 + 4 * e); } \
                    V = sb[(st) * RW_SS + 320 + rh * 32 + rowl]; S = *(const LAS f32x2*)(sb + (st) * RW_SS + 384); } while (0)
                RW_OPS(w, a, bq, k, q, vv, sc, 0);
#pragma unroll
                for (int st = 0; st < RW_T; ++st) {
                    if (st + 1 < RW_T) RW_OPS(nw, na, nb, nk, nq, nvv, nsc, st + 1);
                    float pa = 0.f, pa2 = 0.f, py = 0.f, py2 = 0.f, t[8];
#pragma unroll
                    for (int e = 0; e < 2; ++e) { pa += s[4 * e] * a[e].x; pa2 += s[4 * e + 1] * a[e].y; pa += s[4 * e + 2] * a[e].z; pa2 += s[4 * e + 3] * a[e].w;
                        py += s[4 * e] * q[e].x; py2 += s[4 * e + 1] * q[e].y; py += s[4 * e + 2] * q[e].z; py2 += s[4 * e + 3] * q[e].w;
                        t[4 * e] = s[4 * e] * w[e].x + vv * k[e].x; t[4 * e + 1] = s[4 * e + 1] * w[e].y + vv * k[e].y; t[4 * e + 2] = s[4 * e + 2] * w[e].z + vv * k[e].z; t[4 * e + 3] = s[4 * e + 3] * w[e].w + vv * k[e].w; }
                    pa += pa2; py += py2;
                    red8x2(pa, py);
#pragma unroll
                    for (int e = 0; e < 2; ++e) { s[4 * e] = t[4 * e] + pa * bq[e].x; s[4 * e + 1] = t[4 * e + 1] + pa * bq[e].y; s[4 * e + 2] = t[4 * e + 2] + pa * bq[e].z; s[4 * e + 3] = t[4 * e + 3] + pa * bq[e].w; }
                    const float y = py + pa * sc.x + vv * sc.y;
                    yk = (jl == (st & 7)) ? y : yk;
                    if ((st & 7) == 7) yb[rowl * 33 + (st - 7) + jl] = yk;
#pragma unroll
                    for (int e = 0; e < 2; ++e) { w[e] = nw[e]; a[e] = na[e]; bq[e] = nb[e]; k[e] = nk[e]; q[e] = nq[e]; }
                    vv = nvv; sc = nsc;
                    __builtin_amdgcn_sched_barrier(0);
                }
#undef RW_OPS
                LDS_BARRIER();
            }
        }
#undef RW_ROW
        VM_WAIT(); __syncthreads();
    }
}

__device__ __forceinline__ void p_mix_finish(Frame& F) {
    const int gw = F.bid * 8 + F.wave, NGW = F.G * 8, lane = F.lane;
    const bf16* P = wsp<const bf16>(F, WS_P); const bf16* LO = wsp<const bf16>(F, WS_LOUT);
    const bf16* GO = wsp<const bf16>(F, WS_GLAO); const bf16* RY = wsp<const bf16>(F, WS_RWY); const float* BON = wsp<const float>(F, WS_BONUS);
    bf16* MIX = wsp<bf16>(F, WS_H);
    const int c0 = lane * 8;
    float gng[8], lnw[8], lnb[8], cpv[8], cnv[8];
#pragma unroll
    for (int e = 0; e < 8; ++e) { gng[e] = F.in[I_GNG][(c0 + e) & 127]; lnw[e] = F.in[I_LNW][c0 + e]; lnb[e] = F.in[I_LNB][c0 + e]; cpv[e] = F.in[I_MU][1024 + c0 + e]; cnv[e] = F.in[I_MU][RW_COLS + 1024 + c0 + e]; }
    for (int row = gw; row < NTOK; row += NGW) {
        { const u32x4 a = *(const u32x4*)(GO + (size_t)row * 512 + c0), bb = *(const u32x4*)(GO + ((size_t)NTOK + row) * 512 + c0), og = *(const u32x4*)(P + (size_t)row * PW + 1024 + c0);
          float o[8]; float ss = 0.f;
#pragma unroll
          for (int e = 0; e < 4; ++e) { o[2 * e] = bflo(a[e]) + bflo(bb[e]); o[2 * e + 1] = bfhi(a[e]) + bfhi(bb[e]); ss += o[2 * e] * o[2 * e] + o[2 * e + 1] * o[2 * e + 1]; }
          ss += __shfl_xor(ss, 1); ss += __shfl_xor(ss, 2); ss += __shfl_xor(ss, 4); ss += __shfl_xor(ss, 8);
          const float rstd = 1.f / sqrtf(ss * (1.f / 128.f) + 1e-6f);
          float y[8];
#pragma unroll
          for (int e = 0; e < 4; ++e) { const float g0 = bflo(og[e]), g1 = bfhi(og[e]);
              y[2 * e] = o[2 * e] * rstd * gng[2 * e] * (g0 * __builtin_amdgcn_rcpf(1.f + __expf(-g0))); y[2 * e + 1] = o[2 * e + 1] * rstd * gng[2 * e + 1] * (g1 * __builtin_amdgcn_rcpf(1.f + __expf(-g1))); }
          *(u32x4*)(MIX + (size_t)row * 1024 + c0) = (u32x4){cvt_pk_bf16(y[0], y[1]), cvt_pk_bf16(y[2], y[3]), cvt_pk_bf16(y[4], y[5]), cvt_pk_bf16(y[6], y[7])}; }
        { bool hp, hn; seq_pos(row, hp, hn);
          const u32x4 a = *(const u32x4*)(RY + (size_t)row * 512 + c0), bb = *(const u32x4*)(RY + ((size_t)NTOK + row) * 512 + c0);
          const bf16* pv = P + (size_t)row * PW + RW0 + 1024 + c0;
          const u32x4 v0 = *(const u32x4*)pv; u32x4 vm = (u32x4){0u, 0u, 0u, 0u}, vn = (u32x4){0u, 0u, 0u, 0u};
          if (hp) vm = *(const u32x4*)(pv - PW); if (hn) vn = *(const u32x4*)(pv + PW);
          const u32x4 gg = *(const u32x4*)(LO + (size_t)row * LRN + 2048 + c0);
          const int hd = lane >> 3; const float bon = BON[(size_t)row * 8 + hd] + BON[((size_t)NTOK + row) * 8 + hd];
          float yv[8]; float sm = 0.f;
#pragma unroll
          for (int e = 0; e < 4; ++e) { yv[2 * e] = bflo(a[e]) + bflo(bb[e]); yv[2 * e + 1] = bfhi(a[e]) + bfhi(bb[e]); sm += yv[2 * e] + yv[2 * e + 1]; }
          sm += __shfl_xor(sm, 1); sm += __shfl_xor(sm, 2); sm += __shfl_xor(sm, 4);
          const float mean = sm * (1.f / 64.f); float sv = 0.f;
#pragma unroll
          for (int e = 0; e < 8; ++e) { const float d = yv[e] - mean; sv += d * d; }
          sv += __shfl_xor(sv, 1); sv += __shfl_xor(sv, 2); sv += __shfl_xor(sv, 4);
          const float rstd = 1.f / sqrtf(sv * (1.f / 64.f) + 64e-5f);
          float o[8];
#pragma unroll
          for (int e = 0; e < 8; ++e) { const unsigned w0 = v0[e >> 1], wm = vm[e >> 1], wn = vn[e >> 1];
              const float p0 = (e & 1) ? bfhi(w0) : bflo(w0), pm = (e & 1) ? bfhi(wm) : bflo(wm), pn = (e & 1) ? bfhi(wn) : bflo(wn);
              const float xv = p0 + cpv[e] * (pm - p0) + cnv[e] * (pn - p0);
              const float g = (e & 1) ? bfhi(gg[e >> 1]) : bflo(gg[e >> 1]);
              o[e] = ((yv[e] - mean) * rstd * lnw[e] + lnb[e] + bon * xv) * g; }
          *(u32x4*)(MIX + (size_t)row * 1024 + 512 + c0) = (u32x4){cvt_pk_bf16(o[0], o[1]), cvt_pk_bf16(o[2], o[3]), cvt_pk_bf16(o[4], o[5]), cvt_pk_bf16(o[6], o[7])}; }
    }
}

__device__ __forceinline__ void p_mla_prep(Frame& F) {
    const int gw = F.bid * 8 + F.wave, NGW = F.G * 8, lane = F.lane;
    const bf16* C = wsp<const bf16>(F, WS_C); bf16* QN = wsp<bf16>(F, WS_QN); bf16* KVN = wsp<bf16>(F, WS_KVN); unsigned char* K8 = wsp<unsigned char>(F, WS_K8);
    const f32x2* ROPE = wsp<const f32x2>(F, WS_ROPE);
    const f32x4 qg = ((const f32x4*)F.in[I_QNORM])[lane]; const f32x4 kg = ((const f32x4*)F.in[I_KVNORM])[lane & 31];
    for (int row = gw; row < NTOK; row += NGW) {
        const bf16* cr = C + (size_t)row * 512;
        const u32x2 cqw = ((const u32x2*)cr)[lane], ckw = ((const u32x2*)(cr + 256))[lane & 31];
        const f32x4 cq = {bflo(cqw.x), bfhi(cqw.x), bflo(cqw.y), bfhi(cqw.y)};
        const f32x4 ck = {bflo(ckw.x), bfhi(ckw.x), bflo(ckw.y), bfhi(ckw.y)};
        const float xr = bflo((unsigned)cr[384 + lane]);
        const float ssq = wave_sum((cq.x * cq.x + cq.y * cq.y) + (cq.z * cq.z + cq.w * cq.w));
        const float ssk = wave_sum(lane < 32 ? (ck.x * ck.x + ck.y * ck.y) + (ck.z * ck.z + ck.w * ck.w) : 0.f);
        if (row < NLAT) { const float rs = 1.f / sqrtf(ssq * (1.f / 256.f) + 1e-6f);
            ((u32x2*)(QN + (size_t)row * 256))[lane] = (u32x2){cvt_pk_bf16(cq.x * rs * qg.x, cq.y * rs * qg.y), cvt_pk_bf16(cq.z * rs * qg.z, cq.w * rs * qg.w)}; }
        { const float rs = 1.f / sqrtf(ssk * (1.f / 128.f) + 1e-6f);
          u32x2 w = (u32x2){0u, 0u};
          if (lane < 32) w = (u32x2){cvt_pk_bf16(ck.x * rs * kg.x, ck.y * rs * kg.y), cvt_pk_bf16(ck.z * rs * kg.z, ck.w * rs * kg.w)};
          ((u32x2*)(KVN + (size_t)row * 256))[lane] = w; }
        float kr = xr; int b, key;
        const float pr = __shfl_xor(xr, 16);
        if (row < NLAT) { b = row >> 13; const int t = row & 8191; key = CTXL + t;
            const f32x2 cs = ROPE[t * 32 + ((lane >> 5) << 4) + (lane & 15)];
            kr = (lane & 16) ? xr * cs.x + pr * cs.y : xr * cs.x - pr * cs.y;
        } else { b = (row - NLAT) >> 8; key = (row - NLAT) & 255; }
        const unsigned char kb = (unsigned char)(pk4_fp8(kr, 0.f, 0.f, 0.f) & 0xffu);
#pragma unroll
        for (int h = 0; h < 8; ++h) K8[((size_t)((b * 8 + h) * NKEY + key)) * K8ROW + 128 + lane] = kb;
    }
}
__host__ __device__ constexpr int att_kperm(int p) { const int hi = p >> 5, j = p & 31, r = j & 15; return (j >> 4) * 32 + (r & 3) + 8 * (r >> 2) + 4 * hi; }

namespace att {
constexpr float SCALE = 0.07216878364870322f;
constexpr float THR = 2.f;
constexpr float PLOG2 = 5.f;
constexpr int KSLOT = 16384, KTILE = 64 * K8ROW, VSLOT = 8192;
constexpr int LDS_K = 0, LDS_V = 4 * KSLOT, LDS_WS = LDS_V + 4 * VSLOT, LDS_Q = LDS_WS + 2048;
constexpr int NT = NKEY / 64;
constexpr int ONE = 0x7F7F7F7F;
constexpr int QSCL = 0x7C7C7C7C;
__device__ __forceinline__ int crow(int r, int hi) { return (r & 3) + 8 * (r >> 2) + 4 * hi; }
constexpr float PMAXSUM = 416.f, PTARGET = 64.f;
__device__ __forceinline__ void partialSM(f32x16& p0, f32x16& p1, float moff) {
#pragma unroll
    for (int r = 0; r < 16; ++r) p0[r] -= moff;
#pragma unroll
    for (int r = 0; r < 16; ++r) p1[r] -= moff;
#pragma unroll
    for (int r = 0; r < 16; ++r) p0[r] = __builtin_amdgcn_exp2f(p0[r]);
}
__device__ __forceinline__ void finishSM(f32x16& p0, f32x16& p1, float& moff, float& alpha, float& l_reg, i32x8& pa) {
#pragma unroll
    for (int r = 0; r < 16; ++r) p1[r] = __builtin_amdgcn_exp2f(p1[r]);
    float ps = 0;
#pragma unroll
    for (int r = 0; r < 16; ++r) ps += p0[r];
#pragma unroll
    for (int r = 0; r < 16; ++r) ps += p1[r];
    { auto rr = __builtin_amdgcn_permlane32_swap(__float_as_uint(ps), __float_as_uint(ps), false, false); ps = __uint_as_float(rr[0]) + __uint_as_float(rr[1]); }
    alpha = 1.f;
    if (__builtin_expect(__any(ps > PMAXSUM), 0)) {
        alpha = ps > PMAXSUM ? PTARGET * __builtin_amdgcn_rcpf(ps) : 1.f;
        ps *= alpha; moff -= __builtin_amdgcn_logf(alpha);
#pragma unroll
        for (int g = 0; g < 4; ++g) { pa[g] = (int)pk4_fp8(p0[4 * g] * alpha, p0[4 * g + 1] * alpha, p0[4 * g + 2] * alpha, p0[4 * g + 3] * alpha); pa[4 + g] = (int)pk4_fp8(p1[4 * g] * alpha, p1[4 * g + 1] * alpha, p1[4 * g + 2] * alpha, p1[4 * g + 3] * alpha); }
    } else {
#pragma unroll
        for (int g = 0; g < 4; ++g) { pa[g] = (int)pk4_fp8(p0[4 * g], p0[4 * g + 1], p0[4 * g + 2], p0[4 * g + 3]); pa[4 + g] = (int)pk4_fp8(p1[4 * g], p1[4 * g + 1], p1[4 * g + 2], p1[4 * g + 3]); }
    }
    l_reg = l_reg * alpha + ps;
}
__device__ __forceinline__ i32x8 ld32(const LAS unsigned char* p0, const LAS unsigned char* p1) { return __builtin_shufflevector(*(const LAS i32x4*)p0, *(const LAS i32x4*)p1, 0, 1, 2, 3, 4, 5, 6, 7); }
__device__ __forceinline__ void qkt(f32x16& p0, f32x16& p1, const LAS unsigned char* Ks, const LAS unsigned char* Qs, int r32, int hi) {
#pragma unroll
    for (int r = 0; r < 16; ++r) { p0[r] = 0.f; p1[r] = 0.f; }
#pragma unroll
    for (int m = 0; m < 3; ++m) { const LAS unsigned char* k0 = Ks + r32 * K8ROW + m * 64 + hi * 32; const LAS unsigned char* k1 = k0 + 32 * K8ROW;
        const i32x8 a0 = ld32(k0, k0 + 16), a1 = ld32(k1, k1 + 16), qm = ld32(Qs + m * 2048, Qs + m * 2048 + 1024);
        p0 = __builtin_amdgcn_mfma_scale_f32_32x32x64_f8f6f4(a0, qm, p0, 0, 0, 0, ONE, 0, QSCL);
        p1 = __builtin_amdgcn_mfma_scale_f32_32x32x64_f8f6f4(a1, qm, p1, 0, 0, 0, ONE, 0, QSCL); }
}
__device__ __forceinline__ void pv(f32x16 (&o)[4], const LAS unsigned char* Vs, const i32x8 pa, int r32, int hi) {
#pragma unroll
    for (int d0 = 0; d0 < 4; ++d0) { const int c = d0 * 32 + r32, sw = (c >> 2) & 3; const LAS unsigned char* vr = Vs + c * 64;
        const i32x8 vb = ld32(vr + (((2 * hi) ^ sw) << 4), vr + (((2 * hi + 1) ^ sw) << 4));
        o[d0] = __builtin_amdgcn_mfma_scale_f32_32x32x64_f8f6f4(pa, vb, o[d0], 0, 0, 0, ONE, 0, ONE); }
}
__device__ __forceinline__ int pk4n(float a, float b, float c, float d, int w) { w = __builtin_amdgcn_cvt_pk_fp8_f32(a, b, w, false); w = __builtin_amdgcn_cvt_pk_fp8_f32(c, d, w, true); return w; }
#define ATT_MMA(a, b, c) __builtin_amdgcn_mfma_scale_f32_32x32x64_f8f6f4(a, b, c, 0, 0, 0, ONE, 0, ONE)
#define ATT_MMQ(a, b, c) __builtin_amdgcn_mfma_scale_f32_32x32x64_f8f6f4(a, b, c, 0, 0, 0, ONE, 0, QSCL)
#define ATT_EXP(P, i0, n) do { _Pragma("unroll") for (int _r = (i0); _r < (i0) + (n); ++_r) P[_r] = __builtin_amdgcn_exp2f(P[_r]); } while (0)
__device__ __forceinline__ void half_step(f32x16& X0, f32x16& X1, f32x16& Y0, f32x16& Y1, const LAS unsigned char* Ks, const LAS unsigned char* Vs, const LAS unsigned char* Qs, f32x16 (&o)[4],
                                          float& moff, float& l_reg, i32x8& pa, bool& offs, LAS float* al_l, int r32, int hi) {
    f32x16 zz;
#pragma unroll
    for (int r = 0; r < 16; ++r) zz[r] = 0.f;
    SBAR();
    const LAS unsigned char* k0 = Ks + r32 * K8ROW + hi * 32; const LAS unsigned char* k1 = k0 + 32 * K8ROW;
#define ATT_Q(m) ld32(Qs + (m) * 2048, Qs + (m) * 2048 + 1024)
#define ATT_V(d0) ld32(Vs + ((d0) * 32 + r32) * 64 + (((2 * hi) ^ ((((d0) * 32 + r32) >> 2) & 3)) << 4), Vs + ((d0) * 32 + r32) * 64 + (((2 * hi + 1) ^ ((((d0) * 32 + r32) >> 2) & 3)) << 4))
    const i32x8 q0 = ATT_Q(0); const i32x8 ka0 = ld32(k0, k0 + 16), kb0 = ld32(k1, k1 + 16);
    const i32x8 q1 = ATT_Q(1); const i32x8 ka1 = ld32(k0 + 64, k0 + 80);
    ATT_EXP(X1, 0, 4); SBAR();
    Y0 = ATT_MMQ(ka0, q0, zz); SBAR();
    const i32x8 kb1 = ld32(k1 + 64, k1 + 80);
    ATT_EXP(X1, 4, 4); SBAR();
    Y1 = ATT_MMQ(kb0, q0, zz); SBAR();
    const i32x8 q2 = ATT_Q(2); const i32x8 ka2 = ld32(k0 + 128, k0 + 144);
    ATT_EXP(X1, 8, 4); SBAR();
    Y0 = ATT_MMQ(ka1, q1, Y0); SBAR();
    const i32x8 kb2 = ld32(k1 + 128, k1 + 144);
    ATT_EXP(X1, 12, 4); SBAR();
    Y1 = ATT_MMQ(kb1, q1, Y1); SBAR();
    f32x2 sa = {X0[0], X0[1]}, sb = {X1[0], X1[1]};
#pragma unroll
    for (int r = 1; r < 8; ++r) { sa += (f32x2){X0[2 * r], X0[2 * r + 1]}; sb += (f32x2){X1[2 * r], X1[2 * r + 1]}; }
    sa += sb; float ps = sa.x + sa.y;
    { auto rr = __builtin_amdgcn_permlane32_swap(__float_as_uint(ps), __float_as_uint(ps), false, false); ps = __uint_as_float(rr[0]) + __uint_as_float(rr[1]); }
    SBAR();
    Y0 = ATT_MMQ(ka2, q2, Y0); SBAR();
    i32x8 vb[4];
    vb[0] = ATT_V(0); vb[1] = ATT_V(1);
#pragma unroll
    for (int g = 0; g < 4; ++g) pa[g] = pk4n(X0[4 * g], X0[4 * g + 1], X0[4 * g + 2], X0[4 * g + 3], pa[g]);
    SBAR();
    Y1 = ATT_MMQ(kb2, q2, Y1); SBAR();
#pragma unroll
    for (int g = 0; g < 4; ++g) pa[4 + g] = pk4n(X1[4 * g], X1[4 * g + 1], X1[4 * g + 2], X1[4 * g + 3], pa[4 + g]);
    asm volatile("" :: "v"(Y0), "v"(Y1), "v"(pa));
    SBAR();
    if (__builtin_expect(__any(ps > PMAXSUM), 0)) {
        const float alpha = ps > PMAXSUM ? PTARGET * __builtin_amdgcn_rcpf(ps) : 1.f;
        ps *= alpha; moff -= __builtin_amdgcn_logf(alpha); l_reg *= alpha; offs = true;
#pragma unroll
        for (int g = 0; g < 4; ++g) { pa[g] = (int)pk4_fp8(X0[4 * g] * alpha, X0[4 * g + 1] * alpha, X0[4 * g + 2] * alpha, X0[4 * g + 3] * alpha); pa[4 + g] = (int)pk4_fp8(X1[4 * g] * alpha, X1[4 * g + 1] * alpha, X1[4 * g + 2] * alpha, X1[4 * g + 3] * alpha); }
        if (hi == 0) al_l[r32] = alpha;
        asm volatile("s_waitcnt lgkmcnt(0)" ::: "memory");
#pragma unroll
        for (int d = 0; d < 4; ++d)
#pragma unroll
            for (int r = 0; r < 16; ++r) o[d][r] *= al_l[crow(r, hi)];
    }
    l_reg += ps;
#define ATT_SUB(P) do { _Pragma("unroll") for (int _r = 0; _r < 16; ++_r) P[_r] -= moff; } while (0)
#define ATT_R2(S0, S1) do { SBAR(); \
    o[0] = ATT_MMA(pa, vb[0], o[0]); SBAR(); vb[2] = ATT_V(2); S0; ATT_EXP(Y0, 0, 3); SBAR(); \
    o[1] = ATT_MMA(pa, vb[1], o[1]); SBAR(); vb[3] = ATT_V(3); ATT_EXP(Y0, 3, 5); SBAR(); \
    o[2] = ATT_MMA(pa, vb[2], o[2]); SBAR(); ATT_EXP(Y0, 8, 5); SBAR(); \
    o[3] = ATT_MMA(pa, vb[3], o[3]); SBAR(); ATT_EXP(Y0, 13, 3); S1; \
    asm volatile("" :: "v"(o[0]), "v"(o[1]), "v"(o[2]), "v"(o[3]), "v"(Y0), "v"(Y1));     \
    SBAR(); } while (0)
    if (__builtin_expect(offs, 0)) ATT_R2(ATT_SUB(Y0), ATT_SUB(Y1)); else ATT_R2((void)0, (void)0);
#undef ATT_R2
#undef ATT_SUB
}
__device__ __forceinline__ void glds16(const void* gsrc, LAS unsigned char* lds_wave_base) { unsigned keep; const unsigned dst = (unsigned)__builtin_amdgcn_readfirstlane((int)(uintptr_t)lds_wave_base);
    asm volatile("s_mov_b32 %0, m0\n\ts_mov_b32 m0, %2\n\ts_nop 0\n\tglobal_load_lds_dwordx4 %1, off\n\ts_mov_b32 m0, %0" : "=&s"(keep) : "v"(gsrc), "s"(dst) : "memory"); }

__device__ __forceinline__ void unit(const unsigned char* __restrict__ Qb, const unsigned char* __restrict__ Kh, const unsigned char* __restrict__ Vh, unsigned char* __restrict__ Ob, LAS unsigned char* lds, int tid) {
    const int wid = __builtin_amdgcn_readfirstlane(tid >> 6), lane = tid & 63, r32 = lane & 31, hi = lane >> 5;
    LAS float* ws = (LAS float*)(lds + LDS_WS) + wid * 64; LAS float* li_l = ws; LAS float* al_l = ws + 32;
    float l_reg = 0.f; f32x16 o[4];
#pragma unroll
    for (int d = 0; d < 4; ++d)
#pragma unroll
        for (int r = 0; r < 16; ++r) o[d][r] = 0.f;
    const unsigned char* Qw = Qb + (size_t)(wid * 32 + r32) * QKD + hi * 32;
#pragma unroll
    for (int m = 0; m < 3; ++m) { *(LAS i32x4*)(lds + LDS_Q + wid * 6144 + m * 2048 + lane * 16) = *(const i32x4*)(Qw + m * 64); *(LAS i32x4*)(lds + LDS_Q + wid * 6144 + m * 2048 + 1024 + lane * 16) = *(const i32x4*)(Qw + m * 64 + 16); }
    const LAS unsigned char* Qs = lds + LDS_Q + wid * 6144 + lane * 16;
    const unsigned pofs = (unsigned)(wid * 1024 + lane * 16);
#define DMA_K(j, slot) do { _Pragma("unroll") for (int _i = 0; _i < 2; ++_i) glds16(Kh + (size_t)(j) * KTILE + _i * 8192 + pofs, lds + LDS_K + (slot) * KSLOT + _i * 8192 + wid * 1024); } while (0)
#define DMA_V(j, slot) glds16(Vh + (size_t)(j) * VSLOT + pofs, lds + LDS_V + (slot) * VSLOT + wid * 1024)
#define WAITBAR(n) asm volatile("s_waitcnt vmcnt(" #n ")\n\ts_barrier" ::: "memory")
#define RESC(a) do { if (__any((a) < 1.f)) { if (hi == 0) al_l[r32] = (a); asm volatile("s_waitcnt lgkmcnt(0)" ::: "memory"); \
    _Pragma("unroll") for (int d = 0; d < 4; ++d) _Pragma("unroll") for (int r = 0; r < 16; ++r) o[d][r] *= al_l[crow(r, hi)]; } } while (0)
    f32x16 pA0, pA1, pB0, pB1; float moff = 0.f, al; i32x8 pa = {0, 0, 0, 0, 0, 0, 0, 0}; bool offs = false;
    if (wid >= 4) __builtin_amdgcn_s_setprio(1);
    asm volatile("s_barrier" ::: "memory");
    DMA_K(0, 0); DMA_K(1, 1); DMA_K(2, 2); DMA_V(0, 0); DMA_V(1, 1);
    WAITBAR(6);
    qkt(pA0, pA1, lds + LDS_K, Qs, r32, hi); partialSM(pA0, pA1, moff);
    WAITBAR(0);
    for (int j = 1; j + 1 < NT; j += 2) {
        DMA_K(j + 2, (j + 2) & 3); if (j + 3 < NT) DMA_K(j + 3, (j + 3) & 3);
        DMA_V(j + 1, (j + 1) & 3); DMA_V(j + 2, (j + 2) & 3);
        half_step(pA0, pA1, pB0, pB1, lds + LDS_K + (j & 3) * KSLOT, lds + LDS_V + ((j - 1) & 3) * VSLOT, Qs, o, moff, l_reg, pa, offs, al_l, r32, hi);
        half_step(pB0, pB1, pA0, pA1, lds + LDS_K + ((j + 1) & 3) * KSLOT, lds + LDS_V + (j & 3) * VSLOT, Qs, o, moff, l_reg, pa, offs, al_l, r32, hi);
        WAITBAR(0);
    }
    int vs = (NT - 2) & 3;
    SBAR(); qkt(pB0, pB1, lds + LDS_K + ((NT - 1) & 3) * KSLOT, Qs, r32, hi);
    finishSM(pA0, pA1, moff, al, l_reg, pa); SBAR();
    RESC(al);
    pv(o, lds + LDS_V + vs * VSLOT, pa, r32, hi); partialSM(pB0, pB1, moff);
    vs = (NT - 1) & 3;
    finishSM(pB0, pB1, moff, al, l_reg, pa); SBAR();
    RESC(al);
    pv(o, lds + LDS_V + vs * VSLOT, pa, r32, hi);
    __builtin_amdgcn_s_setprio(0);
    if (hi == 0) li_l[r32] = l_reg; asm volatile("s_waitcnt lgkmcnt(0)" ::: "memory");
    float rli[16];
#pragma unroll
    for (int r = 0; r < 16; ++r) rli[r] = __builtin_amdgcn_rcpf(li_l[crow(r, hi)]);
    unsigned char* Ow = Ob + (size_t)(wid * 32) * 1024;
#pragma unroll
    for (int r = 0; r < 16; ++r) { const int orow = crow(r, hi);
#pragma unroll
        for (int d0 = 0; d0 < 4; ++d0) Ow[(size_t)orow * 1024 + d0 * 32 + r32] = (unsigned char)(pk4_fp8(o[d0][r] * rli[r], 0.f, 0.f, 0.f) & 0xffu); }
#undef DMA_K
#undef DMA_V
#undef WAITBAR
#undef RESC
}
}
__device__ __forceinline__ void p_attention(Frame& F) {
    const unsigned char* Q8 = wsp<const unsigned char>(F, WS_Q8); const unsigned char* K8 = wsp<const unsigned char>(F, WS_K8); const unsigned char* VT = wsp<const unsigned char>(F, WS_V8T); unsigned char* O = wsp<unsigned char>(F, WS_H);
    for (int u = F.bid; u < NB * MH * 32; u += F.G) {
        const int pair = (u >> 8) * 8 + (u & 7), qb = (u & 255) >> 3, b = pair >> 3, h = pair & 7;
        att::unit(Q8 + ((size_t)pair * SEQ + qb * 256) * QKD, K8 + (size_t)pair * NKEY * K8ROW, VT + (size_t)pair * att::NT * att::VSLOT, O + ((size_t)(b * SEQ + qb * 256)) * 1024 + h * 128, F.lds, F.tid);
    }
    VM_WAIT(); __syncthreads();
}

constexpr int N_PHASES = 24;
struct Args { const float* in[37]; float* out; unsigned char* ws; int ph_lo, ph_hi, pad0, pad1; };
__global__ void __launch_bounds__(512, 2) mk_fwd(Args args) {
    extern __shared__ __attribute__((aligned(16))) unsigned char lds_raw[];
    Frame F;
    F.lds = (LAS unsigned char*)lds_raw;
    F.tid = threadIdx.x; F.lane = F.tid & 63; F.wave = __builtin_amdgcn_readfirstlane(F.tid >> 6);
    F.G = gridDim.x; F.bid = blockIdx.x;
    F.in = (const float* const __attribute__((address_space(4)))*)__builtin_amdgcn_kernarg_segment_ptr();
    F.out = args.out; F.ws = args.ws;
    volatile LAS unsigned* MISC = (volatile LAS unsigned*)(F.lds + MISC_OFF);
    if (F.tid < 64) MISC[F.tid] = 0u;
    __syncthreads();
    const int lo = args.ph_lo, hi = args.ph_hi;
    XcdBarrier bar; bar.bar = (unsigned*)(F.ws + WS_CTL) + CW_BAR; bar.x = 0; bar.st = nullptr;
    if (hi - lo > 1) bar = xcd_barrier_post((unsigned*)(F.ws + WS_CTL) + CW_BAR, MISC + 8);
#ifndef ONLY_PHASE
#define ONLY_PHASE -1
#endif
#define IN(k) ((ONLY_PHASE < 0 || ONLY_PHASE == (k)) && lo <= (k) && (k) < hi)
#define SEAM(k) do { if (IN(k) && IN((k) + 1)) xcd_barrier(bar); } while (0)
    LAS unsigned char* ring = F.lds;
    const LAS int* blk_e = (const LAS int*)(F.lds + MT_OFF) + 128;
    const LAS int* mtab = (const LAS int*)(F.lds + MT_OFF);

    if (IN(0)) { p0_mod(F); p0_rope(F); p0_convert(F); } SEAM(0);
    if (IN(1)) { p_norm1_l0(F); } SEAM(1);
    if (IN(2)) {
        pg8::DenseSched S; S.init(NTOK, PW, 2048, wsp<const bf16>(F, WS_WIN), F.G, F.bid);
        pg8::EpiBf16<pg8::MapPlain> E{pg8::MapPlain{wsp<bf16>(F, WS_P), PW}};
        pg8::gemm_phase(ring, wsp<const bf16>(F, WS_H), 2048, S, E);
        { const int slot = F.bid - S.nwg % F.G; if (slot >= 0) p_fill_convert(F, slot, F.G - S.nwg % F.G, 0, FILL_A); }
    } SEAM(2);
    if (IN(3)) { p_alr(F); p_gla_pre(F); } SEAM(3);
    if (IN(4)) {
        pg8::LrSched S; S.init(NTOK, LRN, LRK * 2, wsp<const bf16>(F, WS_WLR), F.G, F.bid);
        pg8::EpiBf16<pg8::MapPlain> E{pg8::MapPlain{wsp<bf16>(F, WS_LOUT), LRN}};
        pg8::gemm_phase(ring, wsp<const bf16>(F, WS_ALR), LRK * 2, S, E);
        { const int slot = F.bid - S.nwg % F.G; if (slot >= 0) p_fill_convert(F, slot, F.G - S.nwg % F.G, FILL_A, FILL_B); }
    } SEAM(4);
    if (IN(5)) { p_gla_scan(F); p_rwkv_scan(F); } SEAM(5);
    if (IN(6)) { p_mix_finish(F); } SEAM(6);
    if (IN(7)) {
        pg8::DenseSched S; S.init(NTOK, 1024, 2048, wsp<const bf16>(F, WS_WOUT), F.G, F.bid);
        pg8::EpiResid E{wsp<bf16>(F, WS_X1), F.in[I_X], F.in[I_CTX], wsp<const float>(F, WS_MOD), 0};
        pg8::gemm_phase(ring, wsp<const bf16>(F, WS_H), 2048, S, E);
        { const int slot = F.bid - S.nwg % F.G; if (slot >= 0) p_fill_convert(F, slot, F.G - S.nwg % F.G, FILL_B, FILL_C); }
    } SEAM(7);
    if (IN(8)) { p_norm2_route(F, 0, NTOK); } SEAM(8);
    if (IN(9)) { p_moe_scatter(F, NTOK); } SEAM(9);
    if (IN(10)) {
        moe_tables(F);
        pg8::MoeSched<true> S{mtab[64], 8, F.G, F.bid, blk_e, wsp<const unsigned>(F, WS_SORT), wsp<const unsigned char>(F, WS_WGU), (size_t)2048 * 1024};
        pg8::EpiSwiglu E{wsp<unsigned char>(F, WS_ACT), F.in[I_GUB], blk_e};
        pg8::gemm_phase<pg8::EpiSwiglu, pg8::MoeSched<true>, true>(ring, wsp<const unsigned char>(F, WS_H), 1024, S, E);
    } SEAM(10);
    if (IN(11)) {
        moe_tables(F);
        pg8::MoeSched<false> S{mtab[64], 4, F.G, F.bid, blk_e, nullptr, wsp<const unsigned char>(F, WS_WDN), (size_t)1024 * 1024};
        pg8::EpiDown E{wsp<unsigned char>(F, WS_YS), F.in[I_DNB], blk_e, wsp<const unsigned>(F, WS_SORT) + MAXSLOT, (const float*)(wsp<const unsigned>(F, WS_SORT) + 2 * MAXSLOT)};
        pg8::gemm_phase<pg8::EpiDown, pg8::MoeSched<false>, true>(ring, wsp<const unsigned char>(F, WS_ACT), 1024, S, E);
    } SEAM(11);
    if (IN(12)) { p_combine_norm1_l1(F); } SEAM(12);
    if (IN(13)) {
        pg8::DenseSched S; S.init(NTOK, 512, 1024, wsp<const unsigned char>(F, WS_WODIN), F.G, F.bid);
        pg8::EpiBf16<pg8::MapPlain> E{pg8::MapPlain{wsp<bf16>(F, WS_C), 512}};
        pg8::gemm_phase<pg8::EpiBf16<pg8::MapPlain>, pg8::DenseSched, true>(ring, wsp<const unsigned char>(F, WS_H), 1024, S, E);
        { const int slot = F.bid - S.nwg % F.G; if (slot >= 0) p_fill_convert(F, slot, F.G - S.nwg % F.G, FILL_C, FILL_D); }
    } SEAM(13);
    if (IN(14)) { p_mla_prep(F); } SEAM(14);
    if (IN(15)) {
        { pg8::DenseSched S; S.init(NLAT, 1536, 512, wsp<const bf16>(F, WS_WQUP), F.G, F.bid);
          pg8::EpiQ8 E{wsp<unsigned char>(F, WS_Q8), wsp<const f32x2>(F, WS_ROPE)};
          pg8::gemm_phase(ring, wsp<const bf16>(F, WS_QN), 512, S, E); }
        { pg8::KvSched S; S.init(NTOK, 2048, 512, wsp<const bf16>(F, WS_WKVUP), F.G, F.bid);
          pg8::EpiKV8 E{wsp<unsigned char>(F, WS_K8), wsp<unsigned char>(F, WS_V8T)};
          pg8::gemm_phase(ring, wsp<const bf16>(F, WS_KVN), 512, S, E);
          { const int slot = F.bid - S.nwg % F.G; if (slot >= 0) p_fill_convert(F, slot, F.G - S.nwg % F.G, FILL_D, FILL_E); } }
    } SEAM(15);
    if (IN(17)) { p_attention(F); } SEAM(17);
    if (IN(18)) {
        pg8::DenseSched S; S.init(NLAT, 1024, 1024, wsp<const unsigned char>(F, WS_WODOUT), F.G, F.bid);
        pg8::EpiResid E{wsp<bf16>(F, WS_X1), F.in[I_X], F.in[I_CTX], wsp<const float>(F, WS_MOD), 1};
        pg8::gemm_phase<pg8::EpiResid, pg8::DenseSched, true>(ring, wsp<const unsigned char>(F, WS_H), 1024, S, E);
    } SEAM(18);
    if (IN(19)) { p_norm2_route(F, 1, NLAT); } SEAM(19);
    if (IN(20)) { p_moe_scatter(F, NLAT); } SEAM(20);
    if (IN(21)) {
        moe_tables(F);
        pg8::MoeSched<true> S{mtab[64], 8, F.G, F.bid, blk_e, wsp<const unsigned>(F, WS_SORT), wsp<const unsigned char>(F, WS_WGU) + (size_t)32 * 2048 * 1024, (size_t)2048 * 1024};
        pg8::EpiSwiglu E{wsp<unsigned char>(F, WS_ACT), F.in[I_GUB] + 32 * 2048, blk_e};
        pg8::gemm_phase<pg8::EpiSwiglu, pg8::MoeSched<true>, true>(ring, wsp<const unsigned char>(F, WS_H), 1024, S, E);
    } SEAM(21);
    if (IN(22)) {
        moe_tables(F);
        pg8::MoeSched<false> S{mtab[64], 4, F.G, F.bid, blk_e, nullptr, wsp<const unsigned char>(F, WS_WDN) + (size_t)32 * 1024 * 1024, (size_t)1024 * 1024};
        pg8::EpiDown E{wsp<unsigned char>(F, WS_YS), F.in[I_DNB] + 32 * 1024, blk_e, wsp<const unsigned>(F, WS_SORT) + MAXSLOT, (const float*)(wsp<const unsigned>(F, WS_SORT) + 2 * MAXSLOT)};
        pg8::gemm_phase<pg8::EpiDown, pg8::MoeSched<false>, true>(ring, wsp<const unsigned char>(F, WS_ACT), 1024, S, E);
    } SEAM(22);
    if (IN(23)) { p_final(F); }
#undef IN
#undef SEAM
}

extern "C" void kernel_launch(void* const* d_in, const int* in_sizes, int n_in, void* d_out, int out_size, void* d_ws, size_t ws_size, hipStream_t stream) {
    static int grid = 0;
    if (grid == 0) {
        if (n_in != 37 || out_size != NLAT * DM || ws_size < WS_END) { fprintf(stderr, "kernel_launch: built for 37 inputs, %d outputs, >= %zu bytes of workspace; got n_in %d, out %d, ws %zu\n", NLAT * DM, (size_t)WS_END, n_in, out_size, ws_size); grid = -1; return; }
        int dev = 0, cus = 0, per_cu = 0;
        if (hipGetDevice(&dev) != hipSuccess || hipDeviceGetAttribute(&cus, hipDeviceAttributeMultiprocessorCount, dev) != hipSuccess) { grid = -1; return; }
        if (hipFuncSetAttribute((const void*)mk_fwd, hipFuncAttributeMaxDynamicSharedMemorySize, LDS_BYTES) != hipSuccess) { fprintf(stderr, "kernel_launch: hipFuncSetAttribute failed\n"); grid = -1; return; }
        if (hipOccupancyMaxActiveBlocksPerMultiprocessor(&per_cu, (const void*)mk_fwd, 512, LDS_BYTES) != hipSuccess || per_cu < 1) fprintf(stderr, "kernel_launch: occupancy query says %d\n", per_cu);
        (void)hipGetLastError();
        grid = cus;
    }
    if (grid < 0) return;
    if (hipMemsetAsync((char*)d_ws + WS_CTL, 0, CTL_ZERO_BYTES, stream) != hipSuccess) return;
    Args a{};
    for (int i = 0; i < 37; ++i) a.in[i] = (const float*)d_in[i];
    a.out = (float*)d_out; a.ws = (unsigned char*)d_ws;
#if MK_N_LAUNCHES == 1
    a.ph_lo = 0; a.ph_hi = N_PHASES;
    hipLaunchKernelGGL(mk_fwd, dim3(grid), dim3(512), LDS_BYTES, stream, a);
#else
    for (int p = 0; p < N_PHASES; ++p) { a.ph_lo = p; a.ph_hi = p + 1; hipLaunchKernelGGL(mk_fwd, dim3(grid), dim3(512), LDS_BYTES, stream, a); }
#endif
    const hipError_t le = hipPeekAtLastError();
    if (le != hipSuccess) fprintf(stderr, "kernel_launch: launch failed: %s\n", hipGetErrorName(le));
}
```

```cpp
#include <hip/hip_runtime.h>
#include <cstdio>
#include <cstdint>

#ifndef MK_N_LAUNCHES
#define MK_N_LAUNCHES 1
#endif

#define GAS __attribute__((address_space(1)))
#define LAS __attribute__((address_space(3)))
typedef unsigned short bf16;
typedef short bf16x8 __attribute__((ext_vector_type(8)));
typedef short s16x4 __attribute__((ext_vector_type(4)));
typedef float f32x4 __attribute__((ext_vector_type(4)));
typedef float f32x2 __attribute__((ext_vector_type(2)));
typedef float f32x16 __attribute__((ext_vector_type(16)));
typedef unsigned u32x4 __attribute__((ext_vector_type(4)));
typedef unsigned u32x2 __attribute__((ext_vector_type(2)));
typedef int i32x4 __attribute__((ext_vector_type(4)));
typedef int i32x8 __attribute__((ext_vector_type(8)));
typedef GAS unsigned gu32;
#define RLX_AGENT __ATOMIC_RELAXED, __HIP_MEMORY_SCOPE_AGENT
#define LDS_WAIT() asm volatile("s_waitcnt lgkmcnt(0)" ::: "memory")
#define VM_WAIT() asm volatile("s_waitcnt vmcnt(0)" ::: "memory")
#define SBAR() __builtin_amdgcn_sched_barrier(0)

constexpr int DM = 1024, NB = 8, SEQ = 8192, CTXL = 256;
constexpr int NLAT = NB * SEQ;
constexpr int NCTX = NB * CTXL;
constexpr int NTOK = NLAT + NCTX;
constexpr int GLA_COLS = 1552, RW_COLS = 1824, RW0 = 1664, PW = 3584;
constexpr int LRK = 384, LRN = 2560;
constexpr int NE = 32, TOPK = 4, DE = 1024;
constexpr int NASG0 = NTOK * TOPK;
constexpr int MAXSLOT = NASG0 + NE * 256;
constexpr int YS_DUMMY = NASG0;
constexpr int NKEY = CTXL + SEQ;
constexpr float YS_SCALE = 16.f;
constexpr int MH = 8, QKD = 192, VD = 128;

constexpr size_t MiB = 1u << 20;
constexpr size_t WS_CTL = 0, CTL_ZERO_BYTES = 1 * MiB;
constexpr size_t WS_MOD = 1 * MiB;
constexpr size_t WS_ROPE = 2 * MiB;
constexpr size_t WS_WIN = 4 * MiB;
constexpr size_t WS_WOUT = 11 * MiB;
constexpr size_t WS_WLR = 13 * MiB;
constexpr size_t WS_WODIN = 15 * MiB;
constexpr size_t WS_WQUP = 16 * MiB;
constexpr size_t WS_WKVUP = 17 * MiB;
constexpr size_t WS_WODOUT = 18 * MiB;
constexpr size_t WS_ROUTE = 20 * MiB;
constexpr size_t WS_WGU = 24 * MiB;
constexpr size_t WS_WDN = 280 * MiB;
constexpr size_t WS_X1 = 408 * MiB;
constexpr size_t WS_H = 672 * MiB;
constexpr size_t WS_ARENA = 804 * MiB;
constexpr size_t WS_P = WS_ARENA;
constexpr size_t WS_LOUT = WS_P + 462 * MiB;
constexpr size_t WS_GLAO = WS_LOUT + 330 * MiB;
constexpr size_t WS_RWY = WS_GLAO + 132 * MiB;
constexpr size_t WS_ALR = WS_RWY + 132 * MiB;
constexpr size_t WS_BONUS = WS_ALR + 50 * MiB;
constexpr size_t WS_ACT = WS_ARENA;
constexpr size_t WS_YS = WS_ACT + 544 * MiB;
constexpr size_t WS_C = WS_ARENA;
constexpr size_t WS_QN = WS_C + 132 * MiB;
constexpr size_t WS_KVN = WS_QN + 32 * MiB;
constexpr size_t WS_Q8 = WS_KVN + 33 * MiB;
constexpr size_t WS_QR = WS_Q8 + 101 * MiB;
constexpr size_t WS_K8 = WS_QR + 64 * MiB;
constexpr size_t WS_V8T = WS_K8 + 108 * MiB;
constexpr size_t WS_V = WS_V8T + 67 * MiB;
constexpr size_t WS_END = 2048 * MiB;
static_assert(WS_BONUS + 5 * MiB <= WS_END && WS_YS + 529 * MiB <= WS_END && WS_V + 132 * MiB <= WS_END, "d_ws map");
constexpr int K8ROW = 208;
constexpr size_t RT_E = 0;
constexpr size_t RT_POS = 512 * 1024;
constexpr size_t RT_GATE = 1024 * 1024 + 512 * 1024;
constexpr size_t RT_HIST = 3 * MiB;
constexpr size_t RT_TOK = 3 * MiB + 64 * 1024;
constexpr size_t WS_SORT = WS_YS + 529 * MiB;
static_assert(WS_SORT + 4 * MiB <= WS_END, "sort lists");

constexpr int CW_TMO = 0, CW_CODE = 1;
constexpr int CW_BAR = 4096;

constexpr int RING_BYTES = 131072;
constexpr int LDS_BYTES = 163840;
constexpr int MISC_OFF = 163840 - 256;

__device__ __forceinline__ unsigned f2bf(float f) { unsigned u = __builtin_bit_cast(unsigned, f); return (u + 0x7fffu + ((u >> 16) & 1u)) >> 16; }
__device__ __forceinline__ float bf2f(unsigned h) { return __builtin_bit_cast(float, h << 16); }
typedef __bf16 bf16x2v __attribute__((ext_vector_type(2)));
__device__ __forceinline__ unsigned cvt_pk_bf16(float lo, float hi) { const f32x2 v = {lo, hi}; const bf16x2v r = __builtin_convertvector(v, bf16x2v); return __builtin_bit_cast(unsigned, r); }
__device__ __forceinline__ unsigned pk4_fp8(float a, float b, float c, float d) { unsigned w = 0u; w = (unsigned)__builtin_amdgcn_cvt_pk_fp8_f32(a, b, (int)w, false); w = (unsigned)__builtin_amdgcn_cvt_pk_fp8_f32(c, d, (int)w, true); return w; }
__device__ __forceinline__ float bflo(unsigned w) { return __builtin_bit_cast(float, w << 16); }
__device__ __forceinline__ float bfhi(unsigned w) { return __builtin_bit_cast(float, w & 0xffff0000u); }
__device__ __forceinline__ float wave_sum(float v) {
#pragma unroll
    for (int o = 1; o < 64; o <<= 1) v += __shfl_xor(v, o);
    return v;
}
__device__ __forceinline__ float sigmoidf_(float x) { return 1.f / (1.f + __expf(-x)); }

namespace pg8 {
constexpr int BM = 256, BK = 64, HALF = 128, HTB = HALF * BK * 2, STAGE_BYTES = 8 * HTB;
__host__ __device__ __forceinline__ int lds_byte(int r, int c) { const int st = (r >> 4) * 2 + (c >> 5), rr = r & 15, cc = c & 31, ob = rr * 64 + cc * 2; return st * 1024 + (ob ^ (((ob >> 9) & 1) << 5)); }
__host__ __device__ __forceinline__ void stage_rc(int b, int& R, int& C) { const int st = b / 1024, sb = b % 1024, swz = sb ^ (((sb >> 9) & 1) << 5); R = (st >> 1) * 16 + swz / 64; C = (st & 1) * 32 + (swz % 64) / 2; }
__host__ __device__ __forceinline__ int perm32(int rho) { const int n = rho >> 4, i = rho & 15; return 8 * (i >> 2) + 4 * n + (i & 3); }
struct Unit { int pm, pn; };

template <class Epi, class Sched, bool FP8 = false>
__device__ __forceinline__ void gemm_phase(LAS unsigned char* lds, const void* Abase, const int KBc, const Sched& S, const Epi& E) {
    int K = KBc; asm volatile("" : "+s"(K));
    const int tid = threadIdx.x, wid = __builtin_amdgcn_readfirstlane(tid >> 6), lane = tid & 63, wr = wid >> 2, wc = wid & 3, fr = lane & 15, fq = lane >> 4;
    const int nt = K / 128;
    int sR[2], sC[2]; unsigned voffB[2];
#pragma unroll
    for (int i = 0; i < 2; ++i) { int R, C; stage_rc(tid * 16 + i * 8192, R, C); const int Rb = Epi::PERM ? ((R & ~31) + perm32(R & 31)) : R; sR[i] = R; sC[i] = C; voffB[i] = (unsigned)(Rb * K + C * 2); }
    const size_t kstep = (size_t)(BK * 2);
    const size_t hstep = (size_t)HALF * K;
    const unsigned ldsw = (unsigned)wid * 1024u;
    const int aoff = lds_byte(wr * 64 + fr, fq * 8), boff = lds_byte(wc * 32 + fr, fq * 8);
    const char* Ab = (const char*)Abase;
#define PG8_SA(b, h) (((b) * 2 + (h)) * HTB)
#define PG8_SB(b, h) ((4 + (b) * 2 + (h)) * HTB)
#define PG8_STAGE(bufoff, gbase, voff) do { _Pragma("unroll") for (int _i = 0; _i < 2; ++_i) \
        __builtin_amdgcn_global_load_lds((const unsigned*)((const char*)(gbase) + (voff)[_i]), (LAS unsigned*)(lds + (bufoff) + ldsw + _i * 8192), 16, 0, 0); } while (0)
#define PG8_STAGEA(bufoff, kb, ao, h) do { _Pragma("unroll") for (int _i = 0; _i < 2; ++_i) \
        __builtin_amdgcn_global_load_lds((const unsigned*)((Ab + (kb)) + (ao)[h][_i]), (LAS unsigned*)(lds + (bufoff) + ldsw + _i * 8192), 16, 0, 0); } while (0)
#define PG8_STAGEA2(bufoff, kb, h) do { _Pragma("unroll") for (int _i = 0; _i < 2; ++_i) \
        __builtin_amdgcn_global_load_lds((const unsigned*)((Ab + (kb)) + (last ? nao[h][_i] : cao[h][_i])), (LAS unsigned*)(lds + (bufoff) + ldsw + _i * 8192), 16, 0, 0); } while (0)
#define PG8_LD8(p) __builtin_shufflevector(*(const LAS i32x4*)(p), *(const LAS i32x4*)((p) + 1024), 0, 1, 2, 3, 4, 5, 6, 7)
#define PG8_LDA(dst, b, h) do { _Pragma("unroll") for (int m = 0; m < 4; ++m) dst[m] = PG8_LD8(lds + PG8_SA(b, h) + aoff + m * 2048); } while (0)
#define PG8_LDB(dst, b, h) do { _Pragma("unroll") for (int n = 0; n < 2; ++n) dst[n] = PG8_LD8(lds + PG8_SB(b, h) + boff + n * 2048); } while (0)
#define PG8_MMA(ai, bj, At, Bt) do { __builtin_amdgcn_s_setprio(1); _Pragma("unroll") for (int m = 0; m < 4; ++m) _Pragma("unroll") for (int n = 0; n < 2; ++n) { \
        if constexpr (FP8) asm volatile("v_mfma_scale_f32_16x16x128_f8f6f4 %0, %1, %2, %0, %3, %4 op_sel_hi:[0,0,0]" : "+v"(acc[ai][bj][m][n]) : "v"(Bt[n]), "v"(At[m]), "v"(scl_w), "v"(scl_x)); \
        else { acc[ai][bj][m][n] = __builtin_amdgcn_mfma_f32_16x16x32_bf16(__builtin_bit_cast(bf16x8, __builtin_shufflevector(Bt[n], Bt[n], 0, 1, 2, 3)), __builtin_bit_cast(bf16x8, __builtin_shufflevector(At[m], At[m], 0, 1, 2, 3)), acc[ai][bj][m][n], 0, 0, 0); \
               acc[ai][bj][m][n] = __builtin_amdgcn_mfma_f32_16x16x32_bf16(__builtin_bit_cast(bf16x8, __builtin_shufflevector(Bt[n], Bt[n], 4, 5, 6, 7)), __builtin_bit_cast(bf16x8, __builtin_shufflevector(At[m], At[m], 4, 5, 6, 7)), acc[ai][bj][m][n], 0, 0, 0); } } \
        __builtin_amdgcn_s_setprio(0); } while (0)
#define PG8_WAIT_V(n) asm volatile("s_waitcnt vmcnt(" #n ")" ::: "memory")
#define PG8_WAIT_L(n) asm volatile("s_waitcnt lgkmcnt(" #n ")" ::: "memory")
#define PG8_BAR __builtin_amdgcn_s_barrier()
#define PG8_SCHED __builtin_amdgcn_sched_barrier(0)
    Unit cur, nxt; int ui = 0;
    if (!S.next(0, cur)) return;
    int ntc = S.ktiles(cur, nt);
    f32x4 acc[2][2][4][2];
#pragma unroll
    for (int a = 0; a < 2; ++a)
#pragma unroll
        for (int b = 0; b < 2; ++b)
#pragma unroll
            for (int m = 0; m < 4; ++m)
#pragma unroll
                for (int n = 0; n < 2; ++n) acc[a][b][m][n] = (f32x4){0.f, 0.f, 0.f, 0.f};
    i32x8 At[4], B0[2], B1[2];
    int scl_w = 0x7A7A7A7A, scl_x = 0x7F7F7F7F;
    asm volatile("" : "+v"(scl_w), "+v"(scl_x));
    unsigned cao[2][2], nao[2][2];
    S.a_offs(cur, cao, sR, sC);
    const char* cB = S.b_tile(cur);
    PG8_STAGE(PG8_SB(0, 0), cB, voffB); PG8_STAGE(PG8_SB(0, 1), cB + hstep, voffB); PG8_STAGEA(PG8_SA(0, 0), 0, cao, 0); PG8_STAGEA(PG8_SA(0, 1), 0, cao, 1);
    if (wr == 1) PG8_BAR;
    PG8_WAIT_V(2); PG8_BAR;
    PG8_STAGE(PG8_SB(1, 0), cB + kstep, voffB); PG8_STAGEA(PG8_SA(1, 0), kstep, cao, 0); PG8_STAGE(PG8_SB(1, 1), cB + hstep + kstep, voffB);
    PG8_WAIT_V(6); PG8_BAR;
    for (;;) {
        const bool has_next = S.next(ui + 1, nxt);
        const char* nB = cB;
        if (has_next) { S.a_offs(nxt, nao, sR, sC); nB = S.b_tile(nxt); }
        else {
#pragma unroll
            for (int h = 0; h < 2; ++h)
#pragma unroll
                for (int i = 0; i < 2; ++i) nao[h][i] = cao[h][i];
        }
        for (int t = 0; t < ntc; t += 2) {
            const bool last = (t == ntc - 2);
            const size_t a1k = (size_t)(t + 1) * kstep;
            const size_t a2k = last ? 0 : (size_t)(t + 2) * kstep; const char* b2 = last ? nB : cB + (size_t)(t + 2) * kstep;
            const size_t a3k = a2k + kstep; const char* b3 = b2 + kstep;
            PG8_LDB(B0, 0, 0); PG8_LDB(B1, 0, 1); PG8_SCHED; PG8_LDA(At, 0, 0); PG8_STAGEA(PG8_SA(1, 1), a1k, cao, 1);
            PG8_WAIT_V(8); PG8_WAIT_L(0); PG8_BAR; PG8_MMA(0, 0, At, B0); PG8_MMA(0, 1, At, B1); PG8_BAR; PG8_SCHED;
            PG8_LDA(At, 0, 1); PG8_STAGE(PG8_SB(0, 0), b2, voffB); PG8_STAGE(PG8_SB(0, 1), b2 + hstep, voffB); PG8_STAGEA2(PG8_SA(0, 0), a2k, 0);
            PG8_WAIT_V(8); PG8_WAIT_L(0); PG8_BAR; PG8_MMA(1, 0, At, B0); PG8_MMA(1, 1, At, B1); PG8_BAR; PG8_SCHED;
            PG8_LDB(B0, 1, 0); PG8_LDB(B1, 1, 1); PG8_SCHED; PG8_LDA(At, 1, 0); PG8_STAGEA2(PG8_SA(0, 1), a2k, 1);
            PG8_WAIT_V(8); PG8_WAIT_L(0); PG8_BAR; PG8_MMA(0, 0, At, B0); PG8_MMA(0, 1, At, B1); PG8_BAR; PG8_SCHED;
            PG8_LDA(At, 1, 1); PG8_STAGE(PG8_SB(1, 0), b3, voffB); PG8_STAGE(PG8_SB(1, 1), b3 + hstep, voffB); PG8_STAGEA2(PG8_SA(1, 0), a3k, 0);
            PG8_WAIT_V(8); PG8_WAIT_L(0); PG8_BAR; PG8_MMA(1, 0, At, B0); PG8_MMA(1, 1, At, B1); PG8_BAR; PG8_SCHED;
        }
        if (wr == 0) PG8_BAR;
        if constexpr (FP8) asm volatile("s_nop 15\n\ts_nop 7" ::: "memory");
        E(acc, cur, wr, wc, fr, fq);
        if (!has_next) break;
#pragma unroll
        for (int a = 0; a < 2; ++a)
#pragma unroll
            for (int b = 0; b < 2; ++b)
#pragma unroll
                for (int m = 0; m < 4; ++m)
#pragma unroll
                    for (int n = 0; n < 2; ++n) acc[a][b][m][n] = (f32x4){0.f, 0.f, 0.f, 0.f};
        cur = nxt; cB = nB; ++ui; ntc = S.ktiles(cur, nt);
#pragma unroll
        for (int h = 0; h < 2; ++h)
#pragma unroll
            for (int i = 0; i < 2; ++i) cao[h][i] = nao[h][i];
        if (wr == 1) PG8_BAR;
    }
    PG8_WAIT_V(0);
    PG8_BAR;
#undef PG8_SA
#undef PG8_SB
#undef PG8_STAGE
#undef PG8_STAGEA
#undef PG8_STAGEA2
#undef PG8_LDA
#undef PG8_LDB
#undef PG8_MMA
#undef PG8_WAIT_V
#undef PG8_WAIT_L
#undef PG8_BAR
#undef PG8_SCHED
}
}

#define XB_TMO      128
#define XB_XCNT(j)  (256  + 64 * (j))
#define XB_XSUB(j)  (1280 + 64 * (j))
#define XB_XGEN(j)  (2304 + 64 * (j))
#define XB_TOP      3328
#define XB_TOPGEN   3392
#define XCD_BAR_WORDS 3456
#define XB_SPIN_CAP (1u << 22)
__device__ __forceinline__ unsigned xb_ld(unsigned* p)              { return __hip_atomic_load(p, __ATOMIC_RELAXED, __HIP_MEMORY_SCOPE_AGENT); }
__device__ __forceinline__ unsigned xb_add(unsigned* p, unsigned v) { return __hip_atomic_fetch_add(p, v, __ATOMIC_RELAXED, __HIP_MEMORY_SCOPE_AGENT); }
__device__ __forceinline__ unsigned xb_xcc_id() { return (unsigned)__builtin_amdgcn_s_getreg((3 << 11) | 20) & 0xFu; }
#define XB_SPIN(cond, bar) do { unsigned _sp = 0; while (cond) { __builtin_amdgcn_s_sleep(1); \
    if ((++_sp & 255u) == 0u) { if (xb_ld(&(bar)[XB_TMO])) break; if (_sp > XB_SPIN_CAP) { atomicAdd(&(bar)[XB_TMO], 1u); break; } } } } while (0)
struct XcdBarrier { unsigned* bar; unsigned x; volatile LAS unsigned* st; };
__device__ __forceinline__ XcdBarrier xcd_barrier_post(unsigned* bar, volatile LAS unsigned* st) {
    XcdBarrier b; b.bar = bar; b.x = xb_xcc_id(); b.st = st;
    if (threadIdx.x == 0) (void)xb_add(&bar[XB_XCNT(b.x)], 1u);
    return b;
}
__device__ __forceinline__ void xcd_barrier_complete(unsigned* bar, unsigned x, unsigned& nloc, unsigned& nx) {
    const unsigned G = gridDim.x * gridDim.y * gridDim.z;
    unsigned sum, cnt, mine, sp = 0u;
    for (;;) {
        sum = 0u; cnt = 0u; mine = 0u;
#pragma unroll
        for (unsigned j = 0; j < 16; ++j) { const unsigned c = xb_ld(&bar[XB_XCNT(j)]); sum += c; cnt += (c > 0u) ? 1u : 0u; mine = (j == x) ? c : mine; }
        if (sum == G) break;
        __builtin_amdgcn_s_sleep(1);
        if ((++sp & 255u) == 0u) { if (xb_ld(&bar[XB_TMO])) break; if (sp > XB_SPIN_CAP) { atomicAdd(&bar[XB_TMO], 1u); break; } }
    }
    nloc = mine > 0u ? mine : 1u; nx = cnt > 0u ? cnt : 1u;
}
__device__ __forceinline__ void xcd_barrier(const XcdBarrier& b) {
    asm volatile("s_waitcnt vmcnt(0)" ::: "memory");
    __syncthreads();
    if (threadIdx.x == 0) {
        unsigned* bar = b.bar;
        __builtin_amdgcn_s_waitcnt(0);
        unsigned nloc = b.st[0], nx = b.st[1];
        if (nloc == 0u) { xcd_barrier_complete(bar, b.x, nloc, nx); b.st[0] = nloc; b.st[1] = nx; }
        const unsigned old = xb_add(&bar[XB_XSUB(b.x)], 1u);
        const unsigned gen = old / nloc;
        if (old + 1u == (gen + 1u) * nloc) {
            __builtin_amdgcn_fence(__ATOMIC_RELEASE, "agent");
            asm volatile("s_waitcnt vmcnt(0)" ::: "memory");
            const unsigned og = xb_add(&bar[XB_TOP], 1u);
            const unsigned tg = og / nx;
            if (og + 1u == (tg + 1u) * nx) xb_add(&bar[XB_TOPGEN], 1u);
            else XB_SPIN(xb_ld(&bar[XB_TOPGEN]) == tg, bar);
            __builtin_amdgcn_fence(__ATOMIC_ACQUIRE, "agent");
            xb_add(&bar[XB_XGEN(b.x)], 1u);
            asm volatile("s_waitcnt vmcnt(0)" ::: "memory");
        } else {
            XB_SPIN(xb_ld(&bar[XB_XGEN(b.x)]) == gen, bar);
            __builtin_amdgcn_fence(__ATOMIC_ACQUIRE, "agent");
            asm volatile("s_waitcnt vmcnt(0)" ::: "memory");
        }
    }
    __syncthreads();
}

struct Frame {
    LAS unsigned char* lds;
    int tid, lane, wave, G, bid;
    const float* const __attribute__((address_space(4)))* in;
    float* out;
    unsigned char* ws;
};
enum { I_X = 0, I_C, I_CTX, I_CCTX, I_ADAW, I_ADAB, I_N1G, I_N2G, I_EVWIN, I_EVWOUT, I_GKUP, I_GKB, I_GNG, I_MU, I_W0, I_W2, I_A0, I_A2, I_KK, I_KA, I_RK, I_G2, I_LNW, I_LNB,
       I_ODWIN, I_QNORM, I_WQUP, I_KVNORM, I_WKVUP, I_ODWOUT, I_RW, I_RB, I_GUW, I_GUB, I_DNW, I_DNB, I_FNG };
template <class T> __device__ __forceinline__ T* wsp(const Frame& F, size_t off) { return (T*)(F.ws + off); }
__device__ __forceinline__ int mod_row(int row) { return row < NLAT ? (row >> 13) : 8; }
__device__ __forceinline__ const float* mod_ptr(const Frame& F, int layer, int row, int which) { return wsp<const float>(F, WS_MOD) + ((size_t)(layer * 9 + mod_row(row)) * 6 + which) * 1024; }

__device__ __forceinline__ void p0_mod(Frame& F) {
    LAS float* s = (LAS float*)F.lds;
    LAS float* red = (LAS float*)(F.lds + 9 * 1024 * 4);
    const float* c = F.in[I_C]; const float* cc = F.in[I_CCTX]; const float* W = F.in[I_ADAW]; const float* Bv = F.in[I_ADAB];
    for (int idx = F.tid; idx < 9 * 1024; idx += 512) { const int r = idx >> 10, k = idx & 1023; const float v = r < 8 ? c[r * 1024 + k] : cc[k]; s[idx] = v / (1.f + __expf(-v)); }
    __syncthreads();
    for (int item = F.bid; item < 192; item += F.G) {
        const int l = item / 96, n0 = (item % 96) * 64;
        float acc[9];
#pragma unroll
        for (int r = 0; r < 9; ++r) acc[r] = 0.f;
        const float* wp = W + ((size_t)l * 1024 + F.wave * 128) * 6144 + n0 + F.lane;
        for (int k = 0; k < 128; ++k) { const float wv = wp[(size_t)k * 6144];
#pragma unroll
            for (int r = 0; r < 9; ++r) acc[r] += s[r * 1024 + F.wave * 128 + k] * wv; }
#pragma unroll
        for (int r = 0; r < 9; ++r) red[(F.wave * 9 + r) * 64 + F.lane] = acc[r];
        __syncthreads();
        for (int idx = F.tid; idx < 576; idx += 512) { const int r = idx >> 6, ln = idx & 63; float v = Bv[l * 6144 + n0 + ln];
#pragma unroll
            for (int w = 0; w < 8; ++w) v += red[(w * 9 + r) * 64 + ln];
            wsp<float>(F, WS_MOD)[(size_t)(l * 9 + r) * 6144 + n0 + ln] = v; }
        __syncthreads();
    }
}
__device__ __forceinline__ void p0_rope(Frame& F) {
    for (int idx = F.bid * 512 + F.tid; idx < SEQ * 32; idx += F.G * 512) {
        const int t = idx >> 5, i = idx & 31;
        const float fr = (float)pow(10000.0, -(double)(i & 15) / 16.0);
        const float pos = (float)(i < 16 ? (t >> 6) : (t & 63));
        const float ang = pos * fr;
        const double a = (double)ang;
        wsp<f32x2>(F, WS_ROPE)[idx] = (f32x2){(float)cos(a), (float)sin(a)};
    }
}
template <class V> __device__ __forceinline__ void cvt_item(const V& val, bf16* dst, int K, int item, int nblk, LAS float* scr, int lane) {
    const int kb = item / nblk, nb = item % nblk, k0 = 64 * kb, n0 = 32 * nb;
#pragma unroll 8
    for (int i = 0; i < 32; ++i) { const int kk = 2 * i + (lane >> 5); scr[kk * 33 + (lane & 31)] = val(n0 + (lane & 31), k0 + kk); }
    LDS_WAIT(); asm volatile("" ::: "memory");
    const int c = lane & 7;
#pragma unroll
    for (int j = 0; j < 4; ++j) { const int n = (lane >> 3) + 8 * j; const LAS float* sp = scr + (8 * c) * 33 + n;
        u32x4 o; o.x = f2bf(sp[0 * 33]) | (f2bf(sp[1 * 33]) << 16); o.y = f2bf(sp[2 * 33]) | (f2bf(sp[3 * 33]) << 16); o.z = f2bf(sp[4 * 33]) | (f2bf(sp[5 * 33]) << 16); o.w = f2bf(sp[6 * 33]) | (f2bf(sp[7 * 33]) << 16);
        *(u32x4*)(dst + (size_t)(n0 + n) * K + k0 + 8 * c) = o; }
    LDS_WAIT(); asm volatile("" ::: "memory");
}
template <class V> __device__ __forceinline__ void cvt_item_fp8(const V& val, unsigned char* dst, int K, int item, int nblk, LAS float* scr, int lane) {
    const int kb = item / nblk, nb = item % nblk, k0 = 64 * kb, n0 = 32 * nb;
#pragma unroll 8
    for (int i = 0; i < 32; ++i) { const int kk = 2 * i + (lane >> 5); scr[kk * 33 + (lane & 31)] = 32.f * val(n0 + (lane & 31), k0 + kk); }
    LDS_WAIT(); asm volatile("" ::: "memory");
    const int c = lane & 7;
#pragma unroll
    for (int j = 0; j < 4; ++j) { const int n = (lane >> 3) + 8 * j; const LAS float* sp = scr + (8 * c) * 33 + n;
        *(u32x2*)(dst + (size_t)(n0 + n) * K + k0 + 8 * c) = (u32x2){pk4_fp8(sp[0 * 33], sp[1 * 33], sp[2 * 33], sp[3 * 33]), pk4_fp8(sp[4 * 33], sp[5 * 33], sp[6 * 33], sp[7 * 33])}; }
    LDS_WAIT(); asm volatile("" ::: "memory");
}
template <class V4> __device__ __forceinline__ void cvt_item_fp8_wide(const V4& col4, const float* W, int ld, unsigned char* dst, int K, int item, int nblk, LAS float* scr, int lane) {
    const int kb = item / nblk, nb = item % nblk, k0 = 64 * kb, n0 = 64 * nb;
    const float* src = W + (size_t)(k0 + (lane >> 4)) * ld + col4(n0 + (lane & 15) * 4);
#pragma unroll
    for (int i = 0; i < 16; ++i) { const f32x4 v = *(const f32x4*)(src + (size_t)(4 * i) * ld); LAS float* sp = scr + (4 * i + (lane >> 4)) * 68 + (lane & 15) * 4; *(LAS f32x4*)sp = v; }
    LDS_WAIT(); asm volatile("" ::: "memory");
    const int nl = lane >> 2, part = lane & 3;
#pragma unroll
    for (int j = 0; j < 4; ++j) { const int n = nl + 16 * j; const LAS float* sp = scr + (part * 16) * 68 + n; unsigned o[4];
#pragma unroll
        for (int e = 0; e < 4; ++e) o[e] = pk4_fp8(32.f * sp[(4 * e) * 68], 32.f * sp[(4 * e + 1) * 68], 32.f * sp[(4 * e + 2) * 68], 32.f * sp[(4 * e + 3) * 68]);
        *(u32x4*)(dst + (size_t)(n0 + n) * K + k0 + part * 16) = (u32x4){o[0], o[1], o[2], o[3]}; }
    LDS_WAIT(); asm volatile("" ::: "memory");
}
struct C4Gu { __device__ __forceinline__ int operator()(int n) const { return ((n & 128) ? 1024 : 0) + (n >> 8) * 128 + (n & 127); } };
struct C4Id { __device__ __forceinline__ int operator()(int n) const { return n; } };
struct VPlain { const float* W; int ldn, Nr, Kr; __device__ __forceinline__ float operator()(int n, int k) const { return (n < Nr && k < Kr) ? W[(size_t)k * ldn + n] : 0.f; } };
struct VWin { const float* W; __device__ __forceinline__ float operator()(int n, int k) const { const int col = n < GLA_COLS ? n : ((n >= RW0 && n < RW0 + RW_COLS) ? n - (RW0 - GLA_COLS) : -1); return col >= 0 ? W[(size_t)k * (GLA_COLS + RW_COLS) + col] : 0.f; } };
struct VQup { const float* W; __device__ __forceinline__ float operator()(int n, int k) const { const int col = n < 1024 ? (n >> 7) * 192 + (n & 127) : ((n - 1024) >> 6) * 192 + 128 + ((n - 1024) & 63); return W[(size_t)k * 1536 + col]; } };
struct VGu { const float* W; __device__ __forceinline__ float operator()(int n, int k) const { const int col = ((n & 128) ? 1024 : 0) + (n >> 8) * 128 + (n & 127); return W[(size_t)k * 2048 + col]; } };
struct VLr { const float *w2, *a2, *g2; __device__ __forceinline__ float operator()(int n, int k) const {
        if (n < 1024) return k < 64 ? w2[((size_t)(n >> 9) * 64 + k) * 512 + (n & 511)] : 0.f;
        if (n < 2048) return (k >= 64 && k < 128) ? a2[((size_t)((n - 1024) >> 9) * 64 + (k - 64)) * 512 + (n & 511)] : 0.f;
        return (k >= 128 && k < 288) ? g2[(size_t)(k - 128) * 512 + (n - 2048)] : 0.f; } };
__device__ __forceinline__ void p0_convert(Frame& F) {
    LAS float* scrw = (LAS float*)(F.lds + F.wave * 17408);
    LAS float* scr = scrw;
    const int gw = F.bid * 8 + F.wave, NGW = F.G * 8;
    constexpr int I_WIN = (1024 / 64) * (PW / 32), I_SQ = (1024 / 64) * (1024 / 32), I_LR = (LRK / 64) * (LRN / 32), I_ODIN = (1024 / 64) * (512 / 32), I_QUP = (256 / 64) * (1536 / 32), I_KVUP = (256 / 64) * (2048 / 32);
    constexpr int I_GU1 = (1024 / 64) * (2048 / 64), I_DN1 = (1024 / 64) * (1024 / 64);
    constexpr int NSMALL = I_WIN + I_SQ + I_LR + I_ODIN + I_QUP + I_KVUP + I_SQ;
    constexpr int NITEMS = NSMALL + 32 * I_GU1 + 32 * I_DN1;
    for (int it = gw; it < NITEMS; it += NGW) {
        int r = it;
        if (r < I_WIN) { cvt_item(VWin{F.in[I_EVWIN]}, wsp<bf16>(F, WS_WIN), 1024, r, PW / 32, scr, F.lane); continue; } r -= I_WIN;
        if (r < I_SQ) { cvt_item(VPlain{F.in[I_EVWOUT], 1024, 1024, 1024}, wsp<bf16>(F, WS_WOUT), 1024, r, 32, scr, F.lane); continue; } r -= I_SQ;
        if (r < I_LR) { cvt_item(VLr{F.in[I_W2], F.in[I_A2], F.in[I_G2]}, wsp<bf16>(F, WS_WLR), LRK, r, LRN / 32, scr, F.lane); continue; } r -= I_LR;
        if (r < I_ODIN) { cvt_item_fp8(VPlain{F.in[I_ODWIN], 448, 448, 1024}, wsp<unsigned char>(F, WS_WODIN), 1024, r, 16, scr, F.lane); continue; } r -= I_ODIN;
        if (r < I_QUP) { cvt_item(VQup{F.in[I_WQUP]}, wsp<bf16>(F, WS_WQUP), 256, r, 48, scr, F.lane); continue; } r -= I_QUP;
        if (r < I_KVUP) { cvt_item(VPlain{F.in[I_WKVUP], 2048, 2048, 128}, wsp<bf16>(F, WS_WKVUP), 256, r, 64, scr, F.lane); continue; } r -= I_KVUP;
        if (r < I_SQ) { cvt_item_fp8(VPlain{F.in[I_ODWOUT], 1024, 1024, 1024}, wsp<unsigned char>(F, WS_WODOUT), 1024, r, 32, scr, F.lane); continue; } r -= I_SQ;
        if (r < 32 * I_GU1) { const int le = r / I_GU1, ri = r % I_GU1; cvt_item_fp8_wide(C4Gu{}, F.in[I_GUW] + (size_t)le * 1024 * 2048, 2048, wsp<unsigned char>(F, WS_WGU) + (size_t)le * 2048 * 1024, 1024, ri, 32, scrw, F.lane); continue; } r -= 32 * I_GU1;
        { const int le = r / I_DN1, ri = r % I_DN1; cvt_item_fp8_wide(C4Id{}, F.in[I_DNW] + (size_t)le * 1024 * 1024, 1024, wsp<unsigned char>(F, WS_WDN) + (size_t)le * 1024 * 1024, 1024, ri, 16, scrw, F.lane); }
    }
}

constexpr int FILL_N = 32 * 512 + 32 * 256, FILL_A = 6144, FILL_B = 9216, FILL_C = 19840, FILL_D = 21760, FILL_E = FILL_N;
__device__ __forceinline__ void p_fill_convert(Frame& F, int slot, int nslots, int i0, int i1) {
    LAS float* scrw = (LAS float*)(F.lds + F.wave * 17408);
    for (int i = i0 + slot * 8 + F.wave; i < i1; i += nslots * 8) {
        if (i < 32 * 512) { const int le = 32 + (i >> 9), ri = i & 511; cvt_item_fp8_wide(C4Gu{}, F.in[I_GUW] + (size_t)le * 1024 * 2048, 2048, wsp<unsigned char>(F, WS_WGU) + (size_t)le * 2048 * 1024, 1024, ri, 32, scrw, F.lane); }
        else { const int j = i - 32 * 512; const int le = 32 + (j >> 8), ri = j & 255; cvt_item_fp8_wide(C4Id{}, F.in[I_DNW] + (size_t)le * 1024 * 1024, 1024, wsp<unsigned char>(F, WS_WDN) + (size_t)le * 1024 * 1024, 1024, ri, 16, scrw, F.lane); }
    }
}

struct RowV { f32x4 v[4]; };
__device__ __forceinline__ void row_load(RowV& r, const float* p, int lane) {
#pragma unroll
    for (int j = 0; j < 4; ++j) r.v[j] = ((const f32x4*)p)[lane + 64 * j];
}
__device__ __forceinline__ float row_ss(const RowV& r) {
    float s = 0.f;
#pragma unroll
    for (int j = 0; j < 4; ++j) s += (r.v[j].x * r.v[j].x + r.v[j].y * r.v[j].y) + (r.v[j].z * r.v[j].z + r.v[j].w * r.v[j].w);
    return wave_sum(s);
}
__device__ __forceinline__ void row_modulate(RowV& r, float rstd, const float* g, const float* sh, const float* sc, int lane) {
#pragma unroll
    for (int j = 0; j < 4; ++j) { const f32x4 gv = ((const f32x4*)g)[lane + 64 * j], shv = ((const f32x4*)sh)[lane + 64 * j], scv = ((const f32x4*)sc)[lane + 64 * j];
        r.v[j] = r.v[j] * rstd * gv * (scv + 1.0f) + shv; }
}
__device__ __forceinline__ void row_store_bf16(const RowV& r, bf16* p, int lane) {
#pragma unroll
    for (int j = 0; j < 4; ++j) { u32x2 w; w.x = cvt_pk_bf16(r.v[j].x, r.v[j].y); w.y = cvt_pk_bf16(r.v[j].z, r.v[j].w); ((u32x2*)p)[lane + 64 * j] = w; }
}
__device__ __forceinline__ void row_load_bf16x(RowV& r, const bf16* p, int lane) {
#pragma unroll
    for (int j = 0; j < 4; ++j) { const u32x2 w = ((const u32x2*)p)[lane + 64 * j]; r.v[j] = (f32x4){bflo(w.x), bfhi(w.x), bflo(w.y), bfhi(w.y)}; }
}
__device__ __forceinline__ void row_store_fp8(const RowV& r, unsigned char* p, int lane) {
#pragma unroll
    for (int j = 0; j < 4; ++j) ((unsigned*)p)[lane + 64 * j] = pk4_fp8(r.v[j].x, r.v[j].y, r.v[j].z, r.v[j].w);
}
__device__ __forceinline__ void row_add_moe(RowV& r, const unsigned char* ys, int row, const float* gate, int lane) {
#pragma unroll
    for (int j = 0; j < 4; ++j) { f32x4 s = (f32x4){0.f, 0.f, 0.f, 0.f};
#pragma unroll
        for (int k = 0; k < 4; ++k) { const int w = ((const int*)(ys + (size_t)(row * 4 + k) * 1024))[lane + 64 * j];
            s.x += __builtin_amdgcn_cvt_f32_fp8(w, 0); s.y += __builtin_amdgcn_cvt_f32_fp8(w, 1); s.z += __builtin_amdgcn_cvt_f32_fp8(w, 2); s.w += __builtin_amdgcn_cvt_f32_fp8(w, 3); }
        const f32x4 gv = ((const f32x4*)gate)[lane + 64 * j]; r.v[j] = r.v[j] + gv * s * (1.f / YS_SCALE); }
}
__device__ __forceinline__ const float* src_row_l0(const Frame& F, int row) { return row < NLAT ? F.in[I_X] + (size_t)row * 1024 : F.in[I_CTX] + (size_t)(row - NLAT) * 1024; }

__device__ __forceinline__ void p_norm1_l0(Frame& F) {
    const int gw = F.bid * 8 + F.wave, NGW = F.G * 8;
    for (int row = gw; row < NTOK; row += NGW) {
        RowV r; row_load(r, src_row_l0(F, row), F.lane);
        const float rstd = 1.f / sqrtf(row_ss(r) * (1.f / 1024.f) + 1e-6f);
        row_modulate(r, rstd, F.in[I_N1G], mod_ptr(F, 0, row, 0), mod_ptr(F, 0, row, 1), F.lane);
        row_store_bf16(r, wsp<bf16>(F, WS_H) + (size_t)row * 1024, F.lane);
    }
}
__device__ __forceinline__ void p_combine_norm1_l1(Frame& F) {
    const int gw = F.bid * 8 + F.wave, NGW = F.G * 8;
    for (int row = gw; row < NTOK; row += NGW) {
        bf16* xp = wsp<bf16>(F, WS_X1) + (size_t)row * 1024;
        RowV r; row_load_bf16x(r, xp, F.lane);
        row_add_moe(r, wsp<const unsigned char>(F, WS_YS), row, mod_ptr(F, 0, row, 5), F.lane);
        row_store_bf16(r, xp, F.lane);
        const float rstd = 1.f / sqrtf(row_ss(r) * (1.f / 1024.f) + 1e-6f);
        row_modulate(r, rstd, F.in[I_N1G] + 1024, mod_ptr(F, 1, row, 0), mod_ptr(F, 1, row, 1), F.lane);
        row_store_fp8(r, wsp<unsigned char>(F, WS_H) + (size_t)row * 1024, F.lane);
    }
}
__device__ __forceinline__ void p_final(Frame& F) {
    const int gw = F.bid * 8 + F.wave, NGW = F.G * 8;
    for (int row = gw; row < NLAT; row += NGW) {
        RowV r; row_load_bf16x(r, wsp<const bf16>(F, WS_X1) + (size_t)row * 1024, F.lane);
        row_add_moe(r, wsp<const unsigned char>(F, WS_YS), row, mod_ptr(F, 1, row, 5), F.lane);
        const float rstd = 1.f / sqrtf(row_ss(r) * (1.f / 1024.f) + 1e-6f);
#pragma unroll
        for (int j = 0; j < 4; ++j) { const f32x4 gv = ((const f32x4*)F.in[I_FNG])[F.lane + 64 * j]; ((f32x4*)(F.out + (size_t)row * 1024))[F.lane + 64 * j] = r.v[j] * rstd * gv; }
    }
}

constexpr int RT_WS = 2064;
constexpr int RT_WHI = 0, RT_WLO = 32 * RT_WS;
constexpr int RT_TAB = 2 * 32 * RT_WS;
constexpr int RT_TABSZ = 8320;
constexpr int RT_LDS_CNT = RT_TAB + 2 * RT_TABSZ;
__device__ __forceinline__ void vb_tiles(int vb, int ntok, int& t0, int& nt) { const int ntile = ntok >> 5, q = ntile >> 8, r = ntile & 255; if (vb < r) { t0 = vb * (q + 1); nt = q + 1; } else { t0 = r * (q + 1) + (vb - r) * q; nt = q; } }
__device__ __forceinline__ void p_norm2_route(Frame& F, const int layer, const int ntok) {
    LAS unsigned char* L = F.lds;
    LAS int* cnt = (LAS int*)(L + RT_LDS_CNT);
    const int tid = F.tid, lane = F.lane, wave = F.wave, t = lane & 31, hi = lane >> 5;
    const float* rw = F.in[I_RW] + (size_t)layer * 1024 * 32;
    for (int idx = tid; idx < 1024 * 32; idx += 512) { const int k = idx >> 5, e = idx & 31; const float w = rw[idx]; const unsigned h = f2bf(w); const unsigned l = f2bf(w - bf2f(h));
        *(LAS unsigned short*)(L + RT_WHI + e * RT_WS + k * 2) = (unsigned short)h; *(LAS unsigned short*)(L + RT_WLO + e * RT_WS + k * 2) = (unsigned short)l; }
    unsigned char* rt = F.ws + WS_ROUTE;
    const float* g2 = F.in[I_N2G] + layer * 1024;
    const bf16* X = wsp<const bf16>(F, WS_X1); unsigned char* H8 = wsp<unsigned char>(F, WS_H);
    for (int vb = F.bid; vb < 256; vb += F.G) {
        int t0, nt; vb_tiles(vb, ntok, t0, nt);
        const int mr0 = mod_row(t0 * 32), mr1 = mod_row((t0 + nt) * 32 - 1);
        __syncthreads();
        if (tid < 32) cnt[tid] = 0;
        for (int sl = 0; sl < 2; ++sl) { const int mr = sl ? mr1 : mr0; LAS float* tb = (LAS float*)(L + RT_TAB + sl * RT_TABSZ);
            const float* shp = wsp<const float>(F, WS_MOD) + ((size_t)(layer * 9 + mr) * 6 + 3) * 1024; const float* scp = shp + 1024;
            for (int k = tid; k < 1024; k += 512) { tb[k] = g2[k] * (1.f + scp[k]); tb[1024 + k] = shp[k]; } }
        __syncthreads();
        for (int sl = 0; sl < 2; ++sl) { LAS float* tb = (LAS float*)(L + RT_TAB + sl * RT_TABSZ); LAS float* red = (LAS float*)(L + RT_LDS_CNT + 256);
            const int e = tid & 31, kp = tid >> 5; float sacc = 0.f;
            for (int k = kp * 64; k < kp * 64 + 64; ++k) sacc += tb[1024 + k] * rw[k * 32 + e];
            red[kp * 32 + e] = sacc; __syncthreads();
            if (tid < 32) { float c = F.in[I_RB][layer * 32 + tid]; for (int i = 0; i < 16; ++i) c += red[i * 32 + tid]; tb[2048 + tid] = c; }
            __syncthreads(); }
        for (int ti = wave; ti < nt; ti += 8) {
            const int tile = t0 + ti, row = tile * 32 + t; const int sl = (mod_row(tile * 32) == mr0) ? 0 : 1;
            const LAS float* tb = (const LAS float*)(L + RT_TAB + sl * RT_TABSZ);
            const bf16* xp = X + (size_t)row * 1024 + hi * 8;
            f32x16 acc;
#pragma unroll
            for (int r = 0; r < 16; ++r) acc[r] = 0.f;
            float ss = 0.f;
#pragma unroll 4
            for (int s = 0; s < 64; ++s) {
                const u32x4 xw = *(const u32x4*)(xp + s * 16); const f32x4 x0 = {bflo(xw.x), bfhi(xw.x), bflo(xw.y), bfhi(xw.y)}, x1 = {bflo(xw.z), bfhi(xw.z), bflo(xw.w), bfhi(xw.w)};
                const f32x4 g0 = *(const LAS f32x4*)(tb + s * 16 + hi * 8), g1 = *(const LAS f32x4*)(tb + s * 16 + hi * 8 + 4);
                ss += (x0.x * x0.x + x0.y * x0.y) + (x0.z * x0.z + x0.w * x0.w) + (x1.x * x1.x + x1.y * x1.y) + (x1.z * x1.z + x1.w * x1.w);
                const f32x4 y0 = x0 * g0, y1 = x1 * g1;
                u32x4 hh; hh.x = cvt_pk_bf16(y0.x, y0.y); hh.y = cvt_pk_bf16(y0.z, y0.w); hh.z = cvt_pk_bf16(y1.x, y1.y); hh.w = cvt_pk_bf16(y1.z, y1.w);
                u32x4 ll; ll.x = cvt_pk_bf16(y0.x - bflo(hh.x), y0.y - bfhi(hh.x)); ll.y = cvt_pk_bf16(y0.z - bflo(hh.y), y0.w - bfhi(hh.y)); ll.z = cvt_pk_bf16(y1.x - bflo(hh.z), y1.y - bfhi(hh.z)); ll.w = cvt_pk_bf16(y1.z - bflo(hh.w), y1.w - bfhi(hh.w));
                const bf16x8 xh = __builtin_bit_cast(bf16x8, hh), xl = __builtin_bit_cast(bf16x8, ll);
                const bf16x8 wh = *(const LAS bf16x8*)(L + RT_WHI + t * RT_WS + (s * 16 + hi * 8) * 2), wl = *(const LAS bf16x8*)(L + RT_WLO + t * RT_WS + (s * 16 + hi * 8) * 2);
                acc = __builtin_amdgcn_mfma_f32_32x32x16_bf16(wh, xh, acc, 0, 0, 0);
                acc = __builtin_amdgcn_mfma_f32_32x32x16_bf16(wh, xl, acc, 0, 0, 0);
                acc = __builtin_amdgcn_mfma_f32_32x32x16_bf16(wl, xh, acc, 0, 0, 0);
            }
            { auto rr = __builtin_amdgcn_permlane32_swap(__float_as_uint(ss), __float_as_uint(ss), false, false); ss = __uint_as_float(rr[0]) + __uint_as_float(rr[1]); }
            const float rstd = 1.f / sqrtf(ss * (1.f / 1024.f) + 1e-6f);
            float lg[32];
#pragma unroll
            for (int r = 0; r < 16; ++r) { auto rr = __builtin_amdgcn_permlane32_swap(__float_as_uint(acc[r]), __float_as_uint(acc[r]), false, false);
                const int e0 = (r & 3) + 8 * (r >> 2); lg[e0] = __uint_as_float(rr[0]) * rstd + tb[2048 + e0]; lg[e0 + 4] = __uint_as_float(rr[1]) * rstd + tb[2048 + e0 + 4]; }
            int se[4]; float sv[4];
#pragma unroll
            for (int k = 0; k < 4; ++k) { float best = lg[0]; int bi = 0;
#pragma unroll
                for (int e = 1; e < 32; ++e) { const bool gt = lg[e] > best; best = gt ? lg[e] : best; bi = gt ? e : bi; }
                se[k] = bi; sv[k] = best;
#pragma unroll
                for (int e = 0; e < 32; ++e) lg[e] = (e == bi) ? -3.0e38f : lg[e]; }
            const float e1 = __expf(sv[1] - sv[0]), e2 = __expf(sv[2] - sv[0]), e3 = __expf(sv[3] - sv[0]); const float inv = 1.f / (1.f + e1 + e2 + e3);
            if (hi == 0) {
                const float gk[4] = {inv, e1 * inv, e2 * inv, e3 * inv};
#pragma unroll
                for (int k = 0; k < 4; ++k) { const int pos = __hip_atomic_fetch_add(cnt + se[k], 1, __ATOMIC_RELAXED, __HIP_MEMORY_SCOPE_WORKGROUP);
                    rt[RT_E + (size_t)row * 4 + k] = (unsigned char)se[k]; ((unsigned short*)(rt + RT_POS))[(size_t)row * 4 + k] = (unsigned short)pos; ((float*)(rt + RT_GATE))[(size_t)row * 4 + k] = gk[k]; }
            }
            unsigned char* hp = H8 + (size_t)row * 1024 + hi * 8;
#pragma unroll 4
            for (int s = 0; s < 64; ++s) {
                const u32x4 xw = *(const u32x4*)(xp + s * 16); const f32x4 x0 = {bflo(xw.x), bfhi(xw.x), bflo(xw.y), bfhi(xw.y)}, x1 = {bflo(xw.z), bfhi(xw.z), bflo(xw.w), bfhi(xw.w)};
                const f32x4 g0 = *(const LAS f32x4*)(tb + s * 16 + hi * 8), g1 = *(const LAS f32x4*)(tb + s * 16 + hi * 8 + 4);
                const f32x4 h0 = *(const LAS f32x4*)(tb + 1024 + s * 16 + hi * 8), h1 = *(const LAS f32x4*)(tb + 1024 + s * 16 + hi * 8 + 4);
                const f32x4 y0 = x0 * rstd * g0 + h0, y1 = x1 * rstd * g1 + h1;
                *(u32x2*)(hp + s * 16) = (u32x2){pk4_fp8(y0.x, y0.y, y0.z, y0.w), pk4_fp8(y1.x, y1.y, y1.z, y1.w)};
            }
        }
        __syncthreads();
        if (tid < 32) ((unsigned*)(rt + RT_HIST))[vb * 32 + tid] = (unsigned)cnt[tid];
    }
    __syncthreads();
}
constexpr int MT_OFF = 131072 + 1024;
__device__ __forceinline__ void moe_tables(Frame& F) {
    LAS int* tab = (LAS int*)(F.lds + MT_OFF);
    LAS int* part = (LAS int*)(F.lds + MT_OFF + 8192 + 256);
    const unsigned* hist = (const unsigned*)(F.ws + WS_ROUTE + RT_HIST);
    { const int e = F.tid & 31, p = F.tid >> 5; int c = 0;
#pragma unroll
      for (int i = 0; i < 16; ++i) c += (int)hist[(p * 16 + i) * 32 + e];
      part[p * 32 + e] = c; }
    __syncthreads();
    if (F.tid < 32) { int c = 0;
#pragma unroll
        for (int p = 0; p < 16; ++p) c += part[p * 32 + F.tid];
        tab[32 + F.tid] = c; }
    __syncthreads();
    if (F.tid == 0) { int s = 0; for (int e = 0; e < 32; ++e) { tab[e] = s; s += ((tab[32 + e] + 255) >> 8) << 8; } tab[64] = s >> 8; }
    __syncthreads();
    if (F.tid < 32) { const int s0 = tab[F.tid] >> 8, nb = (tab[32 + F.tid] + 255) >> 8; for (int i = 0; i < nb; ++i) tab[128 + s0 + i] = F.tid; }
    __syncthreads();
}
__device__ __forceinline__ void p_moe_scatter(Frame& F, const int ntok) {
    moe_tables(F);
    LAS int* tab = (LAS int*)(F.lds + MT_OFF);
    LAS int* base = (LAS int*)(F.lds + MT_OFF + 8192);
    const unsigned* hist = (const unsigned*)(F.ws + WS_ROUTE + RT_HIST);
    const unsigned char* rt = F.ws + WS_ROUTE;
    unsigned* stok = wsp<unsigned>(F, WS_SORT); unsigned* sdst = stok + MAXSLOT; float* sgate = (float*)(sdst + MAXSLOT);
    for (int vb = F.bid; vb < 256; vb += F.G) {
        int t0, nt; vb_tiles(vb, ntok, t0, nt);
        if (F.tid < 32) { const LAS int* part = (const LAS int*)(F.lds + MT_OFF + 8192 + 256); int c = 0; for (int p = 0; p < (vb >> 4); ++p) c += part[p * 32 + F.tid];
            for (int b = vb & ~15; b < vb; ++b) c += (int)hist[b * 32 + F.tid]; base[F.tid] = tab[F.tid] + c; }
        __syncthreads();
        for (int i = F.tid; i < nt * 128; i += 512) {
            const int row = t0 * 32 + (i >> 2), k = i & 3; const size_t a = (size_t)row * 4 + k;
            const int e = rt[RT_E + a], pos = ((const unsigned short*)(rt + RT_POS))[a];
            const int slot = base[e] + pos;
            stok[slot] = (unsigned)row; sdst[slot] = (unsigned)(row * 4 + k); sgate[slot] = ((const float*)(rt + RT_GATE))[a];
        }
        if (vb < 32) { const int e = vb, c = tab[32 + e], s0 = tab[e] + c, s1 = tab[e] + (((c + 255) >> 8) << 8);
            for (int s = s0 + F.tid; s < s1; s += 512) { stok[s] = 0u; sdst[s] = (unsigned)YS_DUMMY; sgate[s] = 0.f; } }
        __syncthreads();
    }
}

namespace pg8 {
struct DenseSched {
    int nM, nN, nwg, G, c, KB; const bf16* Bt;
    __device__ __forceinline__ void init(int M, int N, int KB_, const void* Bt_, int G_, int c_) { nM = M / BM; nN = N / BM; nwg = nM * nN; G = G_; c = c_; KB = KB_; Bt = (const bf16*)Bt_; }
    __device__ __forceinline__ bool next(int i, Unit& u) const {
        const long L = (long)i * G + c; if (L >= nwg) return false;
        int wgid = (int)L; { const int q = nwg / 8, r = nwg % 8, xcd = wgid % 8, off = wgid / 8; wgid = (xcd < r ? xcd * (q + 1) : r * (q + 1) + (xcd - r) * q) + off; }
        const int nig = 8 * nN, gid = wgid / nig, fm = gid * 8, gsz = (nM - fm) < 8 ? (nM - fm) : 8;
        u.pm = fm + ((wgid % nig) % gsz); u.pn = (wgid % nig) / gsz; return true;
    }
    __device__ __forceinline__ void a_offs(const Unit& u, unsigned (&ao)[2][2], const int (&R)[2], const int (&C)[2]) const {
#pragma unroll
        for (int h = 0; h < 2; ++h)
#pragma unroll
            for (int i = 0; i < 2; ++i) ao[h][i] = (unsigned)((u.pm * BM + h * HALF + R[i]) * KB + C[i] * 2);
    }
    __device__ __forceinline__ const char* b_tile(const Unit& u) const { return (const char*)Bt + (size_t)u.pn * BM * KB; }
    __device__ __forceinline__ int ktiles(const Unit&, int ntdef) const { return ntdef; }
};
struct LrSched : DenseSched {
    __device__ __forceinline__ unsigned koff(const Unit& u) const { return u.pn < 8 ? 0u : 256u; }
    __device__ __forceinline__ void a_offs(const Unit& u, unsigned (&ao)[2][2], const int (&R)[2], const int (&C)[2]) const { DenseSched::a_offs(u, ao, R, C);
#pragma unroll
        for (int h = 0; h < 2; ++h)
#pragma unroll
            for (int i = 0; i < 2; ++i) ao[h][i] += koff(u); }
    __device__ __forceinline__ const char* b_tile(const Unit& u) const { return DenseSched::b_tile(u) + koff(u); }
    __device__ __forceinline__ int ktiles(const Unit& u, int) const { return u.pn < 8 ? 2 : 4; }
};
struct KvSched : DenseSched { __device__ __forceinline__ int ktiles(const Unit&, int) const { int n = 2; asm volatile("" : "+s"(n)); return n; } };
template <bool GATHER> struct MoeSched {
    int nrb, npn, G, c; const LAS int* blk_e; const unsigned* tok; const unsigned char* Wt; size_t wstride;
    __device__ __forceinline__ bool next(int i, Unit& u) const {
        if ((G & 7) != 0 || ((G >> 3) % npn) != 0) { const long L = (long)i * G + c; if (L >= (long)nrb * npn) return false; u.pm = (int)(L / npn); u.pn = (int)(L % npn); return true; }
        const int x = c & 7, y = c >> 3, per = (G >> 3) / npn;
        u.pm = (i * 8 + x) * per + y / npn; u.pn = y % npn; return u.pm < nrb;
    }
    __device__ __forceinline__ void a_offs(const Unit& u, unsigned (&ao)[2][2], const int (&R)[2], const int (&C)[2]) const {
#pragma unroll
        for (int h = 0; h < 2; ++h)
#pragma unroll
            for (int i = 0; i < 2; ++i) { const int slot = u.pm * BM + h * HALF + R[i]; const unsigned row = GATHER ? tok[slot] : (unsigned)slot; ao[h][i] = row * 1024u + (unsigned)C[i] * 2u; }
    }
    __device__ __forceinline__ const char* b_tile(const Unit& u) const { return (const char*)(Wt + (size_t)blk_e[u.pm] * wstride + (size_t)u.pn * BM * 1024); }
    __device__ __forceinline__ int ktiles(const Unit&, int ntdef) const { return ntdef; }
};

struct MapPlain { bf16* O; int ld; __device__ __forceinline__ bf16* operator()(int row, int col) const { return O + (size_t)row * ld + col; } };
constexpr float ATT_QPRE = 0.8329403702157812f;
struct EpiQ8 {
    static constexpr bool PERM = true; unsigned char* Q8; const f32x2* ROPE;
    __device__ __forceinline__ void operator()(const f32x4 (&acc)[2][2][4][2], const Unit& u, int wr, int wc, int fr, int fq) const {
#pragma unroll
        for (int ai = 0; ai < 2; ++ai)
#pragma unroll
            for (int m = 0; m < 4; ++m) { const int row = u.pm * BM + ai * HALF + wr * 64 + m * 16 + fr; const int b = row >> 13, t = row & 8191;
#pragma unroll
                for (int bj = 0; bj < 2; ++bj) { const int col = u.pn * BM + bj * HALF + wc * 32 + 8 * fq; float v[8];
#pragma unroll
                    for (int e = 0; e < 4; ++e) { v[e] = acc[ai][bj][m][0][e]; v[4 + e] = acc[ai][bj][m][1][e]; }
                    int h, d;
                    if (u.pn < 4) { h = col >> 7; d = col & 127; }
                    else { h = (col - 1024) >> 6; const int dr = (col - 1024) & 63; d = 128 + dr;
                        const f32x2* cs = ROPE + t * 32 + ((dr >> 5) << 4) + (dr & 8);
#pragma unroll
                        for (int e = 0; e < 8; ++e) { auto rr = __builtin_amdgcn_permlane32_swap(__float_as_uint(v[e]), __float_as_uint(v[e]), false, false);
                            const float pr = __uint_as_float(fq < 2 ? rr[1] : rr[0]); const f32x2 c = cs[e]; v[e] = (fq >= 2) ? v[e] * c.x + pr * c.y : v[e] * c.x - pr * c.y; } }
                    *(u32x2*)(Q8 + ((size_t)((b * 8 + h) * SEQ + t)) * QKD + d) = (u32x2){pk4_fp8(v[0] * ATT_QPRE, v[1] * ATT_QPRE, v[2] * ATT_QPRE, v[3] * ATT_QPRE), pk4_fp8(v[4] * ATT_QPRE, v[5] * ATT_QPRE, v[6] * ATT_QPRE, v[7] * ATT_QPRE)}; } }
    }
};
struct EpiKV8 {
    static constexpr bool PERM = true; unsigned char* K8; unsigned char* VT;
    __device__ __forceinline__ void operator()(const f32x4 (&acc)[2][2][4][2], const Unit& u, int wr, int wc, int fr, int fq) const {
#pragma unroll
        for (int ai = 0; ai < 2; ++ai)
#pragma unroll
            for (int m = 0; m < 4; ++m) { const int row = u.pm * BM + ai * HALF + wr * 64 + m * 16 + fr;
                const int b = row < NLAT ? (row >> 13) : ((row - NLAT) >> 8), key = row < NLAT ? CTXL + (row & 8191) : ((row - NLAT) & 255), h = u.pn;
                { const f32x4 v0 = acc[ai][0][m][0], v1 = acc[ai][0][m][1];
                  *(u32x2*)(K8 + ((size_t)((b * 8 + h) * NKEY + key)) * K8ROW + wc * 32 + 8 * fq) = (u32x2){pk4_fp8(v0[0], v0[1], v0[2], v0[3]), pk4_fp8(v1[0], v1[1], v1[2], v1[3])}; }
                { const int k6 = key & 63, kk = k6 & 31, p = 32 * ((kk >> 2) & 1) + (k6 >> 5) * 16 + (kk & 3) + 4 * (kk >> 3);
                  unsigned char* tb = VT + ((size_t)(b * 8 + h) * (NKEY / 64) + (key >> 6)) * 8192 + (p & 15); const int c0 = wc * 32 + 8 * fq, ch = p >> 4;
                  const unsigned w0 = pk4_fp8(acc[ai][1][m][0][0], acc[ai][1][m][0][1], acc[ai][1][m][0][2], acc[ai][1][m][0][3]), w1 = pk4_fp8(acc[ai][1][m][1][0], acc[ai][1][m][1][1], acc[ai][1][m][1][2], acc[ai][1][m][1][3]);
#pragma unroll
                  for (int e = 0; e < 8; ++e) { const int c = c0 + e; tb[c * 64 + ((ch ^ ((c >> 2) & 3)) << 4)] = (unsigned char)(((e < 4 ? w0 : w1) >> (8 * (e & 3))) & 0xffu); } } }
    }
};
template <class Map> struct EpiBf16 {
    static constexpr bool PERM = true; Map map;
    __device__ __forceinline__ void operator()(const f32x4 (&acc)[2][2][4][2], const Unit& u, int wr, int wc, int fr, int fq) const {
#pragma unroll
        for (int ai = 0; ai < 2; ++ai)
#pragma unroll
            for (int m = 0; m < 4; ++m) { const int row = u.pm * BM + ai * HALF + wr * 64 + m * 16 + fr;
#pragma unroll
                for (int bj = 0; bj < 2; ++bj) { const int col = u.pn * BM + bj * HALF + wc * 32 + 8 * fq; const f32x4 v0 = acc[ai][bj][m][0], v1 = acc[ai][bj][m][1];
                    u32x4 w; w.x = cvt_pk_bf16(v0[0], v0[1]); w.y = cvt_pk_bf16(v0[2], v0[3]); w.z = cvt_pk_bf16(v1[0], v1[1]); w.w = cvt_pk_bf16(v1[2], v1[3]);
                    *(u32x4*)map(row, col) = w; } }
    }
};
struct EpiF32 {
    static constexpr bool PERM = false; float* C; int ldc;
    __device__ __forceinline__ void operator()(const f32x4 (&acc)[2][2][4][2], const Unit& u, int wr, int wc, int fr, int fq) const {
#pragma unroll
        for (int ai = 0; ai < 2; ++ai)
#pragma unroll
            for (int m = 0; m < 4; ++m) { float* rowp = C + (size_t)(u.pm * BM + ai * HALF + wr * 64 + m * 16 + fr) * ldc + u.pn * BM + wc * 32 + 4 * fq;
#pragma unroll
                for (int bj = 0; bj < 2; ++bj)
#pragma unroll
                    for (int n = 0; n < 2; ++n) *(f32x4*)(rowp + bj * HALF + n * 16) = acc[ai][bj][m][n]; }
    }
};
struct EpiResid {
    static constexpr bool PERM = false; bf16* X1; const float* xlat; const float* xctx; const float* mod; int layer;
    __device__ __forceinline__ void operator()(const f32x4 (&acc)[2][2][4][2], const Unit& u, int wr, int wc, int fr, int fq) const {
#pragma unroll
        for (int ai = 0; ai < 2; ++ai)
#pragma unroll
            for (int m = 0; m < 4; ++m) { const int row = u.pm * BM + ai * HALF + wr * 64 + m * 16 + fr; const int col0 = u.pn * BM + wc * 32 + 4 * fq;
                const float* bp = row < NLAT ? xlat + (size_t)row * 1024 : xctx + (size_t)(row - NLAT) * 1024;
                const float* gp = mod + ((size_t)(layer * 9 + (row < NLAT ? (row >> 13) : 8)) * 6 + 2) * 1024;
                bf16* op = X1 + (size_t)row * 1024;
#pragma unroll
                for (int bj = 0; bj < 2; ++bj)
#pragma unroll
                    for (int n = 0; n < 2; ++n) { const int c = col0 + bj * HALF + n * 16; f32x4 base;
                        if (layer == 0) base = *(const f32x4*)(bp + c); else { const u32x2 bw = *(const u32x2*)(op + c); base = (f32x4){bflo(bw.x), bfhi(bw.x), bflo(bw.y), bfhi(bw.y)}; }
                        const f32x4 v = base + *(const f32x4*)(gp + c) * acc[ai][bj][m][n];
                        *(u32x2*)(op + c) = (u32x2){cvt_pk_bf16(v.x, v.y), cvt_pk_bf16(v.z, v.w)}; } }
    }
};
struct EpiSwiglu {
    static constexpr bool PERM = true; unsigned char* ACT; const float* bgu; const LAS int* blk_e;
    __device__ __forceinline__ void operator()(const f32x4 (&acc)[2][2][4][2], const Unit& u, int wr, int wc, int fr, int fq) const {
        const int e = blk_e[u.pm]; const int c0 = u.pn * 128 + wc * 32 + 8 * fq;
        const float* bg = bgu + (size_t)e * 2048 + c0;
        f32x4 bgl[2], bln[2];
#pragma unroll
        for (int n = 0; n < 2; ++n) { bgl[n] = *(const f32x4*)(bg + 4 * n); bln[n] = *(const f32x4*)(bg + 1024 + 4 * n); }
#pragma unroll
        for (int ai = 0; ai < 2; ++ai)
#pragma unroll
            for (int m = 0; m < 4; ++m) { const int slot = u.pm * BM + ai * HALF + wr * 64 + m * 16 + fr; float o[8];
#pragma unroll
                for (int n = 0; n < 2; ++n)
#pragma unroll
                    for (int j = 0; j < 4; ++j) { const float xg = fminf(acc[ai][0][m][n][j] + bgl[n][j], 7.0f); const float xl = fminf(fmaxf(acc[ai][1][m][n][j] + bln[n][j], -7.0f), 7.0f);
                        o[n * 4 + j] = xg * __builtin_amdgcn_rcpf(1.f + __expf(-1.702f * xg)) * (xl + 1.0f); }
                *(u32x2*)(ACT + (size_t)slot * 1024 + c0) = (u32x2){pk4_fp8(o[0], o[1], o[2], o[3]), pk4_fp8(o[4], o[5], o[6], o[7])}; }
    }
};
struct EpiDown {
    static constexpr bool PERM = true; unsigned char* YS; const float* bdn; const LAS int* blk_e; const unsigned* dst; const float* gate;
    __device__ __forceinline__ void operator()(const f32x4 (&acc)[2][2][4][2], const Unit& u, int wr, int wc, int fr, int fq) const {
        const int e = blk_e[u.pm]; const int c0 = u.pn * BM + wc * 32 + 8 * fq;
        f32x4 bv[2][2];
#pragma unroll
        for (int bj = 0; bj < 2; ++bj)
#pragma unroll
            for (int n = 0; n < 2; ++n) bv[bj][n] = *(const f32x4*)(bdn + (size_t)e * 1024 + c0 + bj * HALF + 4 * n);
#pragma unroll
        for (int ai = 0; ai < 2; ++ai)
#pragma unroll
            for (int m = 0; m < 4; ++m) { const int slot = u.pm * BM + ai * HALF + wr * 64 + m * 16 + fr; const float g = gate[slot] * YS_SCALE; unsigned char* op = YS + (size_t)dst[slot] * 1024 + c0;
#pragma unroll
                for (int bj = 0; bj < 2; ++bj) { const f32x4 v0 = (acc[ai][bj][m][0] + bv[bj][0]) * g, v1 = (acc[ai][bj][m][1] + bv[bj][1]) * g;
                    *(u32x2*)(op + bj * HALF) = (u32x2){pk4_fp8(v0[0], v0[1], v0[2], v0[3]), pk4_fp8(v1[0], v1[1], v1[2], v1[3])}; } }
    }
};
}

__device__ __forceinline__ float ldbf(const bf16* p) { return bf2f((unsigned)*p); }
__device__ __forceinline__ void seq_pos(int row, bool& hp, bool& hn) { if (row < NLAT) { const int t = row & 8191; hp = t > 0; hn = t < SEQ - 1; } else { const int t = (row - NLAT) & 255; hp = t > 0; hn = t < CTXL - 1; } }

__device__ __forceinline__ void p_alr(Frame& F) {
    const int gw = F.bid * 8 + F.wave, NGW = F.G * 8;
    const bf16* P = wsp<const bf16>(F, WS_P); bf16* A = wsp<bf16>(F, WS_ALR); const float* mu = F.in[I_MU];
    for (int row = gw; row < NTOK; row += NGW) {
        bool hp, hn; seq_pos(row, hp, hn);
        const bf16* pr = P + (size_t)row * PW + RW0 + 1536;
#pragma unroll
        for (int q = 0; q < 6; ++q) { const int c = F.lane + 64 * q; float o = 0.f;
            if (c < 288) { const float p0 = ldbf(pr + c), pm = hp ? ldbf(pr + c - PW) : 0.f, pn = hn ? ldbf(pr + c + PW) : 0.f;
                const float xs = p0 + mu[1536 + c] * (pm - p0) + mu[RW_COLS + 1536 + c] * (pn - p0);
                o = c < 64 ? (1.f - 2.f * __builtin_amdgcn_rcpf(1.f + __expf(2.f * xs))) : (c < 128 ? xs : __builtin_amdgcn_rcpf(1.f + __expf(-xs))); }
            A[(size_t)row * LRK + c] = (bf16)f2bf(o); }
    }
}

constexpr int GL_QRAW = 0, GL_KRAW = 8192, GL_GDS = 16384, GL_QD = 20480, GL_KI = 29696, GL_KE = 38912, GL_AT = 48128, GL_VT = 57344, GL_ST = 61952, GL_GSUM = 71168, GL_DEC = 73216;
constexpr int GL_RS = 144;
__device__ __forceinline__ bf16x8 lds_frag(const LAS unsigned char* base, int row, int kbyte) { return *(const LAS bf16x8*)(base + row * GL_RS + kbyte); }
constexpr int GW_UNIT = 24832;
constexpr int GW_QD = 0, GW_KE = 8192, GW_AT = 16384, GW_DEC = 24576;
#define GLA_ROWF(b, dir, n, i) ((n) < 4 ? NLAT + (b) * 256 + ((dir) ? 3 - (n) : (n)) * 64 + ((dir) ? 63 - (i) : (i)) : (b) * 8192 + ((dir) ? 127 - ((n) - 4) : ((n) - 4)) * 64 + ((dir) ? 63 - (i) : (i)))
__device__ __forceinline__ void p_gla_pre(Frame& F) {
    LAS unsigned char* L = F.lds;
    const bf16* P = wsp<const bf16>(F, WS_P); unsigned char* GW = F.ws + WS_X1;
    const int tid = F.tid, lane = F.lane, wave = F.wave, r32 = lane & 31, hi = lane >> 5;
    const int dk = lane, tg = wave;
    constexpr int NU = NB * 4 * 2 * 132;
    bf16x8 qv, kv, gv;
#define GP_LOAD(u) do { const int n_ = (u) % 132, d_ = ((u) / 132) & 1, h_ = ((u) / 264) & 3, b_ = (u) / 1056; const bf16* rp = P + (size_t)GLA_ROWF(b_, d_, n_, tid >> 3) * PW; \
        qv = *(const bf16x8*)(rp + h_ * 64 + (tid & 7) * 8); kv = *(const bf16x8*)(rp + 256 + h_ * 64 + (tid & 7) * 8); \
        if (tid < 128) gv = *(const bf16x8*)(P + (size_t)GLA_ROWF(b_, d_, n_, tid >> 1) * PW + 1536 + (tid & 1) * 8); } while (0)
    if (F.bid < NU) GP_LOAD(F.bid);
    for (int u = F.bid; u < NU; u += F.G) {
        const int dir = (u / 132) & 1, h = (u / 264) & 3;
        float gkw[16];
#pragma unroll
        for (int r = 0; r < 16; ++r) gkw[r] = F.in[I_GKUP][(size_t)(dir * 16 + r) * 256 + h * 64 + dk];
        const float gkb = F.in[I_GKB][dir * 256 + h * 64 + dk];
        unsigned char* gw = GW + (size_t)u * GW_UNIT;
        *(LAS bf16x8*)(L + GL_QRAW + (tid >> 3) * 128 + (tid & 7) * 16) = qv;
        *(LAS bf16x8*)(L + GL_KRAW + (tid >> 3) * 128 + (tid & 7) * 16) = kv;
        if (tid < 128) { LAS float* gp = (LAS float*)(L + GL_GDS) + (tid >> 1) * 16 + (tid & 1) * 8;
#pragma unroll
            for (int e = 0; e < 8; ++e) gp[e] = bf2f((unsigned)(unsigned short)gv[e]); }
        __syncthreads();
        if (u + F.G < NU) GP_LOAD(u + F.G);
        float Gl[8]; float cum = 0.f;
#pragma unroll
        for (int ii = 0; ii < 8; ++ii) { const LAS float* gp = (const LAS float*)(L + GL_GDS) + (tg * 8 + ii) * 16; float x = gkb;
#pragma unroll
            for (int r = 0; r < 16; ++r) x += gp[r] * gkw[r];
            const float ls = fminf(x, 0.f) - __logf(1.f + __expf(-fabsf(x)));
            cum += ls * (1.f / 16.f); Gl[ii] = cum; }
        ((LAS float*)(L + GL_GSUM))[tg * 64 + dk] = cum;
        __syncthreads();
        float off = 0.f, tot = 0.f;
#pragma unroll
        for (int t2 = 0; t2 < 8; ++t2) { const float gs = ((const LAS float*)(L + GL_GSUM))[t2 * 64 + dk]; tot += gs; off += (t2 < tg) ? gs : 0.f; }
        unsigned kep[4]; const float etot = __expf(tot);
#pragma unroll
        for (int ii = 0; ii < 8; ii += 2) { float kev[2];
#pragma unroll
            for (int z = 0; z < 2; ++z) { const int i = tg * 8 + ii + z; const float G = off + Gl[ii + z];
                const float q = bf2f((unsigned)*(const LAS unsigned short*)(L + GL_QRAW + i * 128 + dk * 2)), k = bf2f((unsigned)*(const LAS unsigned short*)(L + GL_KRAW + i * 128 + dk * 2));
                const float eg = __expf(G), ieg = __builtin_amdgcn_rcpf(eg);
                const unsigned short qd = (unsigned short)f2bf(q * 0.125f * eg);
                *(LAS unsigned short*)(L + GL_QD + i * GL_RS + dk * 2) = qd; *(unsigned short*)(gw + GW_QD + i * 128 + dk * 2) = qd;
                *(LAS unsigned short*)(L + GL_KI + i * GL_RS + dk * 2) = (unsigned short)f2bf(k * ieg);
                kev[z] = k * (etot * ieg); }
            kep[ii >> 1] = cvt_pk_bf16(kev[0], kev[1]); }
        *(u32x4*)(gw + GW_KE + dk * 128 + tg * 16) = (u32x4){kep[0], kep[1], kep[2], kep[3]};
        if (tg == 0) ((float*)(gw + GW_DEC))[dk] = etot;
        __syncthreads();
        if (wave < 4) { const int tj = wave & 1, ti = wave >> 1;
            f32x16 acc;
#pragma unroll
            for (int r = 0; r < 16; ++r) acc[r] = 0.f;
            if (!(ti == 0 && tj == 1)) {
#pragma unroll
                for (int ks = 0; ks < 4; ++ks) acc = __builtin_amdgcn_mfma_f32_32x32x16_bf16(lds_frag(L + GL_KI, tj * 32 + r32, ks * 32 + hi * 16), lds_frag(L + GL_QD, ti * 32 + r32, ks * 32 + hi * 16), acc, 0, 0, 0);
            }
            const int i = ti * 32 + r32;
#pragma unroll
            for (int g = 0; g < 4; ++g) { const int j0 = tj * 32 + 8 * g + 4 * hi; float v4[4];
#pragma unroll
                for (int z = 0; z < 4; ++z) v4[z] = (j0 + z <= i) ? acc[4 * g + z] : 0.f;
                *(u32x2*)(gw + GW_AT + i * 128 + j0 * 2) = (u32x2){cvt_pk_bf16(v4[0], v4[1]), cvt_pk_bf16(v4[2], v4[3])}; } }
        __syncthreads();
    }
#undef GP_LOAD
}
__device__ __forceinline__ void p_gla_scan(Frame& F) {
    LAS unsigned char* L = F.lds;
    const bf16* P = wsp<const bf16>(F, WS_P); const unsigned char* GW = F.ws + WS_X1;
    const int tid = F.tid, lane = F.lane, wave = F.wave, r32 = lane & 31, hi = lane >> 5;
    for (int id = F.bid; id < 256; id += F.G) {
        const int xj_ = id >> 3, gg_ = (xj_ >> 2) + 8 * (id & 7); const int b = gg_ >> 3, h = (gg_ >> 1) & 3, dir = gg_ & 1, vs = xj_ & 3;
        const unsigned char* gwb = GW + (size_t)(((b * 4 + h) * 2 + dir) * 132) * GW_UNIT;
        f32x16 Sacc;
#pragma unroll
        for (int r = 0; r < 16; ++r) Sacc[r] = 0.f;
        for (int i = tid; i < 4608 / 4; i += 512) ((LAS unsigned*)(L + GL_ST))[i] = 0u;
        u32x4 t0, t1, t2, dv; bf16x8 vv;
#define GS_LOAD(n) do { const unsigned char* gu = gwb + (size_t)(n) * GW_UNIT + tid * 16; t0 = *(const u32x4*)(gu); t1 = *(const u32x4*)(gu + 8192); t2 = *(const u32x4*)(gu + 16384); \
        if (tid < 16) dv = *(const u32x4*)(gwb + (size_t)(n) * GW_UNIT + GW_DEC + tid * 16); \
        if (tid < 256) vv = *(const bf16x8*)(P + (size_t)GLA_ROWF(b, dir, n, tid >> 2) * PW + 512 + h * 128 + vs * 32 + (tid & 3) * 8); } while (0)
        GS_LOAD(0);
        __syncthreads();
        for (int n = 0; n < 132; ++n) {
            { const int row = tid >> 3, c16 = (tid & 7) * 16;
              *(LAS u32x4*)(L + GL_QD + row * GL_RS + c16) = t0; *(LAS u32x4*)(L + GL_KE + row * GL_RS + c16) = t1; *(LAS u32x4*)(L + GL_AT + row * GL_RS + c16) = t2; }
            if (tid < 16) *(LAS u32x4*)(L + GL_DEC + tid * 16) = dv;
            if (tid < 256) { const int i = tid >> 2;
#pragma unroll
                for (int e = 0; e < 8; ++e) *(LAS unsigned short*)(L + GL_VT + ((tid & 3) * 8 + e) * GL_RS + i * 2) = (unsigned short)vv[e]; }
            __syncthreads();
            if (n + 1 < 132) GS_LOAD(n + 1);
            const LAS unsigned char* STc = L + GL_ST + (n & 1) * 4608; LAS unsigned char* STn = L + GL_ST + ((n + 1) & 1) * 4608;
            if (wave < 2) {
                const int ti = wave; f32x16 acc;
#pragma unroll
                for (int r = 0; r < 16; ++r) acc[r] = 0.f;
#pragma unroll
                for (int ks = 0; ks < 4; ++ks) acc = __builtin_amdgcn_mfma_f32_32x32x16_bf16(lds_frag(L + GL_AT, ti * 32 + r32, ks * 32 + hi * 16), lds_frag(L + GL_VT, r32, ks * 32 + hi * 16), acc, 0, 0, 0);
#pragma unroll
                for (int ks = 0; ks < 4; ++ks) acc = __builtin_amdgcn_mfma_f32_32x32x16_bf16(lds_frag(L + GL_QD, ti * 32 + r32, ks * 32 + hi * 16), lds_frag(STc, r32, ks * 32 + hi * 16), acc, 0, 0, 0);
                bf16* O = wsp<bf16>(F, WS_GLAO) + (size_t)dir * NTOK * 512 + h * 128 + vs * 32 + r32;
#pragma unroll
                for (int r = 0; r < 16; ++r) { const int i = ti * 32 + (r & 3) + 8 * (r >> 2) + 4 * hi; O[(size_t)GLA_ROWF(b, dir, n, i) * 512] = (bf16)f2bf(acc[r]); }
            } else if (wave < 4) {
                const int dt = wave - 2;
#pragma unroll
                for (int g = 0; g < 4; ++g) { const f32x4 dvv = *(const LAS f32x4*)(L + GL_DEC + (dt * 32 + 8 * g + 4 * hi) * 4);
#pragma unroll
                    for (int z = 0; z < 4; ++z) Sacc[4 * g + z] *= dvv[z]; }
#pragma unroll
                for (int ks = 0; ks < 4; ++ks) Sacc = __builtin_amdgcn_mfma_f32_32x32x16_bf16(lds_frag(L + GL_KE, dt * 32 + r32, ks * 32 + hi * 16), lds_frag(L + GL_VT, r32, ks * 32 + hi * 16), Sacc, 0, 0, 0);
#pragma unroll
                for (int g = 0; g < 4; ++g) *(LAS u32x2*)(STn + r32 * GL_RS + (dt * 32 + 8 * g + 4 * hi) * 2) = (u32x2){cvt_pk_bf16(Sacc[4 * g], Sacc[4 * g + 1]), cvt_pk_bf16(Sacc[4 * g + 2], Sacc[4 * g + 3])};
            }
            __syncthreads();
        }
#undef GS_LOAD
    }
}
__device__ __forceinline__ void wave_sum4(float& a, float& b, float& c, float& d) {
#define WS4_STEP(ctl) "v_add_f32_dpp %0, %0, %0 " ctl "\n\tv_add_f32_dpp %1, %1, %1 " ctl "\n\tv_add_f32_dpp %2, %2, %2 " ctl "\n\tv_add_f32_dpp %3, %3, %3 " ctl "\n\t"
    asm volatile("s_nop 1\n\t"
                 WS4_STEP("quad_perm:[1,0,3,2] row_mask:0xf bank_mask:0xf")
                 WS4_STEP("quad_perm:[2,3,0,1] row_mask:0xf bank_mask:0xf")
                 WS4_STEP("row_half_mirror row_mask:0xf bank_mask:0xf")
                 WS4_STEP("row_mirror row_mask:0xf bank_mask:0xf")
                 WS4_STEP("row_bcast:15 row_mask:0xa bank_mask:0xf")
                 WS4_STEP("row_bcast:31 row_mask:0xc bank_mask:0xf")
                 "s_nop 0"
                 : "+v"(a), "+v"(b), "+v"(c), "+v"(d));
#undef WS4_STEP
    a = __builtin_bit_cast(float, __builtin_amdgcn_readlane(__builtin_bit_cast(int, a), 63)); b = __builtin_bit_cast(float, __builtin_amdgcn_readlane(__builtin_bit_cast(int, b), 63));
    c = __builtin_bit_cast(float, __builtin_amdgcn_readlane(__builtin_bit_cast(int, c), 63)); d = __builtin_bit_cast(float, __builtin_amdgcn_readlane(__builtin_bit_cast(int, d), 63));
}
#define LDS_BARRIER() asm volatile("s_waitcnt lgkmcnt(0)\n\ts_barrier" ::: "memory")
__device__ __forceinline__ void red16x2(float& a, float& b) {
    asm volatile("s_nop 1\n\t"
                 "v_add_f32_dpp %0, %0, %0 quad_perm:[1,0,3,2] row_mask:0xf bank_mask:0xf\n\t"
                 "v_add_f32_dpp %1, %1, %1 quad_perm:[1,0,3,2] row_mask:0xf bank_mask:0xf\n\t"
                 "s_nop 0\n\t"
                 "v_add_f32_dpp %0, %0, %0 quad_perm:[2,3,0,1] row_mask:0xf bank_mask:0xf\n\t"
                 "v_add_f32_dpp %1, %1, %1 quad_perm:[2,3,0,1] row_mask:0xf bank_mask:0xf\n\t"
                 "s_nop 0\n\t"
                 "v_add_f32_dpp %0, %0, %0 row_half_mirror row_mask:0xf bank_mask:0xf\n\t"
                 "v_add_f32_dpp %1, %1, %1 row_half_mirror row_mask:0xf bank_mask:0xf\n\t"
                 "s_nop 0\n\t"
                 "v_add_f32_dpp %0, %0, %0 row_mirror row_mask:0xf bank_mask:0xf\n\t"
                 "v_add_f32_dpp %1, %1, %1 row_mirror row_mask:0xf bank_mask:0xf"
                 : "+v"(a), "+v"(b));
}
__device__ __forceinline__ void red8x2(float& a, float& b) {
    asm volatile("s_nop 1\n\t"
                 "v_add_f32_dpp %0, %0, %0 quad_perm:[1,0,3,2] row_mask:0xf bank_mask:0xf\n\t"
                 "v_add_f32_dpp %1, %1, %1 quad_perm:[1,0,3,2] row_mask:0xf bank_mask:0xf\n\t"
                 "s_nop 0\n\t"
                 "v_add_f32_dpp %0, %0, %0 quad_perm:[2,3,0,1] row_mask:0xf bank_mask:0xf\n\t"
                 "v_add_f32_dpp %1, %1, %1 quad_perm:[2,3,0,1] row_mask:0xf bank_mask:0xf\n\t"
                 "s_nop 0\n\t"
                 "v_add_f32_dpp %0, %0, %0 row_half_mirror row_mask:0xf bank_mask:0xf\n\t"
                 "v_add_f32_dpp %1, %1, %1 row_half_mirror row_mask:0xf bank_mask:0xf"
                 : "+v"(a), "+v"(b));
}
constexpr int RW_T = 32;
constexpr int RW_SS = 392;
constexpr int RW_BUF = RW_T * RW_SS * 4;
constexpr int RW_YB = 2 * RW_BUF;
constexpr int RW_YBSZ = 32 * 33 * 4;
__device__ __forceinline__ void p_rwkv_scan(Frame& F) {
    LAS unsigned char* L = F.lds;
    const bf16* P = wsp<const bf16>(F, WS_P); const bf16* LO = wsp<const bf16>(F, WS_LOUT);
    const int lane = F.lane, wave = F.wave;
    constexpr int NRD = (CTXL + SEQ) / RW_T;
    for (int id = F.bid; id < 256; id += F.G) {
        const int xj_ = id >> 3, gg_ = (xj_ >> 1) + 16 * (id & 7); const int b = gg_ >> 4, h = (gg_ >> 1) & 7, dir = gg_ & 1, rh = xj_ & 1;
#define RW_ROW(s) ((s) < 256 ? NLAT + b * 256 + (dir ? 255 - (s) : (s)) : b * 8192 + (dir ? 8191 - ((s) - 256) : ((s) - 256)))
        if (wave >= 4) {
            const int pw = wave - 4, hj = h * 64 + lane;
            const float* mu = F.in[I_MU];
            const float cpr = mu[hj], cnr = mu[RW_COLS + hj], cpk = mu[512 + hj], cnk = mu[RW_COLS + 512 + hj], cpv = mu[1024 + hj], cnv = mu[RW_COLS + 1024 + hj];
            const float w0v = F.in[I_W0][dir * 512 + hj], a0v = F.in[I_A0][dir * 512 + hj], kkc = F.in[I_KK][hj], kac = F.in[I_KA][hj], rkc = F.in[I_RK][hj];
            unsigned xa[30], la[16], xb[30], lb[16];
#define RW_LOAD(rd, X, Lr) do { const int s0_ = (rd) * RW_T + pw * 8; const bool lo_ok = (s0_ != 0) && (s0_ != 256), hi_ok = (s0_ + 8 != 256) && (s0_ + 8 != NKEY); \
                const long sgn_ = dir ? -(long)PW : (long)PW; const bf16* pr0 = P + (size_t)RW_ROW(s0_) * PW + RW0 + hj; \
                _Pragma("unroll") for (int pp = -1; pp < 9; ++pp) { const int pc = (pp < 0 && !lo_ok) ? 0 : ((pp > 7 && !hi_ok) ? 7 : pp); const bf16* pr = pr0 + sgn_ * pc; \
                    X[3 * (pp + 1)] = pr[0]; X[3 * (pp + 1) + 1] = pr[512]; X[3 * (pp + 1) + 2] = pr[1024]; } \
                const long sgl_ = dir ? -(long)LRN : (long)LRN; const bf16* lr0 = LO + (size_t)RW_ROW(s0_) * LRN + dir * 512 + hj; \
                _Pragma("unroll") for (int pp = 0; pp < 8; ++pp) { Lr[2 * pp] = lr0[sgl_ * pp]; Lr[2 * pp + 1] = lr0[sgl_ * pp + 1024]; } } while (0)
#define RW_FEAT(rd, X, Lr) do { const int s0_ = (rd) * RW_T + pw * 8; const bool lo_ok = (s0_ != 0) && (s0_ != 256), hi_ok = (s0_ + 8 != 256) && (s0_ + 8 != NKEY); \
                const int row0_ = RW_ROW(s0_); \
                _Pragma("unroll") for (int q = 0; q < 8; ++q) { const int st = pw * 8 + q; \
                const bool vlo = (q > 0) || lo_ok, vhi = (q < 7) || hi_ok; const bool hp = dir ? vhi : vlo, hn = dir ? vlo : vhi; \
                  \
                const unsigned pr_ = dir ? X[3 * (q + 2)] : X[3 * q], nr_ = dir ? X[3 * q] : X[3 * (q + 2)], pk_ = dir ? X[3 * (q + 2) + 1] : X[3 * q + 1], nk_ = dir ? X[3 * q + 1] : X[3 * (q + 2) + 1], pv_ = dir ? X[3 * (q + 2) + 2] : X[3 * q + 2], nv_ = dir ? X[3 * q + 2] : X[3 * (q + 2) + 2]; \
                const float r0 = bf2f(X[3 * (q + 1)]), k0 = bf2f(X[3 * (q + 1) + 1]), v0 = bf2f(X[3 * (q + 1) + 2]); \
                const float xr = r0 + cpr * ((hp ? bf2f(pr_) : 0.f) - r0) + cnr * ((hn ? bf2f(nr_) : 0.f) - r0); \
                const float xk = k0 + cpk * ((hp ? bf2f(pk_) : 0.f) - k0) + cnk * ((hn ? bf2f(nk_) : 0.f) - k0); \
                const float xv = v0 + cpv * ((hp ? bf2f(pv_) : 0.f) - v0) + cnv * ((hn ? bf2f(nv_) : 0.f) - v0); \
                  \
                const float sg = __builtin_amdgcn_rcpf(1.f + __expf(-(w0v + bf2f(Lr[2 * q])))); \
                const float wdec = __expf(-0.60653066f * sg); \
                const float alr = __builtin_amdgcn_rcpf(1.f + __expf(-(a0v + bf2f(Lr[2 * q + 1])))); \
                const float kkv = xk * kkc; const float kd = xk * (1.f + (alr - 1.f) * kac); \
                float n2 = kkv * kkv, bon = xr * kd * rkc, kr = kd * xr, br = kkv * alr * xr; \
                wave_sum4(n2, bon, kr, br); \
                const float rn = __builtin_amdgcn_rsqf(fmaxf(n2, 1e-24f)); const float kk = kkv * rn; const float bb = kk * alr; br *= rn; \
                if (rh == 0 && lane == 0) wsp<float>(F, WS_BONUS)[((size_t)dir * NTOK + (dir ? row0_ - q : row0_ + q)) * 8 + h] = bon; \
                LAS float* o = (LAS float*)(L + ((rd) & 1) * RW_BUF) + st * RW_SS; \
                o[lane] = wdec; o[64 + lane] = -kk; o[128 + lane] = bb; o[192 + lane] = kd; o[256 + lane] = wdec * xr; o[320 + lane] = xv; \
                if (lane == 0) { o[384] = br; o[385] = kr; } } } while (0)
#define RW_YOUT(rd) do { const LAS float* yb = (const LAS float*)(L + RW_YB + ((rd) & 1) * RW_YBSZ); _Pragma("unroll") for (int e = 0; e < 2; ++e) { const int pt = pw * 64 + lane, st = (pt >> 4) + 16 * e, r2 = (pt & 15) * 2; const int s = (rd) * RW_T + st; \
                *(unsigned*)(wsp<bf16>(F, WS_RWY) + ((size_t)dir * NTOK + RW_ROW(s)) * 512 + h * 64 + rh * 32 + r2) = cvt_pk_bf16(yb[r2 * 33 + st], yb[(r2 + 1) * 33 + st]); } } while (0)
            RW_LOAD(0, xa, la); RW_LOAD(1, xb, lb); RW_FEAT(0, xa, la);
            LDS_BARRIER();
            for (int rd = 0; rd < NRD; rd += 2) {
                if (rd + 2 < NRD) RW_LOAD(rd + 2, xa, la);
                RW_FEAT(rd + 1, xb, lb);
                if (rd > 0) RW_YOUT(rd - 1);
                LDS_BARRIER();
                if (rd + 3 < NRD) RW_LOAD(rd + 3, xb, lb);
                if (rd + 2 < NRD) RW_FEAT(rd + 2, xa, la);
                RW_YOUT(rd);
                LDS_BARRIER();
            }
            RW_YOUT(NRD - 1);
#undef RW_LOAD
#undef RW_FEAT
#undef RW_YOUT
        } else {
            const int rowl = wave * 8 + (lane >> 3), jl = lane & 7;
            float s[8];
#pragma unroll
            for (int e = 0; e < 8; ++e) s[e] = 0.f;
            LDS_BARRIER();
            for (int rd = 0; rd < NRD; ++rd) {
                const LAS float* sb = (const LAS float*)(L + (rd & 1) * RW_BUF);
                LAS float* yb = (LAS float*)(L + RW_YB + (rd & 1) * RW_YBSZ);
                float yk = 0.f;
                f32x4 w[2], a[2], bq[2], k[2], q[2], nw[2], na[2], nb[2], nk[2], nq[2]; float vv, nvv; f32x2 sc, nsc;
#define RW_OPS(W, A, B, K, Q, V, S, st) do { const LAS float* p = sb + (st) * RW_SS + 8 * jl; _Pragma("unroll") for (int e = 0; e < 2; ++e) { W[e] = *(const LAS f32x4*)(p + 4 * e); A[e] = *(const LAS f32x4*)(p + 64 + 4 * e); \
                    B[e] = *(const LAS f32x4*)(p + 128 + 4 * e); K[e] = *(const LAS f32x4*)(p + 192 + 4 * e); Q[e] = *(const LAS f32x4*)(p + 256 + 4 * e); } \
                    V = sb[(st) * RW_SS + 320 + rh * 32 + rowl]; S = *(const LAS f32x2*)(sb + (st) * RW_SS + 384); } while (0)
                RW_OPS(w, a, bq, k, q, vv, sc, 0);
#pragma unroll
                for (int st = 0; st < RW_T; ++st) {
                    if (st + 1 < RW_T) RW_OPS(nw, na, nb, nk, nq, nvv, nsc, st + 1);
                    float pa = 0.f, pa2 = 0.f, py = 0.f, py2 = 0.f, t[8];
#pragma unroll
                    for (int e = 0; e < 2; ++e) { pa += s[4 * e] * a[e].x; pa2 += s[4 * e + 1] * a[e].y; pa += s[4 * e + 2] * a[e].z; pa2 += s[4 * e + 3] * a[e].w;
                        py += s[4 * e] * q[e].x; py2 += s[4 * e + 1] * q[e].y; py += s[4 * e + 2] * q[e].z; py2 += s[4 * e + 3] * q[e].w;
                        t[4 * e] = s[4 * e] * w[e].x + vv * k[e].x; t[4 * e + 1] = s[4 * e + 1] * w[e].y + vv * k[e].y; t[4 * e + 2] = s[4 * e + 2] * w[e].z + vv * k[e].z; t[4 * e + 3] = s[4 * e + 3] * w[e].w + vv * k[e].w; }
                    pa += pa2; py += py2;
                    red8x2(pa, py);
#pragma unroll
                    for (int e = 0; e < 2; ++e) { s[4 * e] = t[4 * e] + pa * bq[e].x; s[4 * e + 1] = t[4 * e + 1] + pa * bq[e].y; s[4 * e + 2] = t[4 * e + 2] + pa * bq[e].z; s[4 * e + 3] = t[4 * e + 3] + pa * bq[e].w; }
                    const float y = py + pa * sc.x + vv * sc.y;
                    yk = (jl == (st & 7)) ? y : yk;
                    if ((st & 7) == 7) yb[rowl * 33 + (st - 7) + jl] = yk;
#pragma unroll
                    for (int e = 0; e < 2; ++e) { w[e] = nw[e]; a[e] = na[e]; bq[e] = nb[e]; k[e] = nk[e]; q[e] = nq[e]; }
                    vv = nvv; sc = nsc;
                    __builtin_amdgcn_sched_barrier(0);
                }
#undef RW_OPS
                LDS_BARRIER();
            }
        }
#undef RW_ROW
        VM_WAIT(); __syncthreads();
    }
}

__device__ __forceinline__ void p_mix_finish(Frame& F) {
    const int gw = F.bid * 8 + F.wave, NGW = F.G * 8, lane = F.lane;
    const bf16* P = wsp<const bf16>(F, WS_P); const bf16* LO = wsp<const bf16>(F, WS_LOUT);
    const bf16* GO = wsp<const bf16>(F, WS_GLAO); const bf16* RY = wsp<const bf16>(F, WS_RWY); const float* BON = wsp<const float>(F, WS_BONUS);
    bf16* MIX = wsp<bf16>(F, WS_H);
    const int c0 = lane * 8;
    float gng[8], lnw[8], lnb[8], cpv[8], cnv[8];
#pragma unroll
    for (int e = 0; e < 8; ++e) { gng[e] = F.in[I_GNG][(c0 + e) & 127]; lnw[e] = F.in[I_LNW][c0 + e]; lnb[e] = F.in[I_LNB][c0 + e]; cpv[e] = F.in[I_MU][1024 + c0 + e]; cnv[e] = F.in[I_MU][RW_COLS + 1024 + c0 + e]; }
    for (int row = gw; row < NTOK; row += NGW) {
        { const u32x4 a = *(const u32x4*)(GO + (size_t)row * 512 + c0), bb = *(const u32x4*)(GO + ((size_t)NTOK + row) * 512 + c0), og = *(const u32x4*)(P + (size_t)row * PW + 1024 + c0);
          float o[8]; float ss = 0.f;
#pragma unroll
          for (int e = 0; e < 4; ++e) { o[2 * e] = bflo(a[e]) + bflo(bb[e]); o[2 * e + 1] = bfhi(a[e]) + bfhi(bb[e]); ss += o[2 * e] * o[2 * e] + o[2 * e + 1] * o[2 * e + 1]; }
          ss += __shfl_xor(ss, 1); ss += __shfl_xor(ss, 2); ss += __shfl_xor(ss, 4); ss += __shfl_xor(ss, 8);
          const float rstd = 1.f / sqrtf(ss * (1.f / 128.f) + 1e-6f);
          float y[8];
#pragma unroll
          for (int e = 0; e < 4; ++e) { const float g0 = bflo(og[e]), g1 = bfhi(og[e]);
              y[2 * e] = o[2 * e] * rstd * gng[2 * e] * (g0 * __builtin_amdgcn_rcpf(1.f + __expf(-g0))); y[2 * e + 1] = o[2 * e + 1] * rstd * gng[2 * e + 1] * (g1 * __builtin_amdgcn_rcpf(1.f + __expf(-g1))); }
          *(u32x4*)(MIX + (size_t)row * 1024 + c0) = (u32x4){cvt_pk_bf16(y[0], y[1]), cvt_pk_bf16(y[2], y[3]), cvt_pk_bf16(y[4], y[5]), cvt_pk_bf16(y[6], y[7])}; }
        { bool hp, hn; seq_pos(row, hp, hn);
          const u32x4 a = *(const u32x4*)(RY + (size_t)row * 512 + c0), bb = *(const u32x4*)(RY + ((size_t)NTOK + row) * 512 + c0);
          const bf16* pv = P + (size_t)row * PW + RW0 + 1024 + c0;
          const u32x4 v0 = *(const u32x4*)pv; u32x4 vm = (u32x4){0u, 0u, 0u, 0u}, vn = (u32x4){0u, 0u, 0u, 0u};
          if (hp) vm = *(const u32x4*)(pv - PW); if (hn) vn = *(const u32x4*)(pv + PW);
          const u32x4 gg = *(const u32x4*)(LO + (size_t)row * LRN + 2048 + c0);
          const int hd = lane >> 3; const float bon = BON[(size_t)row * 8 + hd] + BON[((size_t)NTOK + row) * 8 + hd];
          float yv[8]; float sm = 0.f;
#pragma unroll
          for (int e = 0; e < 4; ++e) { yv[2 * e] = bflo(a[e]) + bflo(bb[e]); yv[2 * e + 1] = bfhi(a[e]) + bfhi(bb[e]); sm += yv[2 * e] + yv[2 * e + 1]; }
          sm += __shfl_xor(sm, 1); sm += __shfl_xor(sm, 2); sm += __shfl_xor(sm, 4);
          const float mean = sm * (1.f / 64.f); float sv = 0.f;
#pragma unroll
          for (int e = 0; e < 8; ++e) { const float d = yv[e] - mean; sv += d * d; }
          sv += __shfl_xor(sv, 1); sv += __shfl_xor(sv, 2); sv += __shfl_xor(sv, 4);
          const float rstd = 1.f / sqrtf(sv * (1.f / 64.f) + 64e-5f);
          float o[8];
#pragma unroll
          for (int e = 0; e < 8; ++e) { const unsigned w0 = v0[e >> 1], wm = vm[e >> 1], wn = vn[e >> 1];
              const float p0 = (e & 1) ? bfhi(w0) : bflo(w0), pm = (e & 1) ? bfhi(wm) : bflo(wm), pn = (e & 1) ? bfhi(wn) : bflo(wn);
              const float xv = p0 + cpv[e] * (pm - p0) + cnv[e] * (pn - p0);
              const float g = (e & 1) ? bfhi(gg[e >> 1]) : bflo(gg[e >> 1]);
              o[e] = ((yv[e] - mean) * rstd * lnw[e] + lnb[e] + bon * xv) * g; }
          *(u32x4*)(MIX + (size_t)row * 1024 + 512 + c0) = (u32x4){cvt_pk_bf16(o[0], o[1]), cvt_pk_bf16(o[2], o[3]), cvt_pk_bf16(o[4], o[5]), cvt_pk_bf16(o[6], o[7])}; }
    }
}

__device__ __forceinline__ void p_mla_prep(Frame& F) {
    const int gw = F.bid * 8 + F.wave, NGW = F.G * 8, lane = F.lane;
    const bf16* C = wsp<const bf16>(F, WS_C); bf16* QN = wsp<bf16>(F, WS_QN); bf16* KVN = wsp<bf16>(F, WS_KVN); unsigned char* K8 = wsp<unsigned char>(F, WS_K8);
    const f32x2* ROPE = wsp<const f32x2>(F, WS_ROPE);
    const f32x4 qg = ((const f32x4*)F.in[I_QNORM])[lane]; const f32x4 kg = ((const f32x4*)F.in[I_KVNORM])[lane & 31];
    for (int row = gw; row < NTOK; row += NGW) {
        const bf16* cr = C + (size_t)row * 512;
        const u32x2 cqw = ((const u32x2*)cr)[lane], ckw = ((const u32x2*)(cr + 256))[lane & 31];
        const f32x4 cq = {bflo(cqw.x), bfhi(cqw.x), bflo(cqw.y), bfhi(cqw.y)};
        const f32x4 ck = {bflo(ckw.x), bfhi(ckw.x), bflo(ckw.y), bfhi(ckw.y)};
        const float xr = bflo((unsigned)cr[384 + lane]);
        const float ssq = wave_sum((cq.x * cq.x + cq.y * cq.y) + (cq.z * cq.z + cq.w * cq.w));
        const float ssk = wave_sum(lane < 32 ? (ck.x * ck.x + ck.y * ck.y) + (ck.z * ck.z + ck.w * ck.w) : 0.f);
        if (row < NLAT) { const float rs = 1.f / sqrtf(ssq * (1.f / 256.f) + 1e-6f);
            ((u32x2*)(QN + (size_t)row * 256))[lane] = (u32x2){cvt_pk_bf16(cq.x * rs * qg.x, cq.y * rs * qg.y), cvt_pk_bf16(cq.z * rs * qg.z, cq.w * rs * qg.w)}; }
        { const float rs = 1.f / sqrtf(ssk * (1.f / 128.f) + 1e-6f);
          u32x2 w = (u32x2){0u, 0u};
          if (lane < 32) w = (u32x2){cvt_pk_bf16(ck.x * rs * kg.x, ck.y * rs * kg.y), cvt_pk_bf16(ck.z * rs * kg.z, ck.w * rs * kg.w)};
          ((u32x2*)(KVN + (size_t)row * 256))[lane] = w; }
        float kr = xr; int b, key;
        const float pr = __shfl_xor(xr, 16);
        if (row < NLAT) { b = row >> 13; const int t = row & 8191; key = CTXL + t;
            const f32x2 cs = ROPE[t * 32 + ((lane >> 5) << 4) + (lane & 15)];
            kr = (lane & 16) ? xr * cs.x + pr * cs.y : xr * cs.x - pr * cs.y;
        } else { b = (row - NLAT) >> 8; key = (row - NLAT) & 255; }
        const unsigned char kb = (unsigned char)(pk4_fp8(kr, 0.f, 0.f, 0.f) & 0xffu);
#pragma unroll
        for (int h = 0; h < 8; ++h) K8[((size_t)((b * 8 + h) * NKEY + key)) * K8ROW + 128 + lane] = kb;
    }
}
__host__ __device__ constexpr int att_kperm(int p) { const int hi = p >> 5, j = p & 31, r = j & 15; return (j >> 4) * 32 + (r & 3) + 8 * (r >> 2) + 4 * hi; }

namespace att {
constexpr float SCALE = 0.07216878364870322f;
constexpr float THR = 2.f;
constexpr float PLOG2 = 5.f;
constexpr int KSLOT = 16384, KTILE = 64 * K8ROW, VSLOT = 8192;
constexpr int LDS_K = 0, LDS_V = 4 * KSLOT, LDS_WS = LDS_V + 4 * VSLOT, LDS_Q = LDS_WS + 2048;
constexpr int NT = NKEY / 64;
constexpr int ONE = 0x7F7F7F7F;
constexpr int QSCL = 0x7C7C7C7C;
__device__ __forceinline__ int crow(int r, int hi) { return (r & 3) + 8 * (r >> 2) + 4 * hi; }
constexpr float PMAXSUM = 416.f, PTARGET = 64.f;
__device__ __forceinline__ void partialSM(f32x16& p0, f32x16& p1, float moff) {
#pragma unroll
    for (int r = 0; r < 16; ++r) p0[r] -= moff;
#pragma unroll
    for (int r = 0; r < 16; ++r) p1[r] -= moff;
#pragma unroll
    for (int r = 0; r < 16; ++r) p0[r] = __builtin_amdgcn_exp2f(p0[r]);
}
__device__ __forceinline__ void finishSM(f32x16& p0, f32x16& p1, float& moff, float& alpha, float& l_reg, i32x8& pa) {
#pragma unroll
    for (int r = 0; r < 16; ++r) p1[r] = __builtin_amdgcn_exp2f(p1[r]);
    float ps = 0;
#pragma unroll
    for (int r = 0; r < 16; ++r) ps += p0[r];
#pragma unroll
    for (int r = 0; r < 16; ++r) ps += p1[r];
    { auto rr = __builtin_amdgcn_permlane32_swap(__float_as_uint(ps), __float_as_uint(ps), false, false); ps = __uint_as_float(rr[0]) + __uint_as_float(rr[1]); }
    alpha = 1.f;
    if (__builtin_expect(__any(ps > PMAXSUM), 0)) {
        alpha = ps > PMAXSUM ? PTARGET * __builtin_amdgcn_rcpf(ps) : 1.f;
        ps *= alpha; moff -= __builtin_amdgcn_logf(alpha);
#pragma unroll
        for (int g = 0; g < 4; ++g) { pa[g] = (int)pk4_fp8(p0[4 * g] * alpha, p0[4 * g + 1] * alpha, p0[4 * g + 2] * alpha, p0[4 * g + 3] * alpha); pa[4 + g] = (int)pk4_fp8(p1[4 * g] * alpha, p1[4 * g + 1] * alpha, p1[4 * g + 2] * alpha, p1[4 * g + 3] * alpha); }
    } else {
#pragma unroll
        for (int g = 0; g < 4; ++g) { pa[g] = (int)pk4_fp8(p0[4 * g], p0[4 * g + 1], p0[4 * g + 2], p0[4 * g + 3]); pa[4 + g] = (int)pk4_fp8(p1[4 * g], p1[4 * g + 1], p1[4 * g + 2], p1[4 * g + 3]); }
    }
    l_reg = l_reg * alpha + ps;
}
__device__ __forceinline__ i32x8 ld32(const LAS unsigned char* p0, const LAS unsigned char* p1) { return __builtin_shufflevector(*(const LAS i32x4*)p0, *(const LAS i32x4*)p1, 0, 1, 2, 3, 4, 5, 6, 7); }
__device__ __forceinline__ void qkt(f32x16& p0, f32x16& p1, const LAS unsigned char* Ks, const LAS unsigned char* Qs, int r32, int hi) {
#pragma unroll
    for (int r = 0; r < 16; ++r) { p0[r] = 0.f; p1[r] = 0.f; }
#pragma unroll
    for (int m = 0; m < 3; ++m) { const LAS unsigned char* k0 = Ks + r32 * K8ROW + m * 64 + hi * 32; const LAS unsigned char* k1 = k0 + 32 * K8ROW;
        const i32x8 a0 = ld32(k0, k0 + 16), a1 = ld32(k1, k1 + 16), qm = ld32(Qs + m * 2048, Qs + m * 2048 + 1024);
        p0 = __builtin_amdgcn_mfma_scale_f32_32x32x64_f8f6f4(a0, qm, p0, 0, 0, 0, ONE, 0, QSCL);
        p1 = __builtin_amdgcn_mfma_scale_f32_32x32x64_f8f6f4(a1, qm, p1, 0, 0, 0, ONE, 0, QSCL); }
}
__device__ __forceinline__ void pv(f32x16 (&o)[4], const LAS unsigned char* Vs, const i32x8 pa, int r32, int hi) {
#pragma unroll
    for (int d0 = 0; d0 < 4; ++d0) { const int c = d0 * 32 + r32, sw = (c >> 2) & 3; const LAS unsigned char* vr = Vs + c * 64;
        const i32x8 vb = ld32(vr + (((2 * hi) ^ sw) << 4), vr + (((2 * hi + 1) ^ sw) << 4));
        o[d0] = __builtin_amdgcn_mfma_scale_f32_32x32x64_f8f6f4(pa, vb, o[d0], 0, 0, 0, ONE, 0, ONE); }
}
__device__ __forceinline__ int pk4n(float a, float b, float c, float d, int w) { w = __builtin_amdgcn_cvt_pk_fp8_f32(a, b, w, false); w = __builtin_amdgcn_cvt_pk_fp8_f32(c, d, w, true); return w; }
#define ATT_MMA(a, b, c) __builtin_amdgcn_mfma_scale_f32_32x32x64_f8f6f4(a, b, c, 0, 0, 0, ONE, 0, ONE)
#define ATT_MMQ(a, b, c) __builtin_amdgcn_mfma_scale_f32_32x32x64_f8f6f4(a, b, c, 0, 0, 0, ONE, 0, QSCL)
#define ATT_EXP(P, i0, n) do { _Pragma("unroll") for (int _r = (i0); _r < (i0) + (n); ++_r) P[_r] = __builtin_amdgcn_exp2f(P[_r]); } while (0)
__device__ __forceinline__ void half_step(f32x16& X0, f32x16& X1, f32x16& Y0, f32x16& Y1, const LAS unsigned char* Ks, const LAS unsigned char* Vs, const LAS unsigned char* Qs, f32x16 (&o)[4],
                                          float& moff, float& l_reg, i32x8& pa, bool& offs, LAS float* al_l, int r32, int hi) {
    f32x16 zz;
#pragma unroll
    for (int r = 0; r < 16; ++r) zz[r] = 0.f;
    SBAR();
    const LAS unsigned char* k0 = Ks + r32 * K8ROW + hi * 32; const LAS unsigned char* k1 = k0 + 32 * K8ROW;
#define ATT_Q(m) ld32(Qs + (m) * 2048, Qs + (m) * 2048 + 1024)
#define ATT_V(d0) ld32(Vs + ((d0) * 32 + r32) * 64 + (((2 * hi) ^ ((((d0) * 32 + r32) >> 2) & 3)) << 4), Vs + ((d0) * 32 + r32) * 64 + (((2 * hi + 1) ^ ((((d0) * 32 + r32) >> 2) & 3)) << 4))
    const i32x8 q0 = ATT_Q(0); const i32x8 ka0 = ld32(k0, k0 + 16), kb0 = ld32(k1, k1 + 16);
    const i32x8 q1 = ATT_Q(1); const i32x8 ka1 = ld32(k0 + 64, k0 + 80);
    ATT_EXP(X1, 0, 4); SBAR();
    Y0 = ATT_MMQ(ka0, q0, zz); SBAR();
    const i32x8 kb1 = ld32(k1 + 64, k1 + 80);
    ATT_EXP(X1, 4, 4); SBAR();
    Y1 = ATT_MMQ(kb0, q0, zz); SBAR();
    const i32x8 q2 = ATT_Q(2); const i32x8 ka2 = ld32(k0 + 128, k0 + 144);
    ATT_EXP(X1, 8, 4); SBAR();
    Y0 = ATT_MMQ(ka1, q1, Y0); SBAR();
    const i32x8 kb2 = ld32(k1 + 128, k1 + 144);
    ATT_EXP(X1, 12, 4); SBAR();
    Y1 = ATT_MMQ(kb1, q1, Y1); SBAR();
    f32x2 sa = {X0[0], X0[1]}, sb = {X1[0], X1[1]};
#pragma unroll
    for (int r = 1; r < 8; ++r) { sa += (f32x2){X0[2 * r], X0[2 * r + 1]}; sb += (f32x2){X1[2 * r], X1[2 * r + 1]}; }
    sa += sb; float ps = sa.x + sa.y;
    { auto rr = __builtin_amdgcn_permlane32_swap(__float_as_uint(ps), __float_as_uint(ps), false, false); ps = __uint_as_float(rr[0]) + __uint_as_float(rr[1]); }
    SBAR();
    Y0 = ATT_MMQ(ka2, q2, Y0); SBAR();
    i32x8 vb[4];
    vb[0] = ATT_V(0); vb[1] = ATT_V(1);
#pragma unroll
    for (int g = 0; g < 4; ++g) pa[g] = pk4n(X0[4 * g], X0[4 * g + 1], X0[4 * g + 2], X0[4 * g + 3], pa[g]);
    SBAR();
    Y1 = ATT_MMQ(kb2, q2, Y1); SBAR();
#pragma unroll
    for (int g = 0; g < 4; ++g) pa[4 + g] = pk4n(X1[4 * g], X1[4 * g + 1], X1[4 * g + 2], X1[4 * g + 3], pa[4 + g]);
    asm volatile("" :: "v"(Y0), "v"(Y1), "v"(pa));
    SBAR();
    if (__builtin_expect(__any(ps > PMAXSUM), 0)) {
        const float alpha = ps > PMAXSUM ? PTARGET * __builtin_amdgcn_rcpf(ps) : 1.f;
        ps *= alpha; moff -= __builtin_amdgcn_logf(alpha); l_reg *= alpha; offs = true;
#pragma unroll
        for (int g = 0; g < 4; ++g) { pa[g] = (int)pk4_fp8(X0[4 * g] * alpha, X0[4 * g + 1] * alpha, X0[4 * g + 2] * alpha, X0[4 * g + 3] * alpha); pa[4 + g] = (int)pk4_fp8(X1[4 * g] * alpha, X1[4 * g + 1] * alpha, X1[4 * g + 2] * alpha, X1[4 * g + 3] * alpha); }
        if (hi == 0) al_l[r32] = alpha;
        asm volatile("s_waitcnt lgkmcnt(0)" ::: "memory");
#pragma unroll
        for (int d = 0; d < 4; ++d)
#pragma unroll
            for (int r = 0; r < 16; ++r) o[d][r] *= al_l[crow(r, hi)];
    }
    l_reg += ps;
#define ATT_SUB(P) do { _Pragma("unroll") for (int _r = 0; _r < 16; ++_r) P[_r] -= moff; } while (0)
#define ATT_R2(S0, S1) do { SBAR(); \
    o[0] = ATT_MMA(pa, vb[0], o[0]); SBAR(); vb[2] = ATT_V(2); S0; ATT_EXP(Y0, 0, 3); SBAR(); \
    o[1] = ATT_MMA(pa, vb[1], o[1]); SBAR(); vb[3] = ATT_V(3); ATT_EXP(Y0, 3, 5); SBAR(); \
    o[2] = ATT_MMA(pa, vb[2], o[2]); SBAR(); ATT_EXP(Y0, 8, 5); SBAR(); \
    o[3] = ATT_MMA(pa, vb[3], o[3]); SBAR(); ATT_EXP(Y0, 13, 3); S1; \
    asm volatile("" :: "v"(o[0]), "v"(o[1]), "v"(o[2]), "v"(o[3]), "v"(Y0), "v"(Y1));     \
    SBAR(); } while (0)
    if (__builtin_expect(offs, 0)) ATT_R2(ATT_SUB(Y0), ATT_SUB(Y1)); else ATT_R2((void)0, (void)0);
#undef ATT_R2
#undef ATT_SUB
}
__device__ __forceinline__ void glds16(const void* gsrc, LAS unsigned char* lds_wave_base) { unsigned keep; const unsigned dst = (unsigned)__builtin_amdgcn_readfirstlane((int)(uintptr_t)lds_wave_base);
    asm volatile("s_mov_b32 %0, m0\n\ts_mov_b32 m0, %2\n\ts_nop 0\n\tglobal_load_lds_dwordx4 %1, off\n\ts_mov_b32 m0, %0" : "=&s"(keep) : "v"(gsrc), "s"(dst) : "memory"); }

__device__ __forceinline__ void unit(const unsigned char* __restrict__ Qb, const unsigned char* __restrict__ Kh, const unsigned char* __restrict__ Vh, unsigned char* __restrict__ Ob, LAS unsigned char* lds, int tid) {
    const int wid = __builtin_amdgcn_readfirstlane(tid >> 6), lane = tid & 63, r32 = lane & 31, hi = lane >> 5;
    LAS float* ws = (LAS float*)(lds + LDS_WS) + wid * 64; LAS float* li_l = ws; LAS float* al_l = ws + 32;
    float l_reg = 0.f; f32x16 o[4];
#pragma unroll
    for (int d = 0; d < 4; ++d)
#pragma unroll
        for (int r = 0; r < 16; ++r) o[d][r] = 0.f;
    const unsigned char* Qw = Qb + (size_t)(wid * 32 + r32) * QKD + hi * 32;
#pragma unroll
    for (int m = 0; m < 3; ++m) { *(LAS i32x4*)(lds + LDS_Q + wid * 6144 + m * 2048 + lane * 16) = *(const i32x4*)(Qw + m * 64); *(LAS i32x4*)(lds + LDS_Q + wid * 6144 + m * 2048 + 1024 + lane * 16) = *(const i32x4*)(Qw + m * 64 + 16); }
    const LAS unsigned char* Qs = lds + LDS_Q + wid * 6144 + lane * 16;
    const unsigned pofs = (unsigned)(wid * 1024 + lane * 16);
#define DMA_K(j, slot) do { _Pragma("unroll") for (int _i = 0; _i < 2; ++_i) glds16(Kh + (size_t)(j) * KTILE + _i * 8192 + pofs, lds + LDS_K + (slot) * KSLOT + _i * 8192 + wid * 1024); } while (0)
#define DMA_V(j, slot) glds16(Vh + (size_t)(j) * VSLOT + pofs, lds + LDS_V + (slot) * VSLOT + wid * 1024)
#define WAITBAR(n) asm volatile("s_waitcnt vmcnt(" #n ")\n\ts_barrier" ::: "memory")
#define RESC(a) do { if (__any((a) < 1.f)) { if (hi == 0) al_l[r32] = (a); asm volatile("s_waitcnt lgkmcnt(0)" ::: "memory"); \
    _Pragma("unroll") for (int d = 0; d < 4; ++d) _Pragma("unroll") for (int r = 0; r < 16; ++r) o[d][r] *= al_l[crow(r, hi)]; } } while (0)
    f32x16 pA0, pA1, pB0, pB1; float moff = 0.f, al; i32x8 pa = {0, 0, 0, 0, 0, 0, 0, 0}; bool offs = false;
    if (wid >= 4) __builtin_amdgcn_s_setprio(1);
    asm volatile("s_barrier" ::: "memory");
    DMA_K(0, 0); DMA_K(1, 1); DMA_K(2, 2); DMA_V(0, 0); DMA_V(1, 1);
    WAITBAR(6);
    qkt(pA0, pA1, lds + LDS_K, Qs, r32, hi); partialSM(pA0, pA1, moff);
    WAITBAR(0);
    for (int j = 1; j + 1 < NT; j += 2) {
        DMA_K(j + 2, (j + 2) & 3); if (j + 3 < NT) DMA_K(j + 3, (j + 3) & 3);
        DMA_V(j + 1, (j + 1) & 3); DMA_V(j + 2, (j + 2) & 3);
        half_step(pA0, pA1, pB0, pB1, lds + LDS_K + (j & 3) * KSLOT, lds + LDS_V + ((j - 1) & 3) * VSLOT, Qs, o, moff, l_reg, pa, offs, al_l, r32, hi);
        half_step(pB0, pB1, pA0, pA1, lds + LDS_K + ((j + 1) & 3) * KSLOT, lds + LDS_V + (j & 3) * VSLOT, Qs, o, moff, l_reg, pa, offs, al_l, r32, hi);
        WAITBAR(0);
    }
    int vs = (NT - 2) & 3;
    SBAR(); qkt(pB0, pB1, lds + LDS_K + ((NT - 1) & 3) * KSLOT, Qs, r32, hi);
    finishSM(pA0, pA1, moff, al, l_reg, pa); SBAR();
    RESC(al);
    pv(o, lds + LDS_V + vs * VSLOT, pa, r32, hi); partialSM(pB0, pB1, moff);
    vs = (NT - 1) & 3;
    finishSM(pB0, pB1, moff, al, l_reg, pa); SBAR();
    RESC(al);
    pv(o, lds + LDS_V + vs * VSLOT, pa, r32, hi);
    __builtin_amdgcn_s_setprio(0);
    if (hi == 0) li_l[r32] = l_reg; asm volatile("s_waitcnt lgkmcnt(0)" ::: "memory");
    float rli[16];
#pragma unroll
    for (int r = 0; r < 16; ++r) rli[r] = __builtin_amdgcn_rcpf(li_l[crow(r, hi)]);
    unsigned char* Ow = Ob + (size_t)(wid * 32) * 1024;
#pragma unroll
    for (int r = 0; r < 16; ++r) { const int orow = crow(r, hi);
#pragma unroll
        for (int d0 = 0; d0 < 4; ++d0) Ow[(size_t)orow * 1024 + d0 * 32 + r32] = (unsigned char)(pk4_fp8(o[d0][r] * rli[r], 0.f, 0.f, 0.f) & 0xffu); }
#undef DMA_K
#undef DMA_V
#undef WAITBAR
#undef RESC
}
}
__device__ __forceinline__ void p_attention(Frame& F) {
    const unsigned char* Q8 = wsp<const unsigned char>(F, WS_Q8); const unsigned char* K8 = wsp<const unsigned char>(F, WS_K8); const unsigned char* VT = wsp<const unsigned char>(F, WS_V8T); unsigned char* O = wsp<unsigned char>(F, WS_H);
    for (int u = F.bid; u < NB * MH * 32; u += F.G) {
        const int pair = (u >> 8) * 8 + (u & 7), qb = (u & 255) >> 3, b = pair >> 3, h = pair & 7;
        att::unit(Q8 + ((size_t)pair * SEQ + qb * 256) * QKD, K8 + (size_t)pair * NKEY * K8ROW, VT + (size_t)pair * att::NT * att::VSLOT, O + ((size_t)(b * SEQ + qb * 256)) * 1024 + h * 128, F.lds, F.tid);
    }
    VM_WAIT(); __syncthreads();
}

constexpr int N_PHASES = 24;
struct Args { const float* in[37]; float* out; unsigned char* ws; int ph_lo, ph_hi, pad0, pad1; };
__global__ void __launch_bounds__(512, 2) mk_fwd(Args args) {
    extern __shared__ __attribute__((aligned(16))) unsigned char lds_raw[];
    Frame F;
    F.lds = (LAS unsigned char*)lds_raw;
    F.tid = threadIdx.x; F.lane = F.tid & 63; F.wave = __builtin_amdgcn_readfirstlane(F.tid >> 6);
    F.G = gridDim.x; F.bid = blockIdx.x;
    F.in = (const float* const __attribute__((address_space(4)))*)__builtin_amdgcn_kernarg_segment_ptr();
    F.out = args.out; F.ws = args.ws;
    volatile LAS unsigned* MISC = (volatile LAS unsigned*)(F.lds + MISC_OFF);
    if (F.tid < 64) MISC[F.tid] = 0u;
    __syncthreads();
    const int lo = args.ph_lo, hi = args.ph_hi;
    XcdBarrier bar; bar.bar = (unsigned*)(F.ws + WS_CTL) + CW_BAR; bar.x = 0; bar.st = nullptr;
    if (hi - lo > 1) bar = xcd_barrier_post((unsigned*)(F.ws + WS_CTL) + CW_BAR, MISC + 8);
#ifndef ONLY_PHASE
#define ONLY_PHASE -1
#endif
#define IN(k) ((ONLY_PHASE < 0 || ONLY_PHASE == (k)) && lo <= (k) && (k) < hi)
#define SEAM(k) do { if (IN(k) && IN((k) + 1)) xcd_barrier(bar); } while (0)
    LAS unsigned char* ring = F.lds;
    const LAS int* blk_e = (const LAS int*)(F.lds + MT_OFF) + 128;
    const LAS int* mtab = (const LAS int*)(F.lds + MT_OFF);

    if (IN(0)) { p0_mod(F); p0_rope(F); p0_convert(F); } SEAM(0);
    if (IN(1)) { p_norm1_l0(F); } SEAM(1);
    if (IN(2)) {
        pg8::DenseSched S; S.init(NTOK, PW, 2048, wsp<const bf16>(F, WS_WIN), F.G, F.bid);
        pg8::EpiBf16<pg8::MapPlain> E{pg8::MapPlain{wsp<bf16>(F, WS_P), PW}};
        pg8::gemm_phase(ring, wsp<const bf16>(F, WS_H), 2048, S, E);
        { const int slot = F.bid - S.nwg % F.G; if (slot >= 0) p_fill_convert(F, slot, F.G - S.nwg % F.G, 0, FILL_A); }
    } SEAM(2);
    if (IN(3)) { p_alr(F); p_gla_pre(F); } SEAM(3);
    if (IN(4)) {
        pg8::LrSched S; S.init(NTOK, LRN, LRK * 2, wsp<const bf16>(F, WS_WLR), F.G, F.bid);
        pg8::EpiBf16<pg8::MapPlain> E{pg8::MapPlain{wsp<bf16>(F, WS_LOUT), LRN}};
        pg8::gemm_phase(ring, wsp<const bf16>(F, WS_ALR), LRK * 2, S, E);
        { const int slot = F.bid - S.nwg % F.G; if (slot >= 0) p_fill_convert(F, slot, F.G - S.nwg % F.G, FILL_A, FILL_B); }
    } SEAM(4);
    if (IN(5)) { p_gla_scan(F); p_rwkv_scan(F); } SEAM(5);
    if (IN(6)) { p_mix_finish(F); } SEAM(6);
    if (IN(7)) {
        pg8::DenseSched S; S.init(NTOK, 1024, 2048, wsp<const bf16>(F, WS_WOUT), F.G, F.bid);
        pg8::EpiResid E{wsp<bf16>(F, WS_X1), F.in[I_X], F.in[I_CTX], wsp<const float>(F, WS_MOD), 0};
        pg8::gemm_phase(ring, wsp<const bf16>(F, WS_H), 2048, S, E);
        { const int slot = F.bid - S.nwg % F.G; if (slot >= 0) p_fill_convert(F, slot, F.G - S.nwg % F.G, FILL_B, FILL_C); }
    } SEAM(7);
    if (IN(8)) { p_norm2_route(F, 0, NTOK); } SEAM(8);
    if (IN(9)) { p_moe_scatter(F, NTOK); } SEAM(9);
    if (IN(10)) {
        moe_tables(F);
        pg8::MoeSched<true> S{mtab[64], 8, F.G, F.bid, blk_e, wsp<const unsigned>(F, WS_SORT), wsp<const unsigned char>(F, WS_WGU), (size_t)2048 * 1024};
        pg8::EpiSwiglu E{wsp<unsigned char>(F, WS_ACT), F.in[I_GUB], blk_e};
        pg8::gemm_phase<pg8::EpiSwiglu, pg8::MoeSched<true>, true>(ring, wsp<const unsigned char>(F, WS_H), 1024, S, E);
    } SEAM(10);
    if (IN(11)) {
        moe_tables(F);
        pg8::MoeSched<false> S{mtab[64], 4, F.G, F.bid, blk_e, nullptr, wsp<const unsigned char>(F, WS_WDN), (size_t)1024 * 1024};
        pg8::EpiDown E{wsp<unsigned char>(F, WS_YS), F.in[I_DNB], blk_e, wsp<const unsigned>(F, WS_SORT) + MAXSLOT, (const float*)(wsp<const unsigned>(F, WS_SORT) + 2 * MAXSLOT)};
        pg8::gemm_phase<pg8::EpiDown, pg8::MoeSched<false>, true>(ring, wsp<const unsigned char>(F, WS_ACT), 1024, S, E);
    } SEAM(11);
    if (IN(12)) { p_combine_norm1_l1(F); } SEAM(12);
    if (IN(13)) {
        pg8::DenseSched S; S.init(NTOK, 512, 1024, wsp<const unsigned char>(F, WS_WODIN), F.G, F.bid);
        pg8::EpiBf16<pg8::MapPlain> E{pg8::MapPlain{wsp<bf16>(F, WS_C), 512}};
        pg8::gemm_phase<pg8::EpiBf16<pg8::MapPlain>, pg8::DenseSched, true>(ring, wsp<const unsigned char>(F, WS_H), 1024, S, E);
        { const int slot = F.bid - S.nwg % F.G; if (slot >= 0) p_fill_convert(F, slot, F.G - S.nwg % F.G, FILL_C, FILL_D); }
    } SEAM(13);
    if (IN(14)) { p_mla_prep(F); } SEAM(14);
    if (IN(15)) {
        { pg8::DenseSched S; S.init(NLAT, 1536, 512, wsp<const bf16>(F, WS_WQUP), F.G, F.bid);
          pg8::EpiQ8 E{wsp<unsigned char>(F, WS_Q8), wsp<const f32x2>(F, WS_ROPE)};
          pg8::gemm_phase(ring, wsp<const bf16>(F, WS_QN), 512, S, E); }
        { pg8::KvSched S; S.init(NTOK, 2048, 512, wsp<const bf16>(F, WS_WKVUP), F.G, F.bid);
          pg8::EpiKV8 E{wsp<unsigned char>(F, WS_K8), wsp<unsigned char>(F, WS_V8T)};
          pg8::gemm_phase(ring, wsp<const bf16>(F, WS_KVN), 512, S, E);
          { const int slot = F.bid - S.nwg % F.G; if (slot >= 0) p_fill_convert(F, slot, F.G - S.nwg % F.G, FILL_D, FILL_E); } }
    } SEAM(15);
    if (IN(17)) { p_attention(F); } SEAM(17);
    if (IN(18)) {
        pg8::DenseSched S; S.init(NLAT, 1024, 1024, wsp<const unsigned char>(F, WS_WODOUT), F.G, F.bid);
        pg8::EpiResid E{wsp<bf16>(F, WS_X1), F.in[I_X], F.in[I_CTX], wsp<const float>(F, WS_MOD), 1};
        pg8::gemm_phase<pg8::EpiResid, pg8::DenseSched, true>(ring, wsp<const unsigned char>(F, WS_H), 1024, S, E);
    } SEAM(18);
    if (IN(19)) { p_norm2_route(F, 1, NLAT); } SEAM(19);
    if (IN(20)) { p_moe_scatter(F, NLAT); } SEAM(20);
    if (IN(21)) {
        moe_tables(F);
        pg8::MoeSched<true> S{mtab[64], 8, F.G, F.bid, blk_e, wsp<const unsigned>(F, WS_SORT), wsp<const unsigned char>(F, WS_WGU) + (size_t)32 * 2048 * 1024, (size_t)2048 * 1024};
        pg8::EpiSwiglu E{wsp<unsigned char>(F, WS_ACT), F.in[I_GUB] + 32 * 2048, blk_e};
        pg8::gemm_phase<pg8::EpiSwiglu, pg8::MoeSched<true>, true>(ring, wsp<const unsigned char>(F, WS_H), 1024, S, E);
    } SEAM(21);
    if (IN(22)) {
        moe_tables(F);
        pg8::MoeSched<false> S{mtab[64], 4, F.G, F.bid, blk_e, nullptr, wsp<const unsigned char>(F, WS_WDN) + (size_t)32 * 1024 * 1024, (size_t)1024 * 1024};
        pg8::EpiDown E{wsp<unsigned char>(F, WS_YS), F.in[I_DNB] + 32 * 1024, blk_e, wsp<const unsigned>(F, WS_SORT) + MAXSLOT, (const float*)(wsp<const unsigned>(F, WS_SORT) + 2 * MAXSLOT)};
        pg8::gemm_phase<pg8::EpiDown, pg8::MoeSched<false>, true>(ring, wsp<const unsigned char>(F, WS_ACT), 1024, S, E);
    } SEAM(22);
    if (IN(23)) { p_final(F); }
#undef IN
#undef SEAM
}

extern "C" void kernel_launch(void* const* d_in, const int* in_sizes, int n_in, void* d_out, int out_size, void* d_ws, size_t ws_size, hipStream_t stream) {
    static int grid = 0;
    if (grid == 0) {
        if (n_in != 37 || out_size != NLAT * DM || ws_size < WS_END) { fprintf(stderr, "kernel_launch: built for 37 inputs, %d outputs, >= %zu bytes of workspace; got n_in %d, out %d, ws %zu\n", NLAT * DM, (size_t)WS_END, n_in, out_size, ws_size); grid = -1; return; }
        int dev = 0, cus = 0, per_cu = 0;
        if (hipGetDevice(&dev) != hipSuccess || hipDeviceGetAttribute(&cus, hipDeviceAttributeMultiprocessorCount, dev) != hipSuccess) { grid = -1; return; }
        if (hipFuncSetAttribute((const void*)mk_fwd, hipFuncAttributeMaxDynamicSharedMemorySize, LDS_BYTES) != hipSuccess) { fprintf(stderr, "kernel_launch: hipFuncSetAttribute failed\n"); grid = -1; return; }
        if (hipOccupancyMaxActiveBlocksPerMultiprocessor(&per_cu, (const void*)mk_fwd, 512, LDS_BYTES) != hipSuccess || per_cu < 1) fprintf(stderr, "kernel_launch: occupancy query says %d\n", per_cu);
        (void)hipGetLastError();
        grid = cus;
    }
    if (grid < 0) return;
    if (hipMemsetAsync((char*)d_ws + WS_CTL, 0, CTL_ZERO_BYTES, stream) != hipSuccess) return;
    Args a{};
    for (int i = 0; i < 37; ++i) a.in[i] = (const float*)d_in[i];
    a.out = (float*)d_out; a.ws = (unsigned char*)d_ws;
#if MK_N_LAUNCHES == 1
    a.ph_lo = 0; a.ph_hi = N_PHASES;
    hipLaunchKernelGGL(mk_fwd, dim3(grid), dim3(512), LDS_BYTES, stream, a);
#else
    for (int p = 0; p < N_PHASES; ++p) { a.ph_lo = p; a.ph_hi = p + 1; hipLaunchKernelGGL(mk_fwd, dim3(grid), dim3(512), LDS_BYTES, stream, a); }
#endif
    const hipError_t le = hipPeekAtLastError();
    if (le != hipSuccess) fprintf(stderr, "kernel_launch: launch failed: %s\n", hipGetErrorName(le));
}
```

```cpp
#include <hip/hip_runtime.h>
#include <cstdio>
#include <cstdint>

#ifndef MK_N_LAUNCHES
#define MK_N_LAUNCHES 1
#endif

#define GAS __attribute__((address_space(1)))
#define LAS __attribute__((address_space(3)))
typedef unsigned short bf16;
typedef short bf16x8 __attribute__((ext_vector_type(8)));
typedef short s16x4 __attribute__((ext_vector_type(4)));
typedef float f32x4 __attribute__((ext_vector_type(4)));
typedef float f32x2 __attribute__((ext_vector_type(2)));
typedef float f32x16 __attribute__((ext_vector_type(16)));
typedef unsigned u32x4 __attribute__((ext_vector_type(4)));
typedef unsigned u32x2 __attribute__((ext_vector_type(2)));
typedef int i32x4 __attribute__((ext_vector_type(4)));
typedef int i32x8 __attribute__((ext_vector_type(8)));
typedef GAS unsigned gu32;
#define RLX_AGENT __ATOMIC_RELAXED, __HIP_MEMORY_SCOPE_AGENT
#define LDS_WAIT() asm volatile("s_waitcnt lgkmcnt(0)" ::: "memory")
#define VM_WAIT() asm volatile("s_waitcnt vmcnt(0)" ::: "memory")
#define SBAR() __builtin_amdgcn_sched_barrier(0)

constexpr int DM = 1024, NB = 8, SEQ = 8192, CTXL = 256;
constexpr int NLAT = NB * SEQ;
constexpr int NCTX = NB * CTXL;
constexpr int NTOK = NLAT + NCTX;
constexpr int GLA_COLS = 1552, RW_COLS = 1824, RW0 = 1664, PW = 3584;
constexpr int LRK = 384, LRN = 2560;
constexpr int NE = 32, TOPK = 4, DE = 1024;
constexpr int NASG0 = NTOK * TOPK;
constexpr int MAXSLOT = NASG0 + NE * 256;
constexpr int YS_DUMMY = NASG0;
constexpr int NKEY = CTXL + SEQ;
constexpr float YS_SCALE = 16.f;
constexpr int MH = 8, QKD = 192, VD = 128;

constexpr size_t MiB = 1u << 20;
constexpr size_t WS_CTL = 0, CTL_ZERO_BYTES = 1 * MiB;
constexpr size_t WS_MOD = 1 * MiB;
constexpr size_t WS_ROPE = 2 * MiB;
constexpr size_t WS_WIN = 4 * MiB;
constexpr size_t WS_WOUT = 11 * MiB;
constexpr size_t WS_WLR = 13 * MiB;
constexpr size_t WS_WODIN = 15 * MiB;
constexpr size_t WS_WQUP = 16 * MiB;
constexpr size_t WS_WKVUP = 17 * MiB;
constexpr size_t WS_WODOUT = 18 * MiB;
constexpr size_t WS_ROUTE = 20 * MiB;
constexpr size_t WS_WGU = 24 * MiB;
constexpr size_t WS_WDN = 280 * MiB;
constexpr size_t WS_X1 = 408 * MiB;
constexpr size_t WS_H = 672 * MiB;
constexpr size_t WS_ARENA = 804 * MiB;
constexpr size_t WS_P = WS_ARENA;
constexpr size_t WS_LOUT = WS_P + 462 * MiB;
constexpr size_t WS_GLAO = WS_LOUT + 330 * MiB;
constexpr size_t WS_RWY = WS_GLAO + 132 * MiB;
constexpr size_t WS_ALR = WS_RWY + 132 * MiB;
constexpr size_t WS_BONUS = WS_ALR + 50 * MiB;
constexpr size_t WS_ACT = WS_ARENA;
constexpr size_t WS_YS = WS_ACT + 544 * MiB;
constexpr size_t WS_C = WS_ARENA;
constexpr size_t WS_QN = WS_C + 132 * MiB;
constexpr size_t WS_KVN = WS_QN + 32 * MiB;
constexpr size_t WS_Q8 = WS_KVN + 33 * MiB;
constexpr size_t WS_QR = WS_Q8 + 101 * MiB;
constexpr size_t WS_K8 = WS_QR + 64 * MiB;
constexpr size_t WS_V8T = WS_K8 + 108 * MiB;
constexpr size_t WS_V = WS_V8T + 67 * MiB;
constexpr size_t WS_END = 2048 * MiB;
static_assert(WS_BONUS + 5 * MiB <= WS_END && WS_YS + 529 * MiB <= WS_END && WS_V + 132 * MiB <= WS_END, "d_ws map");
constexpr int K8ROW = 208;
constexpr size_t RT_E = 0;
constexpr size_t RT_POS = 512 * 1024;
constexpr size_t RT_GATE = 1024 * 1024 + 512 * 1024;
constexpr size_t RT_HIST = 3 * MiB;
constexpr size_t RT_TOK = 3 * MiB + 64 * 1024;
constexpr size_t WS_SORT = WS_YS + 529 * MiB;
static_assert(WS_SORT + 4 * MiB <= WS_END, "sort lists");

constexpr int CW_TMO = 0, CW_CODE = 1;
constexpr int CW_BAR = 4096;

constexpr int RING_BYTES = 131072;
constexpr int LDS_BYTES = 163840;
constexpr int MISC_OFF = 163840 - 256;

__device__ __forceinline__ unsigned f2bf(float f) { unsigned u = __builtin_bit_cast(unsigned, f); return (u + 0x7fffu + ((u >> 16) & 1u)) >> 16; }
__device__ __forceinline__ float bf2f(unsigned h) { return __builtin_bit_cast(float, h << 16); }
typedef __bf16 bf16x2v __attribute__((ext_vector_type(2)));
__device__ __forceinline__ unsigned cvt_pk_bf16(float lo, float hi) { const f32x2 v = {lo, hi}; const bf16x2v r = __builtin_convertvector(v, bf16x2v); return __builtin_bit_cast(unsigned, r); }
__device__ __forceinline__ unsigned pk4_fp8(float a, float b, float c, float d) { unsigned w = 0u; w = (unsigned)__builtin_amdgcn_cvt_pk_fp8_f32(a, b, (int)w, false); w = (unsigned)__builtin_amdgcn_cvt_pk_fp8_f32(c, d, (int)w, true); return w; }
__device__ __forceinline__ float bflo(unsigned w) { return __builtin_bit_cast(float, w << 16); }
__device__ __forceinline__ float bfhi(unsigned w) { return __builtin_bit_cast(float, w & 0xffff0000u); }
__device__ __forceinline__ float wave_sum(float v) {
#pragma unroll
    for (int o = 1; o < 64; o <<= 1) v += __shfl_xor(v, o);
    return v;
}
__device__ __forceinline__ float sigmoidf_(float x) { return 1.f / (1.f + __expf(-x)); }

namespace pg8 {
constexpr int BM = 256, BK = 64, HALF = 128, HTB = HALF * BK * 2, STAGE_BYTES = 8 * HTB;
__host__ __device__ __forceinline__ int lds_byte(int r, int c) { const int st = (r >> 4) * 2 + (c >> 5), rr = r & 15, cc = c & 31, ob = rr * 64 + cc * 2; return st * 1024 + (ob ^ (((ob >> 9) & 1) << 5)); }
__host__ __device__ __forceinline__ void stage_rc(int b, int& R, int& C) { const int st = b / 1024, sb = b % 1024, swz = sb ^ (((sb >> 9) & 1) << 5); R = (st >> 1) * 16 + swz / 64; C = (st & 1) * 32 + (swz % 64) / 2; }
__host__ __device__ __forceinline__ int perm32(int rho) { const int n = rho >> 4, i = rho & 15; return 8 * (i >> 2) + 4 * n + (i & 3); }
struct Unit { int pm, pn; };

template <class Epi, class Sched, bool FP8 = false>
__device__ __forceinline__ void gemm_phase(LAS unsigned char* lds, const void* Abase, const int KBc, const Sched& S, const Epi& E) {
    int K = KBc; asm volatile("" : "+s"(K));
    const int tid = threadIdx.x, wid = __builtin_amdgcn_readfirstlane(tid >> 6), lane = tid & 63, wr = wid >> 2, wc = wid & 3, fr = lane & 15, fq = lane >> 4;
    const int nt = K / 128;
    int sR[2], sC[2]; unsigned voffB[2];
#pragma unroll
    for (int i = 0; i < 2; ++i) { int R, C; stage_rc(tid * 16 + i * 8192, R, C); const int Rb = Epi::PERM ? ((R & ~31) + perm32(R & 31)) : R; sR[i] = R; sC[i] = C; voffB[i] = (unsigned)(Rb * K + C * 2); }
    const size_t kstep = (size_t)(BK * 2);
    const size_t hstep = (size_t)HALF * K;
    const unsigned ldsw = (unsigned)wid * 1024u;
    const int aoff = lds_byte(wr * 64 + fr, fq * 8), boff = lds_byte(wc * 32 + fr, fq * 8);
    const char* Ab = (const char*)Abase;
#define PG8_SA(b, h) (((b) * 2 + (h)) * HTB)
#define PG8_SB(b, h) ((4 + (b) * 2 + (h)) * HTB)
#define PG8_STAGE(bufoff, gbase, voff) do { _Pragma("unroll") for (int _i = 0; _i < 2; ++_i) \
        __builtin_amdgcn_global_load_lds((const unsigned*)((const char*)(gbase) + (voff)[_i]), (LAS unsigned*)(lds + (bufoff) + ldsw + _i * 8192), 16, 0, 0); } while (0)
#define PG8_STAGEA(bufoff, kb, ao, h) do { _Pragma("unroll") for (int _i = 0; _i < 2; ++_i) \
        __builtin_amdgcn_global_load_lds((const unsigned*)((Ab + (kb)) + (ao)[h][_i]), (LAS unsigned*)(lds + (bufoff) + ldsw + _i * 8192), 16, 0, 0); } while (0)
#define PG8_STAGEA2(bufoff, kb, h) do { _Pragma("unroll") for (int _i = 0; _i < 2; ++_i) \
        __builtin_amdgcn_global_load_lds((const unsigned*)((Ab + (kb)) + (last ? nao[h][_i] : cao[h][_i])), (LAS unsigned*)(lds + (bufoff) + ldsw + _i * 8192), 16, 0, 0); } while (0)
#define PG8_LD8(p) __builtin_shufflevector(*(const LAS i32x4*)(p), *(const LAS i32x4*)((p) + 1024), 0, 1, 2, 3, 4, 5, 6, 7)
#define PG8_LDA(dst, b, h) do { _Pragma("unroll") for (int m = 0; m < 4; ++m) dst[m] = PG8_LD8(lds + PG8_SA(b, h) + aoff + m * 2048); } while (0)
#define PG8_LDB(dst, b, h) do { _Pragma("unroll") for (int n = 0; n < 2; ++n) dst[n] = PG8_LD8(lds + PG8_SB(b, h) + boff + n * 2048); } while (0)
#define PG8_MMA(ai, bj, At, Bt) do { __builtin_amdgcn_s_setprio(1); _Pragma("unroll") for (int m = 0; m < 4; ++m) _Pragma("unroll") for (int n = 0; n < 2; ++n) { \
        if constexpr (FP8) asm volatile("v_mfma_scale_f32_16x16x128_f8f6f4 %0, %1, %2, %0, %3, %4 op_sel_hi:[0,0,0]" : "+v"(acc[ai][bj][m][n]) : "v"(Bt[n]), "v"(At[m]), "v"(scl_w), "v"(scl_x)); \
        else { acc[ai][bj][m][n] = __builtin_amdgcn_mfma_f32_16x16x32_bf16(__builtin_bit_cast(bf16x8, __builtin_shufflevector(Bt[n], Bt[n], 0, 1, 2, 3)), __builtin_bit_cast(bf16x8, __builtin_shufflevector(At[m], At[m], 0, 1, 2, 3)), acc[ai][bj][m][n], 0, 0, 0); \
               acc[ai][bj][m][n] = __builtin_amdgcn_mfma_f32_16x16x32_bf16(__builtin_bit_cast(bf16x8, __builtin_shufflevector(Bt[n], Bt[n], 4, 5, 6, 7)), __builtin_bit_cast(bf16x8, __builtin_shufflevector(At[m], At[m], 4, 5, 6, 7)), acc[ai][bj][m][n], 0, 0, 0); } } \
        __builtin_amdgcn_s_setprio(0); } while (0)
#define PG8_WAIT_V(n) asm volatile("s_waitcnt vmcnt(" #n ")" ::: "memory")
#define PG8_WAIT_L(n) asm volatile("s_waitcnt lgkmcnt(" #n ")" ::: "memory")
#define PG8_BAR __builtin_amdgcn_s_barrier()
#define PG8_SCHED __builtin_amdgcn_sched_barrier(0)
    Unit cur, nxt; int ui = 0;
    if (!S.next(0, cur)) return;
    int ntc = S.ktiles(cur, nt);
    f32x4 acc[2][2][4][2];
#pragma unroll
    for (int a = 0; a < 2; ++a)
#pragma unroll
        for (int b = 0; b < 2; ++b)
#pragma unroll
            for (int m = 0; m < 4; ++m)
#pragma unroll
                for (int n = 0; n < 2; ++n) acc[a][b][m][n] = (f32x4){0.f, 0.f, 0.f, 0.f};
    i32x8 At[4], B0[2], B1[2];
    int scl_w = 0x7A7A7A7A, scl_x = 0x7F7F7F7F;
    asm volatile("" : "+v"(scl_w), "+v"(scl_x));
    unsigned cao[2][2], nao[2][2];
    S.a_offs(cur, cao, sR, sC);
    const char* cB = S.b_tile(cur);
    PG8_STAGE(PG8_SB(0, 0), cB, voffB); PG8_STAGE(PG8_SB(0, 1), cB + hstep, voffB); PG8_STAGEA(PG8_SA(0, 0), 0, cao, 0); PG8_STAGEA(PG8_SA(0, 1), 0, cao, 1);
    if (wr == 1) PG8_BAR;
    PG8_WAIT_V(2); PG8_BAR;
    PG8_STAGE(PG8_SB(1, 0), cB + kstep, voffB); PG8_STAGEA(PG8_SA(1, 0), kstep, cao, 0); PG8_STAGE(PG8_SB(1, 1), cB + hstep + kstep, voffB);
    PG8_WAIT_V(6); PG8_BAR;
    for (;;) {
        const bool has_next = S.next(ui + 1, nxt);
        const char* nB = cB;
        if (has_next) { S.a_offs(nxt, nao, sR, sC); nB = S.b_tile(nxt); }
        else {
#pragma unroll
            for (int h = 0; h < 2; ++h)
#pragma unroll
                for (int i = 0; i < 2; ++i) nao[h][i] = cao[h][i];
        }
        for (int t = 0; t < ntc; t += 2) {
            const bool last = (t == ntc - 2);
            const size_t a1k = (size_t)(t + 1) * kstep;
            const size_t a2k = last ? 0 : (size_t)(t + 2) * kstep; const char* b2 = last ? nB : cB + (size_t)(t + 2) * kstep;
            const size_t a3k = a2k + kstep; const char* b3 = b2 + kstep;
            PG8_LDB(B0, 0, 0); PG8_LDB(B1, 0, 1); PG8_SCHED; PG8_LDA(At, 0, 0); PG8_STAGEA(PG8_SA(1, 1), a1k, cao, 1);
            PG8_WAIT_V(8); PG8_WAIT_L(0); PG8_BAR; PG8_MMA(0, 0, At, B0); PG8_MMA(0, 1, At, B1); PG8_BAR; PG8_SCHED;
            PG8_LDA(At, 0, 1); PG8_STAGE(PG8_SB(0, 0), b2, voffB); PG8_STAGE(PG8_SB(0, 1), b2 + hstep, voffB); PG8_STAGEA2(PG8_SA(0, 0), a2k, 0);
            PG8_WAIT_V(8); PG8_WAIT_L(0); PG8_BAR; PG8_MMA(1, 0, At, B0); PG8_MMA(1, 1, At, B1); PG8_BAR; PG8_SCHED;
            PG8_LDB(B0, 1, 0); PG8_LDB(B1, 1, 1); PG8_SCHED; PG8_LDA(At, 1, 0); PG8_STAGEA2(PG8_SA(0, 1), a2k, 1);
            PG8_WAIT_V(8); PG8_WAIT_L(0); PG8_BAR; PG8_MMA(0, 0, At, B0); PG8_MMA(0, 1, At, B1); PG8_BAR; PG8_SCHED;
            PG8_LDA(At, 1, 1); PG8_STAGE(PG8_SB(1, 0), b3, voffB); PG8_STAGE(PG8_SB(1, 1), b3 + hstep, voffB); PG8_STAGEA2(PG8_SA(1, 0), a3k, 0);
            PG8_WAIT_V(8); PG8_WAIT_L(0); PG8_BAR; PG8_MMA(1, 0, At, B0); PG8_MMA(1, 1, At, B1); PG8_BAR; PG8_SCHED;
        }
        if (wr == 0) PG8_BAR;
        if constexpr (FP8) asm volatile("s_nop 15\n\ts_nop 7" ::: "memory");
        E(acc, cur, wr, wc, fr, fq);
        if (!has_next) break;
#pragma unroll
        for (int a = 0; a < 2; ++a)
#pragma unroll
            for (int b = 0; b < 2; ++b)
#pragma unroll
                for (int m = 0; m < 4; ++m)
#pragma unroll
                    for (int n = 0; n < 2; ++n) acc[a][b][m][n] = (f32x4){0.f, 0.f, 0.f, 0.f};
        cur = nxt; cB = nB; ++ui; ntc = S.ktiles(cur, nt);
#pragma unroll
        for (int h = 0; h < 2; ++h)
#pragma unroll
            for (int i = 0; i < 2; ++i) cao[h][i] = nao[h][i];
        if (wr == 1) PG8_BAR;
    }
    PG8_WAIT_V(0);
    PG8_BAR;
#undef PG8_SA
#undef PG8_SB
#undef PG8_STAGE
#undef PG8_STAGEA
#undef PG8_STAGEA2
#undef PG8_LDA
#undef PG8_LDB
#undef PG8_MMA
#undef PG8_WAIT_V
#undef PG8_WAIT_L
#undef PG8_BAR
#undef PG8_SCHED
}
}

#define XB_TMO      128
#define XB_XCNT(j)  (256  + 64 * (j))
#define XB_XSUB(j)  (1280 + 64 * (j))
#define XB_XGEN(j)  (2304 + 64 * (j))
#define XB_TOP      3328
#define XB_TOPGEN   3392
#define XCD_BAR_WORDS 3456
#define XB_SPIN_CAP (1u << 22)
__device__ __forceinline__ unsigned xb_ld(unsigned* p)              { return __hip_atomic_load(p, __ATOMIC_RELAXED, __HIP_MEMORY_SCOPE_AGENT); }
__device__ __forceinline__ unsigned xb_add(unsigned* p, unsigned v) { return __hip_atomic_fetch_add(p, v, __ATOMIC_RELAXED, __HIP_MEMORY_SCOPE_AGENT); }
__device__ __forceinline__ unsigned xb_xcc_id() { return (unsigned)__builtin_amdgcn_s_getreg((3 << 11) | 20) & 0xFu; }
#define XB_SPIN(cond, bar) do { unsigned _sp = 0; while (cond) { __builtin_amdgcn_s_sleep(1); \
    if ((++_sp & 255u) == 0u) { if (xb_ld(&(bar)[XB_TMO])) break; if (_sp > XB_SPIN_CAP) { atomicAdd(&(bar)[XB_TMO], 1u); break; } } } } while (0)
struct XcdBarrier { unsigned* bar; unsigned x; volatile LAS unsigned* st; };
__device__ __forceinline__ XcdBarrier xcd_barrier_post(unsigned* bar, volatile LAS unsigned* st) {
    XcdBarrier b; b.bar = bar; b.x = xb_xcc_id(); b.st = st;
    if (threadIdx.x == 0) (void)xb_add(&bar[XB_XCNT(b.x)], 1u);
    return b;
}
__device__ __forceinline__ void xcd_barrier_complete(unsigned* bar, unsigned x, unsigned& nloc, unsigned& nx) {
    const unsigned G = gridDim.x * gridDim.y * gridDim.z;
    unsigned sum, cnt, mine, sp = 0u;
    for (;;) {
        sum = 0u; cnt = 0u; mine = 0u;
#pragma unroll
        for (unsigned j = 0; j < 16; ++j) { const unsigned c = xb_ld(&bar[XB_XCNT(j)]); sum += c; cnt += (c > 0u) ? 1u : 0u; mine = (j == x) ? c : mine; }
        if (sum == G) break;
        __builtin_amdgcn_s_sleep(1);
        if ((++sp & 255u) == 0u) { if (xb_ld(&bar[XB_TMO])) break; if (sp > XB_SPIN_CAP) { atomicAdd(&bar[XB_TMO], 1u); break; } }
    }
    nloc = mine > 0u ? mine : 1u; nx = cnt > 0u ? cnt : 1u;
}
__device__ __forceinline__ void xcd_barrier(const XcdBarrier& b) {
    asm volatile("s_waitcnt vmcnt(0)" ::: "memory");
    __syncthreads();
    if (threadIdx.x == 0) {
        unsigned* bar = b.bar;
        __builtin_amdgcn_s_waitcnt(0);
        unsigned nloc = b.st[0], nx = b.st[1];
        if (nloc == 0u) { xcd_barrier_complete(bar, b.x, nloc, nx); b.st[0] = nloc; b.st[1] = nx; }
        const unsigned old = xb_add(&bar[XB_XSUB(b.x)], 1u);
        const unsigned gen = old / nloc;
        if (old + 1u == (gen + 1u) * nloc) {
            __builtin_amdgcn_fence(__ATOMIC_RELEASE, "agent");
            asm volatile("s_waitcnt vmcnt(0)" ::: "memory");
            const unsigned og = xb_add(&bar[XB_TOP], 1u);
            const unsigned tg = og / nx;
            if (og + 1u == (tg + 1u) * nx) xb_add(&bar[XB_TOPGEN], 1u);
            else XB_SPIN(xb_ld(&bar[XB_TOPGEN]) == tg, bar);
            __builtin_amdgcn_fence(__ATOMIC_ACQUIRE, "agent");
            xb_add(&bar[XB_XGEN(b.x)], 1u);
            asm volatile("s_waitcnt vmcnt(0)" ::: "memory");
        } else {
            XB_SPIN(xb_ld(&bar[XB_XGEN(b.x)]) == gen, bar);
            __builtin_amdgcn_fence(__ATOMIC_ACQUIRE, "agent");
            asm volatile("s_waitcnt vmcnt(0)" ::: "memory");
        }
    }
    __syncthreads();
}

struct Frame {
    LAS unsigned char* lds;
    int tid, lane, wave, G, bid;
    const float* const __attribute__((address_space(4)))* in;
    float* out;
    unsigned char* ws;
};
enum { I_X = 0, I_C, I_CTX, I_CCTX, I_ADAW, I_ADAB, I_N1G, I_N2G, I_EVWIN, I_EVWOUT, I_GKUP, I_GKB, I_GNG, I_MU, I_W0, I_W2, I_A0, I_A2, I_KK, I_KA, I_RK, I_G2, I_LNW, I_LNB,
       I_ODWIN, I_QNORM, I_WQUP, I_KVNORM, I_WKVUP, I_ODWOUT, I_RW, I_RB, I_GUW, I_GUB, I_DNW, I_DNB, I_FNG };
template <class T> __device__ __forceinline__ T* wsp(const Frame& F, size_t off) { return (T*)(F.ws + off); }
__device__ __forceinline__ int mod_row(int row) { return row < NLAT ? (row >> 13) : 8; }
__device__ __forceinline__ const float* mod_ptr(const Frame& F, int layer, int row, int which) { return wsp<const float>(F, WS_MOD) + ((size_t)(layer * 9 + mod_row(row)) * 6 + which) * 1024; }

__device__ __forceinline__ void p0_mod(Frame& F) {
    LAS float* s = (LAS float*)F.lds;
    LAS float* red = (LAS float*)(F.lds + 9 * 1024 * 4);
    const float* c = F.in[I_C]; const float* cc = F.in[I_CCTX]; const float* W = F.in[I_ADAW]; const float* Bv = F.in[I_ADAB];
    for (int idx = F.tid; idx < 9 * 1024; idx += 512) { const int r = idx >> 10, k = idx & 1023; const float v = r < 8 ? c[r * 1024 + k] : cc[k]; s[idx] = v / (1.f + __expf(-v)); }
    __syncthreads();
    for (int item = F.bid; item < 192; item += F.G) {
        const int l = item / 96, n0 = (item % 96) * 64;
        float acc[9];
#pragma unroll
        for (int r = 0; r < 9; ++r) acc[r] = 0.f;
        const float* wp = W + ((size_t)l * 1024 + F.wave * 128) * 6144 + n0 + F.lane;
        for (int k = 0; k < 128; ++k) { const float wv = wp[(size_t)k * 6144];
#pragma unroll
            for (int r = 0; r < 9; ++r) acc[r] += s[r * 1024 + F.wave * 128 + k] * wv; }
#pragma unroll
        for (int r = 0; r < 9; ++r) red[(F.wave * 9 + r) * 64 + F.lane] = acc[r];
        __syncthreads();
        for (int idx = F.tid; idx < 576; idx += 512) { const int r = idx >> 6, ln = idx & 63; float v = Bv[l * 6144 + n0 + ln];
#pragma unroll
            for (int w = 0; w < 8; ++w) v += red[(w * 9 + r) * 64 + ln];
            wsp<float>(F, WS_MOD)[(size_t)(l * 9 + r) * 6144 + n0 + ln] = v; }
        __syncthreads();
    }
}
__device__ __forceinline__ void p0_rope(Frame& F) {
    for (int idx = F.bid * 512 + F.tid; idx < SEQ * 32; idx += F.G * 512) {
        const int t = idx >> 5, i = idx & 31;
        const float fr = (float)pow(10000.0, -(double)(i & 15) / 16.0);
        const float pos = (float)(i < 16 ? (t >> 6) : (t & 63));
        const float ang = pos * fr;
        const double a = (double)ang;
        wsp<f32x2>(F, WS_ROPE)[idx] = (f32x2){(float)cos(a), (float)sin(a)};
    }
}
template <class V> __device__ __forceinline__ void cvt_item(const V& val, bf16* dst, int K, int item, int nblk, LAS float* scr, int lane) {
    const int kb = item / nblk, nb = item % nblk, k0 = 64 * kb, n0 = 32 * nb;
#pragma unroll 8
    for (int i = 0; i < 32; ++i) { const int kk = 2 * i + (lane >> 5); scr[kk * 33 + (lane & 31)] = val(n0 + (lane & 31), k0 + kk); }
    LDS_WAIT(); asm volatile("" ::: "memory");
    const int c = lane & 7;
#pragma unroll
    for (int j = 0; j < 4; ++j) { const int n = (lane >> 3) + 8 * j; const LAS float* sp = scr + (8 * c) * 33 + n;
        u32x4 o; o.x = f2bf(sp[0 * 33]) | (f2bf(sp[1 * 33]) << 16); o.y = f2bf(sp[2 * 33]) | (f2bf(sp[3 * 33]) << 16); o.z = f2bf(sp[4 * 33]) | (f2bf(sp[5 * 33]) << 16); o.w = f2bf(sp[6 * 33]) | (f2bf(sp[7 * 33]) << 16);
        *(u32x4*)(dst + (size_t)(n0 + n) * K + k0 + 8 * c) = o; }
    LDS_WAIT(); asm volatile("" ::: "memory");
}
template <class V> __device__ __forceinline__ void cvt_item_fp8(const V& val, unsigned char* dst, int K, int item, int nblk, LAS float* scr, int lane) {
    const int kb = item / nblk, nb = item % nblk, k0 = 64 * kb, n0 = 32 * nb;
#pragma unroll 8
    for (int i = 0; i < 32; ++i) { const int kk = 2 * i + (lane >> 5); scr[kk * 33 + (lane & 31)] = 32.f * val(n0 + (lane & 31), k0 + kk); }
    LDS_WAIT(); asm volatile("" ::: "memory");
    const int c = lane & 7;
#pragma unroll
    for (int j = 0; j < 4; ++j) { const int n = (lane >> 3) + 8 * j; const LAS float* sp = scr + (8 * c) * 33 + n;
        *(u32x2*)(dst + (size_t)(n0 + n) * K + k0 + 8 * c) = (u32x2){pk4_fp8(sp[0 * 33], sp[1 * 33], sp[2 * 33], sp[3 * 33]), pk4_fp8(sp[4 * 33], sp[5 * 33], sp[6 * 33], sp[7 * 33])}; }
    LDS_WAIT(); asm volatile("" ::: "memory");
}
template <class V4> __device__ __forceinline__ void cvt_item_fp8_wide(const V4& col4, const float* W, int ld, unsigned char* dst, int K, int item, int nblk, LAS float* scr, int lane) {
    const int kb = item / nblk, nb = item % nblk, k0 = 64 * kb, n0 = 64 * nb;
    const float* src = W + (size_t)(k0 + (lane >> 4)) * ld + col4(n0 + (lane & 15) * 4);
#pragma unroll
    for (int i = 0; i < 16; ++i) { const f32x4 v = *(const f32x4*)(src + (size_t)(4 * i) * ld); LAS float* sp = scr + (4 * i + (lane >> 4)) * 68 + (lane & 15) * 4; *(LAS f32x4*)sp = v; }
    LDS_WAIT(); asm volatile("" ::: "memory");
    const int nl = lane >> 2, part = lane & 3;
#pragma unroll
    for (int j = 0; j < 4; ++j) { const int n = nl + 16 * j; const LAS float* sp = scr + (part * 16) * 68 + n; unsigned o[4];
#pragma unroll
        for (int e = 0; e < 4; ++e) o[e] = pk4_fp8(32.f * sp[(4 * e) * 68], 32.f * sp[(4 * e + 1) * 68], 32.f * sp[(4 * e + 2) * 68], 32.f * sp[(4 * e + 3) * 68]);
        *(u32x4*)(dst + (size_t)(n0 + n) * K + k0 + part * 16) = (u32x4){o[0], o[1], o[2], o[3]}; }
    LDS_WAIT(); asm volatile("" ::: "memory");
}
struct C4Gu { __device__ __forceinline__ int operator()(int n) const { return ((n & 128) ? 1024 : 0) + (n >> 8) * 128 + (n & 127); } };
struct C4Id { __device__ __forceinline__ int operator()(int n) const { return n; } };
struct VPlain { const float* W; int ldn, Nr, Kr; __device__ __forceinline__ float operator()(int n, int k) const { return (n < Nr && k < Kr) ? W[(size_t)k * ldn + n] : 0.f; } };
struct VWin { const float* W; __device__ __forceinline__ float operator()(int n, int k) const { const int col = n < GLA_COLS ? n : ((n >= RW0 && n < RW0 + RW_COLS) ? n - (RW0 - GLA_COLS) : -1); return col >= 0 ? W[(size_t)k * (GLA_COLS + RW_COLS) + col] : 0.f; } };
struct VQup { const float* W; __device__ __forceinline__ float operator()(int n, int k) const { const int col = n < 1024 ? (n >> 7) * 192 + (n & 127) : ((n - 1024) >> 6) * 192 + 128 + ((n - 1024) & 63); return W[(size_t)k * 1536 + col]; } };
struct VGu { const float* W; __device__ __forceinline__ float operator()(int n, int k) const { const int col = ((n & 128) ? 1024 : 0) + (n >> 8) * 128 + (n & 127); return W[(size_t)k * 2048 + col]; } };
struct VLr { const float *w2, *a2, *g2; __device__ __forceinline__ float operator()(int n, int k) const {
        if (n < 1024) return k < 64 ? w2[((size_t)(n >> 9) * 64 + k) * 512 + (n & 511)] : 0.f;
        if (n < 2048) return (k >= 64 && k < 128) ? a2[((size_t)((n - 1024) >> 9) * 64 + (k - 64)) * 512 + (n & 511)] : 0.f;
        return (k >= 128 && k < 288) ? g2[(size_t)(k - 128) * 512 + (n - 2048)] : 0.f; } };
__device__ __forceinline__ void p0_convert(Frame& F) {
    LAS float* scrw = (LAS float*)(F.lds + F.wave * 17408);
    LAS float* scr = scrw;
    const int gw = F.bid * 8 + F.wave, NGW = F.G * 8;
    constexpr int I_WIN = (1024 / 64) * (PW / 32), I_SQ = (1024 / 64) * (1024 / 32), I_LR = (LRK / 64) * (LRN / 32), I_ODIN = (1024 / 64) * (512 / 32), I_QUP = (256 / 64) * (1536 / 32), I_KVUP = (256 / 64) * (2048 / 32);
    constexpr int I_GU1 = (1024 / 64) * (2048 / 64), I_DN1 = (1024 / 64) * (1024 / 64);
    constexpr int NSMALL = I_WIN + I_SQ + I_LR + I_ODIN + I_QUP + I_KVUP + I_SQ;
    constexpr int NITEMS = NSMALL + 32 * I_GU1 + 32 * I_DN1;
    for (int it = gw; it < NITEMS; it += NGW) {
        int r = it;
        if (r < I_WIN) { cvt_item(VWin{F.in[I_EVWIN]}, wsp<bf16>(F, WS_WIN), 1024, r, PW / 32, scr, F.lane); continue; } r -= I_WIN;
        if (r < I_SQ) { cvt_item(VPlain{F.in[I_EVWOUT], 1024, 1024, 1024}, wsp<bf16>(F, WS_WOUT), 1024, r, 32, scr, F.lane); continue; } r -= I_SQ;
        if (r < I_LR) { cvt_item(VLr{F.in[I_W2], F.in[I_A2], F.in[I_G2]}, wsp<bf16>(F, WS_WLR), LRK, r, LRN / 32, scr, F.lane); continue; } r -= I_LR;
        if (r < I_ODIN) { cvt_item_fp8(VPlain{F.in[I_ODWIN], 448, 448, 1024}, wsp<unsigned char>(F, WS_WODIN), 1024, r, 16, scr, F.lane); continue; } r -= I_ODIN;
        if (r < I_QUP) { cvt_item(VQup{F.in[I_WQUP]}, wsp<bf16>(F, WS_WQUP), 256, r, 48, scr, F.lane); continue; } r -= I_QUP;
        if (r < I_KVUP) { cvt_item(VPlain{F.in[I_WKVUP], 2048, 2048, 128}, wsp<bf16>(F, WS_WKVUP), 256, r, 64, scr, F.lane); continue; } r -= I_KVUP;
        if (r < I_SQ) { cvt_item_fp8(VPlain{F.in[I_ODWOUT], 1024, 1024, 1024}, wsp<unsigned char>(F, WS_WODOUT), 1024, r, 32, scr, F.lane); continue; } r -= I_SQ;
        if (r < 32 * I_GU1) { const int le = r / I_GU1, ri = r % I_GU1; cvt_item_fp8_wide(C4Gu{}, F.in[I_GUW] + (size_t)le * 1024 * 2048, 2048, wsp<unsigned char>(F, WS_WGU) + (size_t)le * 2048 * 1024, 1024, ri, 32, scrw, F.lane); continue; } r -= 32 * I_GU1;
        { const int le = r / I_DN1, ri = r % I_DN1; cvt_item_fp8_wide(C4Id{}, F.in[I_DNW] + (size_t)le * 1024 * 1024, 1024, wsp<unsigned char>(F, WS_WDN) + (size_t)le * 1024 * 1024, 1024, ri, 16, scrw, F.lane); }
    }
}

constexpr int FILL_N = 32 * 512 + 32 * 256, FILL_A = 7168, FILL_B = 9216, FILL_C = 20608, FILL_D = 22528, FILL_E = FILL_N;
__device__ __forceinline__ void p_fill_convert(Frame& F, int slot, int nslots, int i0, int i1) {
    LAS float* scrw = (LAS float*)(F.lds + F.wave * 17408);
    for (int i = i0 + slot * 8 + F.wave; i < i1; i += nslots * 8) {
        if (i < 32 * 512) { const int le = 32 + (i >> 9), ri = i & 511; cvt_item_fp8_wide(C4Gu{}, F.in[I_GUW] + (size_t)le * 1024 * 2048, 2048, wsp<unsigned char>(F, WS_WGU) + (size_t)le * 2048 * 1024, 1024, ri, 32, scrw, F.lane); }
        else { const int j = i - 32 * 512; const int le = 32 + (j >> 8), ri = j & 255; cvt_item_fp8_wide(C4Id{}, F.in[I_DNW] + (size_t)le * 1024 * 1024, 1024, wsp<unsigned char>(F, WS_WDN) + (size_t)le * 1024 * 1024, 1024, ri, 16, scrw, F.lane); }
    }
}

struct RowV { f32x4 v[4]; };
__device__ __forceinline__ void row_load(RowV& r, const float* p, int lane) {
#pragma unroll
    for (int j = 0; j < 4; ++j) r.v[j] = ((const f32x4*)p)[lane + 64 * j];
}
__device__ __forceinline__ float row_ss(const RowV& r) {
    float s = 0.f;
#pragma unroll
    for (int j = 0; j < 4; ++j) s += (r.v[j].x * r.v[j].x + r.v[j].y * r.v[j].y) + (r.v[j].z * r.v[j].z + r.v[j].w * r.v[j].w);
    return wave_sum(s);
}
__device__ __forceinline__ void row_modulate(RowV& r, float rstd, const float* g, const float* sh, const float* sc, int lane) {
#pragma unroll
    for (int j = 0; j < 4; ++j) { const f32x4 gv = ((const f32x4*)g)[lane + 64 * j], shv = ((const f32x4*)sh)[lane + 64 * j], scv = ((const f32x4*)sc)[lane + 64 * j];
        r.v[j] = r.v[j] * rstd * gv * (scv + 1.0f) + shv; }
}
__device__ __forceinline__ void row_store_bf16(const RowV& r, bf16* p, int lane) {
#pragma unroll
    for (int j = 0; j < 4; ++j) { u32x2 w; w.x = cvt_pk_bf16(r.v[j].x, r.v[j].y); w.y = cvt_pk_bf16(r.v[j].z, r.v[j].w); ((u32x2*)p)[lane + 64 * j] = w; }
}
__device__ __forceinline__ void row_load_bf16x(RowV& r, const bf16* p, int lane) {
#pragma unroll
    for (int j = 0; j < 4; ++j) { const u32x2 w = ((const u32x2*)p)[lane + 64 * j]; r.v[j] = (f32x4){bflo(w.x), bfhi(w.x), bflo(w.y), bfhi(w.y)}; }
}
__device__ __forceinline__ void row_store_fp8(const RowV& r, unsigned char* p, int lane) {
#pragma unroll
    for (int j = 0; j < 4; ++j) ((unsigned*)p)[lane + 64 * j] = pk4_fp8(r.v[j].x, r.v[j].y, r.v[j].z, r.v[j].w);
}
__device__ __forceinline__ void row_add_moe(RowV& r, const unsigned char* ys, int row, const float* gate, int lane) {
#pragma unroll
    for (int j = 0; j < 4; ++j) { f32x4 s = (f32x4){0.f, 0.f, 0.f, 0.f};
#pragma unroll
        for (int k = 0; k < 4; ++k) { const int w = ((const int*)(ys + (size_t)(row * 4 + k) * 1024))[lane + 64 * j];
            s.x += __builtin_amdgcn_cvt_f32_fp8(w, 0); s.y += __builtin_amdgcn_cvt_f32_fp8(w, 1); s.z += __builtin_amdgcn_cvt_f32_fp8(w, 2); s.w += __builtin_amdgcn_cvt_f32_fp8(w, 3); }
        const f32x4 gv = ((const f32x4*)gate)[lane + 64 * j]; r.v[j] = r.v[j] + gv * s * (1.f / YS_SCALE); }
}
__device__ __forceinline__ const float* src_row_l0(const Frame& F, int row) { return row < NLAT ? F.in[I_X] + (size_t)row * 1024 : F.in[I_CTX] + (size_t)(row - NLAT) * 1024; }

__device__ __forceinline__ void p_norm1_l0(Frame& F) {
    const int gw = F.bid * 8 + F.wave, NGW = F.G * 8;
    for (int row = gw; row < NTOK; row += NGW) {
        RowV r; row_load(r, src_row_l0(F, row), F.lane);
        const float rstd = 1.f / sqrtf(row_ss(r) * (1.f / 1024.f) + 1e-6f);
        row_modulate(r, rstd, F.in[I_N1G], mod_ptr(F, 0, row, 0), mod_ptr(F, 0, row, 1), F.lane);
        row_store_bf16(r, wsp<bf16>(F, WS_H) + (size_t)row * 1024, F.lane);
    }
}
__device__ __forceinline__ void p_combine_norm1_l1(Frame& F) {
    const int gw = F.bid * 8 + F.wave, NGW = F.G * 8;
    for (int row = gw; row < NTOK; row += NGW) {
        bf16* xp = wsp<bf16>(F, WS_X1) + (size_t)row * 1024;
        RowV r; row_load_bf16x(r, xp, F.lane);
        row_add_moe(r, wsp<const unsigned char>(F, WS_YS), row, mod_ptr(F, 0, row, 5), F.lane);
        row_store_bf16(r, xp, F.lane);
        const float rstd = 1.f / sqrtf(row_ss(r) * (1.f / 1024.f) + 1e-6f);
        row_modulate(r, rstd, F.in[I_N1G] + 1024, mod_ptr(F, 1, row, 0), mod_ptr(F, 1, row, 1), F.lane);
        row_store_fp8(r, wsp<unsigned char>(F, WS_H) + (size_t)row * 1024, F.lane);
    }
}
__device__ __forceinline__ void p_final(Frame& F) {
    const int gw = F.bid * 8 + F.wave, NGW = F.G * 8;
    for (int row = gw; row < NLAT; row += NGW) {
        RowV r; row_load_bf16x(r, wsp<const bf16>(F, WS_X1) + (size_t)row * 1024, F.lane);
        row_add_moe(r, wsp<const unsigned char>(F, WS_YS), row, mod_ptr(F, 1, row, 5), F.lane);
        const float rstd = 1.f / sqrtf(row_ss(r) * (1.f / 1024.f) + 1e-6f);
#pragma unroll
        for (int j = 0; j < 4; ++j) { const f32x4 gv = ((const f32x4*)F.in[I_FNG])[F.lane + 64 * j]; ((f32x4*)(F.out + (size_t)row * 1024))[F.lane + 64 * j] = r.v[j] * rstd * gv; }
    }
}

constexpr int RT_WS = 2064;
constexpr int RT_WHI = 0, RT_WLO = 32 * RT_WS;
constexpr int RT_TAB = 2 * 32 * RT_WS;
constexpr int RT_TABSZ = 8320;
constexpr int RT_LDS_CNT = RT_TAB + 2 * RT_TABSZ;
__device__ __forceinline__ void vb_tiles(int vb, int ntok, int& t0, int& nt) { const int ntile = ntok >> 5, q = ntile >> 8, r = ntile & 255; if (vb < r) { t0 = vb * (q + 1); nt = q + 1; } else { t0 = r * (q + 1) + (vb - r) * q; nt = q; } }
__device__ __forceinline__ void p_norm2_route(Frame& F, const int layer, const int ntok) {
    LAS unsigned char* L = F.lds;
    LAS int* cnt = (LAS int*)(L + RT_LDS_CNT);
    const int tid = F.tid, lane = F.lane, wave = F.wave, t = lane & 31, hi = lane >> 5;
    const float* rw = F.in[I_RW] + (size_t)layer * 1024 * 32;
    for (int idx = tid; idx < 1024 * 32; idx += 512) { const int k = idx >> 5, e = idx & 31; const float w = rw[idx]; const unsigned h = f2bf(w); const unsigned l = f2bf(w - bf2f(h));
        *(LAS unsigned short*)(L + RT_WHI + e * RT_WS + k * 2) = (unsigned short)h; *(LAS unsigned short*)(L + RT_WLO + e * RT_WS + k * 2) = (unsigned short)l; }
    unsigned char* rt = F.ws + WS_ROUTE;
    const float* g2 = F.in[I_N2G] + layer * 1024;
    const bf16* X = wsp<const bf16>(F, WS_X1); unsigned char* H8 = wsp<unsigned char>(F, WS_H);
    for (int vb = F.bid; vb < 256; vb += F.G) {
        int t0, nt; vb_tiles(vb, ntok, t0, nt);
        const int mr0 = mod_row(t0 * 32), mr1 = mod_row((t0 + nt) * 32 - 1);
        __syncthreads();
        if (tid < 32) cnt[tid] = 0;
        for (int sl = 0; sl < 2; ++sl) { const int mr = sl ? mr1 : mr0; LAS float* tb = (LAS float*)(L + RT_TAB + sl * RT_TABSZ);
            const float* shp = wsp<const float>(F, WS_MOD) + ((size_t)(layer * 9 + mr) * 6 + 3) * 1024; const float* scp = shp + 1024;
            for (int k = tid; k < 1024; k += 512) { tb[k] = g2[k] * (1.f + scp[k]); tb[1024 + k] = shp[k]; } }
        __syncthreads();
        for (int sl = 0; sl < 2; ++sl) { LAS float* tb = (LAS float*)(L + RT_TAB + sl * RT_TABSZ); LAS float* red = (LAS float*)(L + RT_LDS_CNT + 256);
            const int e = tid & 31, kp = tid >> 5; float sacc = 0.f;
            for (int k = kp * 64; k < kp * 64 + 64; ++k) sacc += tb[1024 + k] * rw[k * 32 + e];
            red[kp * 32 + e] = sacc; __syncthreads();
            if (tid < 32) { float c = F.in[I_RB][layer * 32 + tid]; for (int i = 0; i < 16; ++i) c += red[i * 32 + tid]; tb[2048 + tid] = c; }
            __syncthreads(); }
        for (int ti = wave; ti < nt; ti += 8) {
            const int tile = t0 + ti, row = tile * 32 + t; const int sl = (mod_row(tile * 32) == mr0) ? 0 : 1;
            const LAS float* tb = (const LAS float*)(L + RT_TAB + sl * RT_TABSZ);
            const bf16* xp = X + (size_t)row * 1024 + hi * 8;
            f32x16 acc;
#pragma unroll
            for (int r = 0; r < 16; ++r) acc[r] = 0.f;
            float ss = 0.f;
#pragma unroll 4
            for (int s = 0; s < 64; ++s) {
                const u32x4 xw = *(const u32x4*)(xp + s * 16); const f32x4 x0 = {bflo(xw.x), bfhi(xw.x), bflo(xw.y), bfhi(xw.y)}, x1 = {bflo(xw.z), bfhi(xw.z), bflo(xw.w), bfhi(xw.w)};
                const f32x4 g0 = *(const LAS f32x4*)(tb + s * 16 + hi * 8), g1 = *(const LAS f32x4*)(tb + s * 16 + hi * 8 + 4);
                ss += (x0.x * x0.x + x0.y * x0.y) + (x0.z * x0.z + x0.w * x0.w) + (x1.x * x1.x + x1.y * x1.y) + (x1.z * x1.z + x1.w * x1.w);
                const f32x4 y0 = x0 * g0, y1 = x1 * g1;
                u32x4 hh; hh.x = cvt_pk_bf16(y0.x, y0.y); hh.y = cvt_pk_bf16(y0.z, y0.w); hh.z = cvt_pk_bf16(y1.x, y1.y); hh.w = cvt_pk_bf16(y1.z, y1.w);
                u32x4 ll; ll.x = cvt_pk_bf16(y0.x - bflo(hh.x), y0.y - bfhi(hh.x)); ll.y = cvt_pk_bf16(y0.z - bflo(hh.y), y0.w - bfhi(hh.y)); ll.z = cvt_pk_bf16(y1.x - bflo(hh.z), y1.y - bfhi(hh.z)); ll.w = cvt_pk_bf16(y1.z - bflo(hh.w), y1.w - bfhi(hh.w));
                const bf16x8 xh = __builtin_bit_cast(bf16x8, hh), xl = __builtin_bit_cast(bf16x8, ll);
                const bf16x8 wh = *(const LAS bf16x8*)(L + RT_WHI + t * RT_WS + (s * 16 + hi * 8) * 2), wl = *(const LAS bf16x8*)(L + RT_WLO + t * RT_WS + (s * 16 + hi * 8) * 2);
                acc = __builtin_amdgcn_mfma_f32_32x32x16_bf16(wh, xh, acc, 0, 0, 0);
                acc = __builtin_amdgcn_mfma_f32_32x32x16_bf16(wh, xl, acc, 0, 0, 0);
                acc = __builtin_amdgcn_mfma_f32_32x32x16_bf16(wl, xh, acc, 0, 0, 0);
            }
            { auto rr = __builtin_amdgcn_permlane32_swap(__float_as_uint(ss), __float_as_uint(ss), false, false); ss = __uint_as_float(rr[0]) + __uint_as_float(rr[1]); }
            const float rstd = 1.f / sqrtf(ss * (1.f / 1024.f) + 1e-6f);
            float lg[32];
#pragma unroll
            for (int r = 0; r < 16; ++r) { auto rr = __builtin_amdgcn_permlane32_swap(__float_as_uint(acc[r]), __float_as_uint(acc[r]), false, false);
                const int e0 = (r & 3) + 8 * (r >> 2); lg[e0] = __uint_as_float(rr[0]) * rstd + tb[2048 + e0]; lg[e0 + 4] = __uint_as_float(rr[1]) * rstd + tb[2048 + e0 + 4]; }
            int se[4]; float sv[4];
#pragma unroll
            for (int k = 0; k < 4; ++k) { float best = lg[0]; int bi = 0;
#pragma unroll
                for (int e = 1; e < 32; ++e) { const bool gt = lg[e] > best; best = gt ? lg[e] : best; bi = gt ? e : bi; }
                se[k] = bi; sv[k] = best;
#pragma unroll
                for (int e = 0; e < 32; ++e) lg[e] = (e == bi) ? -3.0e38f : lg[e]; }
            const float e1 = __expf(sv[1] - sv[0]), e2 = __expf(sv[2] - sv[0]), e3 = __expf(sv[3] - sv[0]); const float inv = 1.f / (1.f + e1 + e2 + e3);
            if (hi == 0) {
                const float gk[4] = {inv, e1 * inv, e2 * inv, e3 * inv};
#pragma unroll
                for (int k = 0; k < 4; ++k) { const int pos = __hip_atomic_fetch_add(cnt + se[k], 1, __ATOMIC_RELAXED, __HIP_MEMORY_SCOPE_WORKGROUP);
                    rt[RT_E + (size_t)row * 4 + k] = (unsigned char)se[k]; ((unsigned short*)(rt + RT_POS))[(size_t)row * 4 + k] = (unsigned short)pos; ((float*)(rt + RT_GATE))[(size_t)row * 4 + k] = gk[k]; }
            }
            unsigned char* hp = H8 + (size_t)row * 1024 + hi * 8;
#pragma unroll 4
            for (int s = 0; s < 64; ++s) {
                const u32x4 xw = *(const u32x4*)(xp + s * 16); const f32x4 x0 = {bflo(xw.x), bfhi(xw.x), bflo(xw.y), bfhi(xw.y)}, x1 = {bflo(xw.z), bfhi(xw.z), bflo(xw.w), bfhi(xw.w)};
                const f32x4 g0 = *(const LAS f32x4*)(tb + s * 16 + hi * 8), g1 = *(const LAS f32x4*)(tb + s * 16 + hi * 8 + 4);
                const f32x4 h0 = *(const LAS f32x4*)(tb + 1024 + s * 16 + hi * 8), h1 = *(const LAS f32x4*)(tb + 1024 + s * 16 + hi * 8 + 4);
                const f32x4 y0 = x0 * rstd * g0 + h0, y1 = x1 * rstd * g1 + h1;
                *(u32x2*)(hp + s * 16) = (u32x2){pk4_fp8(y0.x, y0.y, y0.z, y0.w), pk4_fp8(y1.x, y1.y, y1.z, y1.w)};
            }
        }
        __syncthreads();
        if (tid < 32) ((unsigned*)(rt + RT_HIST))[vb * 32 + tid] = (unsigned)cnt[tid];
    }
    __syncthreads();
}
constexpr int MT_OFF = 131072 + 1024;
__device__ __forceinline__ void moe_tables(Frame& F) {
    LAS int* tab = (LAS int*)(F.lds + MT_OFF);
    LAS int* part = (LAS int*)(F.lds + MT_OFF + 8192 + 256);
    const unsigned* hist = (const unsigned*)(F.ws + WS_ROUTE + RT_HIST);
    { const int e = F.tid & 31, p = F.tid >> 5; int c = 0;
#pragma unroll
      for (int i = 0; i < 16; ++i) c += (int)hist[(p * 16 + i) * 32 + e];
      part[p * 32 + e] = c; }
    __syncthreads();
    if (F.tid < 32) { int c = 0;
#pragma unroll
        for (int p = 0; p < 16; ++p) c += part[p * 32 + F.tid];
        tab[32 + F.tid] = c; }
    __syncthreads();
    if (F.tid == 0) { int s = 0; for (int e = 0; e < 32; ++e) { tab[e] = s; s += ((tab[32 + e] + 255) >> 8) << 8; } tab[64] = s >> 8; }
    __syncthreads();
    if (F.tid < 32) { const int s0 = tab[F.tid] >> 8, nb = (tab[32 + F.tid] + 255) >> 8; for (int i = 0; i < nb; ++i) tab[128 + s0 + i] = F.tid; }
    __syncthreads();
}
__device__ __forceinline__ void p_moe_scatter(Frame& F, const int ntok) {
    moe_tables(F);
    LAS int* tab = (LAS int*)(F.lds + MT_OFF);
    LAS int* base = (LAS int*)(F.lds + MT_OFF + 8192);
    const unsigned* hist = (const unsigned*)(F.ws + WS_ROUTE + RT_HIST);
    const unsigned char* rt = F.ws + WS_ROUTE;
    unsigned* stok = wsp<unsigned>(F, WS_SORT); unsigned* sdst = stok + MAXSLOT; float* sgate = (float*)(sdst + MAXSLOT);
    for (int vb = F.bid; vb < 256; vb += F.G) {
        int t0, nt; vb_tiles(vb, ntok, t0, nt);
        if (F.tid < 32) { const LAS int* part = (const LAS int*)(F.lds + MT_OFF + 8192 + 256); int c = 0; for (int p = 0; p < (vb >> 4); ++p) c += part[p * 32 + F.tid];
            for (int b = vb & ~15; b < vb; ++b) c += (int)hist[b * 32 + F.tid]; base[F.tid] = tab[F.tid] + c; }
        __syncthreads();
        for (int i = F.tid; i < nt * 128; i += 512) {
            const int row = t0 * 32 + (i >> 2), k = i & 3; const size_t a = (size_t)row * 4 + k;
            const int e = rt[RT_E + a], pos = ((const unsigned short*)(rt + RT_POS))[a];
            const int slot = base[e] + pos;
            stok[slot] = (unsigned)row; sdst[slot] = (unsigned)(row * 4 + k); sgate[slot] = ((const float*)(rt + RT_GATE))[a];
        }
        if (vb < 32) { const int e = vb, c = tab[32 + e], s0 = tab[e] + c, s1 = tab[e] + (((c + 255) >> 8) << 8);
            for (int s = s0 + F.tid; s < s1; s += 512) { stok[s] = 0u; sdst[s] = (unsigned)YS_DUMMY; sgate[s] = 0.f; } }
        __syncthreads();
    }
}

namespace pg8 {
struct DenseSched {
    int nM, nN, nwg, G, c, KB; const bf16* Bt;
    __device__ __forceinline__ void init(int M, int N, int KB_, const void* Bt_, int G_, int c_) { nM = M / BM; nN = N / BM; nwg = nM * nN; G = G_; c = c_; KB = KB_; Bt = (const bf16*)Bt_; }
    __device__ __forceinline__ bool next(int i, Unit& u) const {
        const long L = (long)i * G + c; if (L >= nwg) return false;
        int wgid = (int)L; { const int q = nwg / 8, r = nwg % 8, xcd = wgid % 8, off = wgid / 8; wgid = (xcd < r ? xcd * (q + 1) : r * (q + 1) + (xcd - r) * q) + off; }
        const int nig = 8 * nN, gid = wgid / nig, fm = gid * 8, gsz = (nM - fm) < 8 ? (nM - fm) : 8;
        u.pm = fm + ((wgid % nig) % gsz); u.pn = (wgid % nig) / gsz; return true;
    }
    __device__ __forceinline__ void a_offs(const Unit& u, unsigned (&ao)[2][2], const int (&R)[2], const int (&C)[2]) const {
#pragma unroll
        for (int h = 0; h < 2; ++h)
#pragma unroll
            for (int i = 0; i < 2; ++i) ao[h][i] = (unsigned)((u.pm * BM + h * HALF + R[i]) * KB + C[i] * 2);
    }
    __device__ __forceinline__ const char* b_tile(const Unit& u) const { return (const char*)Bt + (size_t)u.pn * BM * KB; }
    __device__ __forceinline__ int ktiles(const Unit&, int ntdef) const { return ntdef; }
};
struct LrSched : DenseSched {
    __device__ __forceinline__ unsigned koff(const Unit& u) const { return u.pn < 8 ? 0u : 256u; }
    __device__ __forceinline__ void a_offs(const Unit& u, unsigned (&ao)[2][2], const int (&R)[2], const int (&C)[2]) const { DenseSched::a_offs(u, ao, R, C);
#pragma unroll
        for (int h = 0; h < 2; ++h)
#pragma unroll
            for (int i = 0; i < 2; ++i) ao[h][i] += koff(u); }
    __device__ __forceinline__ const char* b_tile(const Unit& u) const { return DenseSched::b_tile(u) + koff(u); }
    __device__ __forceinline__ int ktiles(const Unit& u, int) const { return u.pn < 8 ? 2 : 4; }
};
struct KvSched : DenseSched { __device__ __forceinline__ int ktiles(const Unit&, int) const { int n = 2; asm volatile("" : "+s"(n)); return n; } };
template <bool GATHER> struct MoeSched {
    int nrb, npn, G, c; const LAS int* blk_e; const unsigned* tok; const unsigned char* Wt; size_t wstride;
    __device__ __forceinline__ bool next(int i, Unit& u) const {
        if ((G & 7) != 0 || ((G >> 3) % npn) != 0) { const long L = (long)i * G + c; if (L >= (long)nrb * npn) return false; u.pm = (int)(L / npn); u.pn = (int)(L % npn); return true; }
        const int x = c & 7, y = c >> 3, per = (G >> 3) / npn;
        u.pm = (i * 8 + x) * per + y / npn; u.pn = y % npn; return u.pm < nrb;
    }
    __device__ __forceinline__ void a_offs(const Unit& u, unsigned (&ao)[2][2], const int (&R)[2], const int (&C)[2]) const {
#pragma unroll
        for (int h = 0; h < 2; ++h)
#pragma unroll
            for (int i = 0; i < 2; ++i) { const int slot = u.pm * BM + h * HALF + R[i]; const unsigned row = GATHER ? tok[slot] : (unsigned)slot; ao[h][i] = row * 1024u + (unsigned)C[i] * 2u; }
    }
    __device__ __forceinline__ const char* b_tile(const Unit& u) const { return (const char*)(Wt + (size_t)blk_e[u.pm] * wstride + (size_t)u.pn * BM * 1024); }
    __device__ __forceinline__ int ktiles(const Unit&, int ntdef) const { return ntdef; }
};

struct MapPlain { bf16* O; int ld; __device__ __forceinline__ bf16* operator()(int row, int col) const { return O + (size_t)row * ld + col; } };
constexpr float ATT_QPRE = 0.8329403702157812f;
struct EpiQ8 {
    static constexpr bool PERM = true; unsigned char* Q8; const f32x2* ROPE;
    __device__ __forceinline__ void operator()(const f32x4 (&acc)[2][2][4][2], const Unit& u, int wr, int wc, int fr, int fq) const {
#pragma unroll
        for (int ai = 0; ai < 2; ++ai)
#pragma unroll
            for (int m = 0; m < 4; ++m) { const int row = u.pm * BM + ai * HALF + wr * 64 + m * 16 + fr; const int b = row >> 13, t = row & 8191;
#pragma unroll
                for (int bj = 0; bj < 2; ++bj) { const int col = u.pn * BM + bj * HALF + wc * 32 + 8 * fq; float v[8];
#pragma unroll
                    for (int e = 0; e < 4; ++e) { v[e] = acc[ai][bj][m][0][e]; v[4 + e] = acc[ai][bj][m][1][e]; }
                    int h, d;
                    if (u.pn < 4) { h = col >> 7; d = col & 127; }
                    else { h = (col - 1024) >> 6; const int dr = (col - 1024) & 63; d = 128 + dr;
                        const f32x2* cs = ROPE + t * 32 + ((dr >> 5) << 4) + (dr & 8);
#pragma unroll
                        for (int e = 0; e < 8; ++e) { auto rr = __builtin_amdgcn_permlane32_swap(__float_as_uint(v[e]), __float_as_uint(v[e]), false, false);
                            const float pr = __uint_as_float(fq < 2 ? rr[1] : rr[0]); const f32x2 c = cs[e]; v[e] = (fq >= 2) ? v[e] * c.x + pr * c.y : v[e] * c.x - pr * c.y; } }
                    *(u32x2*)(Q8 + ((size_t)((b * 8 + h) * SEQ + t)) * QKD + d) = (u32x2){pk4_fp8(v[0] * ATT_QPRE, v[1] * ATT_QPRE, v[2] * ATT_QPRE, v[3] * ATT_QPRE), pk4_fp8(v[4] * ATT_QPRE, v[5] * ATT_QPRE, v[6] * ATT_QPRE, v[7] * ATT_QPRE)}; } }
    }
};
struct EpiKV8 {
    static constexpr bool PERM = true; unsigned char* K8; unsigned char* VT;
    __device__ __forceinline__ void operator()(const f32x4 (&acc)[2][2][4][2], const Unit& u, int wr, int wc, int fr, int fq) const {
#pragma unroll
        for (int ai = 0; ai < 2; ++ai)
#pragma unroll
            for (int m = 0; m < 4; ++m) { const int row = u.pm * BM + ai * HALF + wr * 64 + m * 16 + fr;
                const int b = row < NLAT ? (row >> 13) : ((row - NLAT) >> 8), key = row < NLAT ? CTXL + (row & 8191) : ((row - NLAT) & 255), h = u.pn;
                { const f32x4 v0 = acc[ai][0][m][0], v1 = acc[ai][0][m][1];
                  *(u32x2*)(K8 + ((size_t)((b * 8 + h) * NKEY + key)) * K8ROW + wc * 32 + 8 * fq) = (u32x2){pk4_fp8(v0[0], v0[1], v0[2], v0[3]), pk4_fp8(v1[0], v1[1], v1[2], v1[3])}; }
                { const int k6 = key & 63, kk = k6 & 31, p = 32 * ((kk >> 2) & 1) + (k6 >> 5) * 16 + (kk & 3) + 4 * (kk >> 3);
                  unsigned char* tb = VT + ((size_t)(b * 8 + h) * (NKEY / 64) + (key >> 6)) * 8192 + (p & 15); const int c0 = wc * 32 + 8 * fq, ch = p >> 4;
                  const unsigned w0 = pk4_fp8(acc[ai][1][m][0][0], acc[ai][1][m][0][1], acc[ai][1][m][0][2], acc[ai][1][m][0][3]), w1 = pk4_fp8(acc[ai][1][m][1][0], acc[ai][1][m][1][1], acc[ai][1][m][1][2], acc[ai][1][m][1][3]);
#pragma unroll
                  for (int e = 0; e < 8; ++e) { const int c = c0 + e; tb[c * 64 + ((ch ^ ((c >> 2) & 3)) << 4)] = (unsigned char)(((e < 4 ? w0 : w1) >> (8 * (e & 3))) & 0xffu); } } }
    }
};
template <class Map> struct EpiBf16 {
    static constexpr bool PERM = true; Map map;
    __device__ __forceinline__ void operator()(const f32x4 (&acc)[2][2][4][2], const Unit& u, int wr, int wc, int fr, int fq) const {
#pragma unroll
        for (int ai = 0; ai < 2; ++ai)
#pragma unroll
            for (int m = 0; m < 4; ++m) { const int row = u.pm * BM + ai * HALF + wr * 64 + m * 16 + fr;
#pragma unroll
                for (int bj = 0; bj < 2; ++bj) { const int col = u.pn * BM + bj * HALF + wc * 32 + 8 * fq; const f32x4 v0 = acc[ai][bj][m][0], v1 = acc[ai][bj][m][1];
                    u32x4 w; w.x = cvt_pk_bf16(v0[0], v0[1]); w.y = cvt_pk_bf16(v0[2], v0[3]); w.z = cvt_pk_bf16(v1[0], v1[1]); w.w = cvt_pk_bf16(v1[2], v1[3]);
                    *(u32x4*)map(row, col) = w; } }
    }
};
struct EpiF32 {
    static constexpr bool PERM = false; float* C; int ldc;
    __device__ __forceinline__ void operator()(const f32x4 (&acc)[2][2][4][2], const Unit& u, int wr, int wc, int fr, int fq) const {
#pragma unroll
        for (int ai = 0; ai < 2; ++ai)
#pragma unroll
            for (int m = 0; m < 4; ++m) { float* rowp = C + (size_t)(u.pm * BM + ai * HALF + wr * 64 + m * 16 + fr) * ldc + u.pn * BM + wc * 32 + 4 * fq;
#pragma unroll
                for (int bj = 0; bj < 2; ++bj)
#pragma unroll
                    for (int n = 0; n < 2; ++n) *(f32x4*)(rowp + bj * HALF + n * 16) = acc[ai][bj][m][n]; }
    }
};
struct EpiResid {
    static constexpr bool PERM = false; bf16* X1; const float* xlat; const float* xctx; const float* mod; int layer;
    __device__ __forceinline__ void operator()(const f32x4 (&acc)[2][2][4][2], const Unit& u, int wr, int wc, int fr, int fq) const {
#pragma unroll
        for (int ai = 0; ai < 2; ++ai)
#pragma unroll
            for (int m = 0; m < 4; ++m) { const int row = u.pm * BM + ai * HALF + wr * 64 + m * 16 + fr; const int col0 = u.pn * BM + wc * 32 + 4 * fq;
                const float* bp = row < NLAT ? xlat + (size_t)row * 1024 : xctx + (size_t)(row - NLAT) * 1024;
                const float* gp = mod + ((size_t)(layer * 9 + (row < NLAT ? (row >> 13) : 8)) * 6 + 2) * 1024;
                bf16* op = X1 + (size_t)row * 1024;
#pragma unroll
                for (int bj = 0; bj < 2; ++bj)
#pragma unroll
                    for (int n = 0; n < 2; ++n) { const int c = col0 + bj * HALF + n * 16; f32x4 base;
                        if (layer == 0) base = *(const f32x4*)(bp + c); else { const u32x2 bw = *(const u32x2*)(op + c); base = (f32x4){bflo(bw.x), bfhi(bw.x), bflo(bw.y), bfhi(bw.y)}; }
                        const f32x4 v = base + *(const f32x4*)(gp + c) * acc[ai][bj][m][n];
                        *(u32x2*)(op + c) = (u32x2){cvt_pk_bf16(v.x, v.y), cvt_pk_bf16(v.z, v.w)}; } }
    }
};
struct EpiSwiglu {
    static constexpr bool PERM = true; unsigned char* ACT; const float* bgu; const LAS int* blk_e;
    __device__ __forceinline__ void operator()(const f32x4 (&acc)[2][2][4][2], const Unit& u, int wr, int wc, int fr, int fq) const {
        const int e = blk_e[u.pm]; const int c0 = u.pn * 128 + wc * 32 + 8 * fq;
        const float* bg = bgu + (size_t)e * 2048 + c0;
        f32x4 bgl[2], bln[2];
#pragma unroll
        for (int n = 0; n < 2; ++n) { bgl[n] = *(const f32x4*)(bg + 4 * n); bln[n] = *(const f32x4*)(bg + 1024 + 4 * n); }
#pragma unroll
        for (int ai = 0; ai < 2; ++ai)
#pragma unroll
            for (int m = 0; m < 4; ++m) { const int slot = u.pm * BM + ai * HALF + wr * 64 + m * 16 + fr; float o[8];
#pragma unroll
                for (int n = 0; n < 2; ++n)
#pragma unroll
                    for (int j = 0; j < 4; ++j) { const float xg = fminf(acc[ai][0][m][n][j] + bgl[n][j], 7.0f); const float xl = fminf(fmaxf(acc[ai][1][m][n][j] + bln[n][j], -7.0f), 7.0f);
                        o[n * 4 + j] = xg * __builtin_amdgcn_rcpf(1.f + __expf(-1.702f * xg)) * (xl + 1.0f); }
                *(u32x2*)(ACT + (size_t)slot * 1024 + c0) = (u32x2){pk4_fp8(o[0], o[1], o[2], o[3]), pk4_fp8(o[4], o[5], o[6], o[7])}; }
    }
};
struct EpiDown {
    static constexpr bool PERM = true; unsigned char* YS; const float* bdn; const LAS int* blk_e; const unsigned* dst; const float* gate;
    __device__ __forceinline__ void operator()(const f32x4 (&acc)[2][2][4][2], const Unit& u, int wr, int wc, int fr, int fq) const {
        const int e = blk_e[u.pm]; const int c0 = u.pn * BM + wc * 32 + 8 * fq;
        f32x4 bv[2][2];
#pragma unroll
        for (int bj = 0; bj < 2; ++bj)
#pragma unroll
            for (int n = 0; n < 2; ++n) bv[bj][n] = *(const f32x4*)(bdn + (size_t)e * 1024 + c0 + bj * HALF + 4 * n);
#pragma unroll
        for (int ai = 0; ai < 2; ++ai)
#pragma unroll
            for (int m = 0; m < 4; ++m) { const int slot = u.pm * BM + ai * HALF + wr * 64 + m * 16 + fr; const float g = gate[slot] * YS_SCALE; unsigned char* op = YS + (size_t)dst[slot] * 1024 + c0;
#pragma unroll
                for (int bj = 0; bj < 2; ++bj) { const f32x4 v0 = (acc[ai][bj][m][0] + bv[bj][0]) * g, v1 = (acc[ai][bj][m][1] + bv[bj][1]) * g;
                    *(u32x2*)(op + bj * HALF) = (u32x2){pk4_fp8(v0[0], v0[1], v0[2], v0[3]), pk4_fp8(v1[0], v1[1], v1[2], v1[3])}; } }
    }
};
}

__device__ __forceinline__ float ldbf(const bf16* p) { return bf2f((unsigned)*p); }
__device__ __forceinline__ void seq_pos(int row, bool& hp, bool& hn) { if (row < NLAT) { const int t = row & 8191; hp = t > 0; hn = t < SEQ - 1; } else { const int t = (row - NLAT) & 255; hp = t > 0; hn = t < CTXL - 1; } }

__device__ __forceinline__ void p_alr(Frame& F) {
    const int gw = F.bid * 8 + F.wave, NGW = F.G * 8;
    const bf16* P = wsp<const bf16>(F, WS_P); bf16* A = wsp<bf16>(F, WS_ALR); const float* mu = F.in[I_MU];
    for (int row = gw; row < NTOK; row += NGW) {
        bool hp, hn; seq_pos(row, hp, hn);
        const bf16* pr = P + (size_t)row * PW + RW0 + 1536;
#pragma unroll
        for (int q = 0; q < 6; ++q) { const int c = F.lane + 64 * q; float o = 0.f;
            if (c < 288) { const float p0 = ldbf(pr + c), pm = hp ? ldbf(pr + c - PW) : 0.f, pn = hn ? ldbf(pr + c + PW) : 0.f;
                const float xs = p0 + mu[1536 + c] * (pm - p0) + mu[RW_COLS + 1536 + c] * (pn - p0);
                o = c < 64 ? (1.f - 2.f * __builtin_amdgcn_rcpf(1.f + __expf(2.f * xs))) : (c < 128 ? xs : __builtin_amdgcn_rcpf(1.f + __expf(-xs))); }
            A[(size_t)row * LRK + c] = (bf16)f2bf(o); }
    }
}

constexpr int GL_QRAW = 0, GL_KRAW = 8192, GL_GDS = 16384, GL_QD = 20480, GL_KI = 29696, GL_KE = 38912, GL_AT = 48128, GL_VT = 57344, GL_ST = 61952, GL_GSUM = 71168, GL_DEC = 73216;
constexpr int GL_RS = 144;
__device__ __forceinline__ bf16x8 lds_frag(const LAS unsigned char* base, int row, int kbyte) { return *(const LAS bf16x8*)(base + row * GL_RS + kbyte); }
constexpr int GW_UNIT = 24832;
constexpr int GW_QD = 0, GW_KE = 8192, GW_AT = 16384, GW_DEC = 24576;
#define GLA_ROWF(b, dir, n, i) ((n) < 4 ? NLAT + (b) * 256 + ((dir) ? 3 - (n) : (n)) * 64 + ((dir) ? 63 - (i) : (i)) : (b) * 8192 + ((dir) ? 127 - ((n) - 4) : ((n) - 4)) * 64 + ((dir) ? 63 - (i) : (i)))
__device__ __forceinline__ void p_gla_pre(Frame& F) {
    LAS unsigned char* L = F.lds;
    const bf16* P = wsp<const bf16>(F, WS_P); unsigned char* GW = F.ws + WS_X1;
    const int tid = F.tid, lane = F.lane, wave = F.wave, r32 = lane & 31, hi = lane >> 5;
    const int dk = lane, tg = wave;
    constexpr int NU = NB * 4 * 2 * 132;
    bf16x8 qv, kv, gv;
#define GP_LOAD(u) do { const int n_ = (u) % 132, d_ = ((u) / 132) & 1, h_ = ((u) / 264) & 3, b_ = (u) / 1056; const bf16* rp = P + (size_t)GLA_ROWF(b_, d_, n_, tid >> 3) * PW; \
        qv = *(const bf16x8*)(rp + h_ * 64 + (tid & 7) * 8); kv = *(const bf16x8*)(rp + 256 + h_ * 64 + (tid & 7) * 8); \
        if (tid < 128) gv = *(const bf16x8*)(P + (size_t)GLA_ROWF(b_, d_, n_, tid >> 1) * PW + 1536 + (tid & 1) * 8); } while (0)
    if (F.bid < NU) GP_LOAD(F.bid);
    for (int u = F.bid; u < NU; u += F.G) {
        const int dir = (u / 132) & 1, h = (u / 264) & 3;
        float gkw[16];
#pragma unroll
        for (int r = 0; r < 16; ++r) gkw[r] = F.in[I_GKUP][(size_t)(dir * 16 + r) * 256 + h * 64 + dk];
        const float gkb = F.in[I_GKB][dir * 256 + h * 64 + dk];
        unsigned char* gw = GW + (size_t)u * GW_UNIT;
        *(LAS bf16x8*)(L + GL_QRAW + (tid >> 3) * 128 + (tid & 7) * 16) = qv;
        *(LAS bf16x8*)(L + GL_KRAW + (tid >> 3) * 128 + (tid & 7) * 16) = kv;
        if (tid < 128) { LAS float* gp = (LAS float*)(L + GL_GDS) + (tid >> 1) * 16 + (tid & 1) * 8;
#pragma unroll
            for (int e = 0; e < 8; ++e) gp[e] = bf2f((unsigned)(unsigned short)gv[e]); }
        __syncthreads();
        if (u + F.G < NU) GP_LOAD(u + F.G);
        float Gl[8]; float cum = 0.f;
#pragma unroll
        for (int ii = 0; ii < 8; ++ii) { const LAS float* gp = (const LAS float*)(L + GL_GDS) + (tg * 8 + ii) * 16; float x = gkb;
#pragma unroll
            for (int r = 0; r < 16; ++r) x += gp[r] * gkw[r];
            const float ls = fminf(x, 0.f) - __logf(1.f + __expf(-fabsf(x)));
            cum += ls * (1.f / 16.f); Gl[ii] = cum; }
        ((LAS float*)(L + GL_GSUM))[tg * 64 + dk] = cum;
        __syncthreads();
        float off = 0.f, tot = 0.f;
#pragma unroll
        for (int t2 = 0; t2 < 8; ++t2) { const float gs = ((const LAS float*)(L + GL_GSUM))[t2 * 64 + dk]; tot += gs; off += (t2 < tg) ? gs : 0.f; }
        unsigned kep[4]; const float etot = __expf(tot);
#pragma unroll
        for (int ii = 0; ii < 8; ii += 2) { float kev[2];
#pragma unroll
            for (int z = 0; z < 2; ++z) { const int i = tg * 8 + ii + z; const float G = off + Gl[ii + z];
                const float q = bf2f((unsigned)*(const LAS unsigned short*)(L + GL_QRAW + i * 128 + dk * 2)), k = bf2f((unsigned)*(const LAS unsigned short*)(L + GL_KRAW + i * 128 + dk * 2));
                const float eg = __expf(G), ieg = __builtin_amdgcn_rcpf(eg);
                const unsigned short qd = (unsigned short)f2bf(q * 0.125f * eg);
                *(LAS unsigned short*)(L + GL_QD + i * GL_RS + dk * 2) = qd; *(unsigned short*)(gw + GW_QD + i * 128 + dk * 2) = qd;
                *(LAS unsigned short*)(L + GL_KI + i * GL_RS + dk * 2) = (unsigned short)f2bf(k * ieg);
                kev[z] = k * (etot * ieg); }
            kep[ii >> 1] = cvt_pk_bf16(kev[0], kev[1]); }
        *(u32x4*)(gw + GW_KE + dk * 128 + tg * 16) = (u32x4){kep[0], kep[1], kep[2], kep[3]};
        if (tg == 0) ((float*)(gw + GW_DEC))[dk] = etot;
        __syncthreads();
        if (wave < 4) { const int tj = wave & 1, ti = wave >> 1;
            f32x16 acc;
#pragma unroll
            for (int r = 0; r < 16; ++r) acc[r] = 0.f;
            if (!(ti == 0 && tj == 1)) {
#pragma unroll
                for (int ks = 0; ks < 4; ++ks) acc = __builtin_amdgcn_mfma_f32_32x32x16_bf16(lds_frag(L + GL_KI, tj * 32 + r32, ks * 32 + hi * 16), lds_frag(L + GL_QD, ti * 32 + r32, ks * 32 + hi * 16), acc, 0, 0, 0);
            }
            const int i = ti * 32 + r32;
#pragma unroll
            for (int g = 0; g < 4; ++g) { const int j0 = tj * 32 + 8 * g + 4 * hi; float v4[4];
#pragma unroll
                for (int z = 0; z < 4; ++z) v4[z] = (j0 + z <= i) ? acc[4 * g + z] : 0.f;
                *(u32x2*)(gw + GW_AT + i * 128 + j0 * 2) = (u32x2){cvt_pk_bf16(v4[0], v4[1]), cvt_pk_bf16(v4[2], v4[3])}; } }
        __syncthreads();
    }
#undef GP_LOAD
}
__device__ __forceinline__ void p_gla_scan(Frame& F) {
    LAS unsigned char* L = F.lds;
    const bf16* P = wsp<const bf16>(F, WS_P); const unsigned char* GW = F.ws + WS_X1;
    const int tid = F.tid, lane = F.lane, wave = F.wave, r32 = lane & 31, hi = lane >> 5;
    for (int id = F.bid; id < 256; id += F.G) {
        const int xj_ = id >> 3, gg_ = (xj_ >> 2) + 8 * (id & 7); const int b = gg_ >> 3, h = (gg_ >> 1) & 3, dir = gg_ & 1, vs = xj_ & 3;
        const unsigned char* gwb = GW + (size_t)(((b * 4 + h) * 2 + dir) * 132) * GW_UNIT;
        f32x16 Sacc;
#pragma unroll
        for (int r = 0; r < 16; ++r) Sacc[r] = 0.f;
        for (int i = tid; i < 4608 / 4; i += 512) ((LAS unsigned*)(L + GL_ST))[i] = 0u;
        u32x4 t0, t1, t2, dv; bf16x8 vv;
#define GS_LOAD(n) do { const unsigned char* gu = gwb + (size_t)(n) * GW_UNIT + tid * 16; t0 = *(const u32x4*)(gu); t1 = *(const u32x4*)(gu + 8192); t2 = *(const u32x4*)(gu + 16384); \
        if (tid < 16) dv = *(const u32x4*)(gwb + (size_t)(n) * GW_UNIT + GW_DEC + tid * 16); \
        if (tid < 256) vv = *(const bf16x8*)(P + (size_t)GLA_ROWF(b, dir, n, tid >> 2) * PW + 512 + h * 128 + vs * 32 + (tid & 3) * 8); } while (0)
        GS_LOAD(0);
        __syncthreads();
        for (int n = 0; n < 132; ++n) {
            { const int row = tid >> 3, c16 = (tid & 7) * 16;
              *(LAS u32x4*)(L + GL_QD + row * GL_RS + c16) = t0; *(LAS u32x4*)(L + GL_KE + row * GL_RS + c16) = t1; *(LAS u32x4*)(L + GL_AT + row * GL_RS + c16) = t2; }
            if (tid < 16) *(LAS u32x4*)(L + GL_DEC + tid * 16) = dv;
            if (tid < 256) { const int i = tid >> 2;
#pragma unroll
                for (int e = 0; e < 8; ++e) *(LAS unsigned short*)(L + GL_VT + ((tid & 3) * 8 + e) * GL_RS + i * 2) = (unsigned short)vv[e]; }
            __syncthreads();
            if (n + 1 < 132) GS_LOAD(n + 1);
            const LAS unsigned char* STc = L + GL_ST + (n & 1) * 4608; LAS unsigned char* STn = L + GL_ST + ((n + 1) & 1) * 4608;
            if (wave < 2) {
                const int ti = wave; f32x16 acc;
#pragma unroll
                for (int r = 0; r < 16; ++r) acc[r] = 0.f;
#pragma unroll
                for (int ks = 0; ks < 4; ++ks) acc = __builtin_amdgcn_mfma_f32_32x32x16_bf16(lds_frag(L + GL_AT, ti * 32 + r32, ks * 32 + hi * 16), lds_frag(L + GL_VT, r32, ks * 32 + hi * 16), acc, 0, 0, 0);
#pragma unroll
                for (int ks = 0; ks < 4; ++ks) acc = __builtin_amdgcn_mfma_f32_32x32x16_bf16(lds_frag(L + GL_QD, ti * 32 + r32, ks * 32 + hi * 16), lds_frag(STc, r32, ks * 32 + hi * 16), acc, 0, 0, 0);
                bf16* O = wsp<bf16>(F, WS_GLAO) + (size_t)dir * NTOK * 512 + h * 128 + vs * 32 + r32;
#pragma unroll
                for (int r = 0; r < 16; ++r) { const int i = ti * 32 + (r & 3) + 8 * (r >> 2) + 4 * hi; O[(size_t)GLA_ROWF(b, dir, n, i) * 512] = (bf16)f2bf(acc[r]); }
            } else if (wave < 4) {
                const int dt = wave - 2;
#pragma unroll
                for (int g = 0; g < 4; ++g) { const f32x4 dvv = *(const LAS f32x4*)(L + GL_DEC + (dt * 32 + 8 * g + 4 * hi) * 4);
#pragma unroll
                    for (int z = 0; z < 4; ++z) Sacc[4 * g + z] *= dvv[z]; }
#pragma unroll
                for (int ks = 0; ks < 4; ++ks) Sacc = __builtin_amdgcn_mfma_f32_32x32x16_bf16(lds_frag(L + GL_KE, dt * 32 + r32, ks * 32 + hi * 16), lds_frag(L + GL_VT, r32, ks * 32 + hi * 16), Sacc, 0, 0, 0);
#pragma unroll
                for (int g = 0; g < 4; ++g) *(LAS u32x2*)(STn + r32 * GL_RS + (dt * 32 + 8 * g + 4 * hi) * 2) = (u32x2){cvt_pk_bf16(Sacc[4 * g], Sacc[4 * g + 1]), cvt_pk_bf16(Sacc[4 * g + 2], Sacc[4 * g + 3])};
            }
            __syncthreads();
        }
#undef GS_LOAD
    }
}
__device__ __forceinline__ void wave_sum4(float& a, float& b, float& c, float& d) {
#define WS4_STEP(ctl) "v_add_f32_dpp %0, %0, %0 " ctl "\n\tv_add_f32_dpp %1, %1, %1 " ctl "\n\tv_add_f32_dpp %2, %2, %2 " ctl "\n\tv_add_f32_dpp %3, %3, %3 " ctl "\n\t"
    asm volatile("s_nop 1\n\t"
                 WS4_STEP("quad_perm:[1,0,3,2] row_mask:0xf bank_mask:0xf")
                 WS4_STEP("quad_perm:[2,3,0,1] row_mask:0xf bank_mask:0xf")
                 WS4_STEP("row_half_mirror row_mask:0xf bank_mask:0xf")
                 WS4_STEP("row_mirror row_mask:0xf bank_mask:0xf")
                 WS4_STEP("row_bcast:15 row_mask:0xa bank_mask:0xf")
                 WS4_STEP("row_bcast:31 row_mask:0xc bank_mask:0xf")
                 "s_nop 0"
                 : "+v"(a), "+v"(b), "+v"(c), "+v"(d));
#undef WS4_STEP
    a = __builtin_bit_cast(float, __builtin_amdgcn_readlane(__builtin_bit_cast(int, a), 63)); b = __builtin_bit_cast(float, __builtin_amdgcn_readlane(__builtin_bit_cast(int, b), 63));
    c = __builtin_bit_cast(float, __builtin_amdgcn_readlane(__builtin_bit_cast(int, c), 63)); d = __builtin_bit_cast(float, __builtin_amdgcn_readlane(__builtin_bit_cast(int, d), 63));
}
#define LDS_BARRIER() asm volatile("s_waitcnt lgkmcnt(0)\n\ts_barrier" ::: "memory")
__device__ __forceinline__ void red16x2(float& a, float& b) {
    asm volatile("s_nop 1\n\t"
                 "v_add_f32_dpp %0, %0, %0 quad_perm:[1,0,3,2] row_mask:0xf bank_mask:0xf\n\t"
                 "v_add_f32_dpp %1, %1, %1 quad_perm:[1,0,3,2] row_mask:0xf bank_mask:0xf\n\t"
                 "s_nop 0\n\t"
                 "v_add_f32_dpp %0, %0, %0 quad_perm:[2,3,0,1] row_mask:0xf bank_mask:0xf\n\t"
                 "v_add_f32_dpp %1, %1, %1 quad_perm:[2,3,0,1] row_mask:0xf bank_mask:0xf\n\t"
                 "s_nop 0\n\t"
                 "v_add_f32_dpp %0, %0, %0 row_half_mirror row_mask:0xf bank_mask:0xf\n\t"
                 "v_add_f32_dpp %1, %1, %1 row_half_mirror row_mask:0xf bank_mask:0xf\n\t"
                 "s_nop 0\n\t"
                 "v_add_f32_dpp %0, %0, %0 row_mirror row_mask:0xf bank_mask:0xf\n\t"
                 "v_add_f32_dpp %1, %1, %1 row_mirror row_mask:0xf bank_mask:0xf"
                 : "+v"(a), "+v"(b));
}
__device__ __forceinline__ void red8x2(float& a, float& b) {
    asm volatile("s_nop 1\n\t"
                 "v_add_f32_dpp %0, %0, %0 quad_perm:[1,0,3,2] row_mask:0xf bank_mask:0xf\n\t"
                 "v_add_f32_dpp %1, %1, %1 quad_perm:[1,0,3,2] row_mask:0xf bank_mask:0xf\n\t"
                 "s_nop 0\n\t"
                 "v_add_f32_dpp %0, %0, %0 quad_perm:[2,3,0,1] row_mask:0xf bank_mask:0xf\n\t"
                 "v_add_f32_dpp %1, %1, %1 quad_perm:[2,3,0,1] row_mask:0xf bank_mask:0xf\n\t"
                 "s_nop 0\n\t"
                 "v_add_f32_dpp %0, %0, %0 row_half_mirror row_mask:0xf bank_mask:0xf\n\t"
                 "v_add_f32_dpp %1, %1, %1 row_half_mirror row_mask:0xf bank_mask:0xf"
                 : "+v"(a), "+v"(b));
}
constexpr int RW_T = 32;
constexpr int RW_SS = 392;
constexpr int RW_BUF = RW_T * RW_SS * 4;
constexpr int RW_YB = 2 * RW_BUF;
constexpr int RW_YBSZ = 32 * 33 * 4;
__device__ __forceinline__ void p_rwkv_scan(Frame& F) {
    LAS unsigned char* L = F.lds;
    const bf16* P = wsp<const bf16>(F, WS_P); const bf16* LO = wsp<const bf16>(F, WS_LOUT);
    const int lane = F.lane, wave = F.wave;
    constexpr int NRD = (CTXL + SEQ) / RW_T;
    for (int id = F.bid; id < 256; id += F.G) {
        const int xj_ = id >> 3, gg_ = (xj_ >> 1) + 16 * (id & 7); const int b = gg_ >> 4, h = (gg_ >> 1) & 7, dir = gg_ & 1, rh = xj_ & 1;
#define RW_ROW(s) ((s) < 256 ? NLAT + b * 256 + (dir ? 255 - (s) : (s)) : b * 8192 + (dir ? 8191 - ((s) - 256) : ((s) - 256)))
        if (wave >= 4) {
            const int pw = wave - 4, hj = h * 64 + lane;
            const float* mu = F.in[I_MU];
            const float cpr = mu[hj], cnr = mu[RW_COLS + hj], cpk = mu[512 + hj], cnk = mu[RW_COLS + 512 + hj], cpv = mu[1024 + hj], cnv = mu[RW_COLS + 1024 + hj];
            const float w0v = F.in[I_W0][dir * 512 + hj], a0v = F.in[I_A0][dir * 512 + hj], kkc = F.in[I_KK][hj], kac = F.in[I_KA][hj], rkc = F.in[I_RK][hj];
            unsigned xa[30], la[16], xb[30], lb[16];
#define RW_LOAD(rd, X, Lr) do { const int s0_ = (rd) * RW_T + pw * 8; const bool lo_ok = (s0_ != 0) && (s0_ != 256), hi_ok = (s0_ + 8 != 256) && (s0_ + 8 != NKEY); \
                const long sgn_ = dir ? -(long)PW : (long)PW; const bf16* pr0 = P + (size_t)RW_ROW(s0_) * PW + RW0 + hj; \
                _Pragma("unroll") for (int pp = -1; pp < 9; ++pp) { const int pc = (pp < 0 && !lo_ok) ? 0 : ((pp > 7 && !hi_ok) ? 7 : pp); const bf16* pr = pr0 + sgn_ * pc; \
                    X[3 * (pp + 1)] = pr[0]; X[3 * (pp + 1) + 1] = pr[512]; X[3 * (pp + 1) + 2] = pr[1024]; } \
                const long sgl_ = dir ? -(long)LRN : (long)LRN; const bf16* lr0 = LO + (size_t)RW_ROW(s0_) * LRN + dir * 512 + hj; \
                _Pragma("unroll") for (int pp = 0; pp < 8; ++pp) { Lr[2 * pp] = lr0[sgl_ * pp]; Lr[2 * pp + 1] = lr0[sgl_ * pp + 1024]; } } while (0)
#define RW_FEAT(rd, X, Lr) do { const int s0_ = (rd) * RW_T + pw * 8; const bool lo_ok = (s0_ != 0) && (s0_ != 256), hi_ok = (s0_ + 8 != 256) && (s0_ + 8 != NKEY); \
                const int row0_ = RW_ROW(s0_); \
                _Pragma("unroll") for (int q = 0; q < 8; ++q) { const int st = pw * 8 + q; \
                const bool vlo = (q > 0) || lo_ok, vhi = (q < 7) || hi_ok; const bool hp = dir ? vhi : vlo, hn = dir ? vlo : vhi; \
                  \
                const unsigned pr_ = dir ? X[3 * (q + 2)] : X[3 * q], nr_ = dir ? X[3 * q] : X[3 * (q + 2)], pk_ = dir ? X[3 * (q + 2) + 1] : X[3 * q + 1], nk_ = dir ? X[3 * q + 1] : X[3 * (q + 2) + 1], pv_ = dir ? X[3 * (q + 2) + 2] : X[3 * q + 2], nv_ = dir ? X[3 * q + 2] : X[3 * (q + 2) + 2]; \
                const float r0 = bf2f(X[3 * (q + 1)]), k0 = bf2f(X[3 * (q + 1) + 1]), v0 = bf2f(X[3 * (q + 1) + 2]); \
                const float xr = r0 + cpr * ((hp ? bf2f(pr_) : 0.f) - r0) + cnr * ((hn ? bf2f(nr_) : 0.f) - r0); \
                const float xk = k0 + cpk * ((hp ? bf2f(pk_) : 0.f) - k0) + cnk * ((hn ? bf2f(nk_) : 0.f) - k0); \
                const float xv = v0 + cpv * ((hp ? bf2f(pv_) : 0.f) - v0) + cnv * ((hn ? bf2f(nv_) : 0.f) - v0); \
                  \
                const float sg = __builtin_amdgcn_rcpf(1.f + __expf(-(w0v + bf2f(Lr[2 * q])))); \
                const float wdec = __expf(-0.60653066f * sg); \
                const float alr = __builtin_amdgcn_rcpf(1.f + __expf(-(a0v + bf2f(Lr[2 * q + 1])))); \
                const float kkv = xk * kkc; const float kd = xk * (1.f + (alr - 1.f) * kac); \
                float n2 = kkv * kkv, bon = xr * kd * rkc, kr = kd * xr, br = kkv * alr * xr; \
                wave_sum4(n2, bon, kr, br); \
                const float rn = __builtin_amdgcn_rsqf(fmaxf(n2, 1e-24f)); const float kk = kkv * rn; const float bb = kk * alr; br *= rn; \
                if (rh == 0 && lane == 0) wsp<float>(F, WS_BONUS)[((size_t)dir * NTOK + (dir ? row0_ - q : row0_ + q)) * 8 + h] = bon; \
                LAS float* o = (LAS float*)(L + ((rd) & 1) * RW_BUF) + st * RW_SS; \
                o[lane] = wdec; o[64 + lane] = -kk; o[128 + lane] = bb; o[192 + lane] = kd; o[256 + lane] = wdec * xr; o[320 + lane] = xv; \
                if (lane == 0) { o[384] = br; o[385] = kr; } } } while (0)
#define RW_YOUT(rd) do { const LAS float* yb = (const LAS float*)(L + RW_YB + ((rd) & 1) * RW_YBSZ); _Pragma("unroll") for (int e = 0; e < 2; ++e) { const int pt = pw * 64 + lane, st = (pt >> 4) + 16 * e, r2 = (pt & 15) * 2; const int s = (rd) * RW_T + st; \
                *(unsigned*)(wsp<bf16>(F, WS_RWY) + ((size_t)dir * NTOK + RW_ROW(s)) * 512 + h * 64 + rh * 32 + r2) = cvt_pk_bf16(yb[r2 * 33 + st], yb[(r2 + 1) * 33 + st]); } } while (0)
            RW_LOAD(0, xa, la); RW_LOAD(1, xb, lb); RW_FEAT(0, xa, la);
            LDS_BARRIER();
            for (int rd = 0; rd < NRD; rd += 2) {
                if (rd + 2 < NRD) RW_LOAD(rd + 2, xa, la);
                RW_FEAT(rd + 1, xb, lb);
                if (rd > 0) RW_YOUT(rd - 1);
                LDS_BARRIER();
                if (rd + 3 < NRD) RW_LOAD(rd + 3, xb, lb);
                if (rd + 2 < NRD) RW_FEAT(rd + 2, xa, la);
                RW_YOUT(rd);
                LDS_BARRIER();
            }
            RW_YOUT(NRD - 1);
#undef RW_LOAD
#undef RW_FEAT
#undef RW_YOUT
        } else {
            const int rowl = wave * 8 + (lane >> 3), jl = lane & 7;
            float s[8];
#pragma unroll
            for (int e = 0; e < 8; ++e) s[e] = 0.f;
            LDS_BARRIER();
            for (int rd = 0; rd < NRD; ++rd) {
                const LAS float* sb = (const LAS float*)(L + (rd & 1) * RW_BUF);
                LAS float* yb = (LAS float*)(L + RW_YB + (rd & 1) * RW_YBSZ);
                float yk = 0.f;
                f32x4 w[2], a[2], bq[2], k[2], q[2], nw[2], na[2], nb[2], nk[2], nq[2]; float vv, nvv; f32x2 sc, nsc;
#define RW_OPS(W, A, B, K, Q, V, S, st) do { const LAS float* p = sb + (st) * RW_SS + 8 * jl; _Pragma("unroll") for (int e = 0; e < 2; ++e) { W[e] = *(const LAS f32x4*)(p + 4 * e); A[e] = *(const LAS f32x4*)(p + 64 + 4 * e); \
                    B[e] = *(const LAS f32x4*)(p + 128 + 4 * e); K[e] = *(const LAS f32x4*)(p + 192 + 4 * e); Q[e] = *(const LAS f32x4*)(p + 256 + 4 * e); } \
                    V = sb[(st) * RW_SS + 320 + rh * 32 + rowl]; S = *(const LAS f32x2*)(sb + (st) * RW_SS + 384); } while (0)
                RW_OPS(w, a, bq, k, q, vv, sc, 0);
#pragma unroll
                for (int st = 0; st < RW_T; ++st) {
                    if (st + 1 < RW_T) RW_OPS(nw, na, nb, nk, nq, nvv, nsc, st + 1);
                    float pa = 0.f, pa2 = 0.f, py = 0.f, py2 = 0.f, t[8];
#pragma unroll
                    for (int e = 0; e < 2; ++e) { pa += s[4 * e] * a[e].x; pa2 += s[4 * e + 1] * a[e].y; pa += s[4 * e + 2] * a[e].z; pa2 += s[4 * e + 3] * a[e].w;
                        py += s[4 * e] * q[e].x; py2 += s[4 * e + 1] * q[e].y; py += s[4 * e + 2] * q[e].z; py2 += s[4 * e + 3] * q[e].w;
                        t[4 * e] = s[4 * e] * w[e].x + vv * k[e].x; t[4 * e + 1] = s[4 * e + 1] * w[e].y + vv * k[e].y; t[4 * e + 2] = s[4 * e + 2] * w[e].z + vv * k[e].z; t[4 * e + 3] = s[4 * e + 3] * w[e].w + vv * k[e].w; }
                    pa += pa2; py += py2;
                    red8x2(pa, py);
#pragma unroll
                    for (int e = 0; e < 2; ++e) { s[4 * e] = t[4 * e] + pa * bq[e].x; s[4 * e + 1] = t[4 * e + 1] + pa * bq[e].y; s[4 * e + 2] = t[4 * e + 2] + pa * bq[e].z; s[4 * e + 3] = t[4 * e + 3] + pa * bq[e].w; }
                    const float y = py + pa * sc.x + vv * sc.y;
                    yk = (jl == (st & 7)) ? y : yk;
                    if ((st & 7) == 7) yb[rowl * 33 + (st - 7) + jl] = yk;
#pragma unroll
                    for (int e = 0; e < 2; ++e) { w[e] = nw[e]; a[e] = na[e]; bq[e] = nb[e]; k[e] = nk[e]; q[e] = nq[e]; }
                    vv = nvv; sc = nsc;
                    __builtin_amdgcn_sched_barrier(0);
                }
#undef RW_OPS
                LDS_BARRIER();
            }
        }
#undef RW_ROW
        VM_WAIT(); __syncthreads();
    }
}

__device__ __forceinline__ void p_mix_finish(Frame& F) {
    const int gw = F.bid * 8 + F.wave, NGW = F.G * 8, lane = F.lane;
    const bf16* P = wsp<const bf16>(F, WS_P); const bf16* LO = wsp<const bf16>(F, WS_LOUT);
    const bf16* GO = wsp<const bf16>(F, WS_GLAO); const bf16* RY = wsp<const bf16>(F, WS_RWY); const float* BON = wsp<const float>(F, WS_BONUS);
    bf16* MIX = wsp<bf16>(F, WS_H);
    const int c0 = lane * 8;
    float gng[8], lnw[8], lnb[8], cpv[8], cnv[8];
#pragma unroll
    for (int e = 0; e < 8; ++e) { gng[e] = F.in[I_GNG][(c0 + e) & 127]; lnw[e] = F.in[I_LNW][c0 + e]; lnb[e] = F.in[I_LNB][c0 + e]; cpv[e] = F.in[I_MU][1024 + c0 + e]; cnv[e] = F.in[I_MU][RW_COLS + 1024 + c0 + e]; }
    for (int row = gw; row < NTOK; row += NGW) {
        { const u32x4 a = *(const u32x4*)(GO + (size_t)row * 512 + c0), bb = *(const u32x4*)(GO + ((size_t)NTOK + row) * 512 + c0), og = *(const u32x4*)(P + (size_t)row * PW + 1024 + c0);
          float o[8]; float ss = 0.f;
#pragma unroll
          for (int e = 0; e < 4; ++e) { o[2 * e] = bflo(a[e]) + bflo(bb[e]); o[2 * e + 1] = bfhi(a[e]) + bfhi(bb[e]); ss += o[2 * e] * o[2 * e] + o[2 * e + 1] * o[2 * e + 1]; }
          ss += __shfl_xor(ss, 1); ss += __shfl_xor(ss, 2); ss += __shfl_xor(ss, 4); ss += __shfl_xor(ss, 8);
          const float rstd = 1.f / sqrtf(ss * (1.f / 128.f) + 1e-6f);
          float y[8];
#pragma unroll
          for (int e = 0; e < 4; ++e) { const float g0 = bflo(og[e]), g1 = bfhi(og[e]);
              y[2 * e] = o[2 * e] * rstd * gng[2 * e] * (g0 * __builtin_amdgcn_rcpf(1.f + __expf(-g0))); y[2 * e + 1] = o[2 * e + 1] * rstd * gng[2 * e + 1] * (g1 * __builtin_amdgcn_rcpf(1.f + __expf(-g1))); }
          *(u32x4*)(MIX + (size_t)row * 1024 + c0) = (u32x4){cvt_pk_bf16(y[0], y[1]), cvt_pk_bf16(y[2], y[3]), cvt_pk_bf16(y[4], y[5]), cvt_pk_bf16(y[6], y[7])}; }
        { bool hp, hn; seq_pos(row, hp, hn);
          const u32x4 a = *(const u32x4*)(RY + (size_t)row * 512 + c0), bb = *(const u32x4*)(RY + ((size_t)NTOK + row) * 512 + c0);
          const bf16* pv = P + (size_t)row * PW + RW0 + 1024 + c0;
          const u32x4 v0 = *(const u32x4*)pv; u32x4 vm = (u32x4){0u, 0u, 0u, 0u}, vn = (u32x4){0u, 0u, 0u, 0u};
          if (hp) vm = *(const u32x4*)(pv - PW); if (hn) vn = *(const u32x4*)(pv + PW);
          const u32x4 gg = *(const u32x4*)(LO + (size_t)row * LRN + 2048 + c0);
          const int hd = lane >> 3; const float bon = BON[(size_t)row * 8 + hd] + BON[((size_t)NTOK + row) * 8 + hd];
          float yv[8]; float sm = 0.f;
#pragma unroll
          for (int e = 0; e < 4; ++e) { yv[2 * e] = bflo(a[e]) + bflo(bb[e]); yv[2 * e + 1] = bfhi(a[e]) + bfhi(bb[e]); sm += yv[2 * e] + yv[2 * e + 1]; }
          sm += __shfl_xor(sm, 1); sm += __shfl_xor(sm, 2); sm += __shfl_xor(sm, 4);
          const float mean = sm * (1.f / 64.f); float sv = 0.f;
#pragma unroll
          for (int e = 0; e < 8; ++e) { const float d = yv[e] - mean; sv += d * d; }
          sv += __shfl_xor(sv, 1); sv += __shfl_xor(sv, 2); sv += __shfl_xor(sv, 4);
          const float rstd = 1.f / sqrtf(sv * (1.f / 64.f) + 64e-5f);
          float o[8];
#pragma unroll
          for (int e = 0; e < 8; ++e) { const unsigned w0 = v0[e >> 1], wm = vm[e >> 1], wn = vn[e >> 1];
              const float p0 = (e & 1) ? bfhi(w0) : bflo(w0), pm = (e & 1) ? bfhi(wm) : bflo(wm), pn = (e & 1) ? bfhi(wn) : bflo(wn);
              const float xv = p0 + cpv[e] * (pm - p0) + cnv[e] * (pn - p0);
              const float g = (e & 1) ? bfhi(gg[e >> 1]) : bflo(gg[e >> 1]);
              o[e] = ((yv[e] - mean) * rstd * lnw[e] + lnb[e] + bon * xv) * g; }
          *(u32x4*)(MIX + (size_t)row * 1024 + 512 + c0) = (u32x4){cvt_pk_bf16(o[0], o[1]), cvt_pk_bf16(o[2], o[3]), cvt_pk_bf16(o[4], o[5]), cvt_pk_bf16(o[6], o[7])}; }
    }
}

__device__ __forceinline__ void p_mla_prep(Frame& F) {
    const int gw = F.bid * 8 + F.wave, NGW = F.G * 8, lane = F.lane;
    const bf16* C = wsp<const bf16>(F, WS_C); bf16* QN = wsp<bf16>(F, WS_QN); bf16* KVN = wsp<bf16>(F, WS_KVN); unsigned char* K8 = wsp<unsigned char>(F, WS_K8);
    const f32x2* ROPE = wsp<const f32x2>(F, WS_ROPE);
    const f32x4 qg = ((const f32x4*)F.in[I_QNORM])[lane]; const f32x4 kg = ((const f32x4*)F.in[I_KVNORM])[lane & 31];
    for (int row = gw; row < NTOK; row += NGW) {
        const bf16* cr = C + (size_t)row * 512;
        const u32x2 cqw = ((const u32x2*)cr)[lane], ckw = ((const u32x2*)(cr + 256))[lane & 31];
        const f32x4 cq = {bflo(cqw.x), bfhi(cqw.x), bflo(cqw.y), bfhi(cqw.y)};
        const f32x4 ck = {bflo(ckw.x), bfhi(ckw.x), bflo(ckw.y), bfhi(ckw.y)};
        const float xr = bflo((unsigned)cr[384 + lane]);
        const float ssq = wave_sum((cq.x * cq.x + cq.y * cq.y) + (cq.z * cq.z + cq.w * cq.w));
        const float ssk = wave_sum(lane < 32 ? (ck.x * ck.x + ck.y * ck.y) + (ck.z * ck.z + ck.w * ck.w) : 0.f);
        if (row < NLAT) { const float rs = 1.f / sqrtf(ssq * (1.f / 256.f) + 1e-6f);
            ((u32x2*)(QN + (size_t)row * 256))[lane] = (u32x2){cvt_pk_bf16(cq.x * rs * qg.x, cq.y * rs * qg.y), cvt_pk_bf16(cq.z * rs * qg.z, cq.w * rs * qg.w)}; }
        { const float rs = 1.f / sqrtf(ssk * (1.f / 128.f) + 1e-6f);
          u32x2 w = (u32x2){0u, 0u};
          if (lane < 32) w = (u32x2){cvt_pk_bf16(ck.x * rs * kg.x, ck.y * rs * kg.y), cvt_pk_bf16(ck.z * rs * kg.z, ck.w * rs * kg.w)};
          ((u32x2*)(KVN + (size_t)row * 256))[lane] = w; }
        float kr = xr; int b, key;
        const float pr = __shfl_xor(xr, 16);
        if (row < NLAT) { b = row >> 13; const int t = row & 8191; key = CTXL + t;
            const f32x2 cs = ROPE[t * 32 + ((lane >> 5) << 4) + (lane & 15)];
            kr = (lane & 16) ? xr * cs.x + pr * cs.y : xr * cs.x - pr * cs.y;
        } else { b = (row - NLAT) >> 8; key = (row - NLAT) & 255; }
        const unsigned char kb = (unsigned char)(pk4_fp8(kr, 0.f, 0.f, 0.f) & 0xffu);
#pragma unroll
        for (int h = 0; h < 8; ++h) K8[((size_t)((b * 8 + h) * NKEY + key)) * K8ROW + 128 + lane] = kb;
    }
}
__host__ __device__ constexpr int att_kperm(int p) { const int hi = p >> 5, j = p & 31, r = j & 15; return (j >> 4) * 32 + (r & 3) + 8 * (r >> 2) + 4 * hi; }

namespace att {
constexpr float SCALE = 0.07216878364870322f;
constexpr float THR = 2.f;
constexpr float PLOG2 = 5.f;
constexpr int KSLOT = 16384, KTILE = 64 * K8ROW, VSLOT = 8192;
constexpr int LDS_K = 0, LDS_V = 4 * KSLOT, LDS_WS = LDS_V + 4 * VSLOT, LDS_Q = LDS_WS + 2048;
constexpr int NT = NKEY / 64;
constexpr int ONE = 0x7F7F7F7F;
constexpr int QSCL = 0x7C7C7C7C;
__device__ __forceinline__ int crow(int r, int hi) { return (r & 3) + 8 * (r >> 2) + 4 * hi; }
constexpr float PMAXSUM = 416.f, PTARGET = 64.f;
__device__ __forceinline__ void partialSM(f32x16& p0, f32x16& p1, float moff) {
#pragma unroll
    for (int r = 0; r < 16; ++r) p0[r] -= moff;
#pragma unroll
    for (int r = 0; r < 16; ++r) p1[r] -= moff;
#pragma unroll
    for (int r = 0; r < 16; ++r) p0[r] = __builtin_amdgcn_exp2f(p0[r]);
}
__device__ __forceinline__ void finishSM(f32x16& p0, f32x16& p1, float& moff, float& alpha, float& l_reg, i32x8& pa) {
#pragma unroll
    for (int r = 0; r < 16; ++r) p1[r] = __builtin_amdgcn_exp2f(p1[r]);
    float ps = 0;
#pragma unroll
    for (int r = 0; r < 16; ++r) ps += p0[r];
#pragma unroll
    for (int r = 0; r < 16; ++r) ps += p1[r];
    { auto rr = __builtin_amdgcn_permlane32_swap(__float_as_uint(ps), __float_as_uint(ps), false, false); ps = __uint_as_float(rr[0]) + __uint_as_float(rr[1]); }
    alpha = 1.f;
    if (__builtin_expect(__any(ps > PMAXSUM), 0)) {
        alpha = ps > PMAXSUM ? PTARGET * __builtin_amdgcn_rcpf(ps) : 1.f;
        ps *= alpha; moff -= __builtin_amdgcn_logf(alpha);
#pragma unroll
        for (int g = 0; g < 4; ++g) { pa[g] = (int)pk4_fp8(p0[4 * g] * alpha, p0[4 * g + 1] * alpha, p0[4 * g + 2] * alpha, p0[4 * g + 3] * alpha); pa[4 + g] = (int)pk4_fp8(p1[4 * g] * alpha, p1[4 * g + 1] * alpha, p1[4 * g + 2] * alpha, p1[4 * g + 3] * alpha); }
    } else {
#pragma unroll
        for (int g = 0; g < 4; ++g) { pa[g] = (int)pk4_fp8(p0[4 * g], p0[4 * g + 1], p0[4 * g + 2], p0[4 * g + 3]); pa[4 + g] = (int)pk4_fp8(p1[4 * g], p1[4 * g + 1], p1[4 * g + 2], p1[4 * g + 3]); }
    }
    l_reg = l_reg * alpha + ps;
}
__device__ __forceinline__ i32x8 ld32(const LAS unsigned char* p0, const LAS unsigned char* p1) { return __builtin_shufflevector(*(const LAS i32x4*)p0, *(const LAS i32x4*)p1, 0, 1, 2, 3, 4, 5, 6, 7); }
__device__ __forceinline__ void qkt(f32x16& p0, f32x16& p1, const LAS unsigned char* Ks, const LAS unsigned char* Qs, int r32, int hi) {
#pragma unroll
    for (int r = 0; r < 16; ++r) { p0[r] = 0.f; p1[r] = 0.f; }
#pragma unroll
    for (int m = 0; m < 3; ++m) { const LAS unsigned char* k0 = Ks + r32 * K8ROW + m * 64 + hi * 32; const LAS unsigned char* k1 = k0 + 32 * K8ROW;
        const i32x8 a0 = ld32(k0, k0 + 16), a1 = ld32(k1, k1 + 16), qm = ld32(Qs + m * 2048, Qs + m * 2048 + 1024);
        p0 = __builtin_amdgcn_mfma_scale_f32_32x32x64_f8f6f4(a0, qm, p0, 0, 0, 0, ONE, 0, QSCL);
        p1 = __builtin_amdgcn_mfma_scale_f32_32x32x64_f8f6f4(a1, qm, p1, 0, 0, 0, ONE, 0, QSCL); }
}
__device__ __forceinline__ void pv(f32x16 (&o)[4], const LAS unsigned char* Vs, const i32x8 pa, int r32, int hi) {
#pragma unroll
    for (int d0 = 0; d0 < 4; ++d0) { const int c = d0 * 32 + r32, sw = (c >> 2) & 3; const LAS unsigned char* vr = Vs + c * 64;
        const i32x8 vb = ld32(vr + (((2 * hi) ^ sw) << 4), vr + (((2 * hi + 1) ^ sw) << 4));
        o[d0] = __builtin_amdgcn_mfma_scale_f32_32x32x64_f8f6f4(pa, vb, o[d0], 0, 0, 0, ONE, 0, ONE); }
}
__device__ __forceinline__ int pk4n(float a, float b, float c, float d, int w) { w = __builtin_amdgcn_cvt_pk_fp8_f32(a, b, w, false); w = __builtin_amdgcn_cvt_pk_fp8_f32(c, d, w, true); return w; }
#define ATT_MMA(a, b, c) __builtin_amdgcn_mfma_scale_f32_32x32x64_f8f6f4(a, b, c, 0, 0, 0, ONE, 0, ONE)
#define ATT_MMQ(a, b, c) __builtin_amdgcn_mfma_scale_f32_32x32x64_f8f6f4(a, b, c, 0, 0, 0, ONE, 0, QSCL)
#define ATT_EXP(P, i0, n) do { _Pragma("unroll") for (int _r = (i0); _r < (i0) + (n); ++_r) P[_r] = __builtin_amdgcn_exp2f(P[_r]); } while (0)
__device__ __forceinline__ void half_step(f32x16& X0, f32x16& X1, f32x16& Y0, f32x16& Y1, const LAS unsigned char* Ks, const LAS unsigned char* Vs, const LAS unsigned char* Qs, f32x16 (&o)[4],
                                          float& moff, float& l_reg, i32x8& pa, bool& offs, LAS float* al_l, int r32, int hi) {
    f32x16 zz;
#pragma unroll
    for (int r = 0; r < 16; ++r) zz[r] = 0.f;
    SBAR();
    const LAS unsigned char* k0 = Ks + r32 * K8ROW + hi * 32; const LAS unsigned char* k1 = k0 + 32 * K8ROW;
#define ATT_Q(m) ld32(Qs + (m) * 2048, Qs + (m) * 2048 + 1024)
#define ATT_V(d0) ld32(Vs + ((d0) * 32 + r32) * 64 + (((2 * hi) ^ ((((d0) * 32 + r32) >> 2) & 3)) << 4), Vs + ((d0) * 32 + r32) * 64 + (((2 * hi + 1) ^ ((((d0) * 32 + r32) >> 2) & 3)) << 4))
    const i32x8 q0 = ATT_Q(0); const i32x8 ka0 = ld32(k0, k0 + 16), kb0 = ld32(k1, k1 + 16);
    const i32x8 q1 = ATT_Q(1); const i32x8 ka1 = ld32(k0 + 64, k0 + 80);
    ATT_EXP(X1, 0, 4); SBAR();
    Y0 = ATT_MMQ(ka0, q0, zz); SBAR();
    const i32x8 kb1 = ld32(k1 + 64, k1 + 80);
    ATT_EXP(X1, 4, 4); SBAR();
    Y1 = ATT_MMQ(kb0, q0, zz); SBAR();
    const i32x8 q2 = ATT_Q(2); const i32x8 ka2 = ld32(k0 + 128, k0 + 144);
    ATT_EXP(X1, 8, 4); SBAR();
    Y0 = ATT_MMQ(ka1, q1, Y0); SBAR();
    const i32x8 kb2 = ld32(k1 + 128, k1 + 144);
    ATT_EXP(X1, 12, 4); SBAR();
    Y1 = ATT_MMQ(kb1, q1, Y1); SBAR();
    f32x2 sa = {X0[0], X0[1]}, sb = {X1[0], X1[1]};
#pragma unroll
    for (int r = 1; r < 8; ++r) { sa += (f32x2){X0[2 * r], X0[2 * r + 1]}; sb += (f32x2){X1[2 * r], X1[2 * r + 1]}; }
    sa += sb; float ps = sa.x + sa.y;
    { auto rr = __builtin_amdgcn_permlane32_swap(__float_as_uint(ps), __float_as_uint(ps), false, false); ps = __uint_as_float(rr[0]) + __uint_as_float(rr[1]); }
    SBAR();
    Y0 = ATT_MMQ(ka2, q2, Y0); SBAR();
    i32x8 vb[4];
    vb[0] = ATT_V(0); vb[1] = ATT_V(1);
#pragma unroll
    for (int g = 0; g < 4; ++g) pa[g] = pk4n(X0[4 * g], X0[4 * g + 1], X0[4 * g + 2], X0[4 * g + 3], pa[g]);
    SBAR();
    Y1 = ATT_MMQ(kb2, q2, Y1); SBAR();
#pragma unroll
    for (int g = 0; g < 4; ++g) pa[4 + g] = pk4n(X1[4 * g], X1[4 * g + 1], X1[4 * g + 2], X1[4 * g + 3], pa[4 + g]);
    asm volatile("" :: "v"(Y0), "v"(Y1), "v"(pa));
    SBAR();
    if (__builtin_expect(__any(ps > PMAXSUM), 0)) {
        const float alpha = ps > PMAXSUM ? PTARGET * __builtin_amdgcn_rcpf(ps) : 1.f;
        ps *= alpha; moff -= __builtin_amdgcn_logf(alpha); l_reg *= alpha; offs = true;
#pragma unroll
        for (int g = 0; g < 4; ++g) { pa[g] = (int)pk4_fp8(X0[4 * g] * alpha, X0[4 * g + 1] * alpha, X0[4 * g + 2] * alpha, X0[4 * g + 3] * alpha); pa[4 + g] = (int)pk4_fp8(X1[4 * g] * alpha, X1[4 * g + 1] * alpha, X1[4 * g + 2] * alpha, X1[4 * g + 3] * alpha); }
        if (hi == 0) al_l[r32] = alpha;
        asm volatile("s_waitcnt lgkmcnt(0)" ::: "memory");
#pragma unroll
        for (int d = 0; d < 4; ++d)
#pragma unroll
            for (int r = 0; r < 16; ++r) o[d][r] *= al_l[crow(r, hi)];
    }
    l_reg += ps;
#define ATT_SUB(P) do { _Pragma("unroll") for (int _r = 0; _r < 16; ++_r) P[_r] -= moff; } while (0)
#define ATT_R2(S0, S1) do { SBAR(); \
    o[0] = ATT_MMA(pa, vb[0], o[0]); SBAR(); vb[2] = ATT_V(2); S0; ATT_EXP(Y0, 0, 3); SBAR(); \
    o[1] = ATT_MMA(pa, vb[1], o[1]); SBAR(); vb[3] = ATT_V(3); ATT_EXP(Y0, 3, 5); SBAR(); \
    o[2] = ATT_MMA(pa, vb[2], o[2]); SBAR(); ATT_EXP(Y0, 8, 5); SBAR(); \
    o[3] = ATT_MMA(pa, vb[3], o[3]); SBAR(); ATT_EXP(Y0, 13, 3); S1; \
    asm volatile("" :: "v"(o[0]), "v"(o[1]), "v"(o[2]), "v"(o[3]), "v"(Y0), "v"(Y1));     \
    SBAR(); } while (0)
    if (__builtin_expect(offs, 0)) ATT_R2(ATT_SUB(Y0), ATT_SUB(Y1)); else ATT_R2((void)0, (void)0);
#undef ATT_R2
#undef ATT_SUB
}
__device__ __forceinline__ void glds16(const void* gsrc, LAS unsigned char* lds_wave_base) { unsigned keep; const unsigned dst = (unsigned)__builtin_amdgcn_readfirstlane((int)(uintptr_t)lds_wave_base);
    asm volatile("s_mov_b32 %0, m0\n\ts_mov_b32 m0, %2\n\ts_nop 0\n\tglobal_load_lds_dwordx4 %1, off\n\ts_mov_b32 m0, %0" : "=&s"(keep) : "v"(gsrc), "s"(dst) : "memory"); }

__device__ __forceinline__ void unit(const unsigned char* __restrict__ Qb, const unsigned char* __restrict__ Kh, const unsigned char* __restrict__ Vh, unsigned char* __restrict__ Ob, LAS unsigned char* lds, int tid) {
    const int wid = __builtin_amdgcn_readfirstlane(tid >> 6), lane = tid & 63, r32 = lane & 31, hi = lane >> 5;
    LAS float* ws = (LAS float*)(lds + LDS_WS) + wid * 64; LAS float* li_l = ws; LAS float* al_l = ws + 32;
    float l_reg = 0.f; f32x16 o[4];
#pragma unroll
    for (int d = 0; d < 4; ++d)
#pragma unroll
        for (int r = 0; r < 16; ++r) o[d][r] = 0.f;
    const unsigned char* Qw = Qb + (size_t)(wid * 32 + r32) * QKD + hi * 32;
#pragma unroll
    for (int m = 0; m < 3; ++m) { *(LAS i32x4*)(lds + LDS_Q + wid * 6144 + m * 2048 + lane * 16) = *(const i32x4*)(Qw + m * 64); *(LAS i32x4*)(lds + LDS_Q + wid * 6144 + m * 2048 + 1024 + lane * 16) = *(const i32x4*)(Qw + m * 64 + 16); }
    const LAS unsigned char* Qs = lds + LDS_Q + wid * 6144 + lane * 16;
    const unsigned pofs = (unsigned)(wid * 1024 + lane * 16);
#define DMA_K(j, slot) do { _Pragma("unroll") for (int _i = 0; _i < 2; ++_i) glds16(Kh + (size_t)(j) * KTILE + _i * 8192 + pofs, lds + LDS_K + (slot) * KSLOT + _i * 8192 + wid * 1024); } while (0)
#define DMA_V(j, slot) glds16(Vh + (size_t)(j) * VSLOT + pofs, lds + LDS_V + (slot) * VSLOT + wid * 1024)
#define WAITBAR(n) asm volatile("s_waitcnt vmcnt(" #n ")\n\ts_barrier" ::: "memory")
#define RESC(a) do { if (__any((a) < 1.f)) { if (hi == 0) al_l[r32] = (a); asm volatile("s_waitcnt lgkmcnt(0)" ::: "memory"); \
    _Pragma("unroll") for (int d = 0; d < 4; ++d) _Pragma("unroll") for (int r = 0; r < 16; ++r) o[d][r] *= al_l[crow(r, hi)]; } } while (0)
    f32x16 pA0, pA1, pB0, pB1; float moff = 0.f, al; i32x8 pa = {0, 0, 0, 0, 0, 0, 0, 0}; bool offs = false;
    if (wid >= 4) __builtin_amdgcn_s_setprio(1);
    asm volatile("s_barrier" ::: "memory");
    DMA_K(0, 0); DMA_K(1, 1); DMA_K(2, 2); DMA_V(0, 0); DMA_V(1, 1);
    WAITBAR(6);
    qkt(pA0, pA1, lds + LDS_K, Qs, r32, hi); partialSM(pA0, pA1, moff);
    WAITBAR(0);
    for (int j = 1; j + 1 < NT; j += 2) {
        DMA_K(j + 2, (j + 2) & 3); if (j + 3 < NT) DMA_K(j + 3, (j + 3) & 3);
        DMA_V(j + 1, (j + 1) & 3); DMA_V(j + 2, (j + 2) & 3);
        half_step(pA0, pA1, pB0, pB1, lds + LDS_K + (j & 3) * KSLOT, lds + LDS_V + ((j - 1) & 3) * VSLOT, Qs, o, moff, l_reg, pa, offs, al_l, r32, hi);
        half_step(pB0, pB1, pA0, pA1, lds + LDS_K + ((j + 1) & 3) * KSLOT, lds + LDS_V + (j & 3) * VSLOT, Qs, o, moff, l_reg, pa, offs, al_l, r32, hi);
        WAITBAR(0);
    }
    int vs = (NT - 2) & 3;
    SBAR(); qkt(pB0, pB1, lds + LDS_K + ((NT - 1) & 3) * KSLOT, Qs, r32, hi);
    finishSM(pA0, pA1, moff, al, l_reg, pa); SBAR();
    RESC(al);
    pv(o, lds + LDS_V + vs * VSLOT, pa, r32, hi); partialSM(pB0, pB1, moff);
    vs = (NT - 1) & 3;
    finishSM(pB0, pB1, moff, al, l_reg, pa); SBAR();
    RESC(al);
    pv(o, lds + LDS_V + vs * VSLOT, pa, r32, hi);
    __builtin_amdgcn_s_setprio(0);
    if (hi == 0) li_l[r32] = l_reg; asm volatile("s_waitcnt lgkmcnt(0)" ::: "memory");
    float rli[16];
#pragma unroll
    for (int r = 0; r < 16; ++r) rli[r] = __builtin_amdgcn_rcpf(li_l[crow(r, hi)]);
    unsigned char* Ow = Ob + (size_t)(wid * 32) * 1024;
#pragma unroll
    for (int r = 0; r < 16; ++r) { const int orow = crow(r, hi);
#pragma unroll
        for (int d0 = 0; d0 < 4; ++d0) Ow[(size_t)orow * 1024 + d0 * 32 + r32] = (unsigned char)(pk4_fp8(o[d0][r] * rli[r], 0.f, 0.f, 0.f) & 0xffu); }
#undef DMA_K
#undef DMA_V
#undef WAITBAR
#undef RESC
}
}
__device__ __forceinline__ void p_attention(Frame& F) {
    const unsigned char* Q8 = wsp<const unsigned char>(F, WS_Q8); const unsigned char* K8 = wsp<const unsigned char>(F, WS_K8); const unsigned char* VT = wsp<const unsigned char>(F, WS_V8T); unsigned char* O = wsp<unsigned char>(F, WS_H);
    for (int u = F.bid; u < NB * MH * 32; u += F.G) {
        const int pair = (u >> 8) * 8 + (u & 7), qb = (u & 255) >> 3, b = pair >> 3, h = pair & 7;
        att::unit(Q8 + ((size_t)pair * SEQ + qb * 256) * QKD, K8 + (size_t)pair * NKEY * K8ROW, VT + (size_t)pair * att::NT * att::VSLOT, O + ((size_t)(b * SEQ + qb * 256)) * 1024 + h * 128, F.lds, F.tid);
    }
    VM_WAIT(); __syncthreads();
}

constexpr int N_PHASES = 24;
struct Args { const float* in[37]; float* out; unsigned char* ws; int ph_lo, ph_hi, pad0, pad1; };
__global__ void __launch_bounds__(512, 2) mk_fwd(Args args) {
    extern __shared__ __attribute__((aligned(16))) unsigned char lds_raw[];
    Frame F;
    F.lds = (LAS unsigned char*)lds_raw;
    F.tid = threadIdx.x; F.lane = F.tid & 63; F.wave = __builtin_amdgcn_readfirstlane(F.tid >> 6);
    F.G = gridDim.x; F.bid = blockIdx.x;
    F.in = (const float* const __attribute__((address_space(4)))*)__builtin_amdgcn_kernarg_segment_ptr();
    F.out = args.out; F.ws = args.ws;
    volatile LAS unsigned* MISC = (volatile LAS unsigned*)(F.lds + MISC_OFF);
    if (F.tid < 64) MISC[F.tid] = 0u;
    __syncthreads();
    const int lo = args.ph_lo, hi = args.ph_hi;
    XcdBarrier bar; bar.bar = (unsigned*)(F.ws + WS_CTL) + CW_BAR; bar.x = 0; bar.st = nullptr;
    if (hi - lo > 1) bar = xcd_barrier_post((unsigned*)(F.ws + WS_CTL) + CW_BAR, MISC + 8);
#ifndef ONLY_PHASE
#define ONLY_PHASE -1
#endif
#define IN(k) ((ONLY_PHASE < 0 || ONLY_PHASE == (k)) && lo <= (k) && (k) < hi)
#define SEAM(k) do { if (IN(k) && IN((k) + 1)) xcd_barrier(bar); } while (0)
    LAS unsigned char* ring = F.lds;
    const LAS int* blk_e = (const LAS int*)(F.lds + MT_OFF) + 128;
    const LAS int* mtab = (const LAS int*)(F.lds + MT_OFF);

    if (IN(0)) { p0_mod(F); p0_rope(F); p0_convert(F); } SEAM(0);
    if (IN(1)) { p_norm1_l0(F); } SEAM(1);
    if (IN(2)) {
        pg8::DenseSched S; S.init(NTOK, PW, 2048, wsp<const bf16>(F, WS_WIN), F.G, F.bid);
        pg8::EpiBf16<pg8::MapPlain> E{pg8::MapPlain{wsp<bf16>(F, WS_P), PW}};
        pg8::gemm_phase(ring, wsp<const bf16>(F, WS_H), 2048, S, E);
        { const int slot = F.bid - S.nwg % F.G; if (slot >= 0) p_fill_convert(F, slot, F.G - S.nwg % F.G, 0, FILL_A); }
    } SEAM(2);
    if (IN(3)) { p_alr(F); p_gla_pre(F); } SEAM(3);
    if (IN(4)) {
        pg8::LrSched S; S.init(NTOK, LRN, LRK * 2, wsp<const bf16>(F, WS_WLR), F.G, F.bid);
        pg8::EpiBf16<pg8::MapPlain> E{pg8::MapPlain{wsp<bf16>(F, WS_LOUT), LRN}};
        pg8::gemm_phase(ring, wsp<const bf16>(F, WS_ALR), LRK * 2, S, E);
        { const int slot = F.bid - S.nwg % F.G; if (slot >= 0) p_fill_convert(F, slot, F.G - S.nwg % F.G, FILL_A, FILL_B); }
    } SEAM(4);
    if (IN(5)) { p_gla_scan(F); p_rwkv_scan(F); } SEAM(5);
    if (IN(6)) { p_mix_finish(F); } SEAM(6);
    if (IN(7)) {
        pg8::DenseSched S; S.init(NTOK, 1024, 2048, wsp<const bf16>(F, WS_WOUT), F.G, F.bid);
        pg8::EpiResid E{wsp<bf16>(F, WS_X1), F.in[I_X], F.in[I_CTX], wsp<const float>(F, WS_MOD), 0};
        pg8::gemm_phase(ring, wsp<const bf16>(F, WS_H), 2048, S, E);
        { const int slot = F.bid - S.nwg % F.G; if (slot >= 0) p_fill_convert(F, slot, F.G - S.nwg % F.G, FILL_B, FILL_C); }
    } SEAM(7);
    if (IN(8)) { p_norm2_route(F, 0, NTOK); } SEAM(8);
    if (IN(9)) { p_moe_scatter(F, NTOK); } SEAM(9);
    if (IN(10)) {
        moe_tables(F);
        pg8::MoeSched<true> S{mtab[64], 8, F.G, F.bid, blk_e, wsp<const unsigned>(F, WS_SORT), wsp<const unsigned char>(F, WS_WGU), (size_t)2048 * 1024};
        pg8::EpiSwiglu E{wsp<unsigned char>(F, WS_ACT), F.in[I_GUB], blk_e};
        pg8::gemm_phase<pg8::EpiSwiglu, pg8::MoeSched<true>, true>(ring, wsp<const unsigned char>(F, WS_H), 1024, S, E);
    } SEAM(10);
    if (IN(11)) {
        moe_tables(F);
        pg8::MoeSched<false> S{mtab[64], 4, F.G, F.bid, blk_e, nullptr, wsp<const unsigned char>(F, WS_WDN), (size_t)1024 * 1024};
        pg8::EpiDown E{wsp<unsigned char>(F, WS_YS), F.in[I_DNB], blk_e, wsp<const unsigned>(F, WS_SORT) + MAXSLOT, (const float*)(wsp<const unsigned>(F, WS_SORT) + 2 * MAXSLOT)};
        pg8::gemm_phase<pg8::EpiDown, pg8::MoeSched<false>, true>(ring, wsp<const unsigned char>(F, WS_ACT), 1024, S, E);
    } SEAM(11);
    if (IN(12)) { p_combine_norm1_l1(F); } SEAM(12);
    if (IN(13)) {
        pg8::DenseSched S; S.init(NTOK, 512, 1024, wsp<const unsigned char>(F, WS_WODIN), F.G, F.bid);
        pg8::EpiBf16<pg8::MapPlain> E{pg8::MapPlain{wsp<bf16>(F, WS_C), 512}};
        pg8::gemm_phase<pg8::EpiBf16<pg8::MapPlain>, pg8::DenseSched, true>(ring, wsp<const unsigned char>(F, WS_H), 1024, S, E);
        { const int slot = F.bid - S.nwg % F.G; if (slot >= 0) p_fill_convert(F, slot, F.G - S.nwg % F.G, FILL_C, FILL_D); }
    } SEAM(13);
    if (IN(14)) { p_mla_prep(F); } SEAM(14);
    if (IN(15)) {
        { pg8::DenseSched S; S.init(NLAT, 1536, 512, wsp<const bf16>(F, WS_WQUP), F.G, F.bid);
          pg8::EpiQ8 E{wsp<unsigned char>(F, WS_Q8), wsp<const f32x2>(F, WS_ROPE)};
          pg8::gemm_phase(ring, wsp<const bf16>(F, WS_QN), 512, S, E); }
        { pg8::KvSched S; S.init(NTOK, 2048, 512, wsp<const bf16>(F, WS_WKVUP), F.G, F.bid);
          pg8::EpiKV8 E{wsp<unsigned char>(F, WS_K8), wsp<unsigned char>(F, WS_V8T)};
          pg8::gemm_phase(ring, wsp<const bf16>(F, WS_KVN), 512, S, E);
          { const int slot = F.bid - S.nwg % F.G; if (slot >= 0) p_fill_convert(F, slot, F.G - S.nwg % F.G, FILL_D, FILL_E); } }
    } SEAM(15);
    if (IN(17)) { p_attention(F); } SEAM(17);
    if (IN(18)) {
        pg8::DenseSched S; S.init(NLAT, 1024, 1024, wsp<const unsigned char>(F, WS_WODOUT), F.G, F.bid);
        pg8::EpiResid E{wsp<bf16>(F, WS_X1), F.in[I_X], F.in[I_CTX], wsp<const float>(F, WS_MOD), 1};
        pg8::gemm_phase<pg8::EpiResid, pg8::DenseSched, true>(ring, wsp<const unsigned char>(F, WS_H), 1024, S, E);
    } SEAM(18);
    if (IN(19)) { p_norm2_route(F, 1, NLAT); } SEAM(19);
    if (IN(20)) { p_moe_scatter(F, NLAT); } SEAM(20);
    if (IN(21)) {
        moe_tables(F);
        pg8::MoeSched<true> S{mtab[64], 8, F.G, F.bid, blk_e, wsp<const unsigned>(F, WS_SORT), wsp<const unsigned char>(F, WS_WGU) + (size_t)32 * 2048 * 1024, (size_t)2048 * 1024};
        pg8::EpiSwiglu E{wsp<unsigned char>(F, WS_ACT), F.in[I_GUB] + 32 * 2048, blk_e};
        pg8::gemm_phase<pg8::EpiSwiglu, pg8::MoeSched<true>, true>(ring, wsp<const unsigned char>(F, WS_H), 1024, S, E);
    } SEAM(21);
    if (IN(22)) {
        moe_tables(F);
        pg8::MoeSched<false> S{mtab[64], 4, F.G, F.bid, blk_e, nullptr, wsp<const unsigned char>(F, WS_WDN) + (size_t)32 * 1024 * 1024, (size_t)1024 * 1024};
        pg8::EpiDown E{wsp<unsigned char>(F, WS_YS), F.in[I_DNB] + 32 * 1024, blk_e, wsp<const unsigned>(F, WS_SORT) + MAXSLOT, (const float*)(wsp<const unsigned>(F, WS_SORT) + 2 * MAXSLOT)};
        pg8::gemm_phase<pg8::EpiDown, pg8::MoeSched<false>, true>(ring, wsp<const unsigned char>(F, WS_ACT), 1024, S, E);
    } SEAM(22);
    if (IN(23)) { p_final(F); }
#undef IN
#undef SEAM
}

extern "C" void kernel_launch(void* const* d_in, const int* in_sizes, int n_in, void* d_out, int out_size, void* d_ws, size_t ws_size, hipStream_t stream) {
    static int grid = 0;
    if (grid == 0) {
        if (n_in != 37 || out_size != NLAT * DM || ws_size < WS_END) { fprintf(stderr, "kernel_launch: built for 37 inputs, %d outputs, >= %zu bytes of workspace; got n_in %d, out %d, ws %zu\n", NLAT * DM, (size_t)WS_END, n_in, out_size, ws_size); grid = -1; return; }
        int dev = 0, cus = 0, per_cu = 0;
        if (hipGetDevice(&dev) != hipSuccess || hipDeviceGetAttribute(&cus, hipDeviceAttributeMultiprocessorCount, dev) != hipSuccess) { grid = -1; return; }
        if (hipFuncSetAttribute((const void*)mk_fwd, hipFuncAttributeMaxDynamicSharedMemorySize, LDS_BYTES) != hipSuccess) { fprintf(stderr, "kernel_launch: hipFuncSetAttribute failed\n"); grid = -1; return; }
        if (hipOccupancyMaxActiveBlocksPerMultiprocessor(&per_cu, (const void*)mk_fwd, 512, LDS_BYTES) != hipSuccess || per_cu < 1) fprintf(stderr, "kernel_launch: occupancy query says %d\n", per_cu);
        (void)hipGetLastError();
        grid = cus;
    }
    if (grid < 0) return;
    if (hipMemsetAsync((char*)d_ws + WS_CTL, 0, CTL_ZERO_BYTES, stream) != hipSuccess) return;
    Args a{};
    for (int i = 0; i < 37; ++i) a.in[i] = (const float*)d_in[i];
    a.out = (float*)d_out; a.ws = (unsigned char*)d_ws;
#if MK_N_LAUNCHES == 1
    a.ph_lo = 0; a.ph_hi = N_PHASES;
    hipLaunchKernelGGL(mk_fwd, dim3(grid), dim3(512), LDS_BYTES, stream, a);
#else
    for (int p = 0; p < N_PHASES; ++p) { a.ph_lo = p; a.ph_hi = p + 1; hipLaunchKernelGGL(mk_fwd, dim3(grid), dim3(512), LDS_BYTES, stream, a); }
#endif
    const hipError_t le = hipPeekAtLastError();
    if (le != hipSuccess) fprintf(stderr, "kernel_launch: launch failed: %s\n", hipGetErrorName(le));
}
```
